# Optimizing an MI355X kernel written in HIP

```python
import math
import jax
import jax.numpy as jnp
from jax import lax
import numpy as np

D_MODEL = 1024
BATCH = 4
SEQ = 4096
DEPTH = 1
DEC_BATCH = 32
DEC_SEQ = 1
PAST_LEN = 16384
PAGE_SIZE = 128

D_MIX = D_MODEL
HEAD_DIM = 64
D_NSA = D_MIX // 2
N_HEADS = D_NSA // HEAD_DIM
N_KV = N_HEADS // 4
HPG = N_HEADS // N_KV
CMP_BLOCK = 32
CMP_STRIDE = 16
CMP_HIDDEN = HEAD_DIM
SEL_BLOCK = 64
TOP_N = 16
WINDOW = 512
Q_BLOCK = 128
D_RET = D_MIX - D_NSA
N_RET_HEADS = 4
DV_RET = D_RET // N_RET_HEADS
DK_RET = DV_RET // 2
RET_CHUNK = 128
ROPE_BASE = 10000.0
EPS = 1e-6
NEG = -1e30
FORCE = 1e4
KV_W = N_KV * HEAD_DIM
COLS = (D_NSA, KV_W, KV_W, KV_W, KV_W, KV_W, KV_W, 3 * N_HEADS, D_NSA,
        N_RET_HEADS * DK_RET, N_RET_HEADS * DK_RET, D_RET, D_RET)
D_IN = sum(COLS)
SPLITS = tuple(int(v) for v in np.cumsum(COLS)[:-1])

kernel_name = 'nsa_retention_hybrid_step'


def rmsnorm(x, g):
    xf = x.astype(jnp.float32)
    y = xf * lax.rsqrt(jnp.mean(xf * xf, axis=-1, keepdims=True) + EPS)
    return (y * g.astype(jnp.float32)).astype(x.dtype)


def masked_softmax(s, mask):
    p = jax.nn.softmax(jnp.where(mask, s, NEG), axis=-1)
    return jnp.where(mask, p, 0.0)


def rotary(x, pos):
    xf = x.astype(jnp.float32)
    half = xf.shape[-1] // 2
    freqs = ROPE_BASE ** (-jnp.arange(half, dtype=jnp.float32) / half)
    ang = pos.astype(jnp.float32)[:, None] * freqs[None, :]
    cos = jnp.cos(ang)[None, :, None, :]
    sin = jnp.sin(ang)[None, :, None, :]
    x1, x2 = xf[..., :half], xf[..., half:]
    return jnp.concatenate([x1 * cos - x2 * sin, x1 * sin + x2 * cos], axis=-1)


def pad_rows(x, mult):
    extra = (-x.shape[1]) % mult
    return jnp.pad(x, ((0, 0), (0, extra)) + ((0, 0),) * (x.ndim - 2))


def gather_pages(cache, page_table):
    rows = cache[page_table]
    return rows.reshape(page_table.shape[0], -1, *cache.shape[2:])


def compress(x, pe, w1, w2):
    b, l = x.shape[:2]
    n_chunk = l // CMP_STRIDE
    span = CMP_BLOCK // CMP_STRIDE
    n_cmp = n_chunk - span + 1
    ch = x.reshape(b, n_chunk, CMP_STRIDE, N_KV, HEAD_DIM)
    blocks = jnp.concatenate([ch[:, o:o + n_cmp] for o in range(span)], axis=2)
    h = jax.nn.silu(jnp.einsum('bnlgd,ldf->bngf', blocks + pe[:, None, :], w1))
    return jnp.einsum('bngf,fd->bngd', h, w2)


def nsa_block(q, q_pos, kc, vc, ks_blk, vs_blk, kw, vw, kw_pos, gates):
    f32 = jnp.float32
    scale = HEAD_DIM ** -0.5
    q = q.astype(f32)
    b, nq = q.shape[:2]
    n_cmp, n_sel = kc.shape[1], ks_blk.shape[1]
    t = q_pos[:, None]
    c_end = jnp.arange(n_cmp, dtype=jnp.int32) * CMP_STRIDE + CMP_BLOCK - 1
    c_mask = (c_end[None, :] <= t)[None, :, None, None, :]
    s_c = jnp.einsum('bqghd,bngd->bqghn', q, kc.astype(f32)) * scale
    p_c = masked_softmax(s_c, c_mask)
    o_c = jnp.einsum('bqghn,bngd->bqghd', p_c, vc.astype(f32))
    ratio = SEL_BLOCK // CMP_STRIDE
    span = CMP_BLOCK // CMP_STRIDE
    imp = jnp.pad(p_c.sum(axis=3), ((0, 0), (0, 0), (0, 0), (span - 1, ratio * n_sel - n_cmp)))
    imp_t = imp[..., span - 1:span - 1 + ratio * n_sel]
    for n in range(1, span):
        imp_t = imp_t + imp[..., span - 1 - n:span - 1 - n + ratio * n_sel]
    imp_s = imp_t.reshape(b, nq, N_KV, n_sel, ratio).sum(axis=-1)
    blk = jnp.arange(n_sel, dtype=jnp.int32)[None, :]
    jt = (q_pos // SEL_BLOCK)[:, None]
    s_valid = blk * SEL_BLOCK <= t
    forced = (blk == 0) | (blk == jt) | (blk == jt - 1)
    score = jnp.where(s_valid[None, :, None, :], jnp.where(forced[None, :, None, :], FORCE, imp_s), NEG)
    k_eff = min(TOP_N, n_sel)
    _, idx = lax.top_k(score, k_eff)
    b_i = jnp.arange(b)[:, None, None, None]
    g_i = jnp.arange(N_KV)[None, None, :, None]
    ks_sel = ks_blk.transpose(0, 3, 1, 2, 4)[b_i, g_i, idx]
    vs_sel = vs_blk.transpose(0, 3, 1, 2, 4)[b_i, g_i, idx]
    kpos = idx[..., None] * SEL_BLOCK + jnp.arange(SEL_BLOCK, dtype=jnp.int32)
    s_mask = (kpos <= q_pos[None, :, None, None, None]).reshape(b, nq, N_KV, 1, k_eff * SEL_BLOCK)
    s_s = jnp.einsum('bqghd,bqgksd->bqghks', q, ks_sel.astype(f32)) * scale
    s_s = s_s.reshape(b, nq, N_KV, HPG, k_eff * SEL_BLOCK)
    p_s = masked_softmax(s_s, s_mask).reshape(b, nq, N_KV, HPG, k_eff, SEL_BLOCK)
    o_s = jnp.einsum('bqghks,bqgksd->bqghd', p_s, vs_sel.astype(f32))
    kp = kw_pos[None, :]
    w_mask = ((kp <= t) & (kp > t - WINDOW) & (kp >= 0))[None, :, None, None, :]
    s_w = jnp.einsum('bqghd,bwgd->bqghw', q, kw.astype(f32)) * scale
    p_w = masked_softmax(s_w, w_mask)
    o_w = jnp.einsum('bqghw,bwgd->bqghd', p_w, vw.astype(f32))
    g = gates.astype(f32)
    return g[..., 0:1] * o_c + g[..., 1:2] * o_s + g[..., 2:3] * o_w


def retention(q, k, v, s0):
    b, l = q.shape[:2]
    cl = math.gcd(l, RET_CHUNK)
    n = l // cl
    log_g = jnp.log(1.0 - 2.0 ** (-5.0 - jnp.arange(N_RET_HEADS, dtype=jnp.float32)))
    i = jnp.arange(cl, dtype=jnp.float32)
    diff = i[:, None] - i[None, :]
    d_in = jnp.where(diff >= 0, jnp.exp(log_g[:, None, None] * jnp.maximum(diff, 0.0)), 0.0)
    xi = jnp.exp(log_g[None, :] * (i[:, None] + 1.0))
    zeta = jnp.exp(log_g[None, :] * (cl - 1.0 - i[:, None]))
    g_c = jnp.exp(log_g * cl)

    def chunks(a):
        return a.reshape(b, n, cl, *a.shape[2:]).swapaxes(0, 1)

    def step(s, inp):
        qc, kc, vc = inp
        a = jnp.einsum('bihd,bjhd->bhij', qc, kc) * d_in
        o = jnp.einsum('bhij,bjhe->bihe', a, vc) + jnp.einsum('bihd,bhde->bihe', qc, s) * xi[None, :, :, None]
        s = s * g_c[None, :, None, None] + jnp.einsum('bjhd,bjhe->bhde', kc * zeta[None, :, :, None], vc)
        return s, o

    s, o = lax.scan(step, s0, (chunks(q), chunks(k), chunks(v)))
    return o.swapaxes(0, 1).reshape(b, l, N_RET_HEADS, DV_RET), s


def mix_inputs(x, c, g_norm, w_ada, b_ada, w_in, g_q, g_ks, g_kw):
    b, l = x.shape[:2]
    shift, scale, gate = jnp.split(jax.nn.silu(c) @ w_ada + b_ada, 3, axis=-1)
    h = rmsnorm(x, g_norm) * (1.0 + scale[:, None, :]) + shift[:, None, :]
    q, kc, vc, ks, vs, kw, vw, br, g_a, rq, rk, rv, g_r = jnp.split(h @ w_in, SPLITS, axis=-1)

    def kv(a):
        return a.reshape(b, l, N_KV, HEAD_DIM)

    q = rmsnorm(q.reshape(b, l, N_HEADS, HEAD_DIM), g_q).reshape(b, l, N_KV, HPG, HEAD_DIM)
    br = jax.nn.sigmoid(br).reshape(b, l, N_KV, HPG, 3)
    return (gate, q, kv(kc), kv(vc), rmsnorm(kv(ks), g_ks), kv(vs), rmsnorm(kv(kw), g_kw), kv(vw), br, g_a,
            rq.reshape(b, l, N_RET_HEADS, DK_RET), rk.reshape(b, l, N_RET_HEADS, DK_RET),
            rv.reshape(b, l, N_RET_HEADS, DV_RET), g_r)


def mix_outputs(x, gate, o_nsa, g_a, o_ret, g_r, g_ret, w_out):
    b, l = x.shape[:2]
    y_a = o_nsa.reshape(b, l, D_NSA).astype(x.dtype) * jax.nn.silu(g_a)
    y_r = rmsnorm(o_ret, g_ret).reshape(b, l, D_RET).astype(x.dtype) * jax.nn.silu(g_r)
    return x + gate[:, None, :] * (jnp.concatenate([y_a, y_r], axis=-1) @ w_out)


def prompt_layer(x, c, W):
    (g_norm, w_ada, b_ada, w_in, g_q, g_kc, g_ks, g_kw, pe_ck, w_ck1, w_ck2,
     pe_cv, w_cv1, w_cv2, g_ret, w_out) = W
    b, l = x.shape[:2]
    pos = jnp.arange(l, dtype=jnp.int32)
    (gate, q, kc_raw, vc_raw, ks, vs, kw, vw, br, g_a, rq, rk, rv, g_r) = mix_inputs(
        x, c, g_norm, w_ada, b_ada, w_in, g_q, g_ks, g_kw)
    kc = rmsnorm(compress(kc_raw, pe_ck, w_ck1, w_ck2), g_kc)
    vc = compress(vc_raw, pe_cv, w_cv1, w_cv2)
    ks_blk = ks.reshape(b, l // SEL_BLOCK, SEL_BLOCK, N_KV, HEAD_DIM)
    vs_blk = vs.reshape(b, l // SEL_BLOCK, SEL_BLOCK, N_KV, HEAD_DIM)
    pad_w = ((0, 0), (WINDOW, 0), (0, 0), (0, 0))
    kw_pad = jnp.pad(kw, pad_w)
    vw_pad = jnp.pad(vw, pad_w)
    qb = min(Q_BLOCK, l)

    def q_block(i):
        s0 = i * qb
        return nsa_block(lax.dynamic_slice_in_dim(q, s0, qb, axis=1),
                         s0 + jnp.arange(qb, dtype=jnp.int32), kc, vc, ks_blk, vs_blk,
                         lax.dynamic_slice_in_dim(kw_pad, s0, WINDOW + qb, axis=1),
                         lax.dynamic_slice_in_dim(vw_pad, s0, WINDOW + qb, axis=1),
                         s0 - WINDOW + jnp.arange(WINDOW + qb, dtype=jnp.int32),
                         lax.dynamic_slice_in_dim(br, s0, qb, axis=1))

    o_nsa = lax.map(q_block, jnp.arange(l // qb, dtype=jnp.int32))
    o_nsa = o_nsa.swapaxes(0, 1).reshape(b, l, N_KV, HPG, HEAD_DIM)
    s_init = jnp.zeros((b, N_RET_HEADS, DK_RET, DV_RET), jnp.float32)
    o_ret, s_ret = retention(rotary(rq, pos), rotary(rk, pos) * DK_RET ** -0.5, rv.astype(jnp.float32), s_init)
    y = mix_outputs(x, gate, o_nsa, g_a, o_ret, g_r, g_ret, w_out)
    keep = min(WINDOW, l)
    return y, (jnp.stack([kc_raw, vc_raw], axis=2), jnp.stack([ks, vs], axis=2),
               jnp.stack([kw[:, l - keep:], vw[:, l - keep:]], axis=2), s_ret.astype(x.dtype))


def sample_layer(x, c, cache_cmp, cache_slc, state_win, state_ret, page_table, W):
    (g_norm, w_ada, b_ada, w_in, g_q, g_kc, g_ks, g_kw, pe_ck, w_ck1, w_ck2,
     pe_cv, w_cv1, w_cv2, g_ret, w_out) = W
    b, l = x.shape[:2]
    pos = PAST_LEN + jnp.arange(l, dtype=jnp.int32)
    (gate, q, kc_raw, vc_raw, ks, vs, kw, vw, br, g_a, rq, rk, rv, g_r) = mix_inputs(
        x, c, g_norm, w_ada, b_ada, w_in, g_q, g_ks, g_kw)
    new_cmp = jnp.stack([kc_raw, vc_raw], axis=2)
    new_slc = jnp.stack([ks, vs], axis=2)
    full_cmp = pad_rows(jnp.concatenate(
        [gather_pages(cache_cmp, page_table).astype(x.dtype), new_cmp], axis=1), CMP_STRIDE)
    kc = rmsnorm(compress(full_cmp[:, :, 0], pe_ck, w_ck1, w_ck2), g_kc)
    vc = compress(full_cmp[:, :, 1], pe_cv, w_cv1, w_cv2)
    full_slc = pad_rows(jnp.concatenate(
        [gather_pages(cache_slc, page_table).astype(x.dtype), new_slc], axis=1), SEL_BLOCK)
    slc_blk = full_slc.reshape(b, -1, SEL_BLOCK, 2, N_KV, HEAD_DIM)
    wb = state_win.shape[1]
    win = jnp.concatenate([state_win.astype(x.dtype), jnp.stack([kw, vw], axis=2)], axis=1)
    win_pos = PAST_LEN - wb + jnp.arange(wb + l, dtype=jnp.int32)
    o_nsa = nsa_block(q, pos, kc, vc, slc_blk[:, :, :, 0], slc_blk[:, :, :, 1],
                      win[:, :, 0], win[:, :, 1], win_pos, br)
    o_ret, s_ret = retention(rotary(rq, pos), rotary(rk, pos) * DK_RET ** -0.5,
                             rv.astype(jnp.float32), state_ret.astype(jnp.float32))
    y = mix_outputs(x, gate, o_nsa, g_a, o_ret, g_r, g_ret, w_out)
    keep = min(WINDOW, wb + l)
    return y, (new_cmp, new_slc, win[:, wb + l - keep:], s_ret.astype(x.dtype))


def setup_inputs(seed: int = 0) -> dict:
    key = jax.random.key(seed)
    k = jax.random.split(key, 25)
    n_pages = PAST_LEN // PAGE_SIZE
    n_used = DEC_BATCH * n_pages
    n_phys = n_used + n_used // 4
    win_len = min(WINDOW, PAST_LEN)

    def nrm(kk, shape, s):
        return s * jax.random.normal(kk, shape, jnp.float32)

    def gain(kk, n):
        return 1.0 + nrm(kk, (DEPTH, n), 0.01)

    kv_page = (DEPTH, n_phys, PAGE_SIZE, 2, N_KV, HEAD_DIM)
    page_table = jax.random.permutation(k[8], n_phys)[:n_used].reshape(DEC_BATCH, n_pages).astype(jnp.int32)
    return {
        'x_prompt': nrm(k[0], (BATCH, SEQ, D_MODEL), 1.0),
        'x_sample': nrm(k[1], (DEC_BATCH, DEC_SEQ, D_MODEL), 1.0),
        'c_prompt': nrm(k[2], (BATCH, D_MODEL), 1.0),
        'c_sample': nrm(k[3], (DEC_BATCH, D_MODEL), 1.0),
        'cache_cmp': nrm(k[4], kv_page, 1.0),
        'cache_slc': nrm(k[5], kv_page, 1.0),
        'state_win': nrm(k[6], (DEPTH, DEC_BATCH, win_len, 2, N_KV, HEAD_DIM), 1.0),
        'state_ret': nrm(k[7], (DEPTH, DEC_BATCH, N_RET_HEADS, DK_RET, DV_RET), 0.5),
        'page_table': page_table,
        'g_norm': gain(k[9], D_MODEL),
        'w_ada': nrm(k[10], (DEPTH, D_MODEL, 3 * D_MODEL), 0.5 * D_MODEL ** -0.5),
        'b_ada': nrm(k[11], (DEPTH, 3 * D_MODEL), 0.02),
        'w_in': nrm(k[12], (DEPTH, D_MODEL, D_IN), D_MODEL ** -0.5),
        'g_q': gain(k[13], HEAD_DIM),
        'g_kc': gain(k[14], HEAD_DIM),
        'g_ks': gain(k[15], HEAD_DIM),
        'g_kw': gain(k[16], HEAD_DIM),
        'pe_ck': nrm(k[17], (DEPTH, CMP_BLOCK, HEAD_DIM), 0.1),
        'w_ck1': nrm(k[18], (DEPTH, CMP_BLOCK, HEAD_DIM, CMP_HIDDEN), (CMP_BLOCK * HEAD_DIM) ** -0.5),
        'w_ck2': nrm(k[19], (DEPTH, CMP_HIDDEN, HEAD_DIM), CMP_HIDDEN ** -0.5),
        'pe_cv': nrm(k[20], (DEPTH, CMP_BLOCK, HEAD_DIM), 0.1),
        'w_cv1': nrm(k[21], (DEPTH, CMP_BLOCK, HEAD_DIM, CMP_HIDDEN), (CMP_BLOCK * HEAD_DIM) ** -0.5),
        'w_cv2': nrm(k[22], (DEPTH, CMP_HIDDEN, HEAD_DIM), CMP_HIDDEN ** -0.5),
        'g_ret': gain(k[23], DV_RET),
        'w_out': nrm(k[24], (DEPTH, D_MIX, D_MODEL), D_MIX ** -0.5),
    }


def reference(x_prompt, x_sample, c_prompt, c_sample, cache_cmp, cache_slc, state_win, state_ret, page_table,
              g_norm, w_ada, b_ada, w_in, g_q, g_kc, g_ks, g_kw, pe_ck, w_ck1, w_ck2, pe_cv, w_cv1, w_cv2,
              g_ret, w_out):
    xp, xs = x_prompt, x_sample
    new_p, new_s = [], []
    for li in range(DEPTH):
        W = (g_norm[li], w_ada[li], b_ada[li], w_in[li], g_q[li], g_kc[li], g_ks[li], g_kw[li],
             pe_ck[li], w_ck1[li], w_ck2[li], pe_cv[li], w_cv1[li], w_cv2[li], g_ret[li], w_out[li])
        xp, st_p = prompt_layer(xp, c_prompt, W)
        xs, st_s = sample_layer(xs, c_sample, cache_cmp[li], cache_slc[li], state_win[li], state_ret[li],
                                page_table, W)
        new_p.append(st_p)
        new_s.append(st_s)

    def stack(group, j):
        return jnp.stack([st[j] for st in group])

    return (xp, xs, stack(new_p, 0), stack(new_p, 1), stack(new_p, 2), stack(new_p, 3),
            stack(new_s, 0), stack(new_s, 1), stack(new_s, 2), stack(new_s, 3))
```

```cpp
#include <hip/hip_runtime.h>
#include <stdint.h>
#include <stdio.h>

namespace {
typedef unsigned short bf16_t;
typedef short bf16x8 __attribute__((ext_vector_type(8)));
typedef float f32x4 __attribute__((ext_vector_type(4)));

constexpr int D_MODEL = 1024, BATCH = 4, SEQ = 4096, DEC_BATCH = 32, PAST = 16384;
constexpr int NPAGES = 128, NPHYS = 5120;
constexpr int TP = BATCH * SEQ;
constexpr int R = TP + DEC_BATCH;
constexpr int RPAD = 16640;
constexpr int D_IN = 3352, NPAD = 3584;
constexpr int C_Q = 0, C_KC = 512, C_KS = 768, C_KW = 1024, C_BR = 1280, C_GA = 1304, C_RQ = 1816, C_RK = 2072, C_RV = 2328, C_GR = 2840;
constexpr float EPS = 1e-6f;
constexpr int NT = 512;
constexpr int LDS_BYTES = 147456 + 64;

struct Params {
    const float *x_prompt, *x_sample, *c_prompt, *c_sample, *cache_cmp, *cache_slc, *state_win, *state_ret;
    const int* page_table;
    const float *g_norm, *w_ada, *b_ada, *w_in, *g_q, *g_kc, *g_ks, *g_kw, *pe_ck, *w_ck1, *w_ck2, *pe_cv, *w_cv1, *w_cv2, *g_ret, *w_out;
    float *y, *p_cmp, *p_slc, *p_win, *p_ret, *s_cmp, *s_slc, *s_win, *s_ret;
    unsigned* bar;
    float* mod;
    bf16_t* bt_in;
    bf16_t* bt_out;
    bf16_t* H;
    float* praw;
    bf16_t* qn;
    bf16_t *kcr, *vcr, *ks, *vs, *kw, *vw;
    float* gates;
    bf16_t *ga, *gr;
    bf16_t *rq, *rk;
    bf16_t* rv;
    bf16_t *kc, *vc;
    bf16_t *kcs, *vcs;
    bf16_t* yar;
    float *sloc, *spre;
    float* oret;
};

__device__ __forceinline__ bf16_t f2bf(float f) { unsigned u = __float_as_uint(f); u += 0x7fffu + ((u >> 16) & 1u); return (bf16_t)(u >> 16); }
__device__ __forceinline__ float bf2f(bf16_t h) { return __uint_as_float(((unsigned)h) << 16); }
__device__ __forceinline__ float wave_sum(float v) {
#pragma unroll
    for (int o = 1; o < 64; o <<= 1) v += __shfl_xor(v, o);
    return v;
}
__device__ __forceinline__ float wave_max(float v) {
#pragma unroll
    for (int o = 1; o < 64; o <<= 1) v = fmaxf(v, __shfl_xor(v, o));
    return v;
}
__device__ __forceinline__ float silu(float v) { return v / (1.f + __expf(-v)); }
__device__ __forceinline__ float sigmoidf(float v) { return 1.f / (1.f + __expf(-v)); }
#define WSYNC() asm volatile("s_waitcnt lgkmcnt(0)" ::: "memory")

__device__ __forceinline__ void load8(const bf16_t* p, float (&f)[8]) {
    uint4 u = *(const uint4*)p;
    f[0] = __uint_as_float(u.x << 16); f[1] = __uint_as_float(u.x & 0xffff0000u);
    f[2] = __uint_as_float(u.y << 16); f[3] = __uint_as_float(u.y & 0xffff0000u);
    f[4] = __uint_as_float(u.z << 16); f[5] = __uint_as_float(u.z & 0xffff0000u);
    f[6] = __uint_as_float(u.w << 16); f[7] = __uint_as_float(u.w & 0xffff0000u);
}
__device__ __forceinline__ void load8(const float* p, float (&f)[8]) {
    float4 a = *(const float4*)p, b = *(const float4*)(p + 4);
    f[0] = a.x; f[1] = a.y; f[2] = a.z; f[3] = a.w; f[4] = b.x; f[5] = b.y; f[6] = b.z; f[7] = b.w;
}
__device__ __forceinline__ float load1(const bf16_t* p) { return bf2f(*p); }
__device__ __forceinline__ float load1(const float* p) { return *p; }

__device__ void p0_adaln(const Params& p, char* lds, int bid, int nblk) {
    float* sc = (float*)lds;
    const int tid = threadIdx.x, lane = tid & 63, wave = tid >> 6;
    if (bid >= 48) return;
    for (int i = tid; i < 36 * 1024; i += NT) {
        const int row = i >> 10, k = i & 1023;
        const float c = row < 4 ? p.c_prompt[row * 1024 + k] : p.c_sample[(row - 4) * 1024 + k];
        sc[i] = silu(c);
    }
    __syncthreads();
    for (int item = bid; item < 48; item += nblk) {
        const int j = item * 64 + lane;
        float acc[36];
#pragma unroll
        for (int r = 0; r < 36; ++r) acc[r] = 0.f;
        const int k0 = wave * 128;
        for (int k = k0; k < k0 + 128; ++k) {
            const float w = p.w_ada[(size_t)k * 3072 + j];
#pragma unroll
            for (int r = 0; r < 36; ++r) acc[r] += sc[r * 1024 + k] * w;
        }
        __syncthreads();
        float* red = (float*)lds;
#pragma unroll
        for (int r = 0; r < 36; ++r) red[(wave * 36 + r) * 64 + lane] = acc[r];
        __syncthreads();
        for (int i = tid; i < 36 * 64; i += NT) {
            const int r = i >> 6, l = i & 63;
            float s = 0.f;
#pragma unroll
            for (int w = 0; w < 8; ++w) s += red[(w * 36 + r) * 64 + l];
            p.mod[r * 3072 + item * 64 + l] = s + p.b_ada[item * 64 + l];
        }
        __syncthreads();
        if (item + nblk < 48) {
            for (int i = tid; i < 36 * 1024; i += NT) {
                const int row = i >> 10, k = i & 1023;
                const float c = row < 4 ? p.c_prompt[row * 1024 + k] : p.c_sample[(row - 4) * 1024 + k];
                sc[i] = silu(c);
            }
            __syncthreads();
        }
    }
}

__device__ void transpose_item(const float* W, int K, int N, bf16_t* WT, float* scr, int item, int lane, int nblkN) {
    const int kb = item / nblkN, nb = item % nblkN, k0 = kb * 64, n0 = nb * 64;
    for (int kk = 0; kk < 64; ++kk) scr[kk * 65 + lane] = (n0 + lane < N) ? W[(size_t)(k0 + kk) * N + n0 + lane] : 0.f;
    WSYNC();
    for (int nn = 0; nn < 64; ++nn) WT[(size_t)(n0 + nn) * K + k0 + lane] = f2bf(scr[lane * 65 + nn]);
    WSYNC();
}
__device__ void p0_weights(const Params& p, char* lds, int bid, int nblk) {
    const int tid = threadIdx.x, lane = tid & 63, wave = tid >> 6;
    float* scr = (float*)lds + wave * (64 * 65);
    const int gw = bid * 8 + wave, ngw = nblk * 8;
    constexpr int I_IN = 16 * 56, I_OUT = 16 * 16;
    for (int it = gw; it < I_IN + I_OUT; it += ngw) {
        if (it < I_IN) transpose_item(p.w_in, 1024, D_IN, p.bt_in, scr, it, lane, 56);
        else transpose_item(p.w_out, 1024, 1024, p.bt_out, scr, it - I_IN, lane, 16);
    }
    const size_t gt = (size_t)bid * NT + tid, ngt = (size_t)nblk * NT;
    for (size_t i = gt; i < (size_t)32 * 511 * 64; i += ngt) {
        const int b = (int)(i / (511 * 64)), rem = (int)(i % (511 * 64));
        const float4 v = *(const float4*)(p.state_win + (size_t)b * 512 * 256 + 256 + (size_t)rem * 4);
        *(float4*)(p.s_win + (size_t)b * 512 * 256 + (size_t)rem * 4) = v;
    }
}

__device__ void p1_norm(const Params& p, int bid, int nblk) {
    const int tid = threadIdx.x, lane = tid & 63, wave = tid >> 6;
    for (int r = bid * 8 + wave; r < R; r += nblk * 8) {
        const float* xr = r < TP ? p.x_prompt + (size_t)r * 1024 : p.x_sample + (size_t)(r - TP) * 1024;
        const int mrow = r < TP ? (r >> 12) : 4 + (r - TP);
        const float* shift = p.mod + mrow * 3072, *scale = shift + 1024;
        float4 v[4]; float ss = 0.f;
#pragma unroll
        for (int j = 0; j < 4; ++j) { v[j] = *(const float4*)(xr + j * 256 + lane * 4); ss += v[j].x * v[j].x + v[j].y * v[j].y + v[j].z * v[j].z + v[j].w * v[j].w; }
        const float rs = rsqrtf(wave_sum(ss) * (1.f / 1024.f) + EPS);
#pragma unroll
        for (int j = 0; j < 4; ++j) {
            const int c = j * 256 + lane * 4;
            const float4 g = *(const float4*)(p.g_norm + c), sc = *(const float4*)(scale + c), sh = *(const float4*)(shift + c);
            ushort4 o;
            o.x = f2bf(v[j].x * rs * g.x * (1.f + sc.x) + sh.x);
            o.y = f2bf(v[j].y * rs * g.y * (1.f + sc.y) + sh.y);
            o.z = f2bf(v[j].z * rs * g.z * (1.f + sc.z) + sh.z);
            o.w = f2bf(v[j].w * rs * g.w * (1.f + sc.w) + sh.w);
            *(ushort4*)(p.H + (size_t)r * 1024 + c) = o;
        }
    }
}

constexpr int BM = 256, BK = 64, HALF = 128, HT = HALF * BK;
__device__ __forceinline__ int lds_byte(int r, int c) {
    int st = (r >> 4) * 2 + (c >> 5), rr = r & 15, cc = c & 31, ob = rr * 64 + cc * 2;
    return st * 1024 + (ob ^ (((ob >> 9) & 1) << 5));
}
__device__ __forceinline__ void stage_rc(int b, int& Rr, int& Cc) {
    int st = b / 1024, sb = b % 1024, swz = sb ^ (((sb >> 9) & 1) << 5);
    Rr = (st >> 1) * 16 + swz / 64; Cc = (st & 1) * 32 + (swz % 64) / 2;
}

template <class Epi>
__device__ __forceinline__ void gemm_phase(const bf16_t* __restrict__ A, const bf16_t* __restrict__ Bt, int nM, int nN, int K, char* lds, int bid, int nblk, const Epi& epi) {
    bf16_t* shm = (bf16_t*)lds;
#define SA(b, h) (shm + ((b) * 2 + (h)) * HT)
#define SB(b, h) (shm + (4 + (b) * 2 + (h)) * HT)
#define STAGE_X(T, P, BASE, br, kt) do { long _g = (long)(br) * K + (long)(kt) * BK; \
    for (int _i = 0; _i < 2; ++_i) { int _b = (T) * 16 + _i * 8192; int _r, _c; stage_rc(_b, _r, _c); \
      __builtin_amdgcn_global_load_lds((const unsigned*)(BASE + _g + (long)_r * K + _c), \
        (__attribute__((address_space(3))) unsigned*)((char*)(P) + _b), 16, 0, 0); } } while (0)
#define STAGE(P, BASE, br, kt) STAGE_X(threadIdx.x, P, BASE, br, kt)
#define LDA(dst, b, h) for (int m = 0; m < 4; ++m) for (int k = 0; k < 2; ++k) \
    dst[m][k] = *reinterpret_cast<const bf16x8*>((char*)SA(b, h) + lds_byte(wr * 64 + m * 16 + fr, k * 32 + fq * 8))
#define LDB(dst, b, h) for (int n = 0; n < 2; ++n) for (int k = 0; k < 2; ++k) \
    dst[n][k] = *reinterpret_cast<const bf16x8*>((char*)SB(b, h) + lds_byte(wc * 32 + n * 16 + fr, k * 32 + fq * 8))
#define MMA(ai, bj, At, Bt_) do { __builtin_amdgcn_s_setprio(1); \
    for (int m = 0; m < 4; ++m) for (int n = 0; n < 2; ++n) for (int k = 0; k < 2; ++k) \
      acc[ai][bj][m][n] = __builtin_amdgcn_mfma_f32_16x16x32_bf16(At[m][k], Bt_[n][k], acc[ai][bj][m][n], 0, 0, 0); \
    __builtin_amdgcn_s_setprio(0); } while (0)
#define WAIT_V(n) asm volatile("s_waitcnt vmcnt(" #n ")" ::: "memory")
#define WAIT_L(n) asm volatile("s_waitcnt lgkmcnt(" #n ")" ::: "memory")
#define BAR __builtin_amdgcn_s_barrier()
#define SCHED __builtin_amdgcn_sched_barrier(0)
    const int nwg = nM * nN;
    for (int tile = bid; tile < nwg; tile += nblk) {
        const int pm = tile / nN, pn = tile % nN;
        const int brow = pm * BM, bcol = pn * BM;
        int wid = threadIdx.x >> 6, lane = threadIdx.x & 63, wr = wid >> 2, wc = wid & 3, fr = lane & 15, fq = lane >> 4;
        f32x4 acc[2][2][4][2] = {};
        bf16x8 At[4][2], B0[2][2], B1[2][2];
        const int nt = K / BK;
        STAGE(SB(0, 0), Bt, bcol, 0); STAGE(SA(0, 0), A, brow, 0);
        STAGE(SB(0, 1), Bt, bcol + HALF, 0); STAGE(SA(0, 1), A, brow + HALF, 0);
        if (wr == 1) BAR;
        WAIT_V(4); BAR;
        STAGE(SB(1, 0), Bt, bcol, 1); STAGE(SA(1, 0), A, brow, 1); STAGE(SB(1, 1), Bt, bcol + HALF, 1);
        WAIT_V(6); BAR;
        for (int t = 0; t < nt - 2; t += 2) {
            LDB(B0, 0, 0); SCHED; LDA(At, 0, 0); STAGE(SA(1, 1), A, brow + HALF, t + 1);
            WAIT_L(8); BAR; WAIT_L(0); MMA(0, 0, At, B0); BAR; SCHED;
            LDB(B1, 0, 1); STAGE(SB(0, 0), Bt, bcol, t + 2);
            BAR; WAIT_L(0); MMA(0, 1, At, B1); BAR;
            LDA(At, 0, 1); STAGE(SA(0, 0), A, brow, t + 2);
            BAR; WAIT_L(0); MMA(1, 0, At, B0); BAR; SCHED;
            STAGE(SB(0, 1), Bt, bcol + HALF, t + 2);
            WAIT_V(6); BAR; MMA(1, 1, At, B1); BAR;
            LDB(B0, 1, 0); SCHED; LDA(At, 1, 0); STAGE(SA(0, 1), A, brow + HALF, t + 2);
            WAIT_L(8); BAR; WAIT_L(0); MMA(0, 0, At, B0); BAR; SCHED;
            LDB(B1, 1, 1); STAGE(SB(1, 0), Bt, bcol, t + 3);
            BAR; WAIT_L(0); MMA(0, 1, At, B1); BAR;
            LDA(At, 1, 1); STAGE(SA(1, 0), A, brow, t + 3);
            BAR; WAIT_L(0); MMA(1, 0, At, B0); BAR; SCHED;
            STAGE(SB(1, 1), Bt, bcol + HALF, t + 3);
            WAIT_V(6); BAR; MMA(1, 1, At, B1); BAR;
        }
        int tz = threadIdx.x; asm volatile("" : "+v"(tz)); wid = tz >> 6; lane = tz & 63; wr = wid >> 2; wc = wid & 3; fr = lane & 15; fq = lane >> 4;
        { LDB(B0, 0, 0); WAIT_V(0); LDA(At, 0, 0); STAGE_X(tz, SA(1, 1), A, brow + HALF, nt - 1);
          BAR; WAIT_L(0); MMA(0, 0, At, B0); BAR;
          LDB(B1, 0, 1); BAR; WAIT_L(0); MMA(0, 1, At, B1); BAR;
          LDA(At, 0, 1); WAIT_V(4); BAR; WAIT_L(0); MMA(1, 0, At, B0); MMA(1, 1, At, B1); BAR; }
        { LDB(B0, 1, 0); LDA(At, 1, 0); WAIT_V(2); BAR; WAIT_L(0); MMA(0, 0, At, B0); BAR;
          LDB(B1, 1, 1); WAIT_V(0); BAR; WAIT_L(0); MMA(0, 1, At, B1); BAR;
          LDA(At, 1, 1); BAR; WAIT_L(0); MMA(1, 0, At, B0); MMA(1, 1, At, B1); BAR; }
        if (wr == 0) BAR;
        epi(acc, brow, bcol, wr, wc, fr, fq);
    }
#undef SA
#undef SB
#undef STAGE_X
#undef STAGE
#undef LDA
#undef LDB
#undef MMA
}

struct EpiRaw {
    float* C; int ldc;
    __device__ __forceinline__ void operator()(const f32x4 (&acc)[2][2][4][2], int brow, int bcol, int wr, int wc, int fr, int fq) const {
        for (int ai = 0; ai < 2; ++ai) for (int bj = 0; bj < 2; ++bj) for (int m = 0; m < 4; ++m) for (int n = 0; n < 2; ++n) for (int j = 0; j < 4; ++j)
            C[(size_t)(brow + ai * HALF + wr * 64 + m * 16 + fq * 4 + j) * ldc + (bcol + bj * HALF + wc * 32 + n * 16 + fr)] = acc[ai][bj][m][n][j];
    }
};
struct EpiOut {
    const Params* p;
    __device__ __forceinline__ void operator()(const f32x4 (&acc)[2][2][4][2], int brow, int bcol, int wr, int wc, int fr, int fq) const {
        for (int ai = 0; ai < 2; ++ai) for (int m = 0; m < 4; ++m) for (int j = 0; j < 4; ++j) {
            const int r = brow + ai * HALF + wr * 64 + m * 16 + fq * 4 + j;
            if (r < R) {
                const float* xr = r < TP ? p->x_prompt + (size_t)r * 1024 : p->x_sample + (size_t)(r - TP) * 1024;
                const float* gate = p->mod + (r < TP ? (r >> 12) : 4 + (r - TP)) * 3072 + 2048;
                for (int bj = 0; bj < 2; ++bj) for (int n = 0; n < 2; ++n) {
                    const int c = bcol + bj * HALF + wc * 32 + n * 16 + fr;
                    p->y[(size_t)r * 1024 + c] = xr[c] + gate[c] * acc[ai][bj][m][n][j];
                }
            }
        }
    }
};

__device__ void p3_rows(const Params& p, int bid, int nblk) {
    const int tid = threadIdx.x, lane = tid & 63, wave = tid >> 6;
    for (int r = bid * 8 + wave; r < R; r += nblk * 8) {
        const float* pr = p.praw + (size_t)r * NPAD;
        const bool isp = r < TP;
        const int b = isp ? (r >> 12) : (r - TP), t = isp ? (r & 4095) : 0;
        const int pos = isp ? t : PAST;
        {
            const float gq = p.g_q[lane];
            for (int hh = 0; hh < 8; ++hh) {
                const float v = pr[C_Q + hh * 64 + lane];
                const float rs = rsqrtf(wave_sum(v * v) * (1.f / 64.f) + EPS);
                p.qn[(size_t)r * 512 + hh * 64 + lane] = f2bf(v * rs * gq);
            }
        }
        float* o_cmp = isp ? p.p_cmp + (size_t)r * 256 : p.s_cmp + (size_t)b * 256;
        float* o_slc = isp ? p.p_slc + (size_t)r * 256 : p.s_slc + (size_t)b * 256;
        float* o_win = isp ? (t >= SEQ - 512 ? p.p_win + ((size_t)b * 512 + (t - (SEQ - 512))) * 256 : nullptr) : p.s_win + ((size_t)b * 512 + 511) * 256;
        for (int j = 0; j < 4; ++j) {
            const int g = j & 1;
            const size_t cidx = ((size_t)(b * 2 + g) * SEQ + t) * 64 + lane;
            {
                const float v = pr[C_KC + j * 64 + lane];
                o_cmp[j * 64 + lane] = v;
                if (isp) { if (j < 2) p.kcr[cidx] = f2bf(v); else p.vcr[cidx] = f2bf(v); }
            }
            {
                float v = pr[C_KS + j * 64 + lane];
                if (j < 2) { const float rs = rsqrtf(wave_sum(v * v) * (1.f / 64.f) + EPS); v = v * rs * p.g_ks[lane]; }
                o_slc[j * 64 + lane] = v;
                if (isp) { if (j < 2) p.ks[cidx] = f2bf(v); else p.vs[cidx] = f2bf(v); }
            }
            {
                float v = pr[C_KW + j * 64 + lane];
                if (j < 2) { const float rs = rsqrtf(wave_sum(v * v) * (1.f / 64.f) + EPS); v = v * rs * p.g_kw[lane]; }
                if (o_win) o_win[j * 64 + lane] = v;
                if (isp) { if (j < 2) p.kw[cidx] = f2bf(v); else p.vw[cidx] = f2bf(v); }
            }
        }
        if (lane < 24) p.gates[(size_t)r * 24 + lane] = sigmoidf(pr[C_BR + lane]);
        for (int i = 0; i < 8; ++i) {
            p.ga[(size_t)r * 512 + i * 64 + lane] = f2bf(silu(pr[C_GA + i * 64 + lane]));
            p.gr[(size_t)r * 512 + i * 64 + lane] = f2bf(silu(pr[C_GR + i * 64 + lane]));
            p.rv[(size_t)r * 512 + i * 64 + lane] = f2bf(pr[C_RV + i * 64 + lane]);
        }
        {
            const int i = lane & 31;
            const float freq = powf(10000.f, -(float)i / 32.f);
            const float ang = (float)pos * freq;
            float sn, cs; sincosf(ang, &sn, &cs);
            for (int hh = 0; hh < 4; ++hh) {
                const float a = pr[C_RQ + hh * 64 + lane], ao = pr[C_RQ + hh * 64 + (lane ^ 32)];
                const float kq = pr[C_RK + hh * 64 + lane], ko = pr[C_RK + hh * 64 + (lane ^ 32)];
                const float oq = lane < 32 ? a * cs - ao * sn : ao * sn + a * cs;
                const float ok = lane < 32 ? kq * cs - ko * sn : ko * sn + kq * cs;
                p.rq[(size_t)r * 256 + hh * 64 + lane] = f2bf(oq);
                p.rk[(size_t)r * 256 + hh * 64 + lane] = f2bf(ok * 0.125f);
            }
        }
    }
}

__device__ void compress_wave(const Params& p, int kv, const float* xrow_f32, const bf16_t* xrow_bf16, size_t stride, const int* pages, int b, int g, int i, bf16_t* out, int lane) {
    const float* pe = kv ? p.pe_cv : p.pe_ck;
    const float* w1 = kv ? p.w_cv1 : p.w_ck1;
    const float* w2 = kv ? p.w_cv2 : p.w_ck2;
    float acc = 0.f;
    for (int l = 0; l < 32; ++l) {
        const int pos = 16 * i + l;
        const float* xf = nullptr; const bf16_t* xb = nullptr;
        if (pages) { const int pg = pages[pos >> 7]; xf = p.cache_cmp + (((size_t)pg * 128 + (pos & 127)) * 4 + kv * 2 + g) * 64; }
        else xb = xrow_bf16 + (size_t)pos * 64;
#pragma unroll 8
        for (int d = 0; d < 64; ++d) {
            const float xv = (pages ? xf[d] : bf2f(xb[d])) + pe[l * 64 + d];
            acc += xv * w1[(size_t)(l * 64 + d) * 64 + lane];
        }
    }
    const float h = silu(acc);
    float o = 0.f;
    for (int f = 0; f < 64; ++f) o += __shfl(h, f) * w2[f * 64 + lane];
    if (kv == 0) { const float rs = rsqrtf(wave_sum(o * o) * (1.f / 64.f) + EPS); o = o * rs * p.g_kc[lane]; }
    out[lane] = f2bf(o);
}
__device__ void p4_compress(const Params& p, int bid, int nblk) {
    const int tid = threadIdx.x, lane = tid & 63, wave = tid >> 6;
    const int gw = bid * 8 + wave, ngw = nblk * 8;
    constexpr int NP = 4 * 2 * 255 * 2, NS = 32 * 2 * 1023 * 2;
    for (int it = gw; it < NP + NS; it += ngw) {
        if (it < NP) {
            const int kv = it & 1, rest = it >> 1, i = rest % 255, bg = rest / 255, b = bg >> 1, g = bg & 1;
            const bf16_t* src = (kv ? p.vcr : p.kcr) + (size_t)(b * 2 + g) * SEQ * 64;
            bf16_t* out = (kv ? p.vc : p.kc) + ((size_t)(b * 2 + g) * 256 + i) * 64;
            compress_wave(p, kv, nullptr, src, 64, nullptr, b, g, i, out, lane);
        } else {
            const int it2 = it - NP;
            const int kv = it2 & 1, rest = it2 >> 1, i = rest % 1023, bg = rest / 1023, b = bg >> 1, g = bg & 1;
            bf16_t* out = (kv ? p.vcs : p.kcs) + ((size_t)(b * 2 + g) * 1024 + i) * 64;
            compress_wave(p, kv, nullptr, nullptr, 256, p.page_table + b * NPAGES, b, g, i, out, lane);
        }
    }
}

template <typename T>
__device__ __forceinline__ void attend64(const float* qs, float* pl, const T* kbase, const T* vbase, size_t stride, bool valid, int lane, float (&m)[4], float (&l)[4], float (&o)[4]) {
    float s[4] = {0.f, 0.f, 0.f, 0.f};
    if (valid) {
        const T* kr = kbase + (size_t)lane * stride;
#pragma unroll
        for (int c = 0; c < 8; ++c) {
            float kf[8]; load8(kr + c * 8, kf);
#pragma unroll
            for (int h = 0; h < 4; ++h)
#pragma unroll
                for (int j = 0; j < 8; ++j) s[h] += qs[h * 64 + c * 8 + j] * kf[j];
        }
    }
    const unsigned long long vm = __ballot(valid);
    if (vm == 0ull) return;
#pragma unroll
    for (int h = 0; h < 4; ++h) {
        const float sv = valid ? s[h] * 0.125f : -1e30f;
        const float mn = fmaxf(m[h], wave_max(sv));
        const float alpha = __expf(m[h] - mn);
        const float pv = valid ? __expf(sv - mn) : 0.f;
        l[h] = l[h] * alpha + wave_sum(pv); o[h] *= alpha; m[h] = mn;
        pl[h * 64 + lane] = pv;
    }
    WSYNC();
    for (int kk = 0; kk < 64; ++kk) {
        if ((vm >> kk) & 1ull) {
            const float vv = load1(vbase + (size_t)kk * stride + lane);
#pragma unroll
            for (int h = 0; h < 4; ++h) o[h] += pl[h * 64 + kk] * vv;
        }
    }
    WSYNC();
}

__device__ __forceinline__ void cmp_branch(const float* qs, float* pl, float* ps, const bf16_t* kc, const bf16_t* vc, int n_c, int lane, float (&oc)[4]) {
    float m[4] = {-1e30f, -1e30f, -1e30f, -1e30f}, l[4] = {0.f, 0.f, 0.f, 0.f};
    for (int c0 = 0; c0 < n_c; c0 += 64) {
        const bool valid = c0 + lane < n_c;
        float s[4] = {0.f, 0.f, 0.f, 0.f};
        if (valid) {
            const bf16_t* kr = kc + (size_t)(c0 + lane) * 64;
#pragma unroll
            for (int c = 0; c < 8; ++c) {
                float kf[8]; load8(kr + c * 8, kf);
#pragma unroll
                for (int h = 0; h < 4; ++h)
#pragma unroll
                    for (int j = 0; j < 8; ++j) s[h] += qs[h * 64 + c * 8 + j] * kf[j];
            }
        }
#pragma unroll
        for (int h = 0; h < 4; ++h) {
            const float sv = valid ? s[h] * 0.125f : -1e30f;
            const float mn = fmaxf(m[h], wave_max(sv));
            const float pv = valid ? __expf(sv - mn) : 0.f;
            l[h] = l[h] * __expf(m[h] - mn) + wave_sum(pv); m[h] = mn;
        }
    }
    for (int c0 = 0; c0 < n_c; c0 += 64) {
        const bool valid = c0 + lane < n_c;
        float s[4] = {0.f, 0.f, 0.f, 0.f};
        if (valid) {
            const bf16_t* kr = kc + (size_t)(c0 + lane) * 64;
#pragma unroll
            for (int c = 0; c < 8; ++c) {
                float kf[8]; load8(kr + c * 8, kf);
#pragma unroll
                for (int h = 0; h < 4; ++h)
#pragma unroll
                    for (int j = 0; j < 8; ++j) s[h] += qs[h * 64 + c * 8 + j] * kf[j];
            }
        }
        float psum = 0.f;
#pragma unroll
        for (int h = 0; h < 4; ++h) {
            const float pv = valid ? __expf(s[h] * 0.125f - m[h]) / l[h] : 0.f;
            pl[h * 64 + lane] = pv; psum += pv;
        }
        if (valid) ps[1 + c0 + lane] = psum;
        WSYNC();
        const int nk = min(64, n_c - c0);
        for (int kk = 0; kk < nk; ++kk) {
            const float vv = bf2f(vc[(size_t)(c0 + kk) * 64 + lane]);
#pragma unroll
            for (int h = 0; h < 4; ++h) oc[h] += pl[h * 64 + kk] * vv;
        }
        WSYNC();
    }
}

__device__ __forceinline__ void topk16(float* sc, int* sel, int n_sel, int lane) {
    for (int round = 0; round < 16; ++round) {
        float bv = -3.0e38f; int bi = 0x7fffffff;
        for (int j = lane; j < n_sel; j += 64) { const float v = sc[j]; if (v > bv) { bv = v; bi = j; } }
#pragma unroll
        for (int o = 1; o < 64; o <<= 1) {
            const float ov = __shfl_xor(bv, o); const int oi = __shfl_xor(bi, o);
            if (ov > bv || (ov == bv && oi < bi)) { bv = ov; bi = oi; }
        }
        if (lane == 0) { sel[round] = bi; sc[bi] = -3.4e38f; }
        WSYNC();
    }
}

constexpr int ATT_WLDS = 256 + 256 + 1040 + 272 + 16;
__device__ void p5_attention(const Params& p, char* lds, int bid, int nblk) {
    const int tid = threadIdx.x, lane = tid & 63, wave = tid >> 6;
    float* wl = (float*)lds + wave * ATT_WLDS;
    float *qs = wl, *pl = wl + 256, *ps = wl + 512, *sc = wl + 1552; int* sel = (int*)(wl + 1824);
    const int gw = bid * 8 + wave, ngw = nblk * 8;
    for (int it = gw; it < R * 2; it += ngw) {
        const int r = it >> 1, g = it & 1;
        const bool isp = r < TP;
        const int b = isp ? (r >> 12) : (r - TP), t = isp ? (r & 4095) : PAST;
        const int n_sel = isp ? 64 : 257;
        const int n_cmax = isp ? 255 : 1023;
#pragma unroll
        for (int h = 0; h < 4; ++h) qs[h * 64 + lane] = bf2f(p.qn[(size_t)r * 512 + (g * 4 + h) * 64 + lane]);
        for (int i = lane; i < 4 * n_sel + 1; i += 64) ps[i] = 0.f;
        WSYNC();
        int n_c = t >= 31 ? (t - 31) / 16 + 1 : 0; if (n_c > n_cmax) n_c = n_cmax;
        float oc[4] = {0.f, 0.f, 0.f, 0.f};
        {
            const bf16_t* kc = isp ? p.kc + (size_t)(b * 2 + g) * 256 * 64 : p.kcs + (size_t)(b * 2 + g) * 1024 * 64;
            const bf16_t* vc = isp ? p.vc + (size_t)(b * 2 + g) * 256 * 64 : p.vcs + (size_t)(b * 2 + g) * 1024 * 64;
            cmp_branch(qs, pl, ps, kc, vc, n_c, lane, oc);
        }
        const int jt = t >> 6;
        for (int j = lane; j < n_sel; j += 64) {
            float imp = 0.f;
#pragma unroll
            for (int rr = 0; rr < 4; ++rr) imp += ps[4 * j + rr + 1] + ps[4 * j + rr];
            const bool valid = j * 64 <= t, forced = (j == 0) || (j == jt) || (j == jt - 1);
            sc[j] = valid ? (forced ? 1e4f : imp) : -1e30f;
        }
        WSYNC();
        topk16(sc, sel, n_sel, lane);
        float ms[4] = {-1e30f, -1e30f, -1e30f, -1e30f}, lsum[4] = {0.f, 0.f, 0.f, 0.f}, os[4] = {0.f, 0.f, 0.f, 0.f};
        for (int k = 0; k < 16; ++k) {
            const int j = sel[k];
            if (j * 64 > t) continue;
            const bool valid = j * 64 + lane <= t;
            if (isp) {
                const size_t base = ((size_t)(b * 2 + g) * SEQ + (size_t)j * 64) * 64;
                attend64<bf16_t>(qs, pl, p.ks + base, p.vs + base, 64, valid, lane, ms, lsum, os);
            } else if (j == 256) {
                attend64<float>(qs, pl, p.s_slc + (size_t)b * 256 + g * 64, p.s_slc + (size_t)b * 256 + 128 + g * 64, 256, valid, lane, ms, lsum, os);
            } else {
                const int pg = p.page_table[b * NPAGES + (j >> 1)];
                const float* base = p.cache_slc + (((size_t)pg * 128 + (j & 1) * 64) * 4 + g) * 64;
                attend64<float>(qs, pl, base, base + 128, 256, valid, lane, ms, lsum, os);
            }
        }
        float mw[4] = {-1e30f, -1e30f, -1e30f, -1e30f}, lw[4] = {0.f, 0.f, 0.f, 0.f}, ow[4] = {0.f, 0.f, 0.f, 0.f};
        if (isp) {
            const int start = t - 511 > 0 ? t - 511 : 0;
            for (int c0 = start; c0 <= t; c0 += 64) {
                const size_t base = ((size_t)(b * 2 + g) * SEQ + c0) * 64;
                attend64<bf16_t>(qs, pl, p.kw + base, p.vw + base, 64, c0 + lane <= t, lane, mw, lw, ow);
            }
        } else {
            for (int c0 = 0; c0 < 512; c0 += 64) {
                const float* base = p.s_win + ((size_t)b * 512 + c0) * 256 + g * 64;
                attend64<float>(qs, pl, base, base + 128, 256, true, lane, mw, lw, ow);
            }
        }
#pragma unroll
        for (int h = 0; h < 4; ++h) {
            const float* gt = p.gates + (size_t)r * 24 + g * 12 + h * 3;
            const float o = gt[0] * oc[h] + gt[1] * (os[h] / lsum[h]) + gt[2] * (ow[h] / lw[h]);
            const int col = (g * 4 + h) * 64 + lane;
            p.yar[(size_t)r * 1024 + col] = f2bf(o * bf2f(p.ga[(size_t)r * 512 + col]));
        }
    }
}

__device__ __forceinline__ float ret_gamma(int h) { return 1.f - exp2f(-5.f - (float)h); }

__device__ void p6a_local(const Params& p, int bid, int nblk) {
    const int tid = threadIdx.x;
    const int e = tid & 127, dg = tid >> 7;
    for (int it = bid; it < 4 * 4 * 32; it += nblk) {
        const int n = it & 31, h = (it >> 5) & 3, b = it >> 7;
        const float lg = __logf(ret_gamma(h));
        float acc[16];
#pragma unroll
        for (int i = 0; i < 16; ++i) acc[i] = 0.f;
        for (int j = 0; j < 128; ++j) {
            const size_t r = (size_t)b * SEQ + n * 128 + j;
            const float z = __expf(lg * (float)(127 - j));
            const float v = bf2f(p.rv[r * 512 + h * 128 + e]) * z;
            const bf16_t* kr = p.rk + r * 256 + h * 64 + dg * 16;
#pragma unroll
            for (int i = 0; i < 16; ++i) acc[i] += bf2f(kr[i]) * v;
        }
        float* out = p.sloc + ((size_t)it * 64 + dg * 16) * 128 + e;
#pragma unroll
        for (int i = 0; i < 16; ++i) out[i * 128] = acc[i];
    }
}
__device__ void p6b_scan(const Params& p, int bid, int nblk) {
    const size_t gt = (size_t)bid * NT + threadIdx.x, ngt = (size_t)nblk * NT;
    for (size_t i = gt; i < (size_t)16 * 8192; i += ngt) {
        const int bh = (int)(i >> 13), el = (int)(i & 8191), h = bh & 3;
        const float gc = __expf(__logf(ret_gamma(h)) * 128.f);
        float S = 0.f;
        for (int n = 0; n < 32; ++n) {
            const size_t idx = ((size_t)bh * 32 + n) * 8192 + el;
            p.spre[idx] = S;
            S = S * gc + p.sloc[idx];
        }
        p.p_ret[(size_t)bh * 8192 + el] = S;
    }
    for (size_t i = gt; i < (size_t)128 * 8192; i += ngt) {
        const int bh = (int)(i >> 13), el = (int)(i & 8191), h = bh & 3, b = bh >> 2, d = el >> 7, e = el & 127;
        const size_t r = TP + b;
        const float k = bf2f(p.rk[r * 256 + h * 64 + d]), v = bf2f(p.rv[r * 512 + h * 128 + e]);
        p.s_ret[i] = p.state_ret[i] * ret_gamma(h) + k * v;
    }
}
__device__ void p6c_out(const Params& p, char* lds, int bid, int nblk) {
    float* Am = (float*)lds;
    const int tid = threadIdx.x;
    for (int it = bid; it < 4 * 4 * 32 + 128; it += nblk) {
        if (it < 512) {
            const int n = it & 31, h = (it >> 5) & 3, b = it >> 7;
            const float lg = __logf(ret_gamma(h));
            const size_t r0 = (size_t)b * SEQ + n * 128;
            for (int idx = tid; idx < 128 * 128; idx += NT) {
                const int i = idx >> 7, j = idx & 127;
                float a = 0.f;
                if (j <= i) {
                    const bf16_t* qr = p.rq + (r0 + i) * 256 + h * 64; const bf16_t* kr = p.rk + (r0 + j) * 256 + h * 64;
#pragma unroll
                    for (int c = 0; c < 8; ++c) { float qf[8], kf[8]; load8(qr + c * 8, qf); load8(kr + c * 8, kf);
#pragma unroll
                        for (int u = 0; u < 8; ++u) a += qf[u] * kf[u]; }
                    a *= __expf(lg * (float)(i - j));
                }
                Am[i * 129 + j] = a;
            }
            __syncthreads();
            const int e = tid & 127, ig = tid >> 7;
            const float* S = p.spre + (size_t)it * 8192;
            for (int i = ig * 32; i < ig * 32 + 32; ++i) {
                float o = 0.f;
                for (int j = 0; j <= i; ++j) o += Am[i * 129 + j] * bf2f(p.rv[(r0 + j) * 512 + h * 128 + e]);
                float qs = 0.f;
                const bf16_t* qr = p.rq + (r0 + i) * 256 + h * 64;
                for (int d = 0; d < 64; ++d) qs += bf2f(qr[d]) * S[d * 128 + e];
                o += qs * __expf(lg * (float)(i + 1));
                p.oret[(r0 + i) * 512 + h * 128 + e] = o;
            }
            __syncthreads();
        } else {
            const int bh = it - 512, h = bh & 3, b = bh >> 2;
            const size_t r = TP + b;
            if (tid < 128) {
                const int e = tid;
                const bf16_t* qr = p.rq + r * 256 + h * 64; const bf16_t* kr = p.rk + r * 256 + h * 64;
                const float* S0 = p.state_ret + (size_t)bh * 8192;
                float qs = 0.f, qk = 0.f;
                for (int d = 0; d < 64; ++d) { const float q = bf2f(qr[d]); qs += q * S0[d * 128 + e]; qk += q * bf2f(kr[d]); }
                p.oret[r * 512 + h * 128 + e] = qs * ret_gamma(h) + qk * bf2f(p.rv[r * 512 + h * 128 + e]);
            }
        }
    }
}
__device__ void p6d_norm(const Params& p, int bid, int nblk) {
    const int tid = threadIdx.x, lane = tid & 63, wave = tid >> 6;
    for (int it = bid * 8 + wave; it < R * 4; it += nblk * 8) {
        const int r = it >> 2, h = it & 3;
        const float* o = p.oret + (size_t)r * 512 + h * 128;
        const float v0 = o[lane], v1 = o[lane + 64];
        const float rs = rsqrtf(wave_sum(v0 * v0 + v1 * v1) * (1.f / 128.f) + EPS);
        p.yar[(size_t)r * 1024 + 512 + h * 128 + lane] = f2bf(v0 * rs * p.g_ret[lane] * bf2f(p.gr[(size_t)r * 512 + h * 128 + lane]));
        p.yar[(size_t)r * 1024 + 512 + h * 128 + lane + 64] = f2bf(v1 * rs * p.g_ret[lane + 64] * bf2f(p.gr[(size_t)r * 512 + h * 128 + lane + 64]));
    }
}

template <int PH>
__global__ void __launch_bounds__(NT, 2) k_phase(Params p) {
    extern __shared__ __attribute__((aligned(16))) char lds[];
    const int bid = blockIdx.x, nblk = gridDim.x;
    if (PH == 0) { p0_adaln(p, lds, bid, nblk); __syncthreads(); p0_weights(p, lds, bid, nblk); }
    if (PH == 1) p1_norm(p, bid, nblk);
    if (PH == 2) { EpiRaw e{p.praw, NPAD}; gemm_phase(p.H, p.bt_in, RPAD / 256, NPAD / 256, 1024, lds, bid, nblk, e); }
    if (PH == 3) p3_rows(p, bid, nblk);
    if (PH == 4) { p4_compress(p, bid, nblk); p6a_local(p, bid, nblk); }
    if (PH == 5) { p5_attention(p, lds, bid, nblk); p6b_scan(p, bid, nblk); }
    if (PH == 6) p6c_out(p, lds, bid, nblk);
    if (PH == 7) p6d_norm(p, bid, nblk);
    if (PH == 8) { EpiOut e{&p}; gemm_phase(p.yar, p.bt_out, RPAD / 256, 4, 1024, lds, bid, nblk, e); }
}

template <int PH> void launch_phase(const Params& p, int grid, hipStream_t s) {
    static bool init = false;
    if (!init) { hipFuncSetAttribute((const void*)k_phase<PH>, hipFuncAttributeMaxDynamicSharedMemorySize, LDS_BYTES); init = true; }
    hipLaunchKernelGGL(k_phase<PH>, dim3(grid), dim3(NT), LDS_BYTES, s, p);
}
}

extern "C" void kernel_launch(void* const* d_in, const int* in_sizes, int n_in, void* d_out, int out_size, void* d_ws, size_t ws_size, hipStream_t stream) {
    Params p{};
    p.x_prompt = (const float*)d_in[0]; p.x_sample = (const float*)d_in[1]; p.c_prompt = (const float*)d_in[2]; p.c_sample = (const float*)d_in[3];
    p.cache_cmp = (const float*)d_in[4]; p.cache_slc = (const float*)d_in[5]; p.state_win = (const float*)d_in[6]; p.state_ret = (const float*)d_in[7];
    p.page_table = (const int*)d_in[8];
    p.g_norm = (const float*)d_in[9]; p.w_ada = (const float*)d_in[10]; p.b_ada = (const float*)d_in[11]; p.w_in = (const float*)d_in[12];
    p.g_q = (const float*)d_in[13]; p.g_kc = (const float*)d_in[14]; p.g_ks = (const float*)d_in[15]; p.g_kw = (const float*)d_in[16];
    p.pe_ck = (const float*)d_in[17]; p.w_ck1 = (const float*)d_in[18]; p.w_ck2 = (const float*)d_in[19];
    p.pe_cv = (const float*)d_in[20]; p.w_cv1 = (const float*)d_in[21]; p.w_cv2 = (const float*)d_in[22];
    p.g_ret = (const float*)d_in[23]; p.w_out = (const float*)d_in[24];
    float* o = (float*)d_out;
    p.y = o; o += (size_t)R * 1024;
    p.p_cmp = o; o += (size_t)TP * 256; p.p_slc = o; o += (size_t)TP * 256; p.p_win = o; o += (size_t)4 * 512 * 256; p.p_ret = o; o += (size_t)16 * 8192;
    p.s_cmp = o; o += 32 * 256; p.s_slc = o; o += 32 * 256; p.s_win = o; o += (size_t)32 * 512 * 256; p.s_ret = o; o += (size_t)128 * 8192;
    char* w = (char*)d_ws; size_t off = 0;
    auto take = [&](size_t bytes) { char* q = w + off; off += (bytes + 255) & ~(size_t)255; return q; };
    p.bar = (unsigned*)take(16384);
    p.mod = (float*)take(36 * 3072 * 4);
    p.bt_in = (bf16_t*)take((size_t)NPAD * 1024 * 2);
    p.bt_out = (bf16_t*)take((size_t)1024 * 1024 * 2);
    p.H = (bf16_t*)take((size_t)RPAD * 1024 * 2);
    p.praw = (float*)take((size_t)RPAD * NPAD * 4);
    p.qn = (bf16_t*)take((size_t)R * 512 * 2);
    p.kcr = (bf16_t*)take((size_t)TP * 128 * 2); p.vcr = (bf16_t*)take((size_t)TP * 128 * 2);
    p.ks = (bf16_t*)take((size_t)TP * 128 * 2); p.vs = (bf16_t*)take((size_t)TP * 128 * 2);
    p.kw = (bf16_t*)take((size_t)TP * 128 * 2); p.vw = (bf16_t*)take((size_t)TP * 128 * 2);
    p.gates = (float*)take((size_t)R * 24 * 4);
    p.ga = (bf16_t*)take((size_t)R * 512 * 2); p.gr = (bf16_t*)take((size_t)R * 512 * 2);
    p.rq = (bf16_t*)take((size_t)R * 256 * 2); p.rk = (bf16_t*)take((size_t)R * 256 * 2); p.rv = (bf16_t*)take((size_t)R * 512 * 2);
    p.kc = (bf16_t*)take((size_t)4 * 2 * 256 * 64 * 2); p.vc = (bf16_t*)take((size_t)4 * 2 * 256 * 64 * 2);
    p.kcs = (bf16_t*)take((size_t)32 * 2 * 1024 * 64 * 2); p.vcs = (bf16_t*)take((size_t)32 * 2 * 1024 * 64 * 2);
    p.yar = (bf16_t*)take((size_t)RPAD * 1024 * 2);
    p.sloc = (float*)take((size_t)512 * 8192 * 4); p.spre = (float*)take((size_t)512 * 8192 * 4);
    p.oret = (float*)take((size_t)R * 512 * 4);
    if (off > ws_size) { fprintf(stderr, "workspace too small: need %zu have %zu\n", off, ws_size); return; }
    const int grid = 256;
    launch_phase<0>(p, grid, stream);
    launch_phase<1>(p, grid, stream);
    launch_phase<2>(p, grid, stream);
    launch_phase<3>(p, grid, stream);
    launch_phase<4>(p, grid, stream);
    launch_phase<5>(p, grid, stream);
    launch_phase<6>(p, grid, stream);
    launch_phase<7>(p, grid, stream);
    launch_phase<8>(p, grid, stream);
}
```

```cpp
#include <hip/hip_runtime.h>
#include <stdint.h>
#include <stdio.h>

namespace {
typedef unsigned short bf16_t;
typedef short bf16x8 __attribute__((ext_vector_type(8)));
typedef float f32x4 __attribute__((ext_vector_type(4)));

constexpr int D_MODEL = 1024, BATCH = 4, SEQ = 4096, DEC_BATCH = 32, PAST = 16384;
constexpr int NPAGES = 128, NPHYS = 5120;
constexpr int TP = BATCH * SEQ;
constexpr int R = TP + DEC_BATCH;
constexpr int RPAD = 16640;
constexpr int D_IN = 3352, NPAD = 3584;
constexpr int C_Q = 0, C_KC = 512, C_KS = 768, C_KW = 1024, C_BR = 1280, C_GA = 1304, C_RQ = 1816, C_RK = 2072, C_RV = 2328, C_GR = 2840;
constexpr float EPS = 1e-6f;
constexpr int NT = 512;
constexpr int LDS_BYTES = 147456 + 64;

struct Params {
    const float *x_prompt, *x_sample, *c_prompt, *c_sample, *cache_cmp, *cache_slc, *state_win, *state_ret;
    const int* page_table;
    const float *g_norm, *w_ada, *b_ada, *w_in, *g_q, *g_kc, *g_ks, *g_kw, *pe_ck, *w_ck1, *w_ck2, *pe_cv, *w_cv1, *w_cv2, *g_ret, *w_out;
    float *y, *p_cmp, *p_slc, *p_win, *p_ret, *s_cmp, *s_slc, *s_win, *s_ret;
    unsigned* bar;
    float* mod;
    bf16_t* bt_in;
    bf16_t* bt_out;
    bf16_t* H;
    float* praw;
    bf16_t* qn;
    bf16_t *kcr, *vcr, *ks, *vs, *kw, *vw;
    float* gates;
    bf16_t *ga, *gr;
    bf16_t *rq, *rk;
    bf16_t* rv;
    bf16_t *kc, *vc;
    bf16_t *kcs, *vcs;
    bf16_t* yar;
    float *sloc, *spre;
    float* oret;
    bf16_t* w1p;
    bf16_t* w2t;
    float* b1;
    float *seamA, *seamB;
    float* attb;
    float *ropec, *ropes;
};

__device__ __forceinline__ int tile_src(int pn) { return pn <= 4 ? pn * 256 : pn == 13 ? 1280 : 1304 + (pn - 5) * 256; }
__device__ __forceinline__ bf16_t f2bf(float f) { unsigned u = __float_as_uint(f); u += 0x7fffu + ((u >> 16) & 1u); return (bf16_t)(u >> 16); }
__device__ __forceinline__ float bf2f(bf16_t h) { return __uint_as_float(((unsigned)h) << 16); }
__device__ __forceinline__ float wave_sum(float v) {
#pragma unroll
    for (int o = 1; o < 64; o <<= 1) v += __shfl_xor(v, o);
    return v;
}
__device__ __forceinline__ float wave_max(float v) {
#pragma unroll
    for (int o = 1; o < 64; o <<= 1) v = fmaxf(v, __shfl_xor(v, o));
    return v;
}
__device__ __forceinline__ float silu(float v) { return v / (1.f + __expf(-v)); }
__device__ __forceinline__ float sigmoidf(float v) { return 1.f / (1.f + __expf(-v)); }
__device__ __forceinline__ int opaque_tid() { int t = threadIdx.x; asm volatile("" : "+v"(t)); return t; }
typedef __bf16 bf16x2_t __attribute__((ext_vector_type(2)));
typedef float f32x2_t __attribute__((ext_vector_type(2)));
__device__ __forceinline__ unsigned cvt_pk_bf16(float lo, float hi) { const f32x2_t v = {lo, hi}; return __builtin_bit_cast(unsigned, __builtin_convertvector(v, bf16x2_t)); }
#define WSYNC() asm volatile("s_waitcnt lgkmcnt(0)" ::: "memory")

__device__ __forceinline__ void load8(const bf16_t* p, float (&f)[8]) {
    uint4 u = *(const uint4*)p;
    f[0] = __uint_as_float(u.x << 16); f[1] = __uint_as_float(u.x & 0xffff0000u);
    f[2] = __uint_as_float(u.y << 16); f[3] = __uint_as_float(u.y & 0xffff0000u);
    f[4] = __uint_as_float(u.z << 16); f[5] = __uint_as_float(u.z & 0xffff0000u);
    f[6] = __uint_as_float(u.w << 16); f[7] = __uint_as_float(u.w & 0xffff0000u);
}
__device__ __forceinline__ void load8(const float* p, float (&f)[8]) {
    float4 a = *(const float4*)p, b = *(const float4*)(p + 4);
    f[0] = a.x; f[1] = a.y; f[2] = a.z; f[3] = a.w; f[4] = b.x; f[5] = b.y; f[6] = b.z; f[7] = b.w;
}
__device__ __forceinline__ float load1(const bf16_t* p) { return bf2f(*p); }
__device__ __forceinline__ float load1(const float* p) { return *p; }


#define XB_TMO      128
#define XB_XCNT(j)  (256  + 64 * (j))
#define XB_XSUB(j)  (1280 + 64 * (j))
#define XB_XGEN(j)  (2304 + 64 * (j))
#define XB_TOP      3328
#define XB_TOPGEN   3392
#define XCD_BAR_WORDS 3456
#define XB_SPIN_CAP (1u << 18)
#define LAS __attribute__((address_space(3)))
__device__ __forceinline__ unsigned xb_ld(unsigned* p)              { return __hip_atomic_load(p, __ATOMIC_RELAXED, __HIP_MEMORY_SCOPE_AGENT); }
__device__ __forceinline__ unsigned xb_add(unsigned* p, unsigned v) { return __hip_atomic_fetch_add(p, v, __ATOMIC_RELAXED, __HIP_MEMORY_SCOPE_AGENT); }
__device__ __forceinline__ unsigned xb_xcc_id() { return (unsigned)__builtin_amdgcn_s_getreg((3 << 11) | 20) & 0xFu; }
#define XB_SPIN(cond, bar) do { unsigned _sp = 0; while (cond) { __builtin_amdgcn_s_sleep(1); \
    if ((++_sp & 255u) == 0u) { if (xb_ld(&(bar)[XB_TMO])) break; if (_sp > XB_SPIN_CAP) { atomicAdd(&(bar)[XB_TMO], 1u); break; } } } } while (0)
struct XcdBarrier { unsigned* bar; unsigned x; volatile LAS unsigned* st; };
__device__ __forceinline__ XcdBarrier xcd_barrier_post(unsigned* bar, volatile LAS unsigned* st) {
    XcdBarrier b; b.bar = bar; b.x = xb_xcc_id(); b.st = st;
    if (threadIdx.x == 0) (void)xb_add(&bar[XB_XCNT(b.x)], 1u);
    return b;
}
__device__ __forceinline__ void xcd_barrier_complete(unsigned* bar, unsigned x, unsigned& nloc, unsigned& nx) {
    const unsigned G = gridDim.x * gridDim.y * gridDim.z;
    unsigned sum, cnt, mine, sp = 0u;
    for (;;) {
        sum = 0u; cnt = 0u; mine = 0u;
#pragma unroll
        for (unsigned j = 0; j < 16; ++j) { const unsigned c = xb_ld(&bar[XB_XCNT(j)]); sum += c; cnt += (c > 0u) ? 1u : 0u; mine = (j == x) ? c : mine; }
        if (sum == G) break;
        __builtin_amdgcn_s_sleep(1);
        if ((++sp & 255u) == 0u) { if (xb_ld(&bar[XB_TMO])) break; if (sp > XB_SPIN_CAP) { atomicAdd(&bar[XB_TMO], 1u); break; } }
    }
    nloc = mine > 0u ? mine : 1u; nx = cnt > 0u ? cnt : 1u;
}
__device__ __forceinline__ void xcd_barrier(const XcdBarrier& b) {
    asm volatile("s_waitcnt vmcnt(0)" ::: "memory");
    __syncthreads();
    if (threadIdx.x == 0) {
        unsigned* bar = b.bar;
        __builtin_amdgcn_s_waitcnt(0);
        unsigned nloc = b.st[0], nx = b.st[1];
        if (nloc == 0u) { xcd_barrier_complete(bar, b.x, nloc, nx); b.st[0] = nloc; b.st[1] = nx; }
        const unsigned old = xb_add(&bar[XB_XSUB(b.x)], 1u);
        const unsigned gen = old / nloc;
        if (old + 1u == (gen + 1u) * nloc) {
            __builtin_amdgcn_fence(__ATOMIC_RELEASE, "agent");
            asm volatile("s_waitcnt vmcnt(0)" ::: "memory");
            const unsigned og = xb_add(&bar[XB_TOP], 1u);
            const unsigned tg = og / nx;
            if (og + 1u == (tg + 1u) * nx) xb_add(&bar[XB_TOPGEN], 1u);
            else XB_SPIN(xb_ld(&bar[XB_TOPGEN]) == tg, bar);
            __builtin_amdgcn_fence(__ATOMIC_ACQUIRE, "agent");
            xb_add(&bar[XB_XGEN(b.x)], 1u);
            asm volatile("s_waitcnt vmcnt(0)" ::: "memory");
        } else {
            XB_SPIN(xb_ld(&bar[XB_XGEN(b.x)]) == gen, bar);
            __builtin_amdgcn_fence(__ATOMIC_ACQUIRE, "agent");
            asm volatile("s_waitcnt vmcnt(0)" ::: "memory");
        }
    }
    __syncthreads();
}


__device__ __forceinline__ void wg_signal(unsigned* ctr, bool need_release) {
    asm volatile("s_waitcnt vmcnt(0)" ::: "memory");
    __syncthreads();
    if (threadIdx.x == 0) {
        if (need_release) { __builtin_amdgcn_fence(__ATOMIC_RELEASE, "agent"); asm volatile("s_waitcnt vmcnt(0)" ::: "memory"); }
        (void)__hip_atomic_fetch_add(ctr, 1u, __ATOMIC_RELAXED, __HIP_MEMORY_SCOPE_AGENT);
    }
}
__device__ __forceinline__ void wg_wait(unsigned* ctr, unsigned target, unsigned* tmo) {
    if (threadIdx.x == 0) {
        unsigned sp = 0;
        while (__hip_atomic_load(ctr, __ATOMIC_RELAXED, __HIP_MEMORY_SCOPE_AGENT) < target) {
            __builtin_amdgcn_s_sleep(2);
            if (++sp > (1u << 22)) { atomicAdd(tmo, 1u); break; }
        }
        __builtin_amdgcn_fence(__ATOMIC_ACQUIRE, "agent");
        asm volatile("s_waitcnt vmcnt(0)" ::: "memory");
    }
    __syncthreads();
}
__device__ __forceinline__ void p0_adaln(const Params& p, char* lds, int bid, int nblk) {
    float* sc = (float*)lds;
    float* red = (float*)(lds + 73728);
    const int tid = opaque_tid(), lane = tid & 63, wave = tid >> 6;
    for (int item = bid; item < 96; item += nblk) {
        const int cb = item >> 1, r0 = (item & 1) * 18;
        __syncthreads();
        for (int i = tid; i < 18 * 1024; i += NT) {
            const int row = r0 + (i >> 10), k = i & 1023;
            sc[i] = silu(row < 4 ? p.c_prompt[row * 1024 + k] : p.c_sample[(row - 4) * 1024 + k]);
        }
        __syncthreads();
        const int j = cb * 64 + lane;
        float acc[18];
#pragma unroll
        for (int r = 0; r < 18; ++r) acc[r] = 0.f;
        const int k0 = wave * 128;
#pragma unroll 2
        for (int k = k0; k < k0 + 128; k += 4) {
            const float w0 = p.w_ada[(size_t)k * 3072 + j], w1 = p.w_ada[(size_t)(k + 1) * 3072 + j], w2 = p.w_ada[(size_t)(k + 2) * 3072 + j], w3 = p.w_ada[(size_t)(k + 3) * 3072 + j];
#pragma unroll
            for (int r = 0; r < 18; ++r) { const float4 s = *(const float4*)(sc + r * 1024 + k); acc[r] += s.x * w0 + s.y * w1 + s.z * w2 + s.w * w3; }
        }
#pragma unroll
        for (int r = 0; r < 18; ++r) red[(wave * 18 + r) * 64 + lane] = acc[r];
        __syncthreads();
        for (int i = tid; i < 18 * 64; i += NT) {
            const int r = i >> 6, l = i & 63;
            float s = 0.f;
#pragma unroll
            for (int w = 0; w < 8; ++w) s += red[(w * 18 + r) * 64 + l];
            __hip_atomic_store(&p.mod[(r0 + r) * 3072 + cb * 64 + l], s + p.b_ada[cb * 64 + l], __ATOMIC_RELAXED, __HIP_MEMORY_SCOPE_AGENT);
        }
        wg_signal(p.bar + 3520, false);
    }
}

__device__ __forceinline__ void transpose_item(const float* W, int K, int N, bf16_t* WT, float* scr, int item, int lane, int nblkN) {
    const int kb = item / nblkN, nb = item % nblkN, k0 = kb * 64, n0 = nb * 64;
    float tv[64];
#pragma unroll
    for (int kk = 0; kk < 64; ++kk) tv[kk] = (n0 + lane < N) ? W[(size_t)(k0 + kk) * N + n0 + lane] : 0.f;
#pragma unroll
    for (int kk = 0; kk < 64; ++kk) scr[kk * 65 + lane] = tv[kk];
    WSYNC();
    for (int nn = 0; nn < 64; ++nn) WT[(size_t)(n0 + nn) * K + k0 + lane] = f2bf(scr[lane * 65 + nn]);
    WSYNC();
}
__device__ __forceinline__ void p0_weights(const Params& p, char* lds, int bid, int nblk) {
    const int tid = opaque_tid(), lane = tid & 63, wave = tid >> 6;
    float* scr = (float*)lds + wave * (64 * 65);
    const int gw = bid * 8 + wave, ngw = nblk * 8;
    constexpr int I_IN = 16 * 112, I_OUT = 16 * 16;
    for (int it = gw; it < I_IN + I_OUT; it += ngw) {
        if (it < I_IN) {
            const int kb = it / 112, nb = it % 112, k0 = kb * 64, n0 = nb * 32;
            const int pn = n0 >> 8, pl = n0 & 255, bj = pl >> 7, wc = (pl >> 5) & 3;
            const int cb = tile_src(pn) + wc * 64 + bj * 32;
            const int lim = pn == 13 ? 1304 : D_IN;
            float tv[32];
#pragma unroll
            for (int i = 0; i < 32; ++i) { const int kk = 2 * i + (lane >> 5), c = cb + (lane & 31); tv[i] = c < lim ? p.w_in[(size_t)(k0 + kk) * D_IN + c] : 0.f; }
#pragma unroll
            for (int i = 0; i < 32; ++i) scr[(2 * i + (lane >> 5)) * 33 + (lane & 31)] = tv[i];
            WSYNC();
            const int c8 = lane & 7;
            for (int j = 0; j < 4; ++j) {
                const int n = (lane >> 3) + 8 * j; const float* s = scr + (8 * c8) * 33 + n;
                uint4 o; o.x = cvt_pk_bf16(s[0], s[33]); o.y = cvt_pk_bf16(s[66], s[99]); o.z = cvt_pk_bf16(s[132], s[165]); o.w = cvt_pk_bf16(s[198], s[231]);
                *(uint4*)(p.bt_in + (size_t)(n0 + n) * 1024 + k0 + 8 * c8) = o;
            }
            WSYNC();
        } else transpose_item(p.w_out, 1024, 1024, p.bt_out, scr, it - I_IN, lane, 16);
    }
    const size_t gt = (size_t)bid * NT + tid, ngt = (size_t)nblk * NT;
    for (size_t i = gt; i < (size_t)4097 * 32; i += ngt) {
        const int pi = (int)(i >> 5), fi = (int)i & 31;
        const float ang = (float)(pi < 4096 ? pi : PAST) * powf(10000.f, -(float)fi / 32.f);
        float sn, cs; sincosf(ang, &sn, &cs);
        p.ropec[i] = cs; p.ropes[i] = sn;
    }
    if (bid == (nblk > 200 ? 200 : 0) && wave == 0) {
        const float gq = wave_max(fabsf(p.g_q[lane])), gc = wave_max(fabsf(p.g_kc[lane])), gs = wave_max(fabsf(p.g_ks[lane])), gw = wave_max(fabsf(p.g_kw[lane]));
        if (lane == 0) { const float k = 8.f * 1.03f * 1.44269504088896f * gq; p.attb[0] = k * gc; p.attb[1] = k * gs; p.attb[2] = k * gw; p.attb[3] = 0.f; }
    }
    for (size_t i = gt; i < (size_t)2 * 128 * 1024; i += ngt) {
        const int kv = (int)(i >> 17), n = (int)(i >> 10) & 127, kp = (int)i & 1023;
        const int ks = kp >> 5, G = (kp >> 3) & 3, j = kp & 7;
        const int k = ks * 32 + 16 * (j >> 2) + 4 * G + (j & 3);
        const int l = (k >> 6) + (n >= 64 ? 16 : 0), d = k & 63, f = n & 63;
        p.w1p[i] = f2bf((kv ? p.w_cv1 : p.w_ck1)[(size_t)(l * 64 + d) * 64 + f]);
    }
    for (size_t i = gt; i < (size_t)2 * 64 * 64; i += ngt) {
        const int kv = (int)(i >> 12), d = (int)(i >> 6) & 63, f = (int)i & 63;
        p.w2t[i] = f2bf((kv ? p.w_cv2 : p.w_ck2)[f * 64 + d]);
    }
    for (int o = bid * 8 + wave; o < 128; o += nblk * 8) {
        const int kv = o >> 6, f = o & 63;
        const float* w1 = kv ? p.w_cv1 : p.w_ck1; const float* pe = kv ? p.pe_cv : p.pe_ck;
        float s = 0.f;
        for (int k = lane; k < 2048; k += 64) s += pe[k] * w1[(size_t)k * 64 + f];
        s = wave_sum(s);
        if (lane == 0) p.b1[o] = s;
    }
    for (size_t i = gt; i < (size_t)2 * 8 * 64; i += ngt) {
        const int which = (int)(i >> 9), bg = (int)(i >> 6) & 7, d = (int)i & 63;
        (which ? p.vc : p.kc)[((size_t)bg * 256 + 255) * 64 + d] = 0;
    }
    for (size_t i = gt; i < (size_t)32 * 511 * 64; i += ngt) {
        const int b = (int)(i / (511 * 64)), rem = (int)(i % (511 * 64));
        const float4 v = *(const float4*)(p.state_win + (size_t)b * 512 * 256 + 256 + (size_t)rem * 4);
        *(float4*)(p.s_win + (size_t)b * 512 * 256 + (size_t)rem * 4) = v;
    }
}

__device__ __forceinline__ void p1_norm(const Params& p, char* lds, int bid, int nblk) {
    const int tid = opaque_tid(), lane = tid & 63, wave = tid >> 6;
    volatile int* slot = (volatile int*)(lds + 147456 + 16);
    for (;;) {
        __syncthreads();
        if (tid == 0) *slot = (int)__hip_atomic_fetch_add(p.bar + 3456 + 32, 1u, __ATOMIC_RELAXED, __HIP_MEMORY_SCOPE_AGENT);
        __syncthreads();
        const int chunk = *slot;
        if (chunk * 32 >= R) break;
      float4 xn[4];
      { const int r = chunk * 32 + wave;
        if (r < R) { const float* xr = r < TP ? p.x_prompt + (size_t)r * 1024 : p.x_sample + (size_t)(r - TP) * 1024;
#pragma unroll
          for (int j = 0; j < 4; ++j) xn[j] = *(const float4*)(xr + j * 256 + lane * 4); } }
      for (int r = chunk * 32 + wave; r < R && r < chunk * 32 + 32; r += 8) {
        const int mrow = r < TP ? (r >> 12) : 4 + (r - TP);
        const float* shift = p.mod + mrow * 3072, *scale = shift + 1024;
        float4 v[4], g[4], sc[4], sh[4]; float ss = 0.f;
#pragma unroll
        for (int j = 0; j < 4; ++j) { v[j] = xn[j]; const int c = j * 256 + lane * 4; g[j] = *(const float4*)(p.g_norm + c); sc[j] = *(const float4*)(scale + c); sh[j] = *(const float4*)(shift + c); }
        { const int rn = r + 8;
          if (rn < R && rn < chunk * 32 + 32) { const float* xr = rn < TP ? p.x_prompt + (size_t)rn * 1024 : p.x_sample + (size_t)(rn - TP) * 1024;
#pragma unroll
            for (int j = 0; j < 4; ++j) xn[j] = *(const float4*)(xr + j * 256 + lane * 4); } }
#pragma unroll
        for (int j = 0; j < 4; ++j) ss += v[j].x * v[j].x + v[j].y * v[j].y + v[j].z * v[j].z + v[j].w * v[j].w;
        const float rs = rsqrtf(wave_sum(ss) * (1.f / 1024.f) + EPS);
#pragma unroll
        for (int j = 0; j < 4; ++j) {
            const int c = j * 256 + lane * 4;
            ushort4 o;
            o.x = f2bf(v[j].x * rs * g[j].x * (1.f + sc[j].x) + sh[j].x);
            o.y = f2bf(v[j].y * rs * g[j].y * (1.f + sc[j].y) + sh[j].y);
            o.z = f2bf(v[j].z * rs * g[j].z * (1.f + sc[j].z) + sh[j].z);
            o.w = f2bf(v[j].w * rs * g[j].w * (1.f + sc[j].w) + sh[j].w);
            *(ushort4*)(p.H + (size_t)r * 1024 + c) = o;
        }
      }
    }
}

constexpr int BM = 256, BK = 64, HALF = 128, HT = HALF * BK;
__device__ __forceinline__ int lds_byte(int r, int c) {
    int st = (r >> 4) * 2 + (c >> 5), rr = r & 15, cc = c & 31, ob = rr * 64 + cc * 2;
    return st * 1024 + (ob ^ (((ob >> 9) & 1) << 5));
}
__device__ __forceinline__ void stage_rc(int b, int& Rr, int& Cc) {
    int st = b / 1024, sb = b % 1024, swz = sb ^ (((sb >> 9) & 1) << 5);
    Rr = (st >> 1) * 16 + swz / 64; Cc = (st & 1) * 32 + (swz % 64) / 2;
}

template <class Epi>
__device__ __forceinline__ void gemm_phase(const bf16_t* __restrict__ A, const bf16_t* __restrict__ Bt, int nM, int nN, int K, char* lds, int bid, int nblk, const Epi& epi) {
    bf16_t* shm = (bf16_t*)lds;
#define SA(b, h) (shm + ((b) * 2 + (h)) * HT)
#define SB(b, h) (shm + (4 + (b) * 2 + (h)) * HT)
#define STAGE_X(T, P, BASE, br, kt) do { long _g = (long)(br) * K + (long)(kt) * BK; \
    for (int _i = 0; _i < 2; ++_i) { int _b = (T) * 16 + _i * 8192; int _r, _c; stage_rc(_b, _r, _c); \
      __builtin_amdgcn_global_load_lds((const unsigned*)(BASE + _g + (long)_r * K + _c), \
        (__attribute__((address_space(3))) unsigned*)((char*)(P) + _b), 16, 0, 0); } } while (0)
#define STAGE(P, BASE, br, kt) STAGE_X(tz0, P, BASE, br, kt)
#define LDA(dst, b, h) for (int m = 0; m < 4; ++m) for (int k = 0; k < 2; ++k) \
    dst[m][k] = *reinterpret_cast<const bf16x8*>((char*)SA(b, h) + lds_byte(wr * 64 + m * 16 + fr, k * 32 + fq * 8))
#define LDB(dst, b, h) for (int n = 0; n < 2; ++n) for (int k = 0; k < 2; ++k) \
    dst[n][k] = *reinterpret_cast<const bf16x8*>((char*)SB(b, h) + lds_byte(wc * 32 + n * 16 + fr, k * 32 + fq * 8))
#define MMA(ai, bj, At, Bt_) do { __builtin_amdgcn_s_setprio(1); \
    for (int m = 0; m < 4; ++m) for (int n = 0; n < 2; ++n) for (int k = 0; k < 2; ++k) \
      acc[ai][bj][m][n] = __builtin_amdgcn_mfma_f32_16x16x32_bf16(Bt_[n][k], At[m][k], acc[ai][bj][m][n], 0, 0, 0); \
    __builtin_amdgcn_s_setprio(0); } while (0)
#define WAIT_V(n) asm volatile("s_waitcnt vmcnt(" #n ")" ::: "memory")
#define WAIT_L(n) asm volatile("s_waitcnt lgkmcnt(" #n ")" ::: "memory")
#define BAR __builtin_amdgcn_s_barrier()
#define SCHED __builtin_amdgcn_sched_barrier(0)
    const int nwg = nM * nN;
    for (int tile = bid; tile < nwg; tile += nblk) {
        const int pm = tile / nN, pn = tile % nN;
        const int brow = pm * BM, bcol = pn * BM;
        int tz0 = threadIdx.x; asm volatile("" : "+v"(tz0));
        int wid = tz0 >> 6, lane = tz0 & 63, wr = wid >> 2, wc = wid & 3, fr = lane & 15, fq = lane >> 4;
        f32x4 acc[2][2][4][2] = {};
        bf16x8 At[4][2], B0[2][2], B1[2][2];
        const int nt = K / BK;
        STAGE(SB(0, 0), Bt, bcol, 0); STAGE(SA(0, 0), A, brow, 0);
        STAGE(SB(0, 1), Bt, bcol + HALF, 0); STAGE(SA(0, 1), A, brow + HALF, 0);
        if (wr == 1) BAR;
        WAIT_V(4); BAR;
        STAGE(SB(1, 0), Bt, bcol, 1); STAGE(SA(1, 0), A, brow, 1); STAGE(SB(1, 1), Bt, bcol + HALF, 1);
        WAIT_V(6); BAR;
        for (int t = 0; t < nt - 2; t += 2) {
            LDB(B0, 0, 0); SCHED; LDA(At, 0, 0); STAGE(SA(1, 1), A, brow + HALF, t + 1);
            WAIT_L(8); BAR; WAIT_L(0); MMA(0, 0, At, B0); BAR; SCHED;
            LDB(B1, 0, 1); STAGE(SB(0, 0), Bt, bcol, t + 2);
            BAR; WAIT_L(0); MMA(0, 1, At, B1); BAR;
            LDA(At, 0, 1); STAGE(SA(0, 0), A, brow, t + 2);
            BAR; WAIT_L(0); MMA(1, 0, At, B0); BAR; SCHED;
            STAGE(SB(0, 1), Bt, bcol + HALF, t + 2);
            WAIT_V(6); BAR; MMA(1, 1, At, B1); BAR;
            LDB(B0, 1, 0); SCHED; LDA(At, 1, 0); STAGE(SA(0, 1), A, brow + HALF, t + 2);
            WAIT_L(8); BAR; WAIT_L(0); MMA(0, 0, At, B0); BAR; SCHED;
            LDB(B1, 1, 1); STAGE(SB(1, 0), Bt, bcol, t + 3);
            BAR; WAIT_L(0); MMA(0, 1, At, B1); BAR;
            LDA(At, 1, 1); STAGE(SA(1, 0), A, brow, t + 3);
            BAR; WAIT_L(0); MMA(1, 0, At, B0); BAR; SCHED;
            STAGE(SB(1, 1), Bt, bcol + HALF, t + 3);
            WAIT_V(6); BAR; MMA(1, 1, At, B1); BAR;
        }
        int tz = threadIdx.x; asm volatile("" : "+v"(tz)); wid = tz >> 6; lane = tz & 63; wr = wid >> 2; wc = wid & 3; fr = lane & 15; fq = lane >> 4;
        { LDB(B0, 0, 0); WAIT_V(0); LDA(At, 0, 0); STAGE_X(tz, SA(1, 1), A, brow + HALF, nt - 1);
          BAR; WAIT_L(0); MMA(0, 0, At, B0); BAR;
          LDB(B1, 0, 1); BAR; WAIT_L(0); MMA(0, 1, At, B1); BAR;
          LDA(At, 0, 1); WAIT_V(4); BAR; WAIT_L(0); MMA(1, 0, At, B0); MMA(1, 1, At, B1); BAR; }
        { LDB(B0, 1, 0); LDA(At, 1, 0); WAIT_V(2); BAR; WAIT_L(0); MMA(0, 0, At, B0); BAR;
          LDB(B1, 1, 1); WAIT_V(0); BAR; WAIT_L(0); MMA(0, 1, At, B1); BAR;
          LDA(At, 1, 1); BAR; WAIT_L(0); MMA(1, 0, At, B0); MMA(1, 1, At, B1); BAR; }
        if (wr == 0) BAR;
        epi(acc, brow, bcol, wr, wc, fr, fq);
    }
#undef SA
#undef SB
#undef STAGE_X
#undef STAGE
#undef LDA
#undef LDB
#undef MMA
}

struct EpiOut {
    const Params* p;
    __device__ __forceinline__ void operator()(const f32x4 (&acc)[2][2][4][2], int brow, int bcol, int wr, int wc, int fr, int fq) const {
        const float* gate = p->mod + (brow >> 12) * 3072 + 2048;
        float4 gv[2][2];
#pragma unroll
        for (int bj = 0; bj < 2; ++bj)
#pragma unroll
            for (int nt = 0; nt < 2; ++nt) gv[bj][nt] = *(const float4*)(gate + bcol + bj * HALF + wc * 32 + nt * 16 + 4 * fq);
        float4 xv[2][2][2];
#define EPO_LOAD(buf, rg) do { const float* _x = p->x_prompt + (size_t)(brow + ((rg) >> 2) * HALF + wr * 64 + ((rg) & 3) * 16 + fr) * 1024 + bcol + wc * 32 + 4 * fq; \
        xv[buf][0][0] = *(const float4*)(_x); xv[buf][0][1] = *(const float4*)(_x + 16); xv[buf][1][0] = *(const float4*)(_x + HALF); xv[buf][1][1] = *(const float4*)(_x + HALF + 16); } while (0)
        EPO_LOAD(0, 0);
#pragma unroll
        for (int rg = 0; rg < 8; ++rg) {
            const int ai = rg >> 2, mt = rg & 3, cur = rg & 1;
            if (rg + 1 < 8) EPO_LOAD(cur ^ 1, rg + 1);
            float* yr = p->y + (size_t)(brow + ai * HALF + wr * 64 + mt * 16 + fr) * 1024 + bcol + wc * 32 + 4 * fq;
#pragma unroll
            for (int bj = 0; bj < 2; ++bj)
#pragma unroll
                for (int nt = 0; nt < 2; ++nt) {
                    float4 o; o.x = xv[cur][bj][nt].x + gv[bj][nt].x * acc[ai][bj][mt][nt][0]; o.y = xv[cur][bj][nt].y + gv[bj][nt].y * acc[ai][bj][mt][nt][1];
                    o.z = xv[cur][bj][nt].z + gv[bj][nt].z * acc[ai][bj][mt][nt][2]; o.w = xv[cur][bj][nt].w + gv[bj][nt].w * acc[ai][bj][mt][nt][3];
                    *(float4*)(yr + bj * HALF + nt * 16) = o;
                }
        }
#undef EPO_LOAD
    }
};

struct EpiIn {
    const Params* p;
    __device__ __forceinline__ void operator()(const f32x4 (&acc)[2][2][4][2], int brow, int bcol, int wr, int wc, int fr, int fq) const {
        const int pn = bcol >> 8;
        const Params& P = *p;
        const bool normt = pn <= 1 || ((pn == 3 || pn == 4) && wc < 2);
        float4 g4h[2][2];
        { const float* gn = pn <= 1 ? P.g_q : pn == 3 ? P.g_ks : P.g_kw;
#pragma unroll
          for (int bj = 0; bj < 2; ++bj)
#pragma unroll
            for (int nt = 0; nt < 2; ++nt) g4h[bj][nt] = normt ? *(const float4*)(gn + bj * 32 + nt * 16 + 4 * fq) : make_float4(1.f, 1.f, 1.f, 1.f); }
#pragma unroll
        for (int ai = 0; ai < 2; ++ai)
#pragma unroll
            for (int mt = 0; mt < 4; ++mt) {
                const int r = brow + ai * HALF + wr * 64 + mt * 16 + fr;
                const bool rowok = r < R;
                const bool isp = r < TP;
                const int b = isp ? (r >> 12) : (r - TP), t = isp ? (r & 4095) : 0, pidx = isp ? t : 4096;
                f32x4 v[2][2];
#pragma unroll
                for (int bj = 0; bj < 2; ++bj)
#pragma unroll
                    for (int nt = 0; nt < 2; ++nt) v[bj][nt] = acc[ai][bj][mt][nt];
                if (normt) {
                    float ss = 0.f;
#pragma unroll
                    for (int bj = 0; bj < 2; ++bj)
#pragma unroll
                        for (int nt = 0; nt < 2; ++nt)
#pragma unroll
                            for (int rg = 0; rg < 4; ++rg) ss += v[bj][nt][rg] * v[bj][nt][rg];
                    ss += __shfl_xor(ss, 16); ss += __shfl_xor(ss, 32);
                    const float rs = rsqrtf(ss * (1.f / 64.f) + EPS);
#pragma unroll
                    for (int bj = 0; bj < 2; ++bj)
#pragma unroll
                        for (int nt = 0; nt < 2; ++nt) {
                            const float4 g4 = g4h[bj][nt];
                            v[bj][nt][0] *= rs * g4.x; v[bj][nt][1] *= rs * g4.y; v[bj][nt][2] *= rs * g4.z; v[bj][nt][3] *= rs * g4.w;
                        }
                }
                if (!rowok) continue;
                if (pn == 7 || pn == 8) {
                    const float lgm = __log2f(1.f - exp2f(-5.f - (float)wc)) * (float)((isp ? t : PAST) & 127);
                    const float sc = pn == 7 ? exp2f(lgm) : 0.125f * exp2f(-lgm);
#pragma unroll
                    for (int nt = 0; nt < 2; ++nt) {
                        const float4 c4 = *(const float4*)(P.ropec + (size_t)pidx * 32 + nt * 16 + 4 * fq), s4 = *(const float4*)(P.ropes + (size_t)pidx * 32 + nt * 16 + 4 * fq);
                        const f32x4 x1 = v[0][nt], x2 = v[1][nt];
                        v[0][nt][0] = (x1[0] * c4.x - x2[0] * s4.x) * sc; v[1][nt][0] = (x1[0] * s4.x + x2[0] * c4.x) * sc;
                        v[0][nt][1] = (x1[1] * c4.y - x2[1] * s4.y) * sc; v[1][nt][1] = (x1[1] * s4.y + x2[1] * c4.y) * sc;
                        v[0][nt][2] = (x1[2] * c4.z - x2[2] * s4.z) * sc; v[1][nt][2] = (x1[2] * s4.z + x2[2] * c4.z) * sc;
                        v[0][nt][3] = (x1[3] * c4.w - x2[3] * s4.w) * sc; v[1][nt][3] = (x1[3] * s4.w + x2[3] * c4.w) * sc;
                    }
                }
                if (pn == 5 || pn == 6 || pn == 11 || pn == 12) {
#pragma unroll
                    for (int bj = 0; bj < 2; ++bj)
#pragma unroll
                        for (int nt = 0; nt < 2; ++nt)
#pragma unroll
                            for (int rg = 0; rg < 4; ++rg) v[bj][nt][rg] = silu(v[bj][nt][rg]);
                }
                bf16_t* bdst = nullptr; float* fdst = nullptr;
                if (pn <= 1) bdst = P.qn + (size_t)r * 512 + (pn * 4 + wc) * 64;
                else if (pn == 2) fdst = (isp ? P.p_cmp + (size_t)r * 256 : P.s_cmp + (size_t)b * 256) + wc * 64;
                else if (pn == 3) { fdst = (isp ? P.p_slc + (size_t)r * 256 : P.s_slc + (size_t)b * 256) + wc * 64;
                                    if (isp) bdst = (wc < 2 ? P.ks : P.vs) + ((size_t)(b * 2 + (wc & 1)) * SEQ + t) * 64; }
                else if (pn == 4) { fdst = isp ? (t >= SEQ - 512 ? P.p_win + ((size_t)b * 512 + (t - (SEQ - 512))) * 256 + wc * 64 : nullptr) : P.s_win + ((size_t)b * 512 + 511) * 256 + wc * 64;
                                    if (isp) bdst = (wc < 2 ? P.kw : P.vw) + ((size_t)(b * 2 + (wc & 1)) * SEQ + t) * 64; }
                else if (pn == 5 || pn == 6) bdst = P.ga + (size_t)r * 512 + (pn - 5) * 256 + wc * 64;
                else if (pn == 7) bdst = P.rq + (size_t)r * 256 + wc * 64;
                else if (pn == 8) bdst = P.rk + (size_t)r * 256 + wc * 64;
                else if (pn == 9 || pn == 10) bdst = P.rv + (size_t)r * 512 + (pn - 9) * 256 + wc * 64;
                else if (pn == 11 || pn == 12) bdst = P.gr + (size_t)r * 512 + (pn - 11) * 256 + wc * 64;
                if (pn == 13) {
                    if (wc == 0) {
                        float* gd = P.gates + (size_t)r * 24;
                        { float4 o; o.x = sigmoidf(v[0][0][0]); o.y = sigmoidf(v[0][0][1]); o.z = sigmoidf(v[0][0][2]); o.w = sigmoidf(v[0][0][3]); *(float4*)(gd + 4 * fq) = o; }
                        if (fq < 2) { float4 o; o.x = sigmoidf(v[0][1][0]); o.y = sigmoidf(v[0][1][1]); o.z = sigmoidf(v[0][1][2]); o.w = sigmoidf(v[0][1][3]); *(float4*)(gd + 16 + 4 * fq) = o; }
                    }
                    continue;
                }
#pragma unroll
                for (int bj = 0; bj < 2; ++bj)
#pragma unroll
                    for (int nt = 0; nt < 2; ++nt) {
                        const int cl = bj * 32 + nt * 16 + 4 * fq;
                        if (fdst) { float4 o; o.x = v[bj][nt][0]; o.y = v[bj][nt][1]; o.z = v[bj][nt][2]; o.w = v[bj][nt][3]; *(float4*)(fdst + cl) = o; }
                        if (bdst) { uint2 o; o.x = cvt_pk_bf16(v[bj][nt][0], v[bj][nt][1]); o.y = cvt_pk_bf16(v[bj][nt][2], v[bj][nt][3]); *(uint2*)(bdst + cl) = o; }
                    }
            }
    }
};

__device__ __forceinline__ void p3_rows(const Params& p, int bid, int nblk) {
    const int tid = opaque_tid(), lane = tid & 63, wave = tid >> 6;
    for (int r = bid * 8 + wave; r < R; r += nblk * 8) {
        const float* pr = p.praw + (size_t)r * NPAD;
        const bool isp = r < TP;
        const int b = isp ? (r >> 12) : (r - TP), t = isp ? (r & 4095) : 0;
        const int pos = isp ? t : PAST;
        {
            const float gq = p.g_q[lane];
            for (int hh = 0; hh < 8; ++hh) {
                const float v = pr[C_Q + hh * 64 + lane];
                const float rs = rsqrtf(wave_sum(v * v) * (1.f / 64.f) + EPS);
                p.qn[(size_t)r * 512 + hh * 64 + lane] = f2bf(v * rs * gq);
            }
        }
        float* o_cmp = isp ? p.p_cmp + (size_t)r * 256 : p.s_cmp + (size_t)b * 256;
        float* o_slc = isp ? p.p_slc + (size_t)r * 256 : p.s_slc + (size_t)b * 256;
        float* o_win = isp ? (t >= SEQ - 512 ? p.p_win + ((size_t)b * 512 + (t - (SEQ - 512))) * 256 : nullptr) : p.s_win + ((size_t)b * 512 + 511) * 256;
        for (int j = 0; j < 4; ++j) {
            const int g = j & 1;
            const size_t cidx = ((size_t)(b * 2 + g) * SEQ + t) * 64 + lane;
            {
                const float v = pr[C_KC + j * 64 + lane];
                o_cmp[j * 64 + lane] = v;
                if (isp) { if (j < 2) p.kcr[cidx] = f2bf(v); else p.vcr[cidx] = f2bf(v); }
            }
            {
                float v = pr[C_KS + j * 64 + lane];
                if (j < 2) { const float rs = rsqrtf(wave_sum(v * v) * (1.f / 64.f) + EPS); v = v * rs * p.g_ks[lane]; }
                o_slc[j * 64 + lane] = v;
                if (isp) { if (j < 2) p.ks[cidx] = f2bf(v); else p.vs[cidx] = f2bf(v); }
            }
            {
                float v = pr[C_KW + j * 64 + lane];
                if (j < 2) { const float rs = rsqrtf(wave_sum(v * v) * (1.f / 64.f) + EPS); v = v * rs * p.g_kw[lane]; }
                if (o_win) o_win[j * 64 + lane] = v;
                if (isp) { if (j < 2) p.kw[cidx] = f2bf(v); else p.vw[cidx] = f2bf(v); }
            }
        }
        if (lane < 24) p.gates[(size_t)r * 24 + lane] = sigmoidf(pr[C_BR + lane]);
        for (int i = 0; i < 8; ++i) {
            p.ga[(size_t)r * 512 + i * 64 + lane] = f2bf(silu(pr[C_GA + i * 64 + lane]));
            p.gr[(size_t)r * 512 + i * 64 + lane] = f2bf(silu(pr[C_GR + i * 64 + lane]));
            p.rv[(size_t)r * 512 + i * 64 + lane] = f2bf(pr[C_RV + i * 64 + lane]);
        }
        {
            const int i = lane & 31;
            const float freq = powf(10000.f, -(float)i / 32.f);
            const float ang = (float)pos * freq;
            float sn, cs; sincosf(ang, &sn, &cs);
            for (int hh = 0; hh < 4; ++hh) {
                const float a = pr[C_RQ + hh * 64 + lane], ao = pr[C_RQ + hh * 64 + (lane ^ 32)];
                const float kq = pr[C_RK + hh * 64 + lane], ko = pr[C_RK + hh * 64 + (lane ^ 32)];
                const float oq = lane < 32 ? a * cs - ao * sn : ao * sn + a * cs;
                const float ok = lane < 32 ? kq * cs - ko * sn : ko * sn + kq * cs;
                const float lgm = __log2f(1.f - exp2f(-5.f - (float)hh)) * (float)(pos & 127);
                p.rq[(size_t)r * 256 + hh * 64 + lane] = f2bf(oq * exp2f(lgm));
                p.rk[(size_t)r * 256 + hh * 64 + lane] = f2bf(ok * 0.125f * exp2f(-lgm));
            }
        }
    }
}

typedef unsigned u32x4 __attribute__((ext_vector_type(4)));

struct CmpTile {
    int active;
    int b, c0;
    int seam_idx;
    int is_sample;
};

__device__ __forceinline__ void cmp_second_layer(const Params& p, int kv, const f32x4 (&pre)[4], bf16_t* hb  , const bf16_t* w2s  , bf16_t* dst  , int lane) {
    const int fr = lane & 15, G = lane >> 4;
#pragma unroll
    for (int nt = 0; nt < 4; ++nt)
#pragma unroll
        for (int r = 0; r < 4; ++r) hb[(G * 4 + r) * 64 + nt * 16 + fr] = f2bf(silu(pre[nt][r]));
    WSYNC();
    bf16x8 hf[2];
#pragma unroll
    for (int ks = 0; ks < 2; ++ks) hf[ks] = *(const bf16x8*)(hb + fr * 64 + ks * 32 + G * 8);
    f32x4 out[4];
#pragma unroll
    for (int nt = 0; nt < 4; ++nt) {
        out[nt] = (f32x4){0.f, 0.f, 0.f, 0.f};
#pragma unroll
        for (int ks = 0; ks < 2; ++ks) {
            const bf16x8 wf = *(const bf16x8*)(w2s + (nt * 16 + fr) * 64 + ks * 32 + G * 8);
            out[nt] = __builtin_amdgcn_mfma_f32_16x16x32_bf16(hf[ks], wf, out[nt], 0, 0, 0);
        }
    }
    WSYNC();
    float rs[4] = {1.f, 1.f, 1.f, 1.f};
    if (kv == 0) {
#pragma unroll
        for (int r = 0; r < 4; ++r) {
            float ss = 0.f;
#pragma unroll
            for (int nt = 0; nt < 4; ++nt) ss += out[nt][r] * out[nt][r];
            ss += __shfl_xor(ss, 1); ss += __shfl_xor(ss, 2); ss += __shfl_xor(ss, 4); ss += __shfl_xor(ss, 8);
            rs[r] = rsqrtf(ss * (1.f / 64.f) + EPS);
        }
    }
#pragma unroll
    for (int nt = 0; nt < 4; ++nt) {
        const float gk = kv == 0 ? p.g_kc[nt * 16 + fr] : 1.f;
#pragma unroll
        for (int r = 0; r < 4; ++r) {
            const int row = G * 4 + r;
            if (row < 15) dst[(size_t)row * 64 + nt * 16 + fr] = f2bf(out[nt][r] * rs[r] * gk);
        }
    }
}

__device__ __forceinline__ void compress_setup(const Params& p, char* lds, int kv) {
    const int tid = opaque_tid();
    const float* w1 = kv ? p.w_cv1 : p.w_ck1; const float* pe = kv ? p.pe_cv : p.pe_ck; const float* w2 = kv ? p.w_cv2 : p.w_ck2;
    bf16_t* w2s = (bf16_t*)(lds + 32768); float* b1s = (float*)(lds + 40960); float* part = (float*)(lds + 41216);
    __syncthreads();
    for (int i = tid; i < 4096; i += NT) { const int f = i >> 6, d = i & 63; w2s[d * 64 + f] = f2bf(w2[i]); }
    {
      const int fq4 = tid & 15, ks32 = tid >> 4;
      const float* wp = w1 + (size_t)ks32 * 64 * 64 + 4 * fq4; const float* pp = pe + ks32 * 64;
      float4 s = {0.f, 0.f, 0.f, 0.f};
#pragma unroll 16
      for (int k = 0; k < 64; ++k) { const float4 w = *(const float4*)(wp + (size_t)k * 64); const float pv = pp[k]; s.x += pv * w.x; s.y += pv * w.y; s.z += pv * w.z; s.w += pv * w.w; }
      *(float4*)(part + ks32 * 64 + 4 * fq4) = s; }
    __syncthreads();
    if (tid < 64) { float s = 0.f; for (int j = 0; j < 32; ++j) s += part[j * 64 + tid]; b1s[tid] = s; }
    __syncthreads();
}
template <bool PIN>
__device__ __forceinline__ void compress_pass(const Params& p, char* lds, int kv, const CmpTile& T) {
    const int tid = opaque_tid(), lane = tid & 63, wave = tid >> 6, fr = lane & 15, G = lane >> 4;
    char* ring = lds;
    bf16_t* hb = (bf16_t*)(lds + 16384) + wave * 1024;
    const float* abase[2];
#pragma unroll
    for (int i = 0; i < 2; ++i) {
        const int c = T.c0 + (fr & 7) + 8 * i;
        if (T.is_sample) { const int pg = p.page_table[T.b * NPAGES + (c >> 3)]; abase[i] = p.cache_cmp + (((size_t)pg * 128 + (c & 7) * 16) * 4 + kv * 2) * 64 + (fr >> 3) * 16 + G * 4; }
        else abase[i] = p.p_cmp + (((size_t)T.b * SEQ + (size_t)c * 16) * 4 + kv * 2) * 64 + (fr >> 3) * 16 + G * 4;
    }
    const bool lowl = fr < 8;
    const bf16_t* w2s = (const bf16_t*)(lds + 32768); const float* b1s = (const float*)(lds + 40960);
    const int wq_ = tid & 15, wkk = tid >> 4;
    const float* wsrc = (kv ? p.w_cv1 : p.w_ck1) + (size_t)wkk * 64 + 4 * wq_;
    const int wdst = (4 * wq_) * 64 + ((((wkk >> 2) & 3) ^ (wq_ & 3)) * 16) + (((wkk >> 4) * 4 + (wkk & 3)) * 2);
    f32x4 acc[2][8];
#pragma unroll
    for (int g = 0; g < 2; ++g)
#pragma unroll
        for (int nt = 0; nt < 8; ++nt) acc[g][nt] = (f32x4){0.f, 0.f, 0.f, 0.f};
    f32x4 wq[4][2]; f32x4 aq[4][2][2];
#define CMP_LOADW(u, s) do { const float* _w = wsrc + (((s) >> 1) * 64 + ((s) & 1) * 32) * 64; wq[u][0] = *(const f32x4*)(_w); wq[u][1] = *(const f32x4*)(_w + 65536); } while (0)
#define CMP_STOREW(slot, u) do { bf16_t* _r = (bf16_t*)(ring + (slot) * 8192 + wdst); \
        const unsigned _a = cvt_pk_bf16(wq[u][0][0], wq[u][0][1]), _b = cvt_pk_bf16(wq[u][0][2], wq[u][0][3]), _c = cvt_pk_bf16(wq[u][1][0], wq[u][1][1]), _d = cvt_pk_bf16(wq[u][1][2], wq[u][1][3]); \
        _r[0] = (bf16_t)_a; _r[32] = (bf16_t)(_a >> 16); _r[64] = (bf16_t)_b; _r[96] = (bf16_t)(_b >> 16); \
        _r[2048] = (bf16_t)_c; _r[2080] = (bf16_t)(_c >> 16); _r[2112] = (bf16_t)_d; _r[2144] = (bf16_t)(_d >> 16); } while (0)
#define CMP_LOADA(u, s) do { if (T.active) { const int _o = ((s) >> 1) * 256 + ((s) & 1) * 32; \
        aq[u][0][0] = __builtin_nontemporal_load((const f32x4*)(abase[0] + _o)); aq[u][0][1] = __builtin_nontemporal_load((const f32x4*)(abase[1] + _o)); \
        aq[u][1][0] = __builtin_nontemporal_load((const f32x4*)(abase[0] + _o + 64)); aq[u][1][1] = __builtin_nontemporal_load((const f32x4*)(abase[1] + _o + 64)); } } while (0)
#pragma unroll
    for (int u = 0; u < 4; ++u) { CMP_LOADW(u, u); CMP_LOADA(u, u); }
    CMP_STOREW(0, 0);
    __syncthreads();
#pragma unroll
    for (int s0 = 0; s0 < 32; s0 += 4) {
#pragma unroll
        for (int u = 0; u < 4; ++u) {
            const int s = s0 + u;
            CMP_STOREW((s + 1) & 1, (u + 1) & 3);
            bf16x8 af[2];
            if (T.active) {
#pragma unroll
                for (int g = 0; g < 2; ++g) {
                    u32x4 t;
                    f32x4 x0, x1;
#pragma unroll
                    for (int e = 0; e < 4; ++e) {
                        const float give = lowl ? aq[u][g][1][e] : aq[u][g][0][e];
                        const float recv = __builtin_bit_cast(float, __builtin_amdgcn_mov_dpp(__builtin_bit_cast(int, give), 0x128, 0xF, 0xF, true));
                        x0[e] = lowl ? aq[u][g][0][e] : recv; x1[e] = lowl ? recv : aq[u][g][1][e];
                    }
                    t[0] = cvt_pk_bf16(x0[0], x0[1]); t[1] = cvt_pk_bf16(x0[2], x0[3]);
                    t[2] = cvt_pk_bf16(x1[0], x1[1]); t[3] = cvt_pk_bf16(x1[2], x1[3]);
                    af[g] = __builtin_bit_cast(bf16x8, t);
                }
            }
            if (PIN) __builtin_amdgcn_sched_barrier(0);
            { const int sl = s + 4 < 32 ? s + 4 : 31; CMP_LOADW(u, sl); CMP_LOADA(u, sl); }
            if (PIN) __builtin_amdgcn_sched_barrier(0);
            if (T.active) {
                const char* slab = ring + (s & 1) * 8192;
#pragma unroll
                for (int nt = 0; nt < 8; ++nt) {
                    const int n = nt * 16 + fr;
                    const bf16x8 bfrag = *(const bf16x8*)(slab + n * 64 + ((G ^ ((n >> 2) & 3)) * 16));
                    acc[0][nt] = __builtin_amdgcn_mfma_f32_16x16x32_bf16(af[0], bfrag, acc[0][nt], 0, 0, 0);
                    acc[1][nt] = __builtin_amdgcn_mfma_f32_16x16x32_bf16(af[1], bfrag, acc[1][nt], 0, 0, 0);
                }
            }
            __syncthreads();
        }
    }
#undef CMP_LOADW
#undef CMP_STOREW
#undef CMP_LOADA
    if (!T.active) return;
#pragma unroll
    for (int g = 0; g < 2; ++g) {
        f32x4 pre[4];
#pragma unroll
        for (int nt = 0; nt < 4; ++nt) {
            const float bias = b1s[nt * 16 + fr];
            const float nb0 = __shfl_down(acc[g][4 + nt][0], 16);
            pre[nt][0] = acc[g][nt][0] + acc[g][4 + nt][1] + bias;
            pre[nt][1] = acc[g][nt][1] + acc[g][4 + nt][2] + bias;
            pre[nt][2] = acc[g][nt][2] + acc[g][4 + nt][3] + bias;
            pre[nt][3] = acc[g][nt][3] + nb0 + bias;
            if (T.seam_idx >= 0) {
                if (G == 3) p.seamA[((size_t)T.seam_idx * 2 + g) * 64 + nt * 16 + fr] = acc[g][nt][3];
                if (G == 0) p.seamB[((size_t)T.seam_idx * 2 + g) * 64 + nt * 16 + fr] = acc[g][4 + nt][0];
            }
        }
        bf16_t* dst = T.is_sample ? (kv ? p.vcs : p.kcs) + ((size_t)(T.b * 2 + g) * 1024 + T.c0) * 64
                                  : (kv ? p.vc : p.kc) + ((size_t)(T.b * 2 + g) * 256 + T.c0) * 64;
        cmp_second_layer(p, kv, pre, hb, w2s, dst, lane);
    }
}

__device__ __forceinline__ void compress_sample(const Params& p, char* lds, int bid, int nblk) {
    const int wave = opaque_tid() >> 6;
    int kv_set = -1;
    for (int pass = bid; pass < 512; pass += nblk) {
        const int P = pass & 7, kv = (pass >> 3) & 1, b = pass >> 4;
        CmpTile T; T.active = 1; T.b = b; T.c0 = P * 128 + wave * 16; T.is_sample = 1;
        T.seam_idx = (b * 2 + kv) * 64 + (T.c0 >> 4);
        if (kv != kv_set) { compress_setup(p, lds, kv); kv_set = kv; }
        __syncthreads();
        compress_pass<false>(p, lds, kv, T);
    }
}

__device__ __forceinline__ void compress_prompt_ksplit_item(const Params& p, char* lds, int item) {
    const int tid = opaque_tid(), lane = tid & 63, wave = tid >> 6, fr = lane & 15, G = lane >> 4;
    f32x4* part = (f32x4*)lds;
    {
        const int kv = item / 68, tile = item % 68, b = tile / 17, c0 = (tile % 17) * 15;
        const float* abase = p.p_cmp + (((size_t)b * SEQ + (size_t)(c0 + fr) * 16) * 4 + kv * 2) * 64 + G * 4;
        const bf16_t* wbase = p.w1p + ((size_t)kv * 128 + fr) * 1024 + G * 8;
        f32x4 acc[2][8];
#pragma unroll
        for (int g = 0; g < 2; ++g)
#pragma unroll
            for (int nt = 0; nt < 8; ++nt) acc[g][nt] = (f32x4){0.f, 0.f, 0.f, 0.f};
#pragma unroll
        for (int u = 0; u < 4; ++u) {
            const int s = wave * 4 + u;
            const float* a = abase + (s >> 1) * 256 + (s & 1) * 32;
            bf16x8 af[2];
#pragma unroll
            for (int g = 0; g < 2; ++g) {
                const f32x4 x0 = *(const f32x4*)(a + g * 64), x1 = *(const f32x4*)(a + g * 64 + 16);
                u32x4 t; t[0] = cvt_pk_bf16(x0[0], x0[1]); t[1] = cvt_pk_bf16(x0[2], x0[3]); t[2] = cvt_pk_bf16(x1[0], x1[1]); t[3] = cvt_pk_bf16(x1[2], x1[3]);
                af[g] = __builtin_bit_cast(bf16x8, t);
            }
#pragma unroll
            for (int nt = 0; nt < 8; ++nt) {
                const bf16x8 wf = *(const bf16x8*)(wbase + (size_t)nt * 16 * 1024 + s * 32);
                acc[0][nt] = __builtin_amdgcn_mfma_f32_16x16x32_bf16(af[0], wf, acc[0][nt], 0, 0, 0);
                acc[1][nt] = __builtin_amdgcn_mfma_f32_16x16x32_bf16(af[1], wf, acc[1][nt], 0, 0, 0);
            }
        }
        __syncthreads();
#pragma unroll
        for (int g = 0; g < 2; ++g)
#pragma unroll
            for (int nt = 0; nt < 8; ++nt) part[((wave * 2 + g) * 8 + nt) * 64 + lane] = acc[g][nt];
        __syncthreads();
        if (wave < 2) {
            const int g = wave;
            f32x4 tot[8];
#pragma unroll
            for (int nt = 0; nt < 8; ++nt) {
                tot[nt] = part[((0 * 2 + g) * 8 + nt) * 64 + lane];
#pragma unroll
                for (int w = 1; w < 8; ++w) tot[nt] += part[((w * 2 + g) * 8 + nt) * 64 + lane];
            }
            f32x4 pre[4];
#pragma unroll
            for (int nt = 0; nt < 4; ++nt) {
                const float bias = p.b1[kv * 64 + nt * 16 + fr];
                const float nb0 = __shfl_down(tot[4 + nt][0], 16);
                pre[nt][0] = tot[nt][0] + tot[4 + nt][1] + bias; pre[nt][1] = tot[nt][1] + tot[4 + nt][2] + bias;
                pre[nt][2] = tot[nt][2] + tot[4 + nt][3] + bias; pre[nt][3] = tot[nt][3] + nb0 + bias;
            }
            bf16_t* hb = (bf16_t*)(lds + 131072) + wave * 1024;
            bf16_t* dst = (kv ? p.vc : p.kc) + ((size_t)(b * 2 + g) * 256 + c0) * 64;
            cmp_second_layer(p, kv, pre, hb, p.w2t + (size_t)kv * 4096, dst, lane);
        }
        __syncthreads();
    }
}
__device__ __forceinline__ void compress_seams(const Params& p, int bid, int nblk) {
    const int tid = opaque_tid(), lane = tid & 63, wave = tid >> 6;
    if (bid < 0) return;
    for (int it = bid * 8 + wave; it < 32 * 2 * 2 * 63; it += nblk * 8) {
        const int Tt = it % 63, rest = it / 63, g = rest & 1, kv = (rest >> 1) & 1, b = rest >> 2;
        const size_t sa = ((size_t)((b * 2 + kv) * 64 + Tt) * 2 + g) * 64 + lane, sb = ((size_t)((b * 2 + kv) * 64 + Tt + 1) * 2 + g) * 64 + lane;
        const float h = silu(p.seamA[sa] + p.seamB[sb] + p.b1[kv * 64 + lane]);
        const float* w2 = kv ? p.w_cv2 : p.w_ck2;
        float o = 0.f;
        for (int f = 0; f < 64; ++f) o += bf2f(f2bf(__shfl(h, f))) * bf2f(f2bf(w2[f * 64 + lane]));
        if (kv == 0) { const float rs = rsqrtf(wave_sum(o * o) * (1.f / 64.f) + EPS); o = o * rs * p.g_kc[lane]; }
        ((kv ? p.vcs : p.kcs) + ((size_t)(b * 2 + g) * 1024 + 16 * Tt + 15) * 64)[lane] = f2bf(o);
    }
}
__device__ __forceinline__ void compress_prompt(const Params& p, char* lds, int bid, int nblk) {
    const int wave = opaque_tid() >> 6;
    for (int pass = bid; pass < 18; pass += nblk) {
        const int kv = pass / 9, pp = pass % 9, tile = pp * 8 + wave;
        CmpTile T; T.active = tile < 68; T.b = T.active ? tile / 17 : 0; T.c0 = T.active ? (tile % 17) * 15 : 0; T.is_sample = 0; T.seam_idx = -1;
        compress_setup(p, lds, kv);
        __syncthreads();
        compress_pass<false>(p, lds, kv, T);
    }
}

template <typename T>
__device__ __forceinline__ void attend64(const float* qs, float* pl, const T* kbase, const T* vbase, size_t stride, bool valid, int lane, float (&m)[4], float (&l)[4], float (&o)[4]) {
    float s[4] = {0.f, 0.f, 0.f, 0.f};
    if (valid) {
        const T* kr = kbase + (size_t)lane * stride;
        float kfa[8][8];
#pragma unroll
        for (int c = 0; c < 8; ++c) load8(kr + c * 8, kfa[c]);
#pragma unroll
        for (int c = 0; c < 8; ++c)
#pragma unroll
            for (int h = 0; h < 4; ++h)
#pragma unroll
                for (int j = 0; j < 8; ++j) s[h] += qs[h * 64 + c * 8 + j] * kfa[c][j];
    }
    const unsigned long long vm = __ballot(valid);
    if (vm == 0ull) return;
#pragma unroll
    for (int h = 0; h < 4; ++h) {
        const float sv = valid ? s[h] * 0.125f : -1e30f;
        const float mn = fmaxf(m[h], wave_max(sv));
        const float alpha = __expf(m[h] - mn);
        const float pv = valid ? __expf(sv - mn) : 0.f;
        l[h] = l[h] * alpha + wave_sum(pv); o[h] *= alpha; m[h] = mn;
        pl[h * 64 + lane] = pv;
    }
    WSYNC();
    const int kfirst = __ffsll((long long)vm) - 1;
#pragma unroll 16
    for (int kk = 0; kk < 64; ++kk) {
        const int kr = ((vm >> kk) & 1ull) ? kk : kfirst;
        const float vv = load1(vbase + (size_t)kr * stride + lane);
#pragma unroll
        for (int h = 0; h < 4; ++h) o[h] += pl[h * 64 + kk] * vv;
    }
    WSYNC();
}

__device__ __forceinline__ void cmp_branch(const float* qs, float* pl, float* ps, const bf16_t* kc, const bf16_t* vc, int n_c, int lane, float (&oc)[4]) {
    float m[4] = {-1e30f, -1e30f, -1e30f, -1e30f}, l[4] = {0.f, 0.f, 0.f, 0.f};
    for (int c0 = 0; c0 < n_c; c0 += 64) {
        const bool valid = c0 + lane < n_c;
        float s[4] = {0.f, 0.f, 0.f, 0.f};
        if (valid) {
            const bf16_t* kr = kc + (size_t)(c0 + lane) * 64;
#pragma unroll 2
            for (int c = 0; c < 8; ++c) {
                float kf[8]; load8(kr + c * 8, kf);
#pragma unroll
                for (int h = 0; h < 4; ++h)
#pragma unroll
                    for (int j = 0; j < 8; ++j) s[h] += qs[h * 64 + c * 8 + j] * kf[j];
            }
        }
#pragma unroll
        for (int h = 0; h < 4; ++h) {
            const float sv = valid ? s[h] * 0.125f : -1e30f;
            const float mn = fmaxf(m[h], wave_max(sv));
            const float pv = valid ? __expf(sv - mn) : 0.f;
            l[h] = l[h] * __expf(m[h] - mn) + wave_sum(pv); m[h] = mn;
        }
    }
    for (int c0 = 0; c0 < n_c; c0 += 64) {
        const bool valid = c0 + lane < n_c;
        float s[4] = {0.f, 0.f, 0.f, 0.f};
        if (valid) {
            const bf16_t* kr = kc + (size_t)(c0 + lane) * 64;
#pragma unroll 2
            for (int c = 0; c < 8; ++c) {
                float kf[8]; load8(kr + c * 8, kf);
#pragma unroll
                for (int h = 0; h < 4; ++h)
#pragma unroll
                    for (int j = 0; j < 8; ++j) s[h] += qs[h * 64 + c * 8 + j] * kf[j];
            }
        }
        float psum = 0.f;
#pragma unroll
        for (int h = 0; h < 4; ++h) {
            const float pv = valid ? __expf(s[h] * 0.125f - m[h]) / l[h] : 0.f;
            pl[h * 64 + lane] = pv; psum += pv;
        }
        if (valid) ps[1 + c0 + lane] = psum;
        WSYNC();
        const int nk = min(64, n_c - c0);
        for (int kk = 0; kk < nk; ++kk) {
            const float vv = bf2f(vc[(size_t)(c0 + kk) * 64 + lane]);
#pragma unroll
            for (int h = 0; h < 4; ++h) oc[h] += pl[h * 64 + kk] * vv;
        }
        WSYNC();
    }
}

__device__ __forceinline__ void topk16(float* sc, int* sel, int n_sel, int lane) {
    for (int round = 0; round < 16; ++round) {
        float bv = -3.0e38f; int bi = 0x7fffffff;
        for (int j = lane; j < n_sel; j += 64) { const float v = sc[j]; if (v > bv) { bv = v; bi = j; } }
#pragma unroll
        for (int o = 1; o < 64; o <<= 1) {
            const float ov = __shfl_xor(bv, o); const int oi = __shfl_xor(bi, o);
            if (ov > bv || (ov == bv && oi < bi)) { bv = ov; bi = oi; }
        }
        if (lane == 0) { sel[round] = bi; sc[bi] = -3.4e38f; }
        WSYNC();
    }
}

constexpr int ATT_WLDS = 256 + 256 + 1040 + 272 + 16;
__device__ __forceinline__ void p5_attention(const Params& p, char* lds, int bid, int nblk) {
    const int tid = threadIdx.x, lane = tid & 63, wave = tid >> 6;
    float* wl = (float*)lds + wave * ATT_WLDS;
    float *qs = wl, *pl = wl + 256, *ps = wl + 512, *sc = wl + 1552; int* sel = (int*)(wl + 1824);
    const int gw = bid * 8 + wave, ngw = nblk * 8;
    for (int it = gw; it < R * 2; it += ngw) {
        const int r = it >> 1, g = it & 1;
        const bool isp = r < TP;
        const int b = isp ? (r >> 12) : (r - TP), t = isp ? (r & 4095) : PAST;
        const int n_sel = isp ? 64 : 257;
        const int n_cmax = isp ? 255 : 1023;
#pragma unroll
        for (int h = 0; h < 4; ++h) qs[h * 64 + lane] = bf2f(p.qn[(size_t)r * 512 + (g * 4 + h) * 64 + lane]);
        for (int i = lane; i < 4 * n_sel + 1; i += 64) ps[i] = 0.f;
        WSYNC();
        int n_c = t >= 31 ? (t - 31) / 16 + 1 : 0; if (n_c > n_cmax) n_c = n_cmax;
        float oc[4] = {0.f, 0.f, 0.f, 0.f};
        {
            const bf16_t* kc = isp ? p.kc + (size_t)(b * 2 + g) * 256 * 64 : p.kcs + (size_t)(b * 2 + g) * 1024 * 64;
            const bf16_t* vc = isp ? p.vc + (size_t)(b * 2 + g) * 256 * 64 : p.vcs + (size_t)(b * 2 + g) * 1024 * 64;
            cmp_branch(qs, pl, ps, kc, vc, n_c, lane, oc);
        }
        const int jt = t >> 6;
        for (int j = lane; j < n_sel; j += 64) {
            float imp = 0.f;
#pragma unroll
            for (int rr = 0; rr < 4; ++rr) imp += ps[4 * j + rr + 1] + ps[4 * j + rr];
            const bool valid = j * 64 <= t, forced = (j == 0) || (j == jt) || (j == jt - 1);
            sc[j] = valid ? (forced ? 1e4f : imp) : -1e30f;
        }
        WSYNC();
        topk16(sc, sel, n_sel, lane);
        float ms[4] = {-1e30f, -1e30f, -1e30f, -1e30f}, lsum[4] = {0.f, 0.f, 0.f, 0.f}, os[4] = {0.f, 0.f, 0.f, 0.f};
        for (int k = 0; k < 16; ++k) {
            const int j = sel[k];
            if (j * 64 > t) continue;
            const bool valid = j * 64 + lane <= t;
            if (isp) {
                const size_t base = ((size_t)(b * 2 + g) * SEQ + (size_t)j * 64) * 64;
                attend64<bf16_t>(qs, pl, p.ks + base, p.vs + base, 64, valid, lane, ms, lsum, os);
            } else if (j == 256) {
                attend64<float>(qs, pl, p.s_slc + (size_t)b * 256 + g * 64, p.s_slc + (size_t)b * 256 + 128 + g * 64, 256, valid, lane, ms, lsum, os);
            } else {
                const int pg = p.page_table[b * NPAGES + (j >> 1)];
                const float* base = p.cache_slc + (((size_t)pg * 128 + (j & 1) * 64) * 4 + g) * 64;
                attend64<float>(qs, pl, base, base + 128, 256, valid, lane, ms, lsum, os);
            }
        }
        float mw[4] = {-1e30f, -1e30f, -1e30f, -1e30f}, lw[4] = {0.f, 0.f, 0.f, 0.f}, ow[4] = {0.f, 0.f, 0.f, 0.f};
        if (isp) {
            const int start = t - 511 > 0 ? t - 511 : 0;
            for (int c0 = start; c0 <= t; c0 += 64) {
                const size_t base = ((size_t)(b * 2 + g) * SEQ + c0) * 64;
                attend64<bf16_t>(qs, pl, p.kw + base, p.vw + base, 64, c0 + lane <= t, lane, mw, lw, ow);
            }
        } else {
            for (int c0 = 0; c0 < 512; c0 += 64) {
                const float* base = p.s_win + ((size_t)b * 512 + c0) * 256 + g * 64;
                attend64<float>(qs, pl, base, base + 128, 256, true, lane, mw, lw, ow);
            }
        }
#pragma unroll
        for (int h = 0; h < 4; ++h) {
            const float* gt = p.gates + (size_t)r * 24 + g * 12 + h * 3;
            const float o = gt[0] * oc[h] + gt[1] * (os[h] / lsum[h]) + gt[2] * (ow[h] / lw[h]);
            const int col = (g * 4 + h) * 64 + lane;
            p.yar[(size_t)r * 1024 + col] = f2bf(o * bf2f(p.ga[(size_t)r * 512 + col]));
        }
    }
}


typedef short s16x4 __attribute__((ext_vector_type(4)));
#define ATT_NEG (-__builtin_inff())
constexpr int ATT_KC = 0, ATT_VC = 32768, ATT_KB = 65536, ATT_VB = 98304, ATT_SC = 131072;
constexpr float ATT_CS = 0.125f * 1.44269504088896f;

__device__ __forceinline__ void att_stage(LAS char* dst, const bf16_t* rows, int tid) {
    const int key = tid >> 3, slot = tid & 7;
    __builtin_amdgcn_global_load_lds((const unsigned*)(rows + key * 64 + ((slot ^ (key & 7)) * 8)), (LAS unsigned*)(dst + tid * 16), 16, 0, 0);
}
__device__ __forceinline__ void att_qk(const LAS char* Kb, const bf16x8 (&qf)[2], const int (&koff)[2], f32x4 (&st)[4]) {
#pragma unroll
    for (int tk = 0; tk < 4; ++tk) {
        st[tk] = (f32x4){0.f, 0.f, 0.f, 0.f};
#pragma unroll
        for (int ks = 0; ks < 2; ++ks) {
            const bf16x8 kf = *(const LAS bf16x8*)(Kb + tk * 2048 + koff[ks]);
            st[tk] = __builtin_amdgcn_mfma_f32_16x16x32_bf16(kf, qf[ks], st[tk], 0, 0, 0);
        }
    }
}
template <int O0, int O1>
__device__ __forceinline__ void att_tr8(unsigned a0, unsigned a1, unsigned a2, unsigned a3, s16x4 (&v)[8]) {
    asm volatile(
        "ds_read_b64_tr_b16 %0, %8 offset:%12\n\t"
        "ds_read_b64_tr_b16 %1, %8 offset:%13\n\t"
        "ds_read_b64_tr_b16 %2, %9 offset:%12\n\t"
        "ds_read_b64_tr_b16 %3, %9 offset:%13\n\t"
        "ds_read_b64_tr_b16 %4, %10 offset:%12\n\t"
        "ds_read_b64_tr_b16 %5, %10 offset:%13\n\t"
        "ds_read_b64_tr_b16 %6, %11 offset:%12\n\t"
        "ds_read_b64_tr_b16 %7, %11 offset:%13\n\t"
        "s_waitcnt lgkmcnt(0)"
        : "=&v"(v[0]), "=&v"(v[1]), "=&v"(v[2]), "=&v"(v[3]), "=&v"(v[4]), "=&v"(v[5]), "=&v"(v[6]), "=&v"(v[7])
        : "v"(a0), "v"(a1), "v"(a2), "v"(a3), "i"(O0), "i"(O1) : "memory");
}
__device__ __forceinline__ void att_pv(const LAS char* Vb, const f32x4 (&pt)[4], const int (&voff)[4], f32x4 (&o)[4]) {
    const unsigned vb = (unsigned)(unsigned long long)Vb;
    const unsigned a0 = vb + voff[0], a1 = vb + voff[1], a2 = vb + voff[2], a3 = vb + voff[3];
#pragma unroll
    for (int kst = 0; kst < 2; ++kst) {
        u32x4 pk;
        pk[0] = cvt_pk_bf16(pt[2 * kst][0], pt[2 * kst][1]); pk[1] = cvt_pk_bf16(pt[2 * kst][2], pt[2 * kst][3]);
        pk[2] = cvt_pk_bf16(pt[2 * kst + 1][0], pt[2 * kst + 1][1]); pk[3] = cvt_pk_bf16(pt[2 * kst + 1][2], pt[2 * kst + 1][3]);
        const bf16x8 pf = __builtin_bit_cast(bf16x8, pk);
        s16x4 v[8];
        if (kst == 0) att_tr8<0, 2048>(a0, a1, a2, a3, v); else att_tr8<4096, 6144>(a0, a1, a2, a3, v);
#pragma unroll
        for (int dt = 0; dt < 4; ++dt) {
            const s16x4 x0 = v[2 * dt], x1 = v[2 * dt + 1];
            bf16x8 vf; vf[0] = x0[0]; vf[1] = x0[1]; vf[2] = x0[2]; vf[3] = x0[3]; vf[4] = x1[0]; vf[5] = x1[1]; vf[6] = x1[2]; vf[7] = x1[3];
            o[dt] = __builtin_amdgcn_mfma_f32_16x16x32_bf16(vf, pf, o[dt], 0, 0, 0);
        }
    }
}
__device__ __forceinline__ void att_exp(f32x4 (&st)[4], float nb, float& l) {
    typedef float f32x2 __attribute__((ext_vector_type(2)));
    const f32x2 cs2 = {ATT_CS, ATT_CS}, nb2 = {nb, nb};
    f32x2 ls2 = {0.f, 0.f};
#pragma unroll
    for (int tk = 0; tk < 4; ++tk)
#pragma unroll
        for (int r = 0; r < 4; r += 2) {
            const f32x2 s2 = {st[tk][r], st[tk][r + 1]};
            const f32x2 e2 = __builtin_elementwise_fma(s2, cs2, nb2);
            f32x2 p2; p2.x = __builtin_amdgcn_exp2f(e2.x); p2.y = __builtin_amdgcn_exp2f(e2.y);
            st[tk][r] = p2.x; st[tk][r + 1] = p2.y; ls2 += p2;
        }
    l += ls2.x + ls2.y;
}
__device__ __forceinline__ void att_prompt_unit(const Params& p, char* lds, int b, int g, int qt) {
    LAS char* l3 = (LAS char*)lds;
    const int tid = opaque_tid(), lane = tid & 63, wave = tid >> 6, fr = lane & 15, G = lane >> 4;
    const int qi = fr >> 2, h = fr & 3;
    const int t0 = qt * 32, tq0 = t0 + 4 * wave, t_row = tq0 + qi, jt = t0 >> 6;
    const size_t r = (size_t)b * SEQ + t_row;
    const size_t kvbase = (size_t)(b * 2 + g) * SEQ * 64;
    const float shc = p.attb[0], shs = p.attb[1], shw = p.attb[2];
    int koff[2], voff[4];
#pragma unroll
    for (int ks = 0; ks < 2; ++ks) koff[ks] = fr * 128 + (((ks * 4 + G) ^ (fr & 7)) * 16);
    { const int kq = 4 * G + (fr >> 2);
#pragma unroll
      for (int dt = 0; dt < 4; ++dt) voff[dt] = kq * 128 + (((dt * 2 + ((fr & 3) >> 1)) ^ (kq & 7)) * 16) + (fr & 1) * 8; }
    asm volatile("s_waitcnt lgkmcnt(0)" ::: "memory"); __builtin_amdgcn_s_barrier(); asm volatile("" ::: "memory");
    {
        const bf16_t* kc = p.kc + (size_t)(b * 2 + g) * 256 * 64; const bf16_t* vc = p.vc + (size_t)(b * 2 + g) * 256 * 64;
#pragma unroll
        for (int c = 0; c < 4; ++c) { att_stage(l3 + ATT_KC + c * 8192, kc + c * 4096, tid); att_stage(l3 + ATT_VC + c * 8192, vc + c * 4096, tid); }
    }
    bf16x8 qf[2];
#pragma unroll
    for (int ks = 0; ks < 2; ++ks) qf[ks] = *(const bf16x8*)(p.qn + r * 512 + (g * 4 + h) * 64 + ks * 32 + G * 8);
    const int c_lo = (t0 - 511 > 0 ? t0 - 511 : 0) >> 6;
    const int n_s = jt + 1, n_tot = n_s + (jt - c_lo + 1);
#define ATT_STAGE_CHUNK(idx) do { const int _i = (idx); const bool _w = _i >= n_s; const int _cj = _w ? c_lo + (_i - n_s) : _i; \
        att_stage(l3 + ATT_KB + (_i & 3) * 8192, (_w ? p.kw : p.ks) + kvbase + (size_t)_cj * 4096, tid); \
        att_stage(l3 + ATT_VB + (_i & 3) * 8192, (_w ? p.vw : p.vs) + kvbase + (size_t)_cj * 4096, tid); } while (0)
    ATT_STAGE_CHUNK(0); ATT_STAGE_CHUNK(1);
    if (n_tot > 2) { ATT_STAGE_CHUNK(2); asm volatile("s_waitcnt vmcnt(6)" ::: "memory"); }
    else asm volatile("s_waitcnt vmcnt(4)" ::: "memory");
    asm volatile("s_waitcnt lgkmcnt(0)" ::: "memory"); __builtin_amdgcn_s_barrier(); asm volatile("" ::: "memory");
    f32x4 oc[4];
#pragma unroll
    for (int dt = 0; dt < 4; ++dt) oc[dt] = (f32x4){0.f, 0.f, 0.f, 0.f};
    unsigned long long mymask;
    unsigned long long unionmask;
    {
        f32x4 sr[4][4];
#pragma unroll
        for (int c = 0; c < 4; ++c) att_qk(l3 + ATT_KC + c * 8192, qf, koff, sr[c]);
        const int ncrow = t_row >= 31 ? (t_row - 31) / 16 + 1 : 0;
        float lsum = 0.f;
#pragma unroll
        for (int c = 0; c < 4; ++c)
#pragma unroll
            for (int tk = 0; tk < 4; ++tk)
#pragma unroll
                for (int rg = 0; rg < 4; ++rg) {
                    const int i = c * 64 + tk * 16 + G * 4 + rg;
                    const float pv = i < ncrow ? __builtin_amdgcn_exp2f(sr[c][tk][rg] * ATT_CS - shc) : 0.f;
                    sr[c][tk][rg] = pv; lsum += pv;
                }
        lsum += __shfl_xor(lsum, 16); lsum += __shfl_xor(lsum, 32);
        const float inv = lsum > 0.f ? 1.f / lsum : 0.f;
        float* sc = (float*)(lds + ATT_SC) + wave * 512;
        float* bs = sc + 256;
        float av[4][4];
#pragma unroll
        for (int c = 0; c < 4; ++c)
#pragma unroll
            for (int tk = 0; tk < 4; ++tk) {
#pragma unroll
                for (int rg = 0; rg < 4; ++rg) sr[c][tk][rg] *= inv;
                float a = 2.f * (sr[c][tk][0] + sr[c][tk][1] + sr[c][tk][2]) + sr[c][tk][3], b3 = sr[c][tk][3];
                a += __builtin_bit_cast(float, __builtin_amdgcn_mov_dpp(__builtin_bit_cast(int, a), 0xB1, 0xF, 0xF, true));
                a += __builtin_bit_cast(float, __builtin_amdgcn_mov_dpp(__builtin_bit_cast(int, a), 0x4E, 0xF, 0xF, true));
                b3 += __builtin_bit_cast(float, __builtin_amdgcn_mov_dpp(__builtin_bit_cast(int, b3), 0xB1, 0xF, 0xF, true));
                b3 += __builtin_bit_cast(float, __builtin_amdgcn_mov_dpp(__builtin_bit_cast(int, b3), 0x4E, 0xF, 0xF, true));
                av[c][tk] = a;
                if (h == 0) bs[qi * 64 + (c * 4 + tk) * 4 + G] = b3;
            }
        WSYNC();
#pragma unroll
        for (int c = 0; c < 4; ++c)
#pragma unroll
            for (int tk = 0; tk < 4; ++tk) {
                const int j = (c * 4 + tk) * 4 + G;
                const float pr = j > 0 ? bs[qi * 64 + j - 1] : 0.f;
                const bool valid = j * 64 <= t_row, forced = (j == 0) || (j == jt) || (j == jt - 1);
                if (h == 0) sc[qi * 64 + j] = valid ? (forced ? 1e4f : av[c][tk] + pr) : -1e30f;
            }
#pragma unroll
        for (int c = 0; c < 4; ++c) att_pv(l3 + ATT_VC + c * 8192, sr[c], voff, oc);
        WSYNC();
        unsigned long long mq[4];
        {
            float sj[4]; int rank[4] = {0, 0, 0, 0};
#pragma unroll
            for (int q = 0; q < 4; ++q) sj[q] = sc[q * 64 + lane];
#pragma unroll 2
            for (int jp = 0; jp <= jt; ++jp) {
                const bool lower = jp < lane;
#pragma unroll
                for (int q = 0; q < 4; ++q) {
                    const float v = __builtin_bit_cast(float, __builtin_amdgcn_readlane(__builtin_bit_cast(int, sj[q]), jp));
                    rank[q] += (v > sj[q] || (v == sj[q] && lower)) ? 1 : 0;
                }
            }
#pragma unroll
            for (int q = 0; q < 4; ++q) mq[q] = __ballot(rank[q] < 16 && lane * 64 <= tq0 + q);
        }
        unionmask = mq[0] | mq[1] | mq[2] | mq[3];
        mymask = qi == 0 ? mq[0] : qi == 1 ? mq[1] : qi == 2 ? mq[2] : mq[3];
        WSYNC();
    }
    f32x4 os[4], ow[4];
#pragma unroll
    for (int dt = 0; dt < 4; ++dt) { os[dt] = (f32x4){0.f, 0.f, 0.f, 0.f}; ow[dt] = (f32x4){0.f, 0.f, 0.f, 0.f}; }
    float ls = 0.f, lw = 0.f;
    for (int it = 0; it < n_tot; ++it) {
        if (it + 2 < n_tot) asm volatile("s_waitcnt vmcnt(4)" ::: "memory");
        else if (it + 1 < n_tot) asm volatile("s_waitcnt vmcnt(2)" ::: "memory");
        else asm volatile("s_waitcnt vmcnt(0)" ::: "memory");
        asm volatile("s_waitcnt lgkmcnt(0)" ::: "memory"); __builtin_amdgcn_s_barrier(); asm volatile("" ::: "memory");
        if (it + 3 < n_tot) ATT_STAGE_CHUNK(it + 3);
        const LAS char* Kb = l3 + ATT_KB + (it & 3) * 8192; const LAS char* Vb = l3 + ATT_VB + (it & 3) * 8192;
        if (it < n_s) {
            const int j = it;
            if ((unionmask >> j) & 1ull) {
                f32x4 st[4];
                att_qk(Kb, qf, koff, st);
                const float nb = ((mymask >> j) & 1ull) ? -shs : ATT_NEG;
                if (j == jt) {
                    asm volatile("" ::: "memory");
#pragma unroll
                    for (int tk = 0; tk < 4; ++tk)
#pragma unroll
                        for (int rg = 0; rg < 4; ++rg) { const int pos = j * 64 + tk * 16 + G * 4 + rg; if (pos > t_row) st[tk][rg] = ATT_NEG; }
                }
                att_exp(st, nb, ls);
                att_pv(Vb, st, voff, os);
            }
        } else {
            const int cj = c_lo + (it - n_s);
            f32x4 st[4];
            att_qk(Kb, qf, koff, st);
            if (cj * 64 + 63 > tq0 || cj * 64 <= tq0 + 3 - 512) {
                asm volatile("" ::: "memory");
#pragma unroll
                for (int tk = 0; tk < 4; ++tk)
#pragma unroll
                    for (int rg = 0; rg < 4; ++rg) { const int pos = cj * 64 + tk * 16 + G * 4 + rg; if (!(pos <= t_row && pos > t_row - 512)) st[tk][rg] = ATT_NEG; }
            }
            att_exp(st, -shw, lw);
            att_pv(Vb, st, voff, ow);
        }
    }
#undef ATT_STAGE_CHUNK
    ls += __shfl_xor(ls, 16); ls += __shfl_xor(ls, 32);
    lw += __shfl_xor(lw, 16); lw += __shfl_xor(lw, 32);
    const float* gt = p.gates + r * 24 + g * 12 + h * 3;
    const float g0 = gt[0], g1 = gt[1] / ls, g2 = gt[2] / lw;
    const int colb = (g * 4 + h) * 64;
    uint2 gavv[4];
#pragma unroll
    for (int dt = 0; dt < 4; ++dt) gavv[dt] = *(const uint2*)(p.ga + r * 512 + colb + dt * 16 + G * 4);
#pragma unroll
    for (int dt = 0; dt < 4; ++dt) {
        const int d = dt * 16 + G * 4;
        const uint2 gav = gavv[dt];
        float v[4];
#pragma unroll
        for (int rg = 0; rg < 4; ++rg) v[rg] = g0 * oc[dt][rg] + g1 * os[dt][rg] + g2 * ow[dt][rg];
        v[0] *= __uint_as_float(gav.x << 16); v[1] *= __uint_as_float(gav.x & 0xffff0000u);
        v[2] *= __uint_as_float(gav.y << 16); v[3] *= __uint_as_float(gav.y & 0xffff0000u);
        uint2 o; o.x = cvt_pk_bf16(v[0], v[1]); o.y = cvt_pk_bf16(v[2], v[3]);
        *(uint2*)(p.yar + r * 1024 + colb + d) = o;
    }
}

__device__ __forceinline__ void dot4(const float* qs, const bf16_t* kr, float (&s)[4]) {
    uint4 raw[8];
#pragma unroll
    for (int c = 0; c < 8; ++c) raw[c] = *(const uint4*)(kr + c * 8);
#pragma unroll
    for (int c = 0; c < 8; ++c) {
        float kf[8];
        kf[0] = __uint_as_float(raw[c].x << 16); kf[1] = __uint_as_float(raw[c].x & 0xffff0000u); kf[2] = __uint_as_float(raw[c].y << 16); kf[3] = __uint_as_float(raw[c].y & 0xffff0000u);
        kf[4] = __uint_as_float(raw[c].z << 16); kf[5] = __uint_as_float(raw[c].z & 0xffff0000u); kf[6] = __uint_as_float(raw[c].w << 16); kf[7] = __uint_as_float(raw[c].w & 0xffff0000u);
#pragma unroll
        for (int hh = 0; hh < 4; ++hh)
#pragma unroll
            for (int j = 0; j < 8; ++j) s[hh] += qs[hh * 64 + c * 8 + j] * kf[j];
    }
}
__device__ __forceinline__ void att_sample_unit(const Params& p, char* lds, int b, int g) {
    const int tid = opaque_tid(), lane = tid & 63, wave = tid >> 6;
    float* L = (float*)lds;
    float* qs = L;
    float* ps = L + 256;
    float* sc = L + 1296;
    int* sel = (int*)(L + 1568);
    float* red = L + 1600;
    float* part = L + 1664;
    float* pl = L + 1664 + 8 * 3 * 4 * 66 + wave * 256;
    const size_t r = TP + b;
    __syncthreads();
    if (tid < 256) qs[tid] = bf2f(p.qn[r * 512 + g * 256 + tid]);
    for (int i = tid; i < 1040; i += NT) ps[i] = 0.f;
    __syncthreads();
    const bf16_t* kc = p.kcs + (size_t)(b * 2 + g) * 1024 * 64; const bf16_t* vc = p.vcs + (size_t)(b * 2 + g) * 1024 * 64;
    const int n_c = 1023;
    float m1[4] = {-1e30f, -1e30f, -1e30f, -1e30f}, l1[4] = {0.f, 0.f, 0.f, 0.f};
    for (int cc = 0; cc < 2; ++cc) {
        const int i = wave * 128 + cc * 64 + lane; const bool valid = i < n_c;
        float s[4] = {0.f, 0.f, 0.f, 0.f};
        if (valid) dot4(qs, kc + (size_t)i * 64, s);
#pragma unroll
        for (int hh = 0; hh < 4; ++hh) {
            const float sv = valid ? s[hh] * 0.125f : -1e30f;
            const float mn = fmaxf(m1[hh], wave_max(sv));
            l1[hh] = l1[hh] * __expf(m1[hh] - mn) + wave_sum(valid ? __expf(sv - mn) : 0.f); m1[hh] = mn;
        }
    }
    if (lane == 0) {
#pragma unroll
        for (int hh = 0; hh < 4; ++hh) { red[wave * 8 + hh] = m1[hh]; red[wave * 8 + 4 + hh] = l1[hh]; }
    }
    __syncthreads();
    float M[4], Ls[4];
#pragma unroll
    for (int hh = 0; hh < 4; ++hh) {
        float mm = -1e30f;
        for (int w = 0; w < 8; ++w) mm = fmaxf(mm, red[w * 8 + hh]);
        float ll = 0.f;
        for (int w = 0; w < 8; ++w) ll += red[w * 8 + 4 + hh] * __expf(red[w * 8 + hh] - mm);
        M[hh] = mm; Ls[hh] = ll;
    }
    float oc[4] = {0.f, 0.f, 0.f, 0.f};
    for (int cc = 0; cc < 2; ++cc) {
        const int i0 = wave * 128 + cc * 64, i = i0 + lane; const bool valid = i < n_c;
        float s[4] = {0.f, 0.f, 0.f, 0.f};
        if (valid) dot4(qs, kc + (size_t)i * 64, s);
        float psum = 0.f;
#pragma unroll
        for (int hh = 0; hh < 4; ++hh) { const float pv = valid ? __expf(s[hh] * 0.125f - M[hh]) / Ls[hh] : 0.f; pl[hh * 64 + lane] = pv; psum += pv; }
        if (valid) ps[1 + i] = psum;
        WSYNC();
        const int nk = min(64, n_c - i0);
#pragma unroll 16
        for (int kk = 0; kk < 64; ++kk) {
            const float vv = bf2f(vc[(size_t)(i0 + (kk < nk ? kk : 0)) * 64 + lane]);
#pragma unroll
            for (int hh = 0; hh < 4; ++hh) oc[hh] += pl[hh * 64 + kk] * vv;
        }
        WSYNC();
    }
    __syncthreads();
    if (wave == 0) {
        const int t = PAST, jt = t >> 6;
        for (int j = lane; j < 257; j += 64) {
            float imp = 0.f;
#pragma unroll
            for (int rr = 0; rr < 4; ++rr) imp += ps[4 * j + rr + 1] + ps[4 * j + rr];
            const bool valid = j * 64 <= t, forced = (j == 0) || (j == jt) || (j == jt - 1);
            sc[j] = valid ? (forced ? 1e4f : imp) : -1e30f;
        }
        WSYNC();
        topk16(sc, sel, 257, lane);
    }
    __syncthreads();
    float msv[4] = {-1e30f, -1e30f, -1e30f, -1e30f}, lsv[4] = {0.f, 0.f, 0.f, 0.f}, osv[4] = {0.f, 0.f, 0.f, 0.f};
    for (int k = 2 * wave; k < 2 * wave + 2; ++k) {
        const int j = sel[k];
        if (j * 64 > PAST) continue;
        const bool valid = j * 64 + lane <= PAST;
        if (j == 256) attend64<float>(qs, pl, p.s_slc + (size_t)b * 256 + g * 64, p.s_slc + (size_t)b * 256 + 128 + g * 64, 256, valid, lane, msv, lsv, osv);
        else {
            const int pg = p.page_table[b * NPAGES + (j >> 1)];
            const float* base = p.cache_slc + (((size_t)pg * 128 + (j & 1) * 64) * 4 + g) * 64;
            attend64<float>(qs, pl, base, base + 128, 256, valid, lane, msv, lsv, osv);
        }
    }
    float mwv[4] = {-1e30f, -1e30f, -1e30f, -1e30f}, lwv[4] = {0.f, 0.f, 0.f, 0.f}, owv[4] = {0.f, 0.f, 0.f, 0.f};
    {
        const float* base = p.s_win + ((size_t)b * 512 + wave * 64) * 256 + g * 64;
        attend64<float>(qs, pl, base, base + 128, 256, true, lane, mwv, lwv, owv);
    }
#pragma unroll
    for (int hh = 0; hh < 4; ++hh) {
        float* pc = part + ((wave * 3 + 0) * 4 + hh) * 66; pc[lane] = oc[hh];
        float* pS = part + ((wave * 3 + 1) * 4 + hh) * 66; pS[lane] = osv[hh]; if (lane == 0) { pS[64] = msv[hh]; pS[65] = lsv[hh]; }
        float* pw = part + ((wave * 3 + 2) * 4 + hh) * 66; pw[lane] = owv[hh]; if (lane == 0) { pw[64] = mwv[hh]; pw[65] = lwv[hh]; }
    }
    __syncthreads();
    if (tid < 256) {
        const int hh = tid >> 6, d = tid & 63;
        float c = 0.f;
        for (int w = 0; w < 8; ++w) c += part[((w * 3 + 0) * 4 + hh) * 66 + d];
        float res[2];
#pragma unroll
        for (int br = 1; br < 3; ++br) {
            float mm = -1e30f;
            for (int w = 0; w < 8; ++w) mm = fmaxf(mm, part[((w * 3 + br) * 4 + hh) * 66 + 64]);
            float num = 0.f, den = 0.f;
            for (int w = 0; w < 8; ++w) { const float* q = part + ((w * 3 + br) * 4 + hh) * 66; const float e = __expf(q[64] - mm); num += q[d] * e; den += q[65] * e; }
            res[br - 1] = num / den;
        }
        const float* gt = p.gates + r * 24 + g * 12 + hh * 3;
        const int col = (g * 4 + hh) * 64 + d;
        p.yar[r * 1024 + col] = f2bf((gt[0] * c + gt[1] * res[0] + gt[2] * res[1]) * bf2f(p.ga[r * 512 + col]));
    }
    __syncthreads();
}

__device__ __forceinline__ void ret_out_item(const Params& p, char* lds, int it);
__device__ __forceinline__ void att_phase(const Params& p, char* lds, int bid, int nblk) {
    const int x = bid & 7;
    unsigned* ctr = p.bar + 3584 + 64 * x;
    volatile int* slot = (volatile int*)(lds + 147456 + 16);
    const int tid = opaque_tid();
    for (;;) {
        __syncthreads();
        if (tid == 0) *slot = (int)__hip_atomic_fetch_add(ctr, 1u, __ATOMIC_RELAXED, __HIP_MEMORY_SCOPE_AGENT);
        __syncthreads();
        const int w = *slot;
        if (w >= 136) break;
        if (w < 8) att_sample_unit(p, lds, 4 * x + (w >> 1), w & 1);
        else att_prompt_unit(p, lds, x >> 1, x & 1, 127 - (w - 8));
    }
}
__device__ __forceinline__ void ret_out_queue(const Params& p, char* lds, int bid, int nblk) {
    const int x = bid & 7;
    unsigned* ctr = p.bar + 3584 + 64 * x + 16;
    volatile int* slot = (volatile int*)(lds + 147456 + 16);
    const int tid = opaque_tid();
    wg_wait(p.bar + 3456, (unsigned)nblk, p.bar + XB_TMO);
    for (;;) {
        __syncthreads();
        if (tid == 0) *slot = (int)__hip_atomic_fetch_add(ctr, 1u, __ATOMIC_RELAXED, __HIP_MEMORY_SCOPE_AGENT);
        __syncthreads();
        const int w = *slot;
        if (w >= 80) break;
        ret_out_item(p, lds, x + 8 * w);
    }
}

__device__ __forceinline__ float ret_gamma(int h) { return 1.f - exp2f(-5.f - (float)h); }

__device__ __forceinline__ void p6a_local(const Params& p, int bid, int nblk) {
    const int tid = opaque_tid();
    const int e = tid & 127, dg = tid >> 7;
    for (int it = bid; it < 4 * 4 * 32; it += nblk) {
        const int n = it & 31, h = (it >> 5) & 3, b = it >> 7;
        const float lg = __logf(ret_gamma(h));
        float acc[16];
#pragma unroll
        for (int i = 0; i < 16; ++i) acc[i] = 0.f;
        for (int j = 0; j < 128; ++j) {
            const size_t r = (size_t)b * SEQ + n * 128 + j;
            const float z = __expf(lg * (float)(127 - j));
            const float v = bf2f(p.rv[r * 512 + h * 128 + e]) * z;
            const bf16_t* kr = p.rk + r * 256 + h * 64 + dg * 16;
#pragma unroll
            for (int i = 0; i < 16; ++i) acc[i] += bf2f(kr[i]) * v;
        }
        float* out = p.sloc + ((size_t)it * 64 + dg * 16) * 128 + e;
#pragma unroll
        for (int i = 0; i < 16; ++i) out[i * 128] = acc[i];
    }
}
__device__ __forceinline__ void p6b_scan(const Params& p, int bid, int nblk) {
    const size_t gt = (size_t)bid * NT + threadIdx.x, ngt = (size_t)nblk * NT;
    for (size_t i = gt; i < (size_t)16 * 8192; i += ngt) {
        const int bh = (int)(i >> 13), el = (int)(i & 8191), h = bh & 3;
        const float gc = __expf(__logf(ret_gamma(h)) * 128.f);
        float S = 0.f, lv[32];
#pragma unroll
        for (int n = 0; n < 32; ++n) lv[n] = p.sloc[((size_t)bh * 32 + n) * 8192 + el];
#pragma unroll
        for (int n = 0; n < 32; ++n) {
            p.spre[((size_t)bh * 32 + n) * 8192 + el] = S;
            S = S * gc + lv[n];
        }
        p.p_ret[(size_t)bh * 8192 + el] = S;
    }
    for (size_t i = gt; i < (size_t)128 * 8192; i += ngt) {
        const int bh = (int)(i >> 13), el = (int)(i & 8191), h = bh & 3, b = bh >> 2, d = el >> 7, e = el & 127;
        const size_t r = TP + b;
        const float k = bf2f(p.rk[r * 256 + h * 64 + d]), v = bf2f(p.rv[r * 512 + h * 128 + e]);
        p.s_ret[i] = p.state_ret[i] * ret_gamma(h) + k * v;
    }
}
__device__ __forceinline__ void p6c_out(const Params& p, char* lds, int bid, int nblk) {
    float* Am = (float*)lds;
    const int tid = opaque_tid();
    for (int it = bid; it < 4 * 4 * 32 + 128; it += nblk) {
        if (it < 512) {
            const int n = it & 31, h = (it >> 5) & 3, b = it >> 7;
            const float lg = __logf(ret_gamma(h));
            const size_t r0 = (size_t)b * SEQ + n * 128;
            for (int idx = tid; idx < 128 * 128; idx += NT) {
                const int i = idx >> 7, j = idx & 127;
                float a = 0.f;
                if (j <= i) {
                    const bf16_t* qr = p.rq + (r0 + i) * 256 + h * 64; const bf16_t* kr = p.rk + (r0 + j) * 256 + h * 64;
#pragma unroll
                    for (int c = 0; c < 8; ++c) { float qf[8], kf[8]; load8(qr + c * 8, qf); load8(kr + c * 8, kf);
#pragma unroll
                        for (int u = 0; u < 8; ++u) a += qf[u] * kf[u]; }
                    a *= __expf(lg * (float)(i - j));
                }
                Am[i * 129 + j] = a;
            }
            __syncthreads();
            const int e = tid & 127, ig = tid >> 7;
            const float* S = p.spre + (size_t)it * 8192;
            for (int i = ig * 32; i < ig * 32 + 32; ++i) {
                float o = 0.f;
                for (int j = 0; j <= i; ++j) o += Am[i * 129 + j] * bf2f(p.rv[(r0 + j) * 512 + h * 128 + e]);
                float qs = 0.f;
                const bf16_t* qr = p.rq + (r0 + i) * 256 + h * 64;
                for (int d = 0; d < 64; ++d) qs += bf2f(qr[d]) * S[d * 128 + e];
                o += qs * __expf(lg * (float)(i + 1));
                p.oret[(r0 + i) * 512 + h * 128 + e] = o;
            }
            __syncthreads();
        } else {
            const int bh = it - 512, h = bh & 3, b = bh >> 2;
            const size_t r = TP + b;
            if (tid < 128) {
                const int e = tid;
                const bf16_t* qr = p.rq + r * 256 + h * 64; const bf16_t* kr = p.rk + r * 256 + h * 64;
                const float* S0 = p.state_ret + (size_t)bh * 8192;
                float qs = 0.f, qk = 0.f;
                for (int d = 0; d < 64; ++d) { const float q = bf2f(qr[d]); qs += q * S0[d * 128 + e]; qk += q * bf2f(kr[d]); }
                p.oret[r * 512 + h * 128 + e] = qs * ret_gamma(h) + qk * bf2f(p.rv[r * 512 + h * 128 + e]);
            }
        }
    }
}
__device__ __forceinline__ void p6d_norm(const Params& p, int bid, int nblk) {
    const int tid = opaque_tid(), lane = tid & 63, wave = tid >> 6;
    for (int it = bid * 8 + wave; it < R * 4; it += nblk * 8) {
        const int r = it >> 2, h = it & 3;
        const float* o = p.oret + (size_t)r * 512 + h * 128;
        const float v0 = o[lane], v1 = o[lane + 64];
        const float rs = rsqrtf(wave_sum(v0 * v0 + v1 * v1) * (1.f / 128.f) + EPS);
        p.yar[(size_t)r * 1024 + 512 + h * 128 + lane] = f2bf(v0 * rs * p.g_ret[lane] * bf2f(p.gr[(size_t)r * 512 + h * 128 + lane]));
        p.yar[(size_t)r * 1024 + 512 + h * 128 + lane + 64] = f2bf(v1 * rs * p.g_ret[lane + 64] * bf2f(p.gr[(size_t)r * 512 + h * 128 + lane + 64]));
    }
}


__device__ __forceinline__ void ret_stage(LAS char* dst, const bf16_t* src, size_t row_stride, int lg_slots, int npieces, int tid) {
    for (int pc = tid; pc < npieces; pc += NT) {
        const int row = pc >> lg_slots, slot = pc & ((1 << lg_slots) - 1);
        __builtin_amdgcn_global_load_lds((const unsigned*)(src + (size_t)row * row_stride + ((slot ^ (row & 7)) * 8)), (LAS unsigned*)(dst + pc * 16), 16, 0, 0);
    }
}
__device__ __forceinline__ s16x4 ret_tr(const LAS char* img, int RB, int r0, int c0, int fr) {
    const int row = r0 + (fr >> 2), chunk = (c0 >> 3) + ((fr & 3) >> 1);
    return __builtin_amdgcn_ds_read_tr16_b64_v4i16((LAS s16x4*)(img + row * RB + ((chunk ^ (row & 7)) * 16) + (fr & 1) * 8));
}
__device__ __forceinline__ bf16x8 cat8(s16x4 a, s16x4 b) { bf16x8 v; v[0] = a[0]; v[1] = a[1]; v[2] = a[2]; v[3] = a[3]; v[4] = b[0]; v[5] = b[1]; v[6] = b[2]; v[7] = b[3]; return v; }

__device__ __forceinline__ void ret_local_item(const Params& p, char* lds, int it) {
    LAS char* l3 = (LAS char*)lds;
    const int tid = opaque_tid(), lane = tid & 63, wave = tid >> 6, fr = lane & 15, G = lane >> 4;
    {
        const int n = it & 31, h = (it >> 5) & 3, b = it >> 7;
        const size_t r0 = (size_t)b * SEQ + n * 128;
        __syncthreads();
        ret_stage(l3, p.rk + r0 * 256 + h * 64, 256, 3, 1024, tid);
        ret_stage(l3 + 16384, p.rv + r0 * 512 + h * 128, 512, 4, 2048, tid);
        asm volatile("s_waitcnt vmcnt(0)" ::: "memory");
        __syncthreads();
        f32x4 acc[4];
#pragma unroll
        for (int dt = 0; dt < 4; ++dt) acc[dt] = (f32x4){0.f, 0.f, 0.f, 0.f};
#pragma unroll
        for (int js = 0; js < 4; ++js) {
            const int j0 = js * 32 + 4 * G;
            const bf16x8 bfr = cat8(ret_tr(l3 + 16384, 256, j0, wave * 16, fr), ret_tr(l3 + 16384, 256, j0 + 16, wave * 16, fr));
#pragma unroll
            for (int dt = 0; dt < 4; ++dt) {
                const bf16x8 afr = cat8(ret_tr(l3, 128, j0, dt * 16, fr), ret_tr(l3, 128, j0 + 16, dt * 16, fr));
                acc[dt] = __builtin_amdgcn_mfma_f32_16x16x32_bf16(afr, bfr, acc[dt], 0, 0, 0);
            }
        }
        const float sc = exp2f(__log2f(ret_gamma(h)) * 127.f);
        float* out = p.sloc + (size_t)it * 8192 + wave * 16 + fr;
#pragma unroll
        for (int dt = 0; dt < 4; ++dt)
#pragma unroll
            for (int rg = 0; rg < 4; ++rg) out[(dt * 16 + 4 * G + rg) * 128] = acc[dt][rg] * sc;
    }
}

__device__ __forceinline__ void ret_out_item(const Params& p, char* lds, int it) {
    LAS char* l3 = (LAS char*)lds;
    const int tid = opaque_tid(), lane = tid & 63, wave = tid >> 6, fr = lane & 15, G = lane >> 4;
    {
        __syncthreads();
        if (it < 512) {
            const int n = it & 31, h = (it >> 5) & 3, b = it >> 7;
            const size_t r0 = (size_t)b * SEQ + n * 128;
            const float gam = ret_gamma(h);
            ret_stage(l3, p.rk + r0 * 256 + h * 64, 256, 3, 1024, tid);
            ret_stage(l3 + 16384, p.rv + r0 * 512 + h * 128, 512, 4, 2048, tid);
            {
                const float* S = p.spre + (size_t)it * 8192;
                for (int pc = tid; pc < 1024; pc += NT) {
                    const int row = pc >> 4, slot = pc & 15;
                    const float4 a = *(const float4*)(S + row * 128 + slot * 8), c = *(const float4*)(S + row * 128 + slot * 8 + 4);
                    u32x4 v; v[0] = cvt_pk_bf16(a.x * gam, a.y * gam); v[1] = cvt_pk_bf16(a.z * gam, a.w * gam); v[2] = cvt_pk_bf16(c.x * gam, c.y * gam); v[3] = cvt_pk_bf16(c.z * gam, c.w * gam);
                    *(LAS u32x4*)(l3 + 49152 + row * 256 + ((slot ^ (row & 7)) * 16)) = v;
                }
            }
            const size_t ri = r0 + wave * 16 + fr;
            bf16x8 qf[2], qp[2];
#pragma unroll
            for (int ks = 0; ks < 2; ++ks) {
                const bf16_t* qrow = p.rq + ri * 256 + h * 64 + ks * 32;
                qf[ks] = *(const bf16x8*)(qrow + G * 8);
                const s16x4 lo = *(const s16x4*)(qrow + 4 * G), hi = *(const s16x4*)(qrow + 16 + 4 * G);
                qp[ks] = cat8(lo, hi);
            }
            asm volatile("s_waitcnt vmcnt(0)" ::: "memory");
            __syncthreads();
            f32x4 st[8];
#pragma unroll
            for (int jt = 0; jt < 8; ++jt) {
                st[jt] = (f32x4){0.f, 0.f, 0.f, 0.f};
                if (jt <= wave) {
#pragma unroll
                    for (int ks = 0; ks < 2; ++ks) {
                        const int row = jt * 16 + fr;
                        const bf16x8 kf = *(const LAS bf16x8*)(l3 + row * 128 + (((ks * 4 + G) ^ (row & 7)) * 16));
                        st[jt] = __builtin_amdgcn_mfma_f32_16x16x32_bf16(kf, qf[ks], st[jt], 0, 0, 0);
                    }
                    if (jt == wave) {
#pragma unroll
                        for (int rg = 0; rg < 4; ++rg) if (4 * G + rg > fr) st[jt][rg] = 0.f;
                    }
                }
            }
            f32x4 o[8];
#pragma unroll
            for (int et = 0; et < 8; ++et) o[et] = (f32x4){0.f, 0.f, 0.f, 0.f};
#pragma unroll
            for (int js = 0; js < 4; ++js) {
                if (2 * js <= wave) {
                    u32x4 pk;
                    pk[0] = cvt_pk_bf16(st[2 * js][0], st[2 * js][1]); pk[1] = cvt_pk_bf16(st[2 * js][2], st[2 * js][3]);
                    pk[2] = cvt_pk_bf16(st[2 * js + 1][0], st[2 * js + 1][1]); pk[3] = cvt_pk_bf16(st[2 * js + 1][2], st[2 * js + 1][3]);
                    const bf16x8 pf = __builtin_bit_cast(bf16x8, pk);
                    const int j0 = js * 32 + 4 * G;
#pragma unroll
                    for (int et = 0; et < 8; ++et) {
                        const bf16x8 vf = cat8(ret_tr(l3 + 16384, 256, j0, et * 16, fr), ret_tr(l3 + 16384, 256, j0 + 16, et * 16, fr));
                        o[et] = __builtin_amdgcn_mfma_f32_16x16x32_bf16(vf, pf, o[et], 0, 0, 0);
                    }
                }
            }
#pragma unroll
            for (int ks = 0; ks < 2; ++ks) {
                const int d0 = ks * 32 + 4 * G;
#pragma unroll
                for (int et = 0; et < 8; ++et) {
                    const bf16x8 sf = cat8(ret_tr(l3 + 49152, 256, d0, et * 16, fr), ret_tr(l3 + 49152, 256, d0 + 16, et * 16, fr));
                    o[et] = __builtin_amdgcn_mfma_f32_16x16x32_bf16(sf, qp[ks], o[et], 0, 0, 0);
                }
            }
            float ss = 0.f;
#pragma unroll
            for (int et = 0; et < 8; ++et)
#pragma unroll
                for (int rg = 0; rg < 4; ++rg) ss += o[et][rg] * o[et][rg];
            ss += __shfl_xor(ss, 16); ss += __shfl_xor(ss, 32);
            const float rs = rsqrtf(ss * (1.f / 128.f) + EPS);
            float4 grv[8]; uint2 gvv[8];
#pragma unroll
            for (int et = 0; et < 8; ++et) { const int e = et * 16 + 4 * G; grv[et] = *(const float4*)(p.g_ret + e); gvv[et] = *(const uint2*)(p.gr + ri * 512 + h * 128 + e); }
#pragma unroll
            for (int et = 0; et < 8; ++et) {
                const int e = et * 16 + 4 * G;
                const float4 gr = grv[et];
                const uint2 gv = gvv[et];
                uint2 ov;
                ov.x = cvt_pk_bf16(o[et][0] * rs * gr.x * __uint_as_float(gv.x << 16), o[et][1] * rs * gr.y * __uint_as_float(gv.x & 0xffff0000u));
                ov.y = cvt_pk_bf16(o[et][2] * rs * gr.z * __uint_as_float(gv.y << 16), o[et][3] * rs * gr.w * __uint_as_float(gv.y & 0xffff0000u));
                *(uint2*)(p.yar + ri * 1024 + 512 + h * 128 + e) = ov;
            }
        } else {
            const int bh = it - 512, h = bh & 3, b = bh >> 2;
            const size_t r = TP + b;
            float* red = (float*)lds;
            float o = 0.f;
            if (tid < 128) {
                const int e = tid;
                const bf16_t* qr = p.rq + r * 256 + h * 64; const bf16_t* kr = p.rk + r * 256 + h * 64;
                const float* S0 = p.state_ret + (size_t)bh * 8192;
                float qs = 0.f, qk = 0.f;
                for (int d = 0; d < 64; ++d) { const float q = bf2f(qr[d]); qs += q * S0[d * 128 + e]; qk += q * bf2f(kr[d]); }
                o = qs * ret_gamma(h) + qk * bf2f(p.rv[r * 512 + h * 128 + e]);
                const float s2 = wave_sum(o * o);
                if (lane == 0) red[wave] = s2;
            }
            __syncthreads();
            if (tid < 128) {
                const float rs = rsqrtf((red[0] + red[1]) * (1.f / 128.f) + EPS);
                p.yar[r * 1024 + 512 + h * 128 + tid] = f2bf(o * rs * p.g_ret[tid] * bf2f(p.gr[r * 512 + h * 128 + tid]));
            }
        }
    }
}

__device__ __forceinline__ void out_sample(const Params& p, int bid, int nblk) {
    const int tid = opaque_tid(), lane = tid & 63, wave = tid >> 6, fr = lane & 15, G = lane >> 4;
    for (int it = bid * 8 + wave; it < 128; it += nblk * 8) {
        const int mt = it >> 6, nt = it & 63;
        const bf16_t* arow = p.yar + (size_t)(TP + mt * 16 + fr) * 1024 + G * 8;
        const bf16_t* brow = p.bt_out + (size_t)(nt * 16 + fr) * 1024 + G * 8;
        f32x4 acc = {0.f, 0.f, 0.f, 0.f};
#pragma unroll 8
        for (int ks = 0; ks < 32; ++ks) {
            const bf16x8 a = *(const bf16x8*)(arow + ks * 32), b = *(const bf16x8*)(brow + ks * 32);
            acc = __builtin_amdgcn_mfma_f32_16x16x32_bf16(a, b, acc, 0, 0, 0);
        }
        const int c = nt * 16 + fr;
#pragma unroll
        for (int rg = 0; rg < 4; ++rg) {
            const int sb = mt * 16 + 4 * G + rg;
            p.y[(size_t)(TP + sb) * 1024 + c] = p.x_sample[(size_t)sb * 1024 + c] + p.mod[(4 + sb) * 3072 + 2048 + c] * acc[rg];
        }
    }
}
__global__ void __launch_bounds__(NT, 2) k_mega(Params p) {
    extern __shared__ __attribute__((aligned(16))) char lds[];
    const int bid = blockIdx.x, nblk = gridDim.x;
    uint4* xbw = (uint4*)(lds + 147456);
    if (threadIdx.x == 0) *xbw = make_uint4(0u, 0u, 0u, 0u);
    __syncthreads();
    XcdBarrier bar = xcd_barrier_post(p.bar, (volatile LAS unsigned*)xbw);
    p0_adaln(p, lds, bid, nblk); __syncthreads(); p0_weights(p, lds, bid, nblk); __syncthreads(); compress_sample(p, lds, bid, nblk);
    wg_wait(p.bar + 3520, 96u, p.bar + XB_TMO);
    p1_norm(p, lds, bid, nblk);
    xcd_barrier(bar);
    { EpiIn e{&p}; gemm_phase(p.H, p.bt_in, RPAD / 256, NPAD / 256, 1024, lds, bid, nblk, e); }
    if (nblk == 256) compress_seams(p, bid - 142, 114); else compress_seams(p, bid, nblk);
    xcd_barrier(bar);
    {
        volatile int* slot = (volatile int*)(lds + 147456 + 16);
        for (;;) {
            __syncthreads();
            if (threadIdx.x == 0) *slot = (int)__hip_atomic_fetch_add(p.bar + 3456 + 48, 1u, __ATOMIC_RELAXED, __HIP_MEMORY_SCOPE_AGENT);
            __syncthreads();
            const int w = *slot;
            if (w >= 136 + 512) break;
            if (w < 136) compress_prompt_ksplit_item(p, lds, w); else ret_local_item(p, lds, w - 136);
        }
    }
    xcd_barrier(bar);
    p6b_scan(p, bid, nblk); wg_signal(p.bar + 3456, true);
    att_phase(p, lds, bid, nblk);
    ret_out_queue(p, lds, bid, nblk);
    xcd_barrier(bar);
    { EpiOut e{&p}; gemm_phase(p.yar, p.bt_out, TP / 256, 4, 1024, lds, bid, nblk, e); }
    out_sample(p, nblk - 1 - bid, nblk);
}
}

extern "C" void kernel_launch(void* const* d_in, const int* in_sizes, int n_in, void* d_out, int out_size, void* d_ws, size_t ws_size, hipStream_t stream) {
    Params p{};
    p.x_prompt = (const float*)d_in[0]; p.x_sample = (const float*)d_in[1]; p.c_prompt = (const float*)d_in[2]; p.c_sample = (const float*)d_in[3];
    p.cache_cmp = (const float*)d_in[4]; p.cache_slc = (const float*)d_in[5]; p.state_win = (const float*)d_in[6]; p.state_ret = (const float*)d_in[7];
    p.page_table = (const int*)d_in[8];
    p.g_norm = (const float*)d_in[9]; p.w_ada = (const float*)d_in[10]; p.b_ada = (const float*)d_in[11]; p.w_in = (const float*)d_in[12];
    p.g_q = (const float*)d_in[13]; p.g_kc = (const float*)d_in[14]; p.g_ks = (const float*)d_in[15]; p.g_kw = (const float*)d_in[16];
    p.pe_ck = (const float*)d_in[17]; p.w_ck1 = (const float*)d_in[18]; p.w_ck2 = (const float*)d_in[19];
    p.pe_cv = (const float*)d_in[20]; p.w_cv1 = (const float*)d_in[21]; p.w_cv2 = (const float*)d_in[22];
    p.g_ret = (const float*)d_in[23]; p.w_out = (const float*)d_in[24];
    float* o = (float*)d_out;
    p.y = o; o += (size_t)R * 1024;
    p.p_cmp = o; o += (size_t)TP * 256; p.p_slc = o; o += (size_t)TP * 256; p.p_win = o; o += (size_t)4 * 512 * 256; p.p_ret = o; o += (size_t)16 * 8192;
    p.s_cmp = o; o += 32 * 256; p.s_slc = o; o += 32 * 256; p.s_win = o; o += (size_t)32 * 512 * 256; p.s_ret = o; o += (size_t)128 * 8192;
    char* w = (char*)d_ws; size_t off = 0;
    auto take = [&](size_t bytes) { char* q = w + off; off += (bytes + 255) & ~(size_t)255; return q; };
    p.bar = (unsigned*)take(16384);
    p.mod = (float*)take(36 * 3072 * 4);
    p.bt_in = (bf16_t*)take((size_t)NPAD * 1024 * 2);
    p.bt_out = (bf16_t*)take((size_t)1024 * 1024 * 2);
    p.H = (bf16_t*)take((size_t)RPAD * 1024 * 2);
    p.praw = (float*)take((size_t)RPAD * NPAD * 4);
    p.qn = (bf16_t*)take((size_t)R * 512 * 2);
    p.kcr = (bf16_t*)take((size_t)TP * 128 * 2); p.vcr = (bf16_t*)take((size_t)TP * 128 * 2);
    p.ks = (bf16_t*)take((size_t)TP * 128 * 2); p.vs = (bf16_t*)take((size_t)TP * 128 * 2);
    p.kw = (bf16_t*)take((size_t)TP * 128 * 2); p.vw = (bf16_t*)take((size_t)TP * 128 * 2);
    p.gates = (float*)take((size_t)R * 24 * 4);
    p.ga = (bf16_t*)take((size_t)R * 512 * 2); p.gr = (bf16_t*)take((size_t)R * 512 * 2);
    p.rq = (bf16_t*)take((size_t)R * 256 * 2); p.rk = (bf16_t*)take((size_t)R * 256 * 2); p.rv = (bf16_t*)take((size_t)R * 512 * 2);
    p.kc = (bf16_t*)take((size_t)4 * 2 * 256 * 64 * 2); p.vc = (bf16_t*)take((size_t)4 * 2 * 256 * 64 * 2);
    p.kcs = (bf16_t*)take((size_t)32 * 2 * 1024 * 64 * 2); p.vcs = (bf16_t*)take((size_t)32 * 2 * 1024 * 64 * 2);
    p.yar = (bf16_t*)take((size_t)RPAD * 1024 * 2);
    p.sloc = (float*)take((size_t)512 * 8192 * 4); p.spre = (float*)take((size_t)512 * 8192 * 4);
    p.oret = (float*)take((size_t)R * 512 * 4);
    p.w1p = (bf16_t*)take((size_t)2 * 128 * 1024 * 2); p.w2t = (bf16_t*)take((size_t)2 * 64 * 64 * 2); p.b1 = (float*)take(128 * 4);
    p.attb = (float*)take(256);
    p.ropec = (float*)take((size_t)4097 * 32 * 4); p.ropes = (float*)take((size_t)4097 * 32 * 4);
    p.seamA = (float*)take((size_t)32 * 2 * 64 * 2 * 64 * 4); p.seamB = (float*)take((size_t)32 * 2 * 64 * 2 * 64 * 4);
    if (off > ws_size) { fprintf(stderr, "workspace too small: need %zu have %zu\n", off, ws_size); return; }
    static int grid = 0;
    if (grid == 0) {
        int dev = 0, cus = 0, per_cu = 0;
        if (hipGetDevice(&dev) != hipSuccess || hipDeviceGetAttribute(&cus, hipDeviceAttributeMultiprocessorCount, dev) != hipSuccess) { fprintf(stderr, "device query failed\n"); grid = -1; return; }
        if (hipFuncSetAttribute((const void*)k_mega, hipFuncAttributeMaxDynamicSharedMemorySize, LDS_BYTES) != hipSuccess) { fprintf(stderr, "hipFuncSetAttribute failed\n"); grid = -1; return; }
        if (hipOccupancyMaxActiveBlocksPerMultiprocessor(&per_cu, (const void*)k_mega, NT, LDS_BYTES) != hipSuccess || per_cu < 1) { fprintf(stderr, "occupancy query: %d blocks per CU\n", per_cu); grid = -1; return; }
        (void)hipGetLastError();
        grid = cus;
    }
    if (grid < 0) return;
    (void)hipMemsetAsync(p.bar, 0, 16384, stream);
    hipLaunchKernelGGL(k_mega, dim3(grid), dim3(NT), LDS_BYTES, stream, p);
}
```

```cpp
#include <hip/hip_runtime.h>
#include <stdint.h>
#include <stdio.h>

namespace {
typedef unsigned short bf16_t;
typedef short bf16x8 __attribute__((ext_vector_type(8)));
typedef float f32x4 __attribute__((ext_vector_type(4)));

constexpr int D_MODEL = 1024, BATCH = 4, SEQ = 4096, DEC_BATCH = 32, PAST = 16384;
constexpr int NPAGES = 128, NPHYS = 5120;
constexpr int TP = BATCH * SEQ;
constexpr int R = TP + DEC_BATCH;
constexpr int RPAD = 16640;
constexpr int D_IN = 3352, NPAD = 3584;
constexpr int C_Q = 0, C_KC = 512, C_KS = 768, C_KW = 1024, C_BR = 1280, C_GA = 1304, C_RQ = 1816, C_RK = 2072, C_RV = 2328, C_GR = 2840;
constexpr float EPS = 1e-6f;
constexpr int NT = 512;
constexpr int LDS_BYTES = 147456 + 64 + 8192 + 256;

struct Params {
    const float *x_prompt, *x_sample, *c_prompt, *c_sample, *cache_cmp, *cache_slc, *state_win, *state_ret;
    const int* page_table;
    const float *g_norm, *w_ada, *b_ada, *w_in, *g_q, *g_kc, *g_ks, *g_kw, *pe_ck, *w_ck1, *w_ck2, *pe_cv, *w_cv1, *w_cv2, *g_ret, *w_out;
    float *y, *p_cmp, *p_slc, *p_win, *p_ret, *s_cmp, *s_slc, *s_win, *s_ret;
    unsigned* bar;
    float* mod;
    bf16_t* bt_in;
    bf16_t* bt_out;
    bf16_t* H;
    float* praw;
    bf16_t* qn;
    bf16_t *kcr, *vcr, *ks, *vs, *kw, *vw;
    float* gates;
    bf16_t *ga, *gr;
    bf16_t *rq, *rk;
    bf16_t* rv;
    bf16_t *kc, *vc;
    bf16_t *kcs, *vcs;
    bf16_t* yar;
    float *sloc, *spre;
    float* oret;
    bf16_t* w1p;
    bf16_t* w2t;
    float* b1;
    float *seamA, *seamB;
    float* attb;
    float *ropec, *ropes;
};

__device__ __forceinline__ int tile_src(int pn) { return pn <= 4 ? pn * 256 : pn == 13 ? 1280 : 1304 + (pn - 5) * 256; }
__device__ __forceinline__ bf16_t f2bf(float f) { unsigned u = __float_as_uint(f); u += 0x7fffu + ((u >> 16) & 1u); return (bf16_t)(u >> 16); }
__device__ __forceinline__ float bf2f(bf16_t h) { return __uint_as_float(((unsigned)h) << 16); }
__device__ __forceinline__ float wave_sum(float v) {
#pragma unroll
    for (int o = 1; o < 64; o <<= 1) v += __shfl_xor(v, o);
    return v;
}
__device__ __forceinline__ float wave_max(float v) {
#pragma unroll
    for (int o = 1; o < 64; o <<= 1) v = fmaxf(v, __shfl_xor(v, o));
    return v;
}
__device__ __forceinline__ float silu(float v) { return v / (1.f + __expf(-v)); }
__device__ __forceinline__ float sigmoidf(float v) { return 1.f / (1.f + __expf(-v)); }
__device__ __forceinline__ int opaque_tid() { int t = threadIdx.x; asm volatile("" : "+v"(t)); return t; }
typedef __bf16 bf16x2_t __attribute__((ext_vector_type(2)));
typedef float f32x2_t __attribute__((ext_vector_type(2)));
__device__ __forceinline__ unsigned cvt_pk_bf16(float lo, float hi) { const f32x2_t v = {lo, hi}; return __builtin_bit_cast(unsigned, __builtin_convertvector(v, bf16x2_t)); }
#define WSYNC() asm volatile("s_waitcnt lgkmcnt(0)" ::: "memory")

__device__ __forceinline__ void load8(const bf16_t* p, float (&f)[8]) {
    uint4 u = *(const uint4*)p;
    f[0] = __uint_as_float(u.x << 16); f[1] = __uint_as_float(u.x & 0xffff0000u);
    f[2] = __uint_as_float(u.y << 16); f[3] = __uint_as_float(u.y & 0xffff0000u);
    f[4] = __uint_as_float(u.z << 16); f[5] = __uint_as_float(u.z & 0xffff0000u);
    f[6] = __uint_as_float(u.w << 16); f[7] = __uint_as_float(u.w & 0xffff0000u);
}
__device__ __forceinline__ void load8(const float* p, float (&f)[8]) {
    float4 a = *(const float4*)p, b = *(const float4*)(p + 4);
    f[0] = a.x; f[1] = a.y; f[2] = a.z; f[3] = a.w; f[4] = b.x; f[5] = b.y; f[6] = b.z; f[7] = b.w;
}
__device__ __forceinline__ float load1(const bf16_t* p) { return bf2f(*p); }
__device__ __forceinline__ float load1(const float* p) { return *p; }


#define XB_TMO      128
#define XB_XCNT(j)  (256  + 64 * (j))
#define XB_XSUB(j)  (1280 + 64 * (j))
#define XB_XGEN(j)  (2304 + 64 * (j))
#define XB_TOP      3328
#define XB_TOPGEN   3392
#define XCD_BAR_WORDS 3456
#define XB_SPIN_CAP (1u << 18)
#define LAS __attribute__((address_space(3)))
__device__ __forceinline__ unsigned xb_ld(unsigned* p)              { return __hip_atomic_load(p, __ATOMIC_RELAXED, __HIP_MEMORY_SCOPE_AGENT); }
__device__ __forceinline__ unsigned xb_add(unsigned* p, unsigned v) { return __hip_atomic_fetch_add(p, v, __ATOMIC_RELAXED, __HIP_MEMORY_SCOPE_AGENT); }
__device__ __forceinline__ unsigned xb_xcc_id() { return (unsigned)__builtin_amdgcn_s_getreg((3 << 11) | 20) & 0xFu; }
#define XB_SPIN(cond, bar) do { unsigned _sp = 0; while (cond) { __builtin_amdgcn_s_sleep(1); \
    if ((++_sp & 255u) == 0u) { if (xb_ld(&(bar)[XB_TMO])) break; if (_sp > XB_SPIN_CAP) { atomicAdd(&(bar)[XB_TMO], 1u); break; } } } } while (0)
struct XcdBarrier { unsigned* bar; unsigned x; volatile LAS unsigned* st; };
__device__ __forceinline__ XcdBarrier xcd_barrier_post(unsigned* bar, volatile LAS unsigned* st) {
    XcdBarrier b; b.bar = bar; b.x = xb_xcc_id(); b.st = st;
    if (threadIdx.x == 0) (void)xb_add(&bar[XB_XCNT(b.x)], 1u);
    return b;
}
__device__ __forceinline__ void xcd_barrier_complete(unsigned* bar, unsigned x, unsigned& nloc, unsigned& nx) {
    const unsigned G = gridDim.x * gridDim.y * gridDim.z;
    unsigned sum, cnt, mine, sp = 0u;
    for (;;) {
        sum = 0u; cnt = 0u; mine = 0u;
#pragma unroll
        for (unsigned j = 0; j < 16; ++j) { const unsigned c = xb_ld(&bar[XB_XCNT(j)]); sum += c; cnt += (c > 0u) ? 1u : 0u; mine = (j == x) ? c : mine; }
        if (sum == G) break;
        __builtin_amdgcn_s_sleep(1);
        if ((++sp & 255u) == 0u) { if (xb_ld(&bar[XB_TMO])) break; if (sp > XB_SPIN_CAP) { atomicAdd(&bar[XB_TMO], 1u); break; } }
    }
    nloc = mine > 0u ? mine : 1u; nx = cnt > 0u ? cnt : 1u;
}
__device__ __forceinline__ void xcd_barrier(const XcdBarrier& b) {
    asm volatile("s_waitcnt vmcnt(0)" ::: "memory");
    __syncthreads();
    if (threadIdx.x == 0) {
        unsigned* bar = b.bar;
        __builtin_amdgcn_s_waitcnt(0);
        unsigned nloc = b.st[0], nx = b.st[1];
        if (nloc == 0u) { xcd_barrier_complete(bar, b.x, nloc, nx); b.st[0] = nloc; b.st[1] = nx; }
        const unsigned old = xb_add(&bar[XB_XSUB(b.x)], 1u);
        const unsigned gen = old / nloc;
        if (old + 1u == (gen + 1u) * nloc) {
            __builtin_amdgcn_fence(__ATOMIC_RELEASE, "agent");
            asm volatile("s_waitcnt vmcnt(0)" ::: "memory");
            const unsigned og = xb_add(&bar[XB_TOP], 1u);
            const unsigned tg = og / nx;
            if (og + 1u == (tg + 1u) * nx) xb_add(&bar[XB_TOPGEN], 1u);
            else XB_SPIN(xb_ld(&bar[XB_TOPGEN]) == tg, bar);
            __builtin_amdgcn_fence(__ATOMIC_ACQUIRE, "agent");
            xb_add(&bar[XB_XGEN(b.x)], 1u);
            asm volatile("s_waitcnt vmcnt(0)" ::: "memory");
        } else {
            XB_SPIN(xb_ld(&bar[XB_XGEN(b.x)]) == gen, bar);
            __builtin_amdgcn_fence(__ATOMIC_ACQUIRE, "agent");
            asm volatile("s_waitcnt vmcnt(0)" ::: "memory");
        }
    }
    __syncthreads();
}


__device__ __forceinline__ void wg_signal(unsigned* ctr, bool need_release) {
    asm volatile("s_waitcnt vmcnt(0)" ::: "memory");
    __syncthreads();
    if (threadIdx.x == 0) {
        if (need_release) { __builtin_amdgcn_fence(__ATOMIC_RELEASE, "agent"); asm volatile("s_waitcnt vmcnt(0)" ::: "memory"); }
        (void)__hip_atomic_fetch_add(ctr, 1u, __ATOMIC_RELAXED, __HIP_MEMORY_SCOPE_AGENT);
    }
}
__device__ __forceinline__ void wg_wait(unsigned* ctr, unsigned target, unsigned* tmo) {
    if (threadIdx.x == 0) {
        unsigned sp = 0;
        while (__hip_atomic_load(ctr, __ATOMIC_RELAXED, __HIP_MEMORY_SCOPE_AGENT) < target) {
            __builtin_amdgcn_s_sleep(2);
            if (++sp > (1u << 22)) { atomicAdd(tmo, 1u); break; }
        }
        __builtin_amdgcn_fence(__ATOMIC_ACQUIRE, "agent");
        asm volatile("s_waitcnt vmcnt(0)" ::: "memory");
    }
    __syncthreads();
}
__device__ __forceinline__ void p0_adaln(const Params& p, char* lds, int bid, int nblk) {
    float* sc = (float*)lds;
    float* red = (float*)(lds + 73728);
    const int tid = opaque_tid(), lane = tid & 63, wave = tid >> 6;
    for (int item = bid; item < 96; item += nblk) {
        const int cb = item >> 1, r0 = (item & 1) * 18;
        __syncthreads();
        for (int i = tid; i < 18 * 1024; i += NT) {
            const int row = r0 + (i >> 10), k = i & 1023;
            sc[i] = silu(row < 4 ? p.c_prompt[row * 1024 + k] : p.c_sample[(row - 4) * 1024 + k]);
        }
        __syncthreads();
        const int j = cb * 64 + lane;
        float acc[18];
#pragma unroll
        for (int r = 0; r < 18; ++r) acc[r] = 0.f;
        const int k0 = wave * 128;
#pragma unroll 2
        for (int k = k0; k < k0 + 128; k += 4) {
            const float w0 = p.w_ada[(size_t)k * 3072 + j], w1 = p.w_ada[(size_t)(k + 1) * 3072 + j], w2 = p.w_ada[(size_t)(k + 2) * 3072 + j], w3 = p.w_ada[(size_t)(k + 3) * 3072 + j];
#pragma unroll
            for (int r = 0; r < 18; ++r) { const float4 s = *(const float4*)(sc + r * 1024 + k); acc[r] += s.x * w0 + s.y * w1 + s.z * w2 + s.w * w3; }
        }
#pragma unroll
        for (int r = 0; r < 18; ++r) red[(wave * 18 + r) * 64 + lane] = acc[r];
        __syncthreads();
        for (int i = tid; i < 18 * 64; i += NT) {
            const int r = i >> 6, l = i & 63;
            float s = 0.f;
#pragma unroll
            for (int w = 0; w < 8; ++w) s += red[(w * 18 + r) * 64 + l];
            __hip_atomic_store(&p.mod[(r0 + r) * 3072 + cb * 64 + l], s + p.b_ada[cb * 64 + l], __ATOMIC_RELAXED, __HIP_MEMORY_SCOPE_AGENT);
        }
        wg_signal(p.bar + 3520, false);
    }
}

__device__ __forceinline__ void transpose_item(const float* W, int K, int N, bf16_t* WT, float* scr, int item, int lane, int nblkN) {
    const int kb = item / nblkN, nb = item % nblkN, k0 = kb * 64, n0 = nb * 64;
    float tv[64];
#pragma unroll
    for (int kk = 0; kk < 64; ++kk) tv[kk] = (n0 + lane < N) ? W[(size_t)(k0 + kk) * N + n0 + lane] : 0.f;
#pragma unroll
    for (int kk = 0; kk < 64; ++kk) scr[kk * 65 + lane] = tv[kk];
    WSYNC();
    for (int nn = 0; nn < 64; ++nn) WT[(size_t)(n0 + nn) * K + k0 + lane] = f2bf(scr[lane * 65 + nn]);
    WSYNC();
}
__device__ __forceinline__ void p0_w1p(const Params& p, int bid, int nblk) {
    const size_t gt = (size_t)bid * NT + opaque_tid(), ngt = (size_t)nblk * NT;
    for (size_t i = gt; i < (size_t)2 * 128 * 1024; i += ngt) {
        const int kv = (int)(i >> 17), n = (int)(i >> 10) & 127, kp = (int)i & 1023;
        const int ks = kp >> 5, G = (kp >> 3) & 3, j = kp & 7;
        const int k = ks * 32 + 16 * (j >> 2) + 4 * G + (j & 3);
        const int l = (k >> 6) + (n >= 64 ? 16 : 0), d = k & 63, f = n & 63;
        p.w1p[i] = f2bf((kv ? p.w_cv1 : p.w_ck1)[(size_t)(l * 64 + d) * 64 + f]);
    }
}
__device__ __forceinline__ void p0_weights(const Params& p, char* lds, int bid, int nblk) {
    const int tid = opaque_tid(), lane = tid & 63, wave = tid >> 6;
    float* scr = (float*)lds + wave * (64 * 65);
    const int gw = bid * 8 + wave, ngw = nblk * 8;
    constexpr int I_IN = 16 * 112, I_OUT = 16 * 16;
    for (int it = gw; it < I_IN + I_OUT; it += ngw) {
        if (it < I_IN) {
            const int kb = it / 112, nb = it % 112, k0 = kb * 64, n0 = nb * 32;
            const int pn = n0 >> 8, pl = n0 & 255, bj = pl >> 7, wc = (pl >> 5) & 3;
            const int cb = tile_src(pn) + wc * 64 + bj * 32;
            const int lim = pn == 13 ? 1304 : D_IN;
            float tv[32];
#pragma unroll
            for (int i = 0; i < 32; ++i) { const int kk = 2 * i + (lane >> 5), c = cb + (lane & 31); tv[i] = c < lim ? p.w_in[(size_t)(k0 + kk) * D_IN + c] : 0.f; }
#pragma unroll
            for (int i = 0; i < 32; ++i) scr[(2 * i + (lane >> 5)) * 33 + (lane & 31)] = tv[i];
            WSYNC();
            const int c8 = lane & 7;
            for (int j = 0; j < 4; ++j) {
                const int n = (lane >> 3) + 8 * j; const float* s = scr + (8 * c8) * 33 + n;
                uint4 o; o.x = cvt_pk_bf16(s[0], s[33]); o.y = cvt_pk_bf16(s[66], s[99]); o.z = cvt_pk_bf16(s[132], s[165]); o.w = cvt_pk_bf16(s[198], s[231]);
                *(uint4*)(p.bt_in + (size_t)(n0 + n) * 1024 + k0 + 8 * c8) = o;
            }
            WSYNC();
        } else transpose_item(p.w_out, 1024, 1024, p.bt_out, scr, it - I_IN, lane, 16);
    }
    const size_t gt = (size_t)bid * NT + tid, ngt = (size_t)nblk * NT;
    for (size_t i = gt; i < (size_t)4097 * 32; i += ngt) {
        const int pi = (int)(i >> 5), fi = (int)i & 31;
        const float ang = (float)(pi < 4096 ? pi : PAST) * powf(10000.f, -(float)fi / 32.f);
        float sn, cs; sincosf(ang, &sn, &cs);
        p.ropec[i] = cs; p.ropes[i] = sn;
    }
    if (bid == (nblk > 200 ? 200 : 0) && wave == 0) {
        const float gq = wave_max(fabsf(p.g_q[lane])), gc = wave_max(fabsf(p.g_kc[lane])), gs = wave_max(fabsf(p.g_ks[lane])), gw = wave_max(fabsf(p.g_kw[lane]));
        if (lane == 0) { const float k = 8.f * 1.03f * 1.44269504088896f * gq; p.attb[0] = k * gc; p.attb[1] = k * gs; p.attb[2] = k * gw; p.attb[3] = 0.f; }
    }
    for (size_t i = gt; i < (size_t)2 * 64 * 64; i += ngt) {
        const int kv = (int)(i >> 12), d = (int)(i >> 6) & 63, f = (int)i & 63;
        p.w2t[i] = f2bf((kv ? p.w_cv2 : p.w_ck2)[f * 64 + d]);
    }
    for (int o = bid * 8 + wave; o < 128; o += nblk * 8) {
        const int kv = o >> 6, f = o & 63;
        const float* w1 = kv ? p.w_cv1 : p.w_ck1; const float* pe = kv ? p.pe_cv : p.pe_ck;
        float s = 0.f;
        for (int k = lane; k < 2048; k += 64) s += pe[k] * w1[(size_t)k * 64 + f];
        s = wave_sum(s);
        if (lane == 0) p.b1[o] = s;
    }
    for (size_t i = gt; i < (size_t)2 * 8 * 64; i += ngt) {
        const int which = (int)(i >> 9), bg = (int)(i >> 6) & 7, d = (int)i & 63;
        (which ? p.vc : p.kc)[((size_t)bg * 256 + 255) * 64 + d] = 0;
    }
    for (size_t i = gt; i < (size_t)32 * 511 * 64; i += ngt) {
        const int b = (int)(i / (511 * 64)), rem = (int)(i % (511 * 64));
        const float4 v = *(const float4*)(p.state_win + (size_t)b * 512 * 256 + 256 + (size_t)rem * 4);
        *(float4*)(p.s_win + (size_t)b * 512 * 256 + (size_t)rem * 4) = v;
    }
}

__device__ __forceinline__ void p1_norm(const Params& p, char* lds, int bid, int nblk) {
    const int tid = opaque_tid(), lane = tid & 63, wave = tid >> 6;
    volatile int* slot = (volatile int*)(lds + 147456 + 16);
    for (;;) {
        __syncthreads();
        if (tid == 0) *slot = (int)__hip_atomic_fetch_add(p.bar + 3456 + 32, 1u, __ATOMIC_RELAXED, __HIP_MEMORY_SCOPE_AGENT);
        __syncthreads();
        const int chunk = *slot;
        if (chunk * 32 >= R) break;
      for (int r = chunk * 32 + wave; r < R && r < chunk * 32 + 32; r += 8) {
        const float* xr = r < TP ? p.x_prompt + (size_t)r * 1024 : p.x_sample + (size_t)(r - TP) * 1024;
        const int mrow = r < TP ? (r >> 12) : 4 + (r - TP);
        const float* shift = p.mod + mrow * 3072, *scale = shift + 1024;
        float4 v[4]; float ss = 0.f;
#pragma unroll
        for (int j = 0; j < 4; ++j) { v[j] = *(const float4*)(xr + j * 256 + lane * 4); ss += v[j].x * v[j].x + v[j].y * v[j].y + v[j].z * v[j].z + v[j].w * v[j].w; }
        const float rs = rsqrtf(wave_sum(ss) * (1.f / 1024.f) + EPS);
#pragma unroll
        for (int j = 0; j < 4; ++j) {
            const int c = j * 256 + lane * 4;
            const float4 g = *(const float4*)(p.g_norm + c), sc = *(const float4*)(scale + c), sh = *(const float4*)(shift + c);
            ushort4 o;
            o.x = f2bf(v[j].x * rs * g.x * (1.f + sc.x) + sh.x);
            o.y = f2bf(v[j].y * rs * g.y * (1.f + sc.y) + sh.y);
            o.z = f2bf(v[j].z * rs * g.z * (1.f + sc.z) + sh.z);
            o.w = f2bf(v[j].w * rs * g.w * (1.f + sc.w) + sh.w);
            *(ushort4*)(p.H + (size_t)r * 1024 + c) = o;
        }
      }
    }
}

constexpr int BM = 256, BK = 64, HALF = 128, HT = HALF * BK;
__device__ __forceinline__ int lds_byte(int r, int c) {
    int st = (r >> 4) * 2 + (c >> 5), rr = r & 15, cc = c & 31, ob = rr * 64 + cc * 2;
    return st * 1024 + (ob ^ (((ob >> 9) & 1) << 5));
}
__device__ __forceinline__ void stage_rc(int b, int& Rr, int& Cc) {
    int st = b / 1024, sb = b % 1024, swz = sb ^ (((sb >> 9) & 1) << 5);
    Rr = (st >> 1) * 16 + swz / 64; Cc = (st & 1) * 32 + (swz % 64) / 2;
}

template <class Epi>
__device__ __forceinline__ void gemm_phase(const bf16_t* __restrict__ A, const bf16_t* __restrict__ Bt, int nM, int nN, int K, char* lds, int bid, int nblk, const Epi& epi) {
    bf16_t* shm = (bf16_t*)lds;
#define SA(b, h) (shm + ((b) * 2 + (h)) * HT)
#define SB(b, h) (shm + (4 + (b) * 2 + (h)) * HT)
#define STAGE_X(T, P, BASE, br, kt) do { long _g = (long)(br) * K + (long)(kt) * BK; \
    for (int _i = 0; _i < 2; ++_i) { int _b = (T) * 16 + _i * 8192; int _r, _c; stage_rc(_b, _r, _c); \
      __builtin_amdgcn_global_load_lds((const unsigned*)(BASE + _g + (long)_r * K + _c), \
        (__attribute__((address_space(3))) unsigned*)((char*)(P) + _b), 16, 0, 0); } } while (0)
#define STAGE(P, BASE, br, kt) STAGE_X(tz0, P, BASE, br, kt)
#define LDA(dst, b, h) for (int m = 0; m < 4; ++m) for (int k = 0; k < 2; ++k) \
    dst[m][k] = *reinterpret_cast<const bf16x8*>((char*)SA(b, h) + lds_byte(wr * 64 + m * 16 + fr, k * 32 + fq * 8))
#define LDB(dst, b, h) for (int n = 0; n < 2; ++n) for (int k = 0; k < 2; ++k) \
    dst[n][k] = *reinterpret_cast<const bf16x8*>((char*)SB(b, h) + lds_byte(wc * 32 + n * 16 + fr, k * 32 + fq * 8))
#define MMA(ai, bj, At, Bt_) do { __builtin_amdgcn_s_setprio(1); \
    for (int m = 0; m < 4; ++m) for (int n = 0; n < 2; ++n) for (int k = 0; k < 2; ++k) \
      acc[ai][bj][m][n] = __builtin_amdgcn_mfma_f32_16x16x32_bf16(Bt_[n][k], At[m][k], acc[ai][bj][m][n], 0, 0, 0); \
    __builtin_amdgcn_s_setprio(0); } while (0)
#define WAIT_V(n) asm volatile("s_waitcnt vmcnt(" #n ")" ::: "memory")
#define WAIT_L(n) asm volatile("s_waitcnt lgkmcnt(" #n ")" ::: "memory")
#define BAR __builtin_amdgcn_s_barrier()
#define SCHED __builtin_amdgcn_sched_barrier(0)
    const int nwg = nM * nN;
    for (int tile = bid; tile < nwg; tile += nblk) {
        const int pm = tile / nN, pn = tile % nN;
        const int brow = pm * BM, bcol = pn * BM;
        int tz0 = threadIdx.x; asm volatile("" : "+v"(tz0));
        int wid = tz0 >> 6, lane = tz0 & 63, wr = wid >> 2, wc = wid & 3, fr = lane & 15, fq = lane >> 4;
        f32x4 acc[2][2][4][2] = {};
        bf16x8 At[4][2], B0[2][2], B1[2][2];
        const int nt = K / BK;
        STAGE(SB(0, 0), Bt, bcol, 0); STAGE(SA(0, 0), A, brow, 0);
        STAGE(SB(0, 1), Bt, bcol + HALF, 0); STAGE(SA(0, 1), A, brow + HALF, 0);
        if (wr == 1) BAR;
        WAIT_V(4); BAR;
        STAGE(SB(1, 0), Bt, bcol, 1); STAGE(SA(1, 0), A, brow, 1); STAGE(SB(1, 1), Bt, bcol + HALF, 1);
        WAIT_V(6); BAR;
        for (int t = 0; t < nt - 2; t += 2) {
            LDB(B0, 0, 0); SCHED; LDA(At, 0, 0); STAGE(SA(1, 1), A, brow + HALF, t + 1);
            WAIT_L(8); BAR; WAIT_L(0); MMA(0, 0, At, B0); BAR; SCHED;
            LDB(B1, 0, 1); STAGE(SB(0, 0), Bt, bcol, t + 2);
            BAR; WAIT_L(0); MMA(0, 1, At, B1); BAR;
            LDA(At, 0, 1); STAGE(SA(0, 0), A, brow, t + 2);
            BAR; WAIT_L(0); MMA(1, 0, At, B0); BAR; SCHED;
            STAGE(SB(0, 1), Bt, bcol + HALF, t + 2);
            WAIT_V(6); BAR; MMA(1, 1, At, B1); BAR;
            LDB(B0, 1, 0); SCHED; LDA(At, 1, 0); STAGE(SA(0, 1), A, brow + HALF, t + 2);
            WAIT_L(8); BAR; WAIT_L(0); MMA(0, 0, At, B0); BAR; SCHED;
            LDB(B1, 1, 1); STAGE(SB(1, 0), Bt, bcol, t + 3);
            BAR; WAIT_L(0); MMA(0, 1, At, B1); BAR;
            LDA(At, 1, 1); STAGE(SA(1, 0), A, brow, t + 3);
            BAR; WAIT_L(0); MMA(1, 0, At, B0); BAR; SCHED;
            STAGE(SB(1, 1), Bt, bcol + HALF, t + 3);
            WAIT_V(6); BAR; MMA(1, 1, At, B1); BAR;
        }
        int tz = threadIdx.x; asm volatile("" : "+v"(tz)); wid = tz >> 6; lane = tz & 63; wr = wid >> 2; wc = wid & 3; fr = lane & 15; fq = lane >> 4;
        { LDB(B0, 0, 0); WAIT_V(0); LDA(At, 0, 0); STAGE_X(tz, SA(1, 1), A, brow + HALF, nt - 1);
          BAR; WAIT_L(0); MMA(0, 0, At, B0); BAR;
          LDB(B1, 0, 1); BAR; WAIT_L(0); MMA(0, 1, At, B1); BAR;
          LDA(At, 0, 1); WAIT_V(4); BAR; WAIT_L(0); MMA(1, 0, At, B0); MMA(1, 1, At, B1); BAR; }
        { LDB(B0, 1, 0); LDA(At, 1, 0); WAIT_V(2); BAR; WAIT_L(0); MMA(0, 0, At, B0); BAR;
          LDB(B1, 1, 1); WAIT_V(0); BAR; WAIT_L(0); MMA(0, 1, At, B1); BAR;
          LDA(At, 1, 1); BAR; WAIT_L(0); MMA(1, 0, At, B0); MMA(1, 1, At, B1); BAR; }
        if (wr == 0) BAR;
        epi(acc, brow, bcol, wr, wc, fr, fq);
    }
#undef SA
#undef SB
#undef STAGE_X
#undef STAGE
#undef LDA
#undef LDB
#undef MMA
}

struct EpiOut {
    const Params* p;
    __device__ __forceinline__ void operator()(const f32x4 (&acc)[2][2][4][2], int brow, int bcol, int wr, int wc, int fr, int fq) const {
#pragma unroll
        for (int ai = 0; ai < 2; ++ai)
#pragma unroll
            for (int mt = 0; mt < 4; ++mt) {
                const int r = brow + ai * HALF + wr * 64 + mt * 16 + fr;
                if (r < R) {
                    const float* xr = r < TP ? p->x_prompt + (size_t)r * 1024 : p->x_sample + (size_t)(r - TP) * 1024;
                    const float* gate = p->mod + (r < TP ? (r >> 12) : 4 + (r - TP)) * 3072 + 2048;
#pragma unroll
                    for (int bj = 0; bj < 2; ++bj)
#pragma unroll
                        for (int nt = 0; nt < 2; ++nt) {
                            const int c = bcol + bj * HALF + wc * 32 + nt * 16 + 4 * fq;
                            const float4 xv = *(const float4*)(xr + c), gv = *(const float4*)(gate + c);
                            float4 o; o.x = xv.x + gv.x * acc[ai][bj][mt][nt][0]; o.y = xv.y + gv.y * acc[ai][bj][mt][nt][1];
                            o.z = xv.z + gv.z * acc[ai][bj][mt][nt][2]; o.w = xv.w + gv.w * acc[ai][bj][mt][nt][3];
                            *(float4*)(p->y + (size_t)r * 1024 + c) = o;
                        }
                }
            }
    }
};

struct EpiIn {
    const Params* p;
    __device__ __forceinline__ void operator()(const f32x4 (&acc)[2][2][4][2], int brow, int bcol, int wr, int wc, int fr, int fq) const {
        const int pn = bcol >> 8;
        const Params& P = *p;
#pragma unroll
        for (int ai = 0; ai < 2; ++ai)
#pragma unroll
            for (int mt = 0; mt < 4; ++mt) {
                const int r = brow + ai * HALF + wr * 64 + mt * 16 + fr;
                const bool rowok = r < R;
                const bool isp = r < TP;
                const int b = isp ? (r >> 12) : (r - TP), t = isp ? (r & 4095) : 0, pidx = isp ? t : 4096;
                f32x4 v[2][2];
#pragma unroll
                for (int bj = 0; bj < 2; ++bj)
#pragma unroll
                    for (int nt = 0; nt < 2; ++nt) v[bj][nt] = acc[ai][bj][mt][nt];
                if (pn <= 1 || ((pn == 3 || pn == 4) && wc < 2)) {
                    float ss = 0.f;
#pragma unroll
                    for (int bj = 0; bj < 2; ++bj)
#pragma unroll
                        for (int nt = 0; nt < 2; ++nt)
#pragma unroll
                            for (int rg = 0; rg < 4; ++rg) ss += v[bj][nt][rg] * v[bj][nt][rg];
                    ss += __shfl_xor(ss, 16); ss += __shfl_xor(ss, 32);
                    const float rs = rsqrtf(ss * (1.f / 64.f) + EPS);
                    const float* gn = pn <= 1 ? P.g_q : pn == 3 ? P.g_ks : P.g_kw;
#pragma unroll
                    for (int bj = 0; bj < 2; ++bj)
#pragma unroll
                        for (int nt = 0; nt < 2; ++nt) {
                            const float4 g4 = *(const float4*)(gn + bj * 32 + nt * 16 + 4 * fq);
                            v[bj][nt][0] *= rs * g4.x; v[bj][nt][1] *= rs * g4.y; v[bj][nt][2] *= rs * g4.z; v[bj][nt][3] *= rs * g4.w;
                        }
                }
                if (!rowok) continue;
                if (pn == 7 || pn == 8) {
                    const float lgm = __log2f(1.f - exp2f(-5.f - (float)wc)) * (float)((isp ? t : PAST) & 127);
                    const float sc = pn == 7 ? exp2f(lgm) : 0.125f * exp2f(-lgm);
#pragma unroll
                    for (int nt = 0; nt < 2; ++nt) {
                        const float4 c4 = *(const float4*)(P.ropec + (size_t)pidx * 32 + nt * 16 + 4 * fq), s4 = *(const float4*)(P.ropes + (size_t)pidx * 32 + nt * 16 + 4 * fq);
                        const f32x4 x1 = v[0][nt], x2 = v[1][nt];
                        v[0][nt][0] = (x1[0] * c4.x - x2[0] * s4.x) * sc; v[1][nt][0] = (x1[0] * s4.x + x2[0] * c4.x) * sc;
                        v[0][nt][1] = (x1[1] * c4.y - x2[1] * s4.y) * sc; v[1][nt][1] = (x1[1] * s4.y + x2[1] * c4.y) * sc;
                        v[0][nt][2] = (x1[2] * c4.z - x2[2] * s4.z) * sc; v[1][nt][2] = (x1[2] * s4.z + x2[2] * c4.z) * sc;
                        v[0][nt][3] = (x1[3] * c4.w - x2[3] * s4.w) * sc; v[1][nt][3] = (x1[3] * s4.w + x2[3] * c4.w) * sc;
                    }
                }
                if (pn == 5 || pn == 6 || pn == 11 || pn == 12) {
#pragma unroll
                    for (int bj = 0; bj < 2; ++bj)
#pragma unroll
                        for (int nt = 0; nt < 2; ++nt)
#pragma unroll
                            for (int rg = 0; rg < 4; ++rg) v[bj][nt][rg] = silu(v[bj][nt][rg]);
                }
                bf16_t* bdst = nullptr; float* fdst = nullptr;
                if (pn <= 1) bdst = P.qn + (size_t)r * 512 + (pn * 4 + wc) * 64;
                else if (pn == 2) fdst = (isp ? P.p_cmp + (size_t)r * 256 : P.s_cmp + (size_t)b * 256) + wc * 64;
                else if (pn == 3) { fdst = (isp ? P.p_slc + (size_t)r * 256 : P.s_slc + (size_t)b * 256) + wc * 64;
                                    if (isp) bdst = (wc < 2 ? P.ks : P.vs) + ((size_t)(b * 2 + (wc & 1)) * SEQ + t) * 64; }
                else if (pn == 4) { fdst = isp ? (t >= SEQ - 512 ? P.p_win + ((size_t)b * 512 + (t - (SEQ - 512))) * 256 + wc * 64 : nullptr) : P.s_win + ((size_t)b * 512 + 511) * 256 + wc * 64;
                                    if (isp) bdst = (wc < 2 ? P.kw : P.vw) + ((size_t)(b * 2 + (wc & 1)) * SEQ + t) * 64; }
                else if (pn == 5 || pn == 6) bdst = P.ga + (size_t)r * 512 + (pn - 5) * 256 + wc * 64;
                else if (pn == 7) bdst = P.rq + (size_t)r * 256 + wc * 64;
                else if (pn == 8) bdst = P.rk + (size_t)r * 256 + wc * 64;
                else if (pn == 9 || pn == 10) bdst = P.rv + (size_t)r * 512 + (pn - 9) * 256 + wc * 64;
                else if (pn == 11 || pn == 12) bdst = P.gr + (size_t)r * 512 + (pn - 11) * 256 + wc * 64;
                if (pn == 13) {
                    if (wc == 0) {
                        float* gd = P.gates + (size_t)r * 24;
                        { float4 o; o.x = sigmoidf(v[0][0][0]); o.y = sigmoidf(v[0][0][1]); o.z = sigmoidf(v[0][0][2]); o.w = sigmoidf(v[0][0][3]); *(float4*)(gd + 4 * fq) = o; }
                        if (fq < 2) { float4 o; o.x = sigmoidf(v[0][1][0]); o.y = sigmoidf(v[0][1][1]); o.z = sigmoidf(v[0][1][2]); o.w = sigmoidf(v[0][1][3]); *(float4*)(gd + 16 + 4 * fq) = o; }
                    }
                    continue;
                }
#pragma unroll
                for (int bj = 0; bj < 2; ++bj)
#pragma unroll
                    for (int nt = 0; nt < 2; ++nt) {
                        const int cl = bj * 32 + nt * 16 + 4 * fq;
                        if (fdst) { float4 o; o.x = v[bj][nt][0]; o.y = v[bj][nt][1]; o.z = v[bj][nt][2]; o.w = v[bj][nt][3]; *(float4*)(fdst + cl) = o; }
                        if (bdst) { uint2 o; o.x = cvt_pk_bf16(v[bj][nt][0], v[bj][nt][1]); o.y = cvt_pk_bf16(v[bj][nt][2], v[bj][nt][3]); *(uint2*)(bdst + cl) = o; }
                    }
            }
    }
};

__device__ __forceinline__ void p3_rows(const Params& p, int bid, int nblk) {
    const int tid = opaque_tid(), lane = tid & 63, wave = tid >> 6;
    for (int r = bid * 8 + wave; r < R; r += nblk * 8) {
        const float* pr = p.praw + (size_t)r * NPAD;
        const bool isp = r < TP;
        const int b = isp ? (r >> 12) : (r - TP), t = isp ? (r & 4095) : 0;
        const int pos = isp ? t : PAST;
        {
            const float gq = p.g_q[lane];
            for (int hh = 0; hh < 8; ++hh) {
                const float v = pr[C_Q + hh * 64 + lane];
                const float rs = rsqrtf(wave_sum(v * v) * (1.f / 64.f) + EPS);
                p.qn[(size_t)r * 512 + hh * 64 + lane] = f2bf(v * rs * gq);
            }
        }
        float* o_cmp = isp ? p.p_cmp + (size_t)r * 256 : p.s_cmp + (size_t)b * 256;
        float* o_slc = isp ? p.p_slc + (size_t)r * 256 : p.s_slc + (size_t)b * 256;
        float* o_win = isp ? (t >= SEQ - 512 ? p.p_win + ((size_t)b * 512 + (t - (SEQ - 512))) * 256 : nullptr) : p.s_win + ((size_t)b * 512 + 511) * 256;
        for (int j = 0; j < 4; ++j) {
            const int g = j & 1;
            const size_t cidx = ((size_t)(b * 2 + g) * SEQ + t) * 64 + lane;
            {
                const float v = pr[C_KC + j * 64 + lane];
                o_cmp[j * 64 + lane] = v;
                if (isp) { if (j < 2) p.kcr[cidx] = f2bf(v); else p.vcr[cidx] = f2bf(v); }
            }
            {
                float v = pr[C_KS + j * 64 + lane];
                if (j < 2) { const float rs = rsqrtf(wave_sum(v * v) * (1.f / 64.f) + EPS); v = v * rs * p.g_ks[lane]; }
                o_slc[j * 64 + lane] = v;
                if (isp) { if (j < 2) p.ks[cidx] = f2bf(v); else p.vs[cidx] = f2bf(v); }
            }
            {
                float v = pr[C_KW + j * 64 + lane];
                if (j < 2) { const float rs = rsqrtf(wave_sum(v * v) * (1.f / 64.f) + EPS); v = v * rs * p.g_kw[lane]; }
                if (o_win) o_win[j * 64 + lane] = v;
                if (isp) { if (j < 2) p.kw[cidx] = f2bf(v); else p.vw[cidx] = f2bf(v); }
            }
        }
        if (lane < 24) p.gates[(size_t)r * 24 + lane] = sigmoidf(pr[C_BR + lane]);
        for (int i = 0; i < 8; ++i) {
            p.ga[(size_t)r * 512 + i * 64 + lane] = f2bf(silu(pr[C_GA + i * 64 + lane]));
            p.gr[(size_t)r * 512 + i * 64 + lane] = f2bf(silu(pr[C_GR + i * 64 + lane]));
            p.rv[(size_t)r * 512 + i * 64 + lane] = f2bf(pr[C_RV + i * 64 + lane]);
        }
        {
            const int i = lane & 31;
            const float freq = powf(10000.f, -(float)i / 32.f);
            const float ang = (float)pos * freq;
            float sn, cs; sincosf(ang, &sn, &cs);
            for (int hh = 0; hh < 4; ++hh) {
                const float a = pr[C_RQ + hh * 64 + lane], ao = pr[C_RQ + hh * 64 + (lane ^ 32)];
                const float kq = pr[C_RK + hh * 64 + lane], ko = pr[C_RK + hh * 64 + (lane ^ 32)];
                const float oq = lane < 32 ? a * cs - ao * sn : ao * sn + a * cs;
                const float ok = lane < 32 ? kq * cs - ko * sn : ko * sn + kq * cs;
                const float lgm = __log2f(1.f - exp2f(-5.f - (float)hh)) * (float)(pos & 127);
                p.rq[(size_t)r * 256 + hh * 64 + lane] = f2bf(oq * exp2f(lgm));
                p.rk[(size_t)r * 256 + hh * 64 + lane] = f2bf(ok * 0.125f * exp2f(-lgm));
            }
        }
    }
}

typedef unsigned u32x4 __attribute__((ext_vector_type(4)));

struct CmpTile {
    int active;
    int b, c0;
    int seam_idx;
    int is_sample;
};

__device__ __forceinline__ void cmp_second_layer(const Params& p, int kv, const f32x4 (&pre)[4], bf16_t* hb  , const bf16_t* w2s  , bf16_t* dst  , int lane) {
    const int fr = lane & 15, G = lane >> 4;
#pragma unroll
    for (int nt = 0; nt < 4; ++nt)
#pragma unroll
        for (int r = 0; r < 4; ++r) hb[(G * 4 + r) * 64 + nt * 16 + fr] = f2bf(silu(pre[nt][r]));
    WSYNC();
    bf16x8 hf[2];
#pragma unroll
    for (int ks = 0; ks < 2; ++ks) hf[ks] = *(const bf16x8*)(hb + fr * 64 + ks * 32 + G * 8);
    f32x4 out[4];
#pragma unroll
    for (int nt = 0; nt < 4; ++nt) {
        out[nt] = (f32x4){0.f, 0.f, 0.f, 0.f};
#pragma unroll
        for (int ks = 0; ks < 2; ++ks) {
            const bf16x8 wf = *(const bf16x8*)(w2s + (nt * 16 + fr) * 64 + ks * 32 + G * 8);
            out[nt] = __builtin_amdgcn_mfma_f32_16x16x32_bf16(hf[ks], wf, out[nt], 0, 0, 0);
        }
    }
    WSYNC();
    float rs[4] = {1.f, 1.f, 1.f, 1.f};
    if (kv == 0) {
#pragma unroll
        for (int r = 0; r < 4; ++r) {
            float ss = 0.f;
#pragma unroll
            for (int nt = 0; nt < 4; ++nt) ss += out[nt][r] * out[nt][r];
            ss += __shfl_xor(ss, 1); ss += __shfl_xor(ss, 2); ss += __shfl_xor(ss, 4); ss += __shfl_xor(ss, 8);
            rs[r] = rsqrtf(ss * (1.f / 64.f) + EPS);
        }
    }
#pragma unroll
    for (int nt = 0; nt < 4; ++nt) {
        const float gk = kv == 0 ? p.g_kc[nt * 16 + fr] : 1.f;
#pragma unroll
        for (int r = 0; r < 4; ++r) {
            const int row = G * 4 + r;
            if (row < 15) dst[(size_t)row * 64 + nt * 16 + fr] = f2bf(out[nt][r] * rs[r] * gk);
        }
    }
}

constexpr int CMP_HB = 131072, CMP_W2S = 147456 + 64, CMP_B1S = CMP_W2S + 8192;
__device__ __forceinline__ void compress_setup(const Params& p, char* lds, int kv) {
    const int tid = opaque_tid();
    const float* w1 = kv ? p.w_cv1 : p.w_ck1; const float* pe = kv ? p.pe_cv : p.pe_ck; const float* w2 = kv ? p.w_cv2 : p.w_ck2;
    bf16_t* w2s = (bf16_t*)(lds + CMP_W2S); float* b1s = (float*)(lds + CMP_B1S); float* part = (float*)(lds + CMP_HB);
    __syncthreads();
    for (int i = tid; i < 4096; i += NT) { const int f = i >> 6, d = i & 63; w2s[d * 64 + f] = f2bf(w2[i]); }
    {
      const int fq4 = tid & 15, ks32 = tid >> 4;
      const float* wp = w1 + (size_t)ks32 * 64 * 64 + 4 * fq4; const float* pp = pe + ks32 * 64;
      float4 s = {0.f, 0.f, 0.f, 0.f};
#pragma unroll 16
      for (int k = 0; k < 64; ++k) { const float4 w = *(const float4*)(wp + (size_t)k * 64); const float pv = pp[k]; s.x += pv * w.x; s.y += pv * w.y; s.z += pv * w.z; s.w += pv * w.w; }
      *(float4*)(part + ks32 * 64 + 4 * fq4) = s; }
    __syncthreads();
    if (tid < 64) { float s = 0.f; for (int j = 0; j < 32; ++j) s += part[j * 64 + tid]; b1s[tid] = s; }
    __syncthreads();
}
template <int O>
__device__ __forceinline__ void cmp_rd4(unsigned a, bf16x8 (&b)[4]) {
    asm volatile(
        "ds_read_b128 %0, %4 offset:%5\n\t"
        "ds_read_b128 %1, %4 offset:%6\n\t"
        "ds_read_b128 %2, %4 offset:%7\n\t"
        "ds_read_b128 %3, %4 offset:%8\n\t"
        "s_waitcnt lgkmcnt(0)"
        : "=&v"(b[0]), "=&v"(b[1]), "=&v"(b[2]), "=&v"(b[3])
        : "v"(a), "i"(O), "i"(O + 1024), "i"(O + 2048), "i"(O + 3072) : "memory");
}
template <int O0, int O1>
__device__ __forceinline__ void cmp_lda(const float* a0, const float* a1, f32x4 (&q)[2][2]) {
    asm volatile("global_load_dwordx4 %0, %4, off offset:%6 nt\n\t"
                 "global_load_dwordx4 %1, %5, off offset:%6 nt\n\t"
                 "global_load_dwordx4 %2, %4, off offset:%7 nt\n\t"
                 "global_load_dwordx4 %3, %5, off offset:%7 nt"
                 : "=&v"(q[0][0]), "=&v"(q[0][1]), "=&v"(q[1][0]), "=&v"(q[1][1])
                 : "v"(a0), "v"(a1), "i"(O0), "i"(O1) : "memory");
}
template <int N>
__device__ __forceinline__ void cmp_wait(f32x4 (&q)[2][2]) {
    asm volatile("s_waitcnt vmcnt(%4)" : "+v"(q[0][0]), "+v"(q[0][1]), "+v"(q[1][0]), "+v"(q[1][1]) : "n"(N) : "memory");
}
__device__ __forceinline__ void cmp_stage_wq(const Params& p, LAS char* l3, int kv, int q, int tid) {
    const int n = tid >> 2, Gp = (tid & 3) ^ ((n >> 2) & 3);
    const bf16_t* src = p.w1p + ((size_t)kv * 128 + n) * 1024 + q * 256 + Gp * 8;
    LAS char* dst = l3 + (q & 1) * 65536 + tid * 16;
#pragma unroll
    for (int j = 0; j < 8; ++j)
        __builtin_amdgcn_global_load_lds((const unsigned*)(src + j * 32), (LAS unsigned*)(dst + j * 8192), 16, 0, 0);
}
__device__ __forceinline__ void compress_pass_s(const Params& p, char* lds, int kv, int b, int c0w, int seam_idx, bool first, bool more) {
    LAS char* l3 = (LAS char*)lds;
    const int tid = opaque_tid(), lane = tid & 63, wave = tid >> 6, fr = lane & 15, G = lane >> 4;
    bf16_t* hb = (bf16_t*)(lds + CMP_HB) + wave * 1024;
    const bf16_t* w2s = (const bf16_t*)(lds + CMP_W2S); const float* b1s = (const float*)(lds + CMP_B1S);
    const float* abase[2];
#pragma unroll
    for (int i = 0; i < 2; ++i) {
        const int c = c0w + (fr & 7) + 8 * i;
        const int pg = p.page_table[b * NPAGES + (c >> 3)];
        abase[i] = p.cache_cmp + (((size_t)pg * 128 + (c & 7) * 16) * 4 + kv * 2) * 64 + (fr >> 3) * 16 + G * 4;
    }
    const bool lowl = fr < 8;
    const unsigned bl = (unsigned)(unsigned long long)l3 + fr * 64 + ((G ^ (fr >> 2)) * 16);
    f32x4 acc[2][8];
#pragma unroll
    for (int g = 0; g < 2; ++g)
#pragma unroll
        for (int nt = 0; nt < 8; ++nt) acc[g][nt] = (f32x4){0.f, 0.f, 0.f, 0.f};
    f32x4 aq[6][2][2];
#define CMP_LOADA(u, s) do { const float* _a0 = abase[0] + ((s) >> 1) * 256; const float* _a1 = abase[1] + ((s) >> 1) * 256; \
        if ((s) & 1) cmp_lda<128, 384>(_a0, _a1, aq[u]); else cmp_lda<0, 256>(_a0, _a1, aq[u]); } while (0)
#define CMP_WAITA(u, s) do { const int _y = 31 - (s); if (_y >= 5) cmp_wait<20>(aq[u]); else if (_y == 4) cmp_wait<16>(aq[u]); else if (_y == 3) cmp_wait<12>(aq[u]); \
        else if (_y == 2) cmp_wait<8>(aq[u]); else if (_y == 1) cmp_wait<4>(aq[u]); else cmp_wait<0>(aq[u]); } while (0)
#pragma unroll
    for (int u = 0; u < 6; ++u) CMP_LOADA(u, u);
    if (first) { cmp_stage_wq(p, l3, kv, 0, tid); asm volatile("s_waitcnt vmcnt(0)" ::: "memory"); }
#pragma unroll
    for (int s = 0; s < 32; ++s) {
        const int q = s >> 3, u = s % 6;
        if ((s & 7) == 0) {
            asm volatile("" ::: "memory");
            __builtin_amdgcn_s_barrier();
            asm volatile("" ::: "memory");
            if (q < 3 || more) cmp_stage_wq(p, l3, kv, (q + 1) & 3, tid);
            asm volatile("" ::: "memory");
        }
        CMP_WAITA(u, s);
        bf16x8 af[2];
#pragma unroll
        for (int g = 0; g < 2; ++g) {
            u32x4 t;
            f32x4 x0, x1;
#pragma unroll
            for (int e = 0; e < 4; ++e) {
                const float give = lowl ? aq[u][g][1][e] : aq[u][g][0][e];
                const float recv = __builtin_bit_cast(float, __builtin_amdgcn_mov_dpp(__builtin_bit_cast(int, give), 0x128, 0xF, 0xF, true));
                x0[e] = lowl ? aq[u][g][0][e] : recv; x1[e] = lowl ? recv : aq[u][g][1][e];
            }
            t[0] = cvt_pk_bf16(x0[0], x0[1]); t[1] = cvt_pk_bf16(x0[2], x0[3]);
            t[2] = cvt_pk_bf16(x1[0], x1[1]); t[3] = cvt_pk_bf16(x1[2], x1[3]);
            af[g] = __builtin_bit_cast(bf16x8, t);
        }
        if (s + 6 < 32) CMP_LOADA(u, s + 6);
        const unsigned a = bl + (q & 1) * 65536 + (s & 7) * 8192;
        bf16x8 bf[4];
        cmp_rd4<0>(a, bf);
#pragma unroll
        for (int nt = 0; nt < 4; ++nt) {
            acc[0][nt] = __builtin_amdgcn_mfma_f32_16x16x32_bf16(af[0], bf[nt], acc[0][nt], 0, 0, 0);
            acc[1][nt] = __builtin_amdgcn_mfma_f32_16x16x32_bf16(af[1], bf[nt], acc[1][nt], 0, 0, 0);
        }
        cmp_rd4<4096>(a, bf);
#pragma unroll
        for (int nt = 0; nt < 4; ++nt) {
            acc[0][4 + nt] = __builtin_amdgcn_mfma_f32_16x16x32_bf16(af[0], bf[nt], acc[0][4 + nt], 0, 0, 0);
            acc[1][4 + nt] = __builtin_amdgcn_mfma_f32_16x16x32_bf16(af[1], bf[nt], acc[1][4 + nt], 0, 0, 0);
        }
    }
#undef CMP_LOADA
#undef CMP_WAITA
#pragma unroll
    for (int g = 0; g < 2; ++g) {
        f32x4 pre[4];
#pragma unroll
        for (int nt = 0; nt < 4; ++nt) {
            const float bias = b1s[nt * 16 + fr];
            const float nb0 = __shfl_down(acc[g][4 + nt][0], 16);
            pre[nt][0] = acc[g][nt][0] + acc[g][4 + nt][1] + bias;
            pre[nt][1] = acc[g][nt][1] + acc[g][4 + nt][2] + bias;
            pre[nt][2] = acc[g][nt][2] + acc[g][4 + nt][3] + bias;
            pre[nt][3] = acc[g][nt][3] + nb0 + bias;
            if (G == 3) p.seamA[((size_t)seam_idx * 2 + g) * 64 + nt * 16 + fr] = acc[g][nt][3];
            if (G == 0) p.seamB[((size_t)seam_idx * 2 + g) * 64 + nt * 16 + fr] = acc[g][4 + nt][0];
        }
        bf16_t* dst = (kv ? p.vcs : p.kcs) + ((size_t)(b * 2 + g) * 1024 + c0w) * 64;
        cmp_second_layer(p, kv, pre, hb, w2s, dst, lane);
    }
}

__device__ __forceinline__ void compress_sample(const Params& p, char* lds, int bid, int nblk) {
    const int wave = opaque_tid() >> 6;
    int kv_set = -1;
    for (int pass = bid; pass < 512; pass += nblk) {
        const int P = pass & 7, kv = (pass >> 3) & 1, b = pass >> 4;
        const int c0w = P * 128 + wave * 16;
        const bool first = kv != kv_set;
        if (first) { compress_setup(p, lds, kv); kv_set = kv; }
        const int nxt = pass + nblk;
        const bool more = nxt < 512 && ((nxt >> 3) & 1) == kv;
        compress_pass_s(p, lds, kv, b, c0w, (b * 2 + kv) * 64 + (c0w >> 4), first, more);
    }
}

__device__ __forceinline__ void compress_prompt_ksplit_item(const Params& p, char* lds, int item) {
    const int tid = opaque_tid(), lane = tid & 63, wave = tid >> 6, fr = lane & 15, G = lane >> 4;
    f32x4* part = (f32x4*)lds;
    {
        const int kv = item / 68, tile = item % 68, b = tile / 17, c0 = (tile % 17) * 15;
        const float* abase = p.p_cmp + (((size_t)b * SEQ + (size_t)(c0 + fr) * 16) * 4 + kv * 2) * 64 + G * 4;
        const bf16_t* wbase = p.w1p + ((size_t)kv * 128 + fr) * 1024 + G * 8;
        f32x4 acc[2][8];
#pragma unroll
        for (int g = 0; g < 2; ++g)
#pragma unroll
            for (int nt = 0; nt < 8; ++nt) acc[g][nt] = (f32x4){0.f, 0.f, 0.f, 0.f};
#pragma unroll
        for (int u = 0; u < 4; ++u) {
            const int s = wave * 4 + u;
            const float* a = abase + (s >> 1) * 256 + (s & 1) * 32;
            bf16x8 af[2];
#pragma unroll
            for (int g = 0; g < 2; ++g) {
                const f32x4 x0 = *(const f32x4*)(a + g * 64), x1 = *(const f32x4*)(a + g * 64 + 16);
                u32x4 t; t[0] = cvt_pk_bf16(x0[0], x0[1]); t[1] = cvt_pk_bf16(x0[2], x0[3]); t[2] = cvt_pk_bf16(x1[0], x1[1]); t[3] = cvt_pk_bf16(x1[2], x1[3]);
                af[g] = __builtin_bit_cast(bf16x8, t);
            }
#pragma unroll
            for (int nt = 0; nt < 8; ++nt) {
                const bf16x8 wf = *(const bf16x8*)(wbase + (size_t)nt * 16 * 1024 + s * 32);
                acc[0][nt] = __builtin_amdgcn_mfma_f32_16x16x32_bf16(af[0], wf, acc[0][nt], 0, 0, 0);
                acc[1][nt] = __builtin_amdgcn_mfma_f32_16x16x32_bf16(af[1], wf, acc[1][nt], 0, 0, 0);
            }
        }
        __syncthreads();
#pragma unroll
        for (int g = 0; g < 2; ++g)
#pragma unroll
            for (int nt = 0; nt < 8; ++nt) part[((wave * 2 + g) * 8 + nt) * 64 + lane] = acc[g][nt];
        __syncthreads();
        if (wave < 2) {
            const int g = wave;
            f32x4 tot[8];
#pragma unroll
            for (int nt = 0; nt < 8; ++nt) {
                tot[nt] = part[((0 * 2 + g) * 8 + nt) * 64 + lane];
#pragma unroll
                for (int w = 1; w < 8; ++w) tot[nt] += part[((w * 2 + g) * 8 + nt) * 64 + lane];
            }
            f32x4 pre[4];
#pragma unroll
            for (int nt = 0; nt < 4; ++nt) {
                const float bias = p.b1[kv * 64 + nt * 16 + fr];
                const float nb0 = __shfl_down(tot[4 + nt][0], 16);
                pre[nt][0] = tot[nt][0] + tot[4 + nt][1] + bias; pre[nt][1] = tot[nt][1] + tot[4 + nt][2] + bias;
                pre[nt][2] = tot[nt][2] + tot[4 + nt][3] + bias; pre[nt][3] = tot[nt][3] + nb0 + bias;
            }
            bf16_t* hb = (bf16_t*)(lds + 131072) + wave * 1024;
            bf16_t* dst = (kv ? p.vc : p.kc) + ((size_t)(b * 2 + g) * 256 + c0) * 64;
            cmp_second_layer(p, kv, pre, hb, p.w2t + (size_t)kv * 4096, dst, lane);
        }
        __syncthreads();
    }
}
__device__ __forceinline__ void compress_seams(const Params& p, int bid, int nblk) {
    const int tid = opaque_tid(), lane = tid & 63, wave = tid >> 6;
    if (bid < 0) return;
    for (int it = bid * 8 + wave; it < 32 * 2 * 2 * 63; it += nblk * 8) {
        const int Tt = it % 63, rest = it / 63, g = rest & 1, kv = (rest >> 1) & 1, b = rest >> 2;
        const size_t sa = ((size_t)((b * 2 + kv) * 64 + Tt) * 2 + g) * 64 + lane, sb = ((size_t)((b * 2 + kv) * 64 + Tt + 1) * 2 + g) * 64 + lane;
        const float h = silu(p.seamA[sa] + p.seamB[sb] + p.b1[kv * 64 + lane]);
        const float* w2 = kv ? p.w_cv2 : p.w_ck2;
        float o = 0.f;
        for (int f = 0; f < 64; ++f) o += bf2f(f2bf(__shfl(h, f))) * bf2f(f2bf(w2[f * 64 + lane]));
        if (kv == 0) { const float rs = rsqrtf(wave_sum(o * o) * (1.f / 64.f) + EPS); o = o * rs * p.g_kc[lane]; }
        ((kv ? p.vcs : p.kcs) + ((size_t)(b * 2 + g) * 1024 + 16 * Tt + 15) * 64)[lane] = f2bf(o);
    }
}
template <typename T>
__device__ __forceinline__ void attend64(const float* qs, float* pl, const T* kbase, const T* vbase, size_t stride, bool valid, int lane, float (&m)[4], float (&l)[4], float (&o)[4]) {
    float s[4] = {0.f, 0.f, 0.f, 0.f};
    if (valid) {
        const T* kr = kbase + (size_t)lane * stride;
        float kfa[8][8];
#pragma unroll
        for (int c = 0; c < 8; ++c) load8(kr + c * 8, kfa[c]);
#pragma unroll
        for (int c = 0; c < 8; ++c)
#pragma unroll
            for (int h = 0; h < 4; ++h)
#pragma unroll
                for (int j = 0; j < 8; ++j) s[h] += qs[h * 64 + c * 8 + j] * kfa[c][j];
    }
    const unsigned long long vm = __ballot(valid);
    if (vm == 0ull) return;
#pragma unroll
    for (int h = 0; h < 4; ++h) {
        const float sv = valid ? s[h] * 0.125f : -1e30f;
        const float mn = fmaxf(m[h], wave_max(sv));
        const float alpha = __expf(m[h] - mn);
        const float pv = valid ? __expf(sv - mn) : 0.f;
        l[h] = l[h] * alpha + wave_sum(pv); o[h] *= alpha; m[h] = mn;
        pl[h * 64 + lane] = pv;
    }
    WSYNC();
    const int kfirst = __ffsll((long long)vm) - 1;
#pragma unroll 16
    for (int kk = 0; kk < 64; ++kk) {
        const int kr = ((vm >> kk) & 1ull) ? kk : kfirst;
        const float vv = load1(vbase + (size_t)kr * stride + lane);
#pragma unroll
        for (int h = 0; h < 4; ++h) o[h] += pl[h * 64 + kk] * vv;
    }
    WSYNC();
}

__device__ __forceinline__ void cmp_branch(const float* qs, float* pl, float* ps, const bf16_t* kc, const bf16_t* vc, int n_c, int lane, float (&oc)[4]) {
    float m[4] = {-1e30f, -1e30f, -1e30f, -1e30f}, l[4] = {0.f, 0.f, 0.f, 0.f};
    for (int c0 = 0; c0 < n_c; c0 += 64) {
        const bool valid = c0 + lane < n_c;
        float s[4] = {0.f, 0.f, 0.f, 0.f};
        if (valid) {
            const bf16_t* kr = kc + (size_t)(c0 + lane) * 64;
#pragma unroll 2
            for (int c = 0; c < 8; ++c) {
                float kf[8]; load8(kr + c * 8, kf);
#pragma unroll
                for (int h = 0; h < 4; ++h)
#pragma unroll
                    for (int j = 0; j < 8; ++j) s[h] += qs[h * 64 + c * 8 + j] * kf[j];
            }
        }
#pragma unroll
        for (int h = 0; h < 4; ++h) {
            const float sv = valid ? s[h] * 0.125f : -1e30f;
            const float mn = fmaxf(m[h], wave_max(sv));
            const float pv = valid ? __expf(sv - mn) : 0.f;
            l[h] = l[h] * __expf(m[h] - mn) + wave_sum(pv); m[h] = mn;
        }
    }
    for (int c0 = 0; c0 < n_c; c0 += 64) {
        const bool valid = c0 + lane < n_c;
        float s[4] = {0.f, 0.f, 0.f, 0.f};
        if (valid) {
            const bf16_t* kr = kc + (size_t)(c0 + lane) * 64;
#pragma unroll 2
            for (int c = 0; c < 8; ++c) {
                float kf[8]; load8(kr + c * 8, kf);
#pragma unroll
                for (int h = 0; h < 4; ++h)
#pragma unroll
                    for (int j = 0; j < 8; ++j) s[h] += qs[h * 64 + c * 8 + j] * kf[j];
            }
        }
        float psum = 0.f;
#pragma unroll
        for (int h = 0; h < 4; ++h) {
            const float pv = valid ? __expf(s[h] * 0.125f - m[h]) / l[h] : 0.f;
            pl[h * 64 + lane] = pv; psum += pv;
        }
        if (valid) ps[1 + c0 + lane] = psum;
        WSYNC();
        const int nk = min(64, n_c - c0);
        for (int kk = 0; kk < nk; ++kk) {
            const float vv = bf2f(vc[(size_t)(c0 + kk) * 64 + lane]);
#pragma unroll
            for (int h = 0; h < 4; ++h) oc[h] += pl[h * 64 + kk] * vv;
        }
        WSYNC();
    }
}

__device__ __forceinline__ void topk16(float* sc, int* sel, int n_sel, int lane) {
    for (int round = 0; round < 16; ++round) {
        float bv = -3.0e38f; int bi = 0x7fffffff;
        for (int j = lane; j < n_sel; j += 64) { const float v = sc[j]; if (v > bv) { bv = v; bi = j; } }
#pragma unroll
        for (int o = 1; o < 64; o <<= 1) {
            const float ov = __shfl_xor(bv, o); const int oi = __shfl_xor(bi, o);
            if (ov > bv || (ov == bv && oi < bi)) { bv = ov; bi = oi; }
        }
        if (lane == 0) { sel[round] = bi; sc[bi] = -3.4e38f; }
        WSYNC();
    }
}

constexpr int ATT_WLDS = 256 + 256 + 1040 + 272 + 16;
__device__ __forceinline__ void p5_attention(const Params& p, char* lds, int bid, int nblk) {
    const int tid = threadIdx.x, lane = tid & 63, wave = tid >> 6;
    float* wl = (float*)lds + wave * ATT_WLDS;
    float *qs = wl, *pl = wl + 256, *ps = wl + 512, *sc = wl + 1552; int* sel = (int*)(wl + 1824);
    const int gw = bid * 8 + wave, ngw = nblk * 8;
    for (int it = gw; it < R * 2; it += ngw) {
        const int r = it >> 1, g = it & 1;
        const bool isp = r < TP;
        const int b = isp ? (r >> 12) : (r - TP), t = isp ? (r & 4095) : PAST;
        const int n_sel = isp ? 64 : 257;
        const int n_cmax = isp ? 255 : 1023;
#pragma unroll
        for (int h = 0; h < 4; ++h) qs[h * 64 + lane] = bf2f(p.qn[(size_t)r * 512 + (g * 4 + h) * 64 + lane]);
        for (int i = lane; i < 4 * n_sel + 1; i += 64) ps[i] = 0.f;
        WSYNC();
        int n_c = t >= 31 ? (t - 31) / 16 + 1 : 0; if (n_c > n_cmax) n_c = n_cmax;
        float oc[4] = {0.f, 0.f, 0.f, 0.f};
        {
            const bf16_t* kc = isp ? p.kc + (size_t)(b * 2 + g) * 256 * 64 : p.kcs + (size_t)(b * 2 + g) * 1024 * 64;
            const bf16_t* vc = isp ? p.vc + (size_t)(b * 2 + g) * 256 * 64 : p.vcs + (size_t)(b * 2 + g) * 1024 * 64;
            cmp_branch(qs, pl, ps, kc, vc, n_c, lane, oc);
        }
        const int jt = t >> 6;
        for (int j = lane; j < n_sel; j += 64) {
            float imp = 0.f;
#pragma unroll
            for (int rr = 0; rr < 4; ++rr) imp += ps[4 * j + rr + 1] + ps[4 * j + rr];
            const bool valid = j * 64 <= t, forced = (j == 0) || (j == jt) || (j == jt - 1);
            sc[j] = valid ? (forced ? 1e4f : imp) : -1e30f;
        }
        WSYNC();
        topk16(sc, sel, n_sel, lane);
        float ms[4] = {-1e30f, -1e30f, -1e30f, -1e30f}, lsum[4] = {0.f, 0.f, 0.f, 0.f}, os[4] = {0.f, 0.f, 0.f, 0.f};
        for (int k = 0; k < 16; ++k) {
            const int j = sel[k];
            if (j * 64 > t) continue;
            const bool valid = j * 64 + lane <= t;
            if (isp) {
                const size_t base = ((size_t)(b * 2 + g) * SEQ + (size_t)j * 64) * 64;
                attend64<bf16_t>(qs, pl, p.ks + base, p.vs + base, 64, valid, lane, ms, lsum, os);
            } else if (j == 256) {
                attend64<float>(qs, pl, p.s_slc + (size_t)b * 256 + g * 64, p.s_slc + (size_t)b * 256 + 128 + g * 64, 256, valid, lane, ms, lsum, os);
            } else {
                const int pg = p.page_table[b * NPAGES + (j >> 1)];
                const float* base = p.cache_slc + (((size_t)pg * 128 + (j & 1) * 64) * 4 + g) * 64;
                attend64<float>(qs, pl, base, base + 128, 256, valid, lane, ms, lsum, os);
            }
        }
        float mw[4] = {-1e30f, -1e30f, -1e30f, -1e30f}, lw[4] = {0.f, 0.f, 0.f, 0.f}, ow[4] = {0.f, 0.f, 0.f, 0.f};
        if (isp) {
            const int start = t - 511 > 0 ? t - 511 : 0;
            for (int c0 = start; c0 <= t; c0 += 64) {
                const size_t base = ((size_t)(b * 2 + g) * SEQ + c0) * 64;
                attend64<bf16_t>(qs, pl, p.kw + base, p.vw + base, 64, c0 + lane <= t, lane, mw, lw, ow);
            }
        } else {
            for (int c0 = 0; c0 < 512; c0 += 64) {
                const float* base = p.s_win + ((size_t)b * 512 + c0) * 256 + g * 64;
                attend64<float>(qs, pl, base, base + 128, 256, true, lane, mw, lw, ow);
            }
        }
#pragma unroll
        for (int h = 0; h < 4; ++h) {
            const float* gt = p.gates + (size_t)r * 24 + g * 12 + h * 3;
            const float o = gt[0] * oc[h] + gt[1] * (os[h] / lsum[h]) + gt[2] * (ow[h] / lw[h]);
            const int col = (g * 4 + h) * 64 + lane;
            p.yar[(size_t)r * 1024 + col] = f2bf(o * bf2f(p.ga[(size_t)r * 512 + col]));
        }
    }
}


typedef short s16x4 __attribute__((ext_vector_type(4)));
#define ATT_NEG (-__builtin_inff())
constexpr int ATT_KC = 0, ATT_VC = 32768, ATT_KB = 65536, ATT_VB = 98304, ATT_SC = 131072;
constexpr float ATT_CS = 0.125f * 1.44269504088896f;

__device__ __forceinline__ void att_stage(LAS char* dst, const bf16_t* rows, int tid) {
    const int key = tid >> 3, slot = tid & 7;
    __builtin_amdgcn_global_load_lds((const unsigned*)(rows + key * 64 + ((slot ^ (key & 7)) * 8)), (LAS unsigned*)(dst + tid * 16), 16, 0, 0);
}
__device__ __forceinline__ void att_qk(const LAS char* Kb, const bf16x8 (&qf)[2], const int (&koff)[2], f32x4 (&st)[4]) {
#pragma unroll
    for (int tk = 0; tk < 4; ++tk) {
        st[tk] = (f32x4){0.f, 0.f, 0.f, 0.f};
#pragma unroll
        for (int ks = 0; ks < 2; ++ks) {
            const bf16x8 kf = *(const LAS bf16x8*)(Kb + tk * 2048 + koff[ks]);
            st[tk] = __builtin_amdgcn_mfma_f32_16x16x32_bf16(kf, qf[ks], st[tk], 0, 0, 0);
        }
    }
}
template <int O0, int O1>
__device__ __forceinline__ void att_tr8(unsigned a0, unsigned a1, unsigned a2, unsigned a3, s16x4 (&v)[8]) {
    asm volatile(
        "ds_read_b64_tr_b16 %0, %8 offset:%12\n\t"
        "ds_read_b64_tr_b16 %1, %8 offset:%13\n\t"
        "ds_read_b64_tr_b16 %2, %9 offset:%12\n\t"
        "ds_read_b64_tr_b16 %3, %9 offset:%13\n\t"
        "ds_read_b64_tr_b16 %4, %10 offset:%12\n\t"
        "ds_read_b64_tr_b16 %5, %10 offset:%13\n\t"
        "ds_read_b64_tr_b16 %6, %11 offset:%12\n\t"
        "ds_read_b64_tr_b16 %7, %11 offset:%13\n\t"
        "s_waitcnt lgkmcnt(0)"
        : "=&v"(v[0]), "=&v"(v[1]), "=&v"(v[2]), "=&v"(v[3]), "=&v"(v[4]), "=&v"(v[5]), "=&v"(v[6]), "=&v"(v[7])
        : "v"(a0), "v"(a1), "v"(a2), "v"(a3), "i"(O0), "i"(O1) : "memory");
}
__device__ __forceinline__ void att_pv(const LAS char* Vb, const f32x4 (&pt)[4], const int (&voff)[4], f32x4 (&o)[4]) {
    const unsigned vb = (unsigned)(unsigned long long)Vb;
    const unsigned a0 = vb + voff[0], a1 = vb + voff[1], a2 = vb + voff[2], a3 = vb + voff[3];
#pragma unroll
    for (int kst = 0; kst < 2; ++kst) {
        u32x4 pk;
        pk[0] = cvt_pk_bf16(pt[2 * kst][0], pt[2 * kst][1]); pk[1] = cvt_pk_bf16(pt[2 * kst][2], pt[2 * kst][3]);
        pk[2] = cvt_pk_bf16(pt[2 * kst + 1][0], pt[2 * kst + 1][1]); pk[3] = cvt_pk_bf16(pt[2 * kst + 1][2], pt[2 * kst + 1][3]);
        const bf16x8 pf = __builtin_bit_cast(bf16x8, pk);
        s16x4 v[8];
        if (kst == 0) att_tr8<0, 2048>(a0, a1, a2, a3, v); else att_tr8<4096, 6144>(a0, a1, a2, a3, v);
#pragma unroll
        for (int dt = 0; dt < 4; ++dt) {
            const s16x4 x0 = v[2 * dt], x1 = v[2 * dt + 1];
            bf16x8 vf; vf[0] = x0[0]; vf[1] = x0[1]; vf[2] = x0[2]; vf[3] = x0[3]; vf[4] = x1[0]; vf[5] = x1[1]; vf[6] = x1[2]; vf[7] = x1[3];
            o[dt] = __builtin_amdgcn_mfma_f32_16x16x32_bf16(vf, pf, o[dt], 0, 0, 0);
        }
    }
}
__device__ __forceinline__ void att_exp(f32x4 (&st)[4], float nb, float& l) {
    typedef float f32x2 __attribute__((ext_vector_type(2)));
    const f32x2 cs2 = {ATT_CS, ATT_CS}, nb2 = {nb, nb};
    f32x2 ls2 = {0.f, 0.f};
#pragma unroll
    for (int tk = 0; tk < 4; ++tk)
#pragma unroll
        for (int r = 0; r < 4; r += 2) {
            const f32x2 s2 = {st[tk][r], st[tk][r + 1]};
            const f32x2 e2 = __builtin_elementwise_fma(s2, cs2, nb2);
            f32x2 p2; p2.x = __builtin_amdgcn_exp2f(e2.x); p2.y = __builtin_amdgcn_exp2f(e2.y);
            st[tk][r] = p2.x; st[tk][r + 1] = p2.y; ls2 += p2;
        }
    l += ls2.x + ls2.y;
}
__device__ __forceinline__ void att_prompt_unit(const Params& p, char* lds, int b, int g, int qt) {
    LAS char* l3 = (LAS char*)lds;
    const int tid = opaque_tid(), lane = tid & 63, wave = tid >> 6, fr = lane & 15, G = lane >> 4;
    const int qi = fr >> 2, h = fr & 3;
    const int t0 = qt * 32, tq0 = t0 + 4 * wave, t_row = tq0 + qi, jt = t0 >> 6;
    const size_t r = (size_t)b * SEQ + t_row;
    const size_t kvbase = (size_t)(b * 2 + g) * SEQ * 64;
    const float shc = p.attb[0], shs = p.attb[1], shw = p.attb[2];
    int koff[2], voff[4];
#pragma unroll
    for (int ks = 0; ks < 2; ++ks) koff[ks] = fr * 128 + (((ks * 4 + G) ^ (fr & 7)) * 16);
    { const int kq = 4 * G + (fr >> 2);
#pragma unroll
      for (int dt = 0; dt < 4; ++dt) voff[dt] = kq * 128 + (((dt * 2 + ((fr & 3) >> 1)) ^ (kq & 7)) * 16) + (fr & 1) * 8; }
    asm volatile("s_waitcnt lgkmcnt(0)" ::: "memory"); __builtin_amdgcn_s_barrier(); asm volatile("" ::: "memory");
    {
        const bf16_t* kc = p.kc + (size_t)(b * 2 + g) * 256 * 64; const bf16_t* vc = p.vc + (size_t)(b * 2 + g) * 256 * 64;
#pragma unroll
        for (int c = 0; c < 4; ++c) { att_stage(l3 + ATT_KC + c * 8192, kc + c * 4096, tid); att_stage(l3 + ATT_VC + c * 8192, vc + c * 4096, tid); }
    }
    bf16x8 qf[2];
#pragma unroll
    for (int ks = 0; ks < 2; ++ks) qf[ks] = *(const bf16x8*)(p.qn + r * 512 + (g * 4 + h) * 64 + ks * 32 + G * 8);
    const int c_lo = (t0 - 511 > 0 ? t0 - 511 : 0) >> 6;
    const int n_s = jt + 1, n_tot = n_s + (jt - c_lo + 1);
#define ATT_STAGE_CHUNK(idx) do { const int _i = (idx); const bool _w = _i >= n_s; const int _cj = _w ? c_lo + (_i - n_s) : _i; \
        att_stage(l3 + ATT_KB + (_i & 3) * 8192, (_w ? p.kw : p.ks) + kvbase + (size_t)_cj * 4096, tid); \
        att_stage(l3 + ATT_VB + (_i & 3) * 8192, (_w ? p.vw : p.vs) + kvbase + (size_t)_cj * 4096, tid); } while (0)
    ATT_STAGE_CHUNK(0); ATT_STAGE_CHUNK(1);
    if (n_tot > 2) { ATT_STAGE_CHUNK(2); asm volatile("s_waitcnt vmcnt(6)" ::: "memory"); }
    else asm volatile("s_waitcnt vmcnt(4)" ::: "memory");
    asm volatile("s_waitcnt lgkmcnt(0)" ::: "memory"); __builtin_amdgcn_s_barrier(); asm volatile("" ::: "memory");
    f32x4 oc[4];
#pragma unroll
    for (int dt = 0; dt < 4; ++dt) oc[dt] = (f32x4){0.f, 0.f, 0.f, 0.f};
    unsigned long long mymask;
    unsigned long long unionmask;
    {
        f32x4 sr[4][4];
#pragma unroll
        for (int c = 0; c < 4; ++c) att_qk(l3 + ATT_KC + c * 8192, qf, koff, sr[c]);
        const int ncrow = t_row >= 31 ? (t_row - 31) / 16 + 1 : 0;
        float lsum = 0.f;
#pragma unroll
        for (int c = 0; c < 4; ++c)
#pragma unroll
            for (int tk = 0; tk < 4; ++tk)
#pragma unroll
                for (int rg = 0; rg < 4; ++rg) {
                    const int i = c * 64 + tk * 16 + G * 4 + rg;
                    const float pv = i < ncrow ? __builtin_amdgcn_exp2f(sr[c][tk][rg] * ATT_CS - shc) : 0.f;
                    sr[c][tk][rg] = pv; lsum += pv;
                }
        lsum += __shfl_xor(lsum, 16); lsum += __shfl_xor(lsum, 32);
        const float inv = lsum > 0.f ? 1.f / lsum : 0.f;
        float* sc = (float*)(lds + ATT_SC) + wave * 512;
        float* bs = sc + 256;
        float av[4][4];
#pragma unroll
        for (int c = 0; c < 4; ++c)
#pragma unroll
            for (int tk = 0; tk < 4; ++tk) {
#pragma unroll
                for (int rg = 0; rg < 4; ++rg) sr[c][tk][rg] *= inv;
                float a = 2.f * (sr[c][tk][0] + sr[c][tk][1] + sr[c][tk][2]) + sr[c][tk][3], b3 = sr[c][tk][3];
                a += __builtin_bit_cast(float, __builtin_amdgcn_mov_dpp(__builtin_bit_cast(int, a), 0xB1, 0xF, 0xF, true));
                a += __builtin_bit_cast(float, __builtin_amdgcn_mov_dpp(__builtin_bit_cast(int, a), 0x4E, 0xF, 0xF, true));
                b3 += __builtin_bit_cast(float, __builtin_amdgcn_mov_dpp(__builtin_bit_cast(int, b3), 0xB1, 0xF, 0xF, true));
                b3 += __builtin_bit_cast(float, __builtin_amdgcn_mov_dpp(__builtin_bit_cast(int, b3), 0x4E, 0xF, 0xF, true));
                av[c][tk] = a;
                if (h == 0) bs[qi * 64 + (c * 4 + tk) * 4 + G] = b3;
            }
        WSYNC();
#pragma unroll
        for (int c = 0; c < 4; ++c)
#pragma unroll
            for (int tk = 0; tk < 4; ++tk) {
                const int j = (c * 4 + tk) * 4 + G;
                const float pr = j > 0 ? bs[qi * 64 + j - 1] : 0.f;
                const bool valid = j * 64 <= t_row, forced = (j == 0) || (j == jt) || (j == jt - 1);
                if (h == 0) sc[qi * 64 + j] = valid ? (forced ? 1e4f : av[c][tk] + pr) : -1e30f;
            }
#pragma unroll
        for (int c = 0; c < 4; ++c) att_pv(l3 + ATT_VC + c * 8192, sr[c], voff, oc);
        WSYNC();
        unsigned long long mq[4];
        {
            float sj[4]; int rank[4] = {0, 0, 0, 0};
#pragma unroll
            for (int q = 0; q < 4; ++q) sj[q] = sc[q * 64 + lane];
#pragma unroll 2
            for (int jp = 0; jp <= jt; ++jp) {
                const bool lower = jp < lane;
#pragma unroll
                for (int q = 0; q < 4; ++q) {
                    const float v = __builtin_bit_cast(float, __builtin_amdgcn_readlane(__builtin_bit_cast(int, sj[q]), jp));
                    rank[q] += (v > sj[q] || (v == sj[q] && lower)) ? 1 : 0;
                }
            }
#pragma unroll
            for (int q = 0; q < 4; ++q) mq[q] = __ballot(rank[q] < 16 && lane * 64 <= tq0 + q);
        }
        unionmask = mq[0] | mq[1] | mq[2] | mq[3];
        mymask = qi == 0 ? mq[0] : qi == 1 ? mq[1] : qi == 2 ? mq[2] : mq[3];
        WSYNC();
    }
    f32x4 os[4], ow[4];
#pragma unroll
    for (int dt = 0; dt < 4; ++dt) { os[dt] = (f32x4){0.f, 0.f, 0.f, 0.f}; ow[dt] = (f32x4){0.f, 0.f, 0.f, 0.f}; }
    float ls = 0.f, lw = 0.f;
    for (int it = 0; it < n_tot; ++it) {
        if (it + 2 < n_tot) asm volatile("s_waitcnt vmcnt(4)" ::: "memory");
        else if (it + 1 < n_tot) asm volatile("s_waitcnt vmcnt(2)" ::: "memory");
        else asm volatile("s_waitcnt vmcnt(0)" ::: "memory");
        asm volatile("s_waitcnt lgkmcnt(0)" ::: "memory"); __builtin_amdgcn_s_barrier(); asm volatile("" ::: "memory");
        if (it + 3 < n_tot) ATT_STAGE_CHUNK(it + 3);
        const LAS char* Kb = l3 + ATT_KB + (it & 3) * 8192; const LAS char* Vb = l3 + ATT_VB + (it & 3) * 8192;
        if (it < n_s) {
            const int j = it;
            if ((unionmask >> j) & 1ull) {
                f32x4 st[4];
                att_qk(Kb, qf, koff, st);
                const float nb = ((mymask >> j) & 1ull) ? -shs : ATT_NEG;
                if (j == jt) {
                    asm volatile("" ::: "memory");
#pragma unroll
                    for (int tk = 0; tk < 4; ++tk)
#pragma unroll
                        for (int rg = 0; rg < 4; ++rg) { const int pos = j * 64 + tk * 16 + G * 4 + rg; if (pos > t_row) st[tk][rg] = ATT_NEG; }
                }
                att_exp(st, nb, ls);
                att_pv(Vb, st, voff, os);
            }
        } else {
            const int cj = c_lo + (it - n_s);
            f32x4 st[4];
            att_qk(Kb, qf, koff, st);
            if (cj * 64 + 63 > tq0 || cj * 64 <= tq0 + 3 - 512) {
                asm volatile("" ::: "memory");
#pragma unroll
                for (int tk = 0; tk < 4; ++tk)
#pragma unroll
                    for (int rg = 0; rg < 4; ++rg) { const int pos = cj * 64 + tk * 16 + G * 4 + rg; if (!(pos <= t_row && pos > t_row - 512)) st[tk][rg] = ATT_NEG; }
            }
            att_exp(st, -shw, lw);
            att_pv(Vb, st, voff, ow);
        }
    }
#undef ATT_STAGE_CHUNK
    ls += __shfl_xor(ls, 16); ls += __shfl_xor(ls, 32);
    lw += __shfl_xor(lw, 16); lw += __shfl_xor(lw, 32);
    const float* gt = p.gates + r * 24 + g * 12 + h * 3;
    const float g0 = gt[0], g1 = gt[1] / ls, g2 = gt[2] / lw;
    const int colb = (g * 4 + h) * 64;
#pragma unroll
    for (int dt = 0; dt < 4; ++dt) {
        const int d = dt * 16 + G * 4;
        const uint2 gav = *(const uint2*)(p.ga + r * 512 + colb + d);
        float v[4];
#pragma unroll
        for (int rg = 0; rg < 4; ++rg) v[rg] = g0 * oc[dt][rg] + g1 * os[dt][rg] + g2 * ow[dt][rg];
        v[0] *= __uint_as_float(gav.x << 16); v[1] *= __uint_as_float(gav.x & 0xffff0000u);
        v[2] *= __uint_as_float(gav.y << 16); v[3] *= __uint_as_float(gav.y & 0xffff0000u);
        uint2 o; o.x = cvt_pk_bf16(v[0], v[1]); o.y = cvt_pk_bf16(v[2], v[3]);
        *(uint2*)(p.yar + r * 1024 + colb + d) = o;
    }
}

__device__ __forceinline__ void dot4(const float* qs, const bf16_t* kr, float (&s)[4]) {
    uint4 raw[8];
#pragma unroll
    for (int c = 0; c < 8; ++c) raw[c] = *(const uint4*)(kr + c * 8);
#pragma unroll
    for (int c = 0; c < 8; ++c) {
        float kf[8];
        kf[0] = __uint_as_float(raw[c].x << 16); kf[1] = __uint_as_float(raw[c].x & 0xffff0000u); kf[2] = __uint_as_float(raw[c].y << 16); kf[3] = __uint_as_float(raw[c].y & 0xffff0000u);
        kf[4] = __uint_as_float(raw[c].z << 16); kf[5] = __uint_as_float(raw[c].z & 0xffff0000u); kf[6] = __uint_as_float(raw[c].w << 16); kf[7] = __uint_as_float(raw[c].w & 0xffff0000u);
#pragma unroll
        for (int hh = 0; hh < 4; ++hh)
#pragma unroll
            for (int j = 0; j < 8; ++j) s[hh] += qs[hh * 64 + c * 8 + j] * kf[j];
    }
}
__device__ __forceinline__ void att_sample_unit(const Params& p, char* lds, int b, int g) {
    const int tid = opaque_tid(), lane = tid & 63, wave = tid >> 6;
    float* L = (float*)lds;
    float* qs = L;
    float* ps = L + 256;
    float* sc = L + 1296;
    int* sel = (int*)(L + 1568);
    float* red = L + 1600;
    float* part = L + 1664;
    float* pl = L + 1664 + 8 * 3 * 4 * 66 + wave * 256;
    const size_t r = TP + b;
    __syncthreads();
    if (tid < 256) qs[tid] = bf2f(p.qn[r * 512 + g * 256 + tid]);
    for (int i = tid; i < 1040; i += NT) ps[i] = 0.f;
    __syncthreads();
    const bf16_t* kc = p.kcs + (size_t)(b * 2 + g) * 1024 * 64; const bf16_t* vc = p.vcs + (size_t)(b * 2 + g) * 1024 * 64;
    const int n_c = 1023;
    float m1[4] = {-1e30f, -1e30f, -1e30f, -1e30f}, l1[4] = {0.f, 0.f, 0.f, 0.f};
    for (int cc = 0; cc < 2; ++cc) {
        const int i = wave * 128 + cc * 64 + lane; const bool valid = i < n_c;
        float s[4] = {0.f, 0.f, 0.f, 0.f};
        if (valid) dot4(qs, kc + (size_t)i * 64, s);
#pragma unroll
        for (int hh = 0; hh < 4; ++hh) {
            const float sv = valid ? s[hh] * 0.125f : -1e30f;
            const float mn = fmaxf(m1[hh], wave_max(sv));
            l1[hh] = l1[hh] * __expf(m1[hh] - mn) + wave_sum(valid ? __expf(sv - mn) : 0.f); m1[hh] = mn;
        }
    }
    if (lane == 0) {
#pragma unroll
        for (int hh = 0; hh < 4; ++hh) { red[wave * 8 + hh] = m1[hh]; red[wave * 8 + 4 + hh] = l1[hh]; }
    }
    __syncthreads();
    float M[4], Ls[4];
#pragma unroll
    for (int hh = 0; hh < 4; ++hh) {
        float mm = -1e30f;
        for (int w = 0; w < 8; ++w) mm = fmaxf(mm, red[w * 8 + hh]);
        float ll = 0.f;
        for (int w = 0; w < 8; ++w) ll += red[w * 8 + 4 + hh] * __expf(red[w * 8 + hh] - mm);
        M[hh] = mm; Ls[hh] = ll;
    }
    float oc[4] = {0.f, 0.f, 0.f, 0.f};
    for (int cc = 0; cc < 2; ++cc) {
        const int i0 = wave * 128 + cc * 64, i = i0 + lane; const bool valid = i < n_c;
        float s[4] = {0.f, 0.f, 0.f, 0.f};
        if (valid) dot4(qs, kc + (size_t)i * 64, s);
        float psum = 0.f;
#pragma unroll
        for (int hh = 0; hh < 4; ++hh) { const float pv = valid ? __expf(s[hh] * 0.125f - M[hh]) / Ls[hh] : 0.f; pl[hh * 64 + lane] = pv; psum += pv; }
        if (valid) ps[1 + i] = psum;
        WSYNC();
        const int nk = min(64, n_c - i0);
#pragma unroll 16
        for (int kk = 0; kk < 64; ++kk) {
            const float vv = bf2f(vc[(size_t)(i0 + (kk < nk ? kk : 0)) * 64 + lane]);
#pragma unroll
            for (int hh = 0; hh < 4; ++hh) oc[hh] += pl[hh * 64 + kk] * vv;
        }
        WSYNC();
    }
    __syncthreads();
    if (wave == 0) {
        const int t = PAST, jt = t >> 6;
        for (int j = lane; j < 257; j += 64) {
            float imp = 0.f;
#pragma unroll
            for (int rr = 0; rr < 4; ++rr) imp += ps[4 * j + rr + 1] + ps[4 * j + rr];
            const bool valid = j * 64 <= t, forced = (j == 0) || (j == jt) || (j == jt - 1);
            sc[j] = valid ? (forced ? 1e4f : imp) : -1e30f;
        }
        WSYNC();
        topk16(sc, sel, 257, lane);
    }
    __syncthreads();
    float msv[4] = {-1e30f, -1e30f, -1e30f, -1e30f}, lsv[4] = {0.f, 0.f, 0.f, 0.f}, osv[4] = {0.f, 0.f, 0.f, 0.f};
    for (int k = 2 * wave; k < 2 * wave + 2; ++k) {
        const int j = sel[k];
        if (j * 64 > PAST) continue;
        const bool valid = j * 64 + lane <= PAST;
        if (j == 256) attend64<float>(qs, pl, p.s_slc + (size_t)b * 256 + g * 64, p.s_slc + (size_t)b * 256 + 128 + g * 64, 256, valid, lane, msv, lsv, osv);
        else {
            const int pg = p.page_table[b * NPAGES + (j >> 1)];
            const float* base = p.cache_slc + (((size_t)pg * 128 + (j & 1) * 64) * 4 + g) * 64;
            attend64<float>(qs, pl, base, base + 128, 256, valid, lane, msv, lsv, osv);
        }
    }
    float mwv[4] = {-1e30f, -1e30f, -1e30f, -1e30f}, lwv[4] = {0.f, 0.f, 0.f, 0.f}, owv[4] = {0.f, 0.f, 0.f, 0.f};
    {
        const float* base = p.s_win + ((size_t)b * 512 + wave * 64) * 256 + g * 64;
        attend64<float>(qs, pl, base, base + 128, 256, true, lane, mwv, lwv, owv);
    }
#pragma unroll
    for (int hh = 0; hh < 4; ++hh) {
        float* pc = part + ((wave * 3 + 0) * 4 + hh) * 66; pc[lane] = oc[hh];
        float* pS = part + ((wave * 3 + 1) * 4 + hh) * 66; pS[lane] = osv[hh]; if (lane == 0) { pS[64] = msv[hh]; pS[65] = lsv[hh]; }
        float* pw = part + ((wave * 3 + 2) * 4 + hh) * 66; pw[lane] = owv[hh]; if (lane == 0) { pw[64] = mwv[hh]; pw[65] = lwv[hh]; }
    }
    __syncthreads();
    if (tid < 256) {
        const int hh = tid >> 6, d = tid & 63;
        float c = 0.f;
        for (int w = 0; w < 8; ++w) c += part[((w * 3 + 0) * 4 + hh) * 66 + d];
        float res[2];
#pragma unroll
        for (int br = 1; br < 3; ++br) {
            float mm = -1e30f;
            for (int w = 0; w < 8; ++w) mm = fmaxf(mm, part[((w * 3 + br) * 4 + hh) * 66 + 64]);
            float num = 0.f, den = 0.f;
            for (int w = 0; w < 8; ++w) { const float* q = part + ((w * 3 + br) * 4 + hh) * 66; const float e = __expf(q[64] - mm); num += q[d] * e; den += q[65] * e; }
            res[br - 1] = num / den;
        }
        const float* gt = p.gates + r * 24 + g * 12 + hh * 3;
        const int col = (g * 4 + hh) * 64 + d;
        p.yar[r * 1024 + col] = f2bf((gt[0] * c + gt[1] * res[0] + gt[2] * res[1]) * bf2f(p.ga[r * 512 + col]));
    }
    __syncthreads();
}

__device__ __forceinline__ void ret_out_item(const Params& p, char* lds, int it);
__device__ __forceinline__ void att_phase(const Params& p, char* lds, int bid, int nblk) {
    const int x = bid & 7;
    unsigned* ctr = p.bar + 3584 + 64 * x;
    volatile int* slot = (volatile int*)(lds + 147456 + 16);
    const int tid = opaque_tid();
    for (;;) {
        __syncthreads();
        if (tid == 0) *slot = (int)__hip_atomic_fetch_add(ctr, 1u, __ATOMIC_RELAXED, __HIP_MEMORY_SCOPE_AGENT);
        __syncthreads();
        const int w = *slot;
        if (w >= 136) break;
        if (w < 8) att_sample_unit(p, lds, 4 * x + (w >> 1), w & 1);
        else att_prompt_unit(p, lds, x >> 1, x & 1, 127 - (w - 8));
    }
}
__device__ __forceinline__ void ret_out_queue(const Params& p, char* lds, int bid, int nblk) {
    const int x = bid & 7;
    unsigned* ctr = p.bar + 3584 + 64 * x + 16;
    volatile int* slot = (volatile int*)(lds + 147456 + 16);
    const int tid = opaque_tid();
    wg_wait(p.bar + 3456, (unsigned)nblk, p.bar + XB_TMO);
    for (;;) {
        __syncthreads();
        if (tid == 0) *slot = (int)__hip_atomic_fetch_add(ctr, 1u, __ATOMIC_RELAXED, __HIP_MEMORY_SCOPE_AGENT);
        __syncthreads();
        const int w = *slot;
        if (w >= 80) break;
        ret_out_item(p, lds, x + 8 * w);
    }
}

__device__ __forceinline__ float ret_gamma(int h) { return 1.f - exp2f(-5.f - (float)h); }

__device__ __forceinline__ void p6a_local(const Params& p, int bid, int nblk) {
    const int tid = opaque_tid();
    const int e = tid & 127, dg = tid >> 7;
    for (int it = bid; it < 4 * 4 * 32; it += nblk) {
        const int n = it & 31, h = (it >> 5) & 3, b = it >> 7;
        const float lg = __logf(ret_gamma(h));
        float acc[16];
#pragma unroll
        for (int i = 0; i < 16; ++i) acc[i] = 0.f;
        for (int j = 0; j < 128; ++j) {
            const size_t r = (size_t)b * SEQ + n * 128 + j;
            const float z = __expf(lg * (float)(127 - j));
            const float v = bf2f(p.rv[r * 512 + h * 128 + e]) * z;
            const bf16_t* kr = p.rk + r * 256 + h * 64 + dg * 16;
#pragma unroll
            for (int i = 0; i < 16; ++i) acc[i] += bf2f(kr[i]) * v;
        }
        float* out = p.sloc + ((size_t)it * 64 + dg * 16) * 128 + e;
#pragma unroll
        for (int i = 0; i < 16; ++i) out[i * 128] = acc[i];
    }
}
__device__ __forceinline__ void p6b_scan(const Params& p, int bid, int nblk) {
    const size_t gt = (size_t)bid * NT + threadIdx.x, ngt = (size_t)nblk * NT;
    for (size_t i = gt; i < (size_t)16 * 8192; i += ngt) {
        const int bh = (int)(i >> 13), el = (int)(i & 8191), h = bh & 3;
        const float gc = __expf(__logf(ret_gamma(h)) * 128.f);
        float S = 0.f, lv[32];
#pragma unroll
        for (int n = 0; n < 32; ++n) lv[n] = p.sloc[((size_t)bh * 32 + n) * 8192 + el];
#pragma unroll
        for (int n = 0; n < 32; ++n) {
            p.spre[((size_t)bh * 32 + n) * 8192 + el] = S;
            S = S * gc + lv[n];
        }
        p.p_ret[(size_t)bh * 8192 + el] = S;
    }
    for (size_t i = gt; i < (size_t)128 * 8192; i += ngt) {
        const int bh = (int)(i >> 13), el = (int)(i & 8191), h = bh & 3, b = bh >> 2, d = el >> 7, e = el & 127;
        const size_t r = TP + b;
        const float k = bf2f(p.rk[r * 256 + h * 64 + d]), v = bf2f(p.rv[r * 512 + h * 128 + e]);
        p.s_ret[i] = p.state_ret[i] * ret_gamma(h) + k * v;
    }
}
__device__ __forceinline__ void p6c_out(const Params& p, char* lds, int bid, int nblk) {
    float* Am = (float*)lds;
    const int tid = opaque_tid();
    for (int it = bid; it < 4 * 4 * 32 + 128; it += nblk) {
        if (it < 512) {
            const int n = it & 31, h = (it >> 5) & 3, b = it >> 7;
            const float lg = __logf(ret_gamma(h));
            const size_t r0 = (size_t)b * SEQ + n * 128;
            for (int idx = tid; idx < 128 * 128; idx += NT) {
                const int i = idx >> 7, j = idx & 127;
                float a = 0.f;
                if (j <= i) {
                    const bf16_t* qr = p.rq + (r0 + i) * 256 + h * 64; const bf16_t* kr = p.rk + (r0 + j) * 256 + h * 64;
#pragma unroll
                    for (int c = 0; c < 8; ++c) { float qf[8], kf[8]; load8(qr + c * 8, qf); load8(kr + c * 8, kf);
#pragma unroll
                        for (int u = 0; u < 8; ++u) a += qf[u] * kf[u]; }
                    a *= __expf(lg * (float)(i - j));
                }
                Am[i * 129 + j] = a;
            }
            __syncthreads();
            const int e = tid & 127, ig = tid >> 7;
            const float* S = p.spre + (size_t)it * 8192;
            for (int i = ig * 32; i < ig * 32 + 32; ++i) {
                float o = 0.f;
                for (int j = 0; j <= i; ++j) o += Am[i * 129 + j] * bf2f(p.rv[(r0 + j) * 512 + h * 128 + e]);
                float qs = 0.f;
                const bf16_t* qr = p.rq + (r0 + i) * 256 + h * 64;
                for (int d = 0; d < 64; ++d) qs += bf2f(qr[d]) * S[d * 128 + e];
                o += qs * __expf(lg * (float)(i + 1));
                p.oret[(r0 + i) * 512 + h * 128 + e] = o;
            }
            __syncthreads();
        } else {
            const int bh = it - 512, h = bh & 3, b = bh >> 2;
            const size_t r = TP + b;
            if (tid < 128) {
                const int e = tid;
                const bf16_t* qr = p.rq + r * 256 + h * 64; const bf16_t* kr = p.rk + r * 256 + h * 64;
                const float* S0 = p.state_ret + (size_t)bh * 8192;
                float qs = 0.f, qk = 0.f;
                for (int d = 0; d < 64; ++d) { const float q = bf2f(qr[d]); qs += q * S0[d * 128 + e]; qk += q * bf2f(kr[d]); }
                p.oret[r * 512 + h * 128 + e] = qs * ret_gamma(h) + qk * bf2f(p.rv[r * 512 + h * 128 + e]);
            }
        }
    }
}
__device__ __forceinline__ void p6d_norm(const Params& p, int bid, int nblk) {
    const int tid = opaque_tid(), lane = tid & 63, wave = tid >> 6;
    for (int it = bid * 8 + wave; it < R * 4; it += nblk * 8) {
        const int r = it >> 2, h = it & 3;
        const float* o = p.oret + (size_t)r * 512 + h * 128;
        const float v0 = o[lane], v1 = o[lane + 64];
        const float rs = rsqrtf(wave_sum(v0 * v0 + v1 * v1) * (1.f / 128.f) + EPS);
        p.yar[(size_t)r * 1024 + 512 + h * 128 + lane] = f2bf(v0 * rs * p.g_ret[lane] * bf2f(p.gr[(size_t)r * 512 + h * 128 + lane]));
        p.yar[(size_t)r * 1024 + 512 + h * 128 + lane + 64] = f2bf(v1 * rs * p.g_ret[lane + 64] * bf2f(p.gr[(size_t)r * 512 + h * 128 + lane + 64]));
    }
}


__device__ __forceinline__ void ret_stage(LAS char* dst, const bf16_t* src, size_t row_stride, int lg_slots, int npieces, int tid) {
    for (int pc = tid; pc < npieces; pc += NT) {
        const int row = pc >> lg_slots, slot = pc & ((1 << lg_slots) - 1);
        __builtin_amdgcn_global_load_lds((const unsigned*)(src + (size_t)row * row_stride + ((slot ^ (row & 7)) * 8)), (LAS unsigned*)(dst + pc * 16), 16, 0, 0);
    }
}
__device__ __forceinline__ s16x4 ret_tr(const LAS char* img, int RB, int r0, int c0, int fr) {
    const int row = r0 + (fr >> 2), chunk = (c0 >> 3) + ((fr & 3) >> 1);
    return __builtin_amdgcn_ds_read_tr16_b64_v4i16((LAS s16x4*)(img + row * RB + ((chunk ^ (row & 7)) * 16) + (fr & 1) * 8));
}
__device__ __forceinline__ bf16x8 cat8(s16x4 a, s16x4 b) { bf16x8 v; v[0] = a[0]; v[1] = a[1]; v[2] = a[2]; v[3] = a[3]; v[4] = b[0]; v[5] = b[1]; v[6] = b[2]; v[7] = b[3]; return v; }

__device__ __forceinline__ void ret_local_item(const Params& p, char* lds, int it) {
    LAS char* l3 = (LAS char*)lds;
    const int tid = opaque_tid(), lane = tid & 63, wave = tid >> 6, fr = lane & 15, G = lane >> 4;
    {
        const int n = it & 31, h = (it >> 5) & 3, b = it >> 7;
        const size_t r0 = (size_t)b * SEQ + n * 128;
        __syncthreads();
        ret_stage(l3, p.rk + r0 * 256 + h * 64, 256, 3, 1024, tid);
        ret_stage(l3 + 16384, p.rv + r0 * 512 + h * 128, 512, 4, 2048, tid);
        asm volatile("s_waitcnt vmcnt(0)" ::: "memory");
        __syncthreads();
        f32x4 acc[4];
#pragma unroll
        for (int dt = 0; dt < 4; ++dt) acc[dt] = (f32x4){0.f, 0.f, 0.f, 0.f};
#pragma unroll
        for (int js = 0; js < 4; ++js) {
            const int j0 = js * 32 + 4 * G;
            const bf16x8 bfr = cat8(ret_tr(l3 + 16384, 256, j0, wave * 16, fr), ret_tr(l3 + 16384, 256, j0 + 16, wave * 16, fr));
#pragma unroll
            for (int dt = 0; dt < 4; ++dt) {
                const bf16x8 afr = cat8(ret_tr(l3, 128, j0, dt * 16, fr), ret_tr(l3, 128, j0 + 16, dt * 16, fr));
                acc[dt] = __builtin_amdgcn_mfma_f32_16x16x32_bf16(afr, bfr, acc[dt], 0, 0, 0);
            }
        }
        const float sc = exp2f(__log2f(ret_gamma(h)) * 127.f);
        float* out = p.sloc + (size_t)it * 8192 + wave * 16 + fr;
#pragma unroll
        for (int dt = 0; dt < 4; ++dt)
#pragma unroll
            for (int rg = 0; rg < 4; ++rg) out[(dt * 16 + 4 * G + rg) * 128] = acc[dt][rg] * sc;
    }
}

__device__ __forceinline__ void ret_out_item(const Params& p, char* lds, int it) {
    LAS char* l3 = (LAS char*)lds;
    const int tid = opaque_tid(), lane = tid & 63, wave = tid >> 6, fr = lane & 15, G = lane >> 4;
    {
        __syncthreads();
        if (it < 512) {
            const int n = it & 31, h = (it >> 5) & 3, b = it >> 7;
            const size_t r0 = (size_t)b * SEQ + n * 128;
            const float gam = ret_gamma(h);
            ret_stage(l3, p.rk + r0 * 256 + h * 64, 256, 3, 1024, tid);
            ret_stage(l3 + 16384, p.rv + r0 * 512 + h * 128, 512, 4, 2048, tid);
            {
                const float* S = p.spre + (size_t)it * 8192;
                for (int pc = tid; pc < 1024; pc += NT) {
                    const int row = pc >> 4, slot = pc & 15;
                    const float4 a = *(const float4*)(S + row * 128 + slot * 8), c = *(const float4*)(S + row * 128 + slot * 8 + 4);
                    u32x4 v; v[0] = cvt_pk_bf16(a.x * gam, a.y * gam); v[1] = cvt_pk_bf16(a.z * gam, a.w * gam); v[2] = cvt_pk_bf16(c.x * gam, c.y * gam); v[3] = cvt_pk_bf16(c.z * gam, c.w * gam);
                    *(LAS u32x4*)(l3 + 49152 + row * 256 + ((slot ^ (row & 7)) * 16)) = v;
                }
            }
            const size_t ri = r0 + wave * 16 + fr;
            bf16x8 qf[2], qp[2];
#pragma unroll
            for (int ks = 0; ks < 2; ++ks) {
                const bf16_t* qrow = p.rq + ri * 256 + h * 64 + ks * 32;
                qf[ks] = *(const bf16x8*)(qrow + G * 8);
                const s16x4 lo = *(const s16x4*)(qrow + 4 * G), hi = *(const s16x4*)(qrow + 16 + 4 * G);
                qp[ks] = cat8(lo, hi);
            }
            asm volatile("s_waitcnt vmcnt(0)" ::: "memory");
            __syncthreads();
            f32x4 st[8];
#pragma unroll
            for (int jt = 0; jt < 8; ++jt) {
                st[jt] = (f32x4){0.f, 0.f, 0.f, 0.f};
                if (jt <= wave) {
#pragma unroll
                    for (int ks = 0; ks < 2; ++ks) {
                        const int row = jt * 16 + fr;
                        const bf16x8 kf = *(const LAS bf16x8*)(l3 + row * 128 + (((ks * 4 + G) ^ (row & 7)) * 16));
                        st[jt] = __builtin_amdgcn_mfma_f32_16x16x32_bf16(kf, qf[ks], st[jt], 0, 0, 0);
                    }
                    if (jt == wave) {
#pragma unroll
                        for (int rg = 0; rg < 4; ++rg) if (4 * G + rg > fr) st[jt][rg] = 0.f;
                    }
                }
            }
            f32x4 o[8];
#pragma unroll
            for (int et = 0; et < 8; ++et) o[et] = (f32x4){0.f, 0.f, 0.f, 0.f};
#pragma unroll
            for (int js = 0; js < 4; ++js) {
                if (2 * js <= wave) {
                    u32x4 pk;
                    pk[0] = cvt_pk_bf16(st[2 * js][0], st[2 * js][1]); pk[1] = cvt_pk_bf16(st[2 * js][2], st[2 * js][3]);
                    pk[2] = cvt_pk_bf16(st[2 * js + 1][0], st[2 * js + 1][1]); pk[3] = cvt_pk_bf16(st[2 * js + 1][2], st[2 * js + 1][3]);
                    const bf16x8 pf = __builtin_bit_cast(bf16x8, pk);
                    const int j0 = js * 32 + 4 * G;
#pragma unroll
                    for (int et = 0; et < 8; ++et) {
                        const bf16x8 vf = cat8(ret_tr(l3 + 16384, 256, j0, et * 16, fr), ret_tr(l3 + 16384, 256, j0 + 16, et * 16, fr));
                        o[et] = __builtin_amdgcn_mfma_f32_16x16x32_bf16(vf, pf, o[et], 0, 0, 0);
                    }
                }
            }
#pragma unroll
            for (int ks = 0; ks < 2; ++ks) {
                const int d0 = ks * 32 + 4 * G;
#pragma unroll
                for (int et = 0; et < 8; ++et) {
                    const bf16x8 sf = cat8(ret_tr(l3 + 49152, 256, d0, et * 16, fr), ret_tr(l3 + 49152, 256, d0 + 16, et * 16, fr));
                    o[et] = __builtin_amdgcn_mfma_f32_16x16x32_bf16(sf, qp[ks], o[et], 0, 0, 0);
                }
            }
            float ss = 0.f;
#pragma unroll
            for (int et = 0; et < 8; ++et)
#pragma unroll
                for (int rg = 0; rg < 4; ++rg) ss += o[et][rg] * o[et][rg];
            ss += __shfl_xor(ss, 16); ss += __shfl_xor(ss, 32);
            const float rs = rsqrtf(ss * (1.f / 128.f) + EPS);
#pragma unroll
            for (int et = 0; et < 8; ++et) {
                const int e = et * 16 + 4 * G;
                const float4 gr = *(const float4*)(p.g_ret + e);
                const uint2 gv = *(const uint2*)(p.gr + ri * 512 + h * 128 + e);
                uint2 ov;
                ov.x = cvt_pk_bf16(o[et][0] * rs * gr.x * __uint_as_float(gv.x << 16), o[et][1] * rs * gr.y * __uint_as_float(gv.x & 0xffff0000u));
                ov.y = cvt_pk_bf16(o[et][2] * rs * gr.z * __uint_as_float(gv.y << 16), o[et][3] * rs * gr.w * __uint_as_float(gv.y & 0xffff0000u));
                *(uint2*)(p.yar + ri * 1024 + 512 + h * 128 + e) = ov;
            }
        } else {
            const int bh = it - 512, h = bh & 3, b = bh >> 2;
            const size_t r = TP + b;
            float* red = (float*)lds;
            float o = 0.f;
            if (tid < 128) {
                const int e = tid;
                const bf16_t* qr = p.rq + r * 256 + h * 64; const bf16_t* kr = p.rk + r * 256 + h * 64;
                const float* S0 = p.state_ret + (size_t)bh * 8192;
                float qs = 0.f, qk = 0.f;
                for (int d = 0; d < 64; ++d) { const float q = bf2f(qr[d]); qs += q * S0[d * 128 + e]; qk += q * bf2f(kr[d]); }
                o = qs * ret_gamma(h) + qk * bf2f(p.rv[r * 512 + h * 128 + e]);
                const float s2 = wave_sum(o * o);
                if (lane == 0) red[wave] = s2;
            }
            __syncthreads();
            if (tid < 128) {
                const float rs = rsqrtf((red[0] + red[1]) * (1.f / 128.f) + EPS);
                p.yar[r * 1024 + 512 + h * 128 + tid] = f2bf(o * rs * p.g_ret[tid] * bf2f(p.gr[r * 512 + h * 128 + tid]));
            }
        }
    }
}

__device__ __forceinline__ void out_sample(const Params& p, int bid, int nblk) {
    const int tid = opaque_tid(), lane = tid & 63, wave = tid >> 6, fr = lane & 15, G = lane >> 4;
    for (int it = bid * 8 + wave; it < 128; it += nblk * 8) {
        const int mt = it >> 6, nt = it & 63;
        const bf16_t* arow = p.yar + (size_t)(TP + mt * 16 + fr) * 1024 + G * 8;
        const bf16_t* brow = p.bt_out + (size_t)(nt * 16 + fr) * 1024 + G * 8;
        f32x4 acc = {0.f, 0.f, 0.f, 0.f};
#pragma unroll 8
        for (int ks = 0; ks < 32; ++ks) {
            const bf16x8 a = *(const bf16x8*)(arow + ks * 32), b = *(const bf16x8*)(brow + ks * 32);
            acc = __builtin_amdgcn_mfma_f32_16x16x32_bf16(a, b, acc, 0, 0, 0);
        }
        const int c = nt * 16 + fr;
#pragma unroll
        for (int rg = 0; rg < 4; ++rg) {
            const int sb = mt * 16 + 4 * G + rg;
            p.y[(size_t)(TP + sb) * 1024 + c] = p.x_sample[(size_t)sb * 1024 + c] + p.mod[(4 + sb) * 3072 + 2048 + c] * acc[rg];
        }
    }
}
__global__ void __launch_bounds__(NT, 2) k_mega(Params p) {
    extern __shared__ __attribute__((aligned(16))) char lds[];
    const int bid = blockIdx.x, nblk = gridDim.x;
    uint4* xbw = (uint4*)(lds + 147456);
    if (threadIdx.x == 0) *xbw = make_uint4(0u, 0u, 0u, 0u);
    __syncthreads();
    XcdBarrier bar = xcd_barrier_post(p.bar, (volatile LAS unsigned*)xbw);
    p0_w1p(p, bid, nblk); wg_signal(p.bar + 3536, true);
    p0_adaln(p, lds, bid, nblk); __syncthreads(); p0_weights(p, lds, bid, nblk); __syncthreads();
    wg_wait(p.bar + 3536, (unsigned)nblk, p.bar + XB_TMO);
    compress_sample(p, lds, bid, nblk);
    wg_wait(p.bar + 3520, 96u, p.bar + XB_TMO);
    p1_norm(p, lds, bid, nblk);
    xcd_barrier(bar);
    { EpiIn e{&p}; gemm_phase(p.H, p.bt_in, RPAD / 256, NPAD / 256, 1024, lds, bid, nblk, e); }
    if (nblk == 256) compress_seams(p, bid - 142, 114); else compress_seams(p, bid, nblk);
    xcd_barrier(bar);
    {
        volatile int* slot = (volatile int*)(lds + 147456 + 16);
        for (;;) {
            __syncthreads();
            if (threadIdx.x == 0) *slot = (int)__hip_atomic_fetch_add(p.bar + 3456 + 48, 1u, __ATOMIC_RELAXED, __HIP_MEMORY_SCOPE_AGENT);
            __syncthreads();
            const int w = *slot;
            if (w >= 136 + 512) break;
            if (w < 136) compress_prompt_ksplit_item(p, lds, w); else ret_local_item(p, lds, w - 136);
        }
    }
    xcd_barrier(bar);
    p6b_scan(p, bid, nblk); wg_signal(p.bar + 3456, true);
    att_phase(p, lds, bid, nblk);
    ret_out_queue(p, lds, bid, nblk);
    xcd_barrier(bar);
    { EpiOut e{&p}; gemm_phase(p.yar, p.bt_out, TP / 256, 4, 1024, lds, bid, nblk, e); }
    out_sample(p, nblk - 1 - bid, nblk);
}
}

extern "C" void kernel_launch(void* const* d_in, const int* in_sizes, int n_in, void* d_out, int out_size, void* d_ws, size_t ws_size, hipStream_t stream) {
    Params p{};
    p.x_prompt = (const float*)d_in[0]; p.x_sample = (const float*)d_in[1]; p.c_prompt = (const float*)d_in[2]; p.c_sample = (const float*)d_in[3];
    p.cache_cmp = (const float*)d_in[4]; p.cache_slc = (const float*)d_in[5]; p.state_win = (const float*)d_in[6]; p.state_ret = (const float*)d_in[7];
    p.page_table = (const int*)d_in[8];
    p.g_norm = (const float*)d_in[9]; p.w_ada = (const float*)d_in[10]; p.b_ada = (const float*)d_in[11]; p.w_in = (const float*)d_in[12];
    p.g_q = (const float*)d_in[13]; p.g_kc = (const float*)d_in[14]; p.g_ks = (const float*)d_in[15]; p.g_kw = (const float*)d_in[16];
    p.pe_ck = (const float*)d_in[17]; p.w_ck1 = (const float*)d_in[18]; p.w_ck2 = (const float*)d_in[19];
    p.pe_cv = (const float*)d_in[20]; p.w_cv1 = (const float*)d_in[21]; p.w_cv2 = (const float*)d_in[22];
    p.g_ret = (const float*)d_in[23]; p.w_out = (const float*)d_in[24];
    float* o = (float*)d_out;
    p.y = o; o += (size_t)R * 1024;
    p.p_cmp = o; o += (size_t)TP * 256; p.p_slc = o; o += (size_t)TP * 256; p.p_win = o; o += (size_t)4 * 512 * 256; p.p_ret = o; o += (size_t)16 * 8192;
    p.s_cmp = o; o += 32 * 256; p.s_slc = o; o += 32 * 256; p.s_win = o; o += (size_t)32 * 512 * 256; p.s_ret = o; o += (size_t)128 * 8192;
    char* w = (char*)d_ws; size_t off = 0;
    auto take = [&](size_t bytes) { char* q = w + off; off += (bytes + 255) & ~(size_t)255; return q; };
    p.bar = (unsigned*)take(16384);
    p.mod = (float*)take(36 * 3072 * 4);
    p.bt_in = (bf16_t*)take((size_t)NPAD * 1024 * 2);
    p.bt_out = (bf16_t*)take((size_t)1024 * 1024 * 2);
    p.H = (bf16_t*)take((size_t)RPAD * 1024 * 2);
    p.praw = (float*)take((size_t)RPAD * NPAD * 4);
    p.qn = (bf16_t*)take((size_t)R * 512 * 2);
    p.kcr = (bf16_t*)take((size_t)TP * 128 * 2); p.vcr = (bf16_t*)take((size_t)TP * 128 * 2);
    p.ks = (bf16_t*)take((size_t)TP * 128 * 2); p.vs = (bf16_t*)take((size_t)TP * 128 * 2);
    p.kw = (bf16_t*)take((size_t)TP * 128 * 2); p.vw = (bf16_t*)take((size_t)TP * 128 * 2);
    p.gates = (float*)take((size_t)R * 24 * 4);
    p.ga = (bf16_t*)take((size_t)R * 512 * 2); p.gr = (bf16_t*)take((size_t)R * 512 * 2);
    p.rq = (bf16_t*)take((size_t)R * 256 * 2); p.rk = (bf16_t*)take((size_t)R * 256 * 2); p.rv = (bf16_t*)take((size_t)R * 512 * 2);
    p.kc = (bf16_t*)take((size_t)4 * 2 * 256 * 64 * 2); p.vc = (bf16_t*)take((size_t)4 * 2 * 256 * 64 * 2);
    p.kcs = (bf16_t*)take((size_t)32 * 2 * 1024 * 64 * 2); p.vcs = (bf16_t*)take((size_t)32 * 2 * 1024 * 64 * 2);
    p.yar = (bf16_t*)take((size_t)RPAD * 1024 * 2);
    p.sloc = (float*)take((size_t)512 * 8192 * 4); p.spre = (float*)take((size_t)512 * 8192 * 4);
    p.oret = (float*)take((size_t)R * 512 * 4);
    p.w1p = (bf16_t*)take((size_t)2 * 128 * 1024 * 2); p.w2t = (bf16_t*)take((size_t)2 * 64 * 64 * 2); p.b1 = (float*)take(128 * 4);
    p.attb = (float*)take(256);
    p.ropec = (float*)take((size_t)4097 * 32 * 4); p.ropes = (float*)take((size_t)4097 * 32 * 4);
    p.seamA = (float*)take((size_t)32 * 2 * 64 * 2 * 64 * 4); p.seamB = (float*)take((size_t)32 * 2 * 64 * 2 * 64 * 4);
    if (off > ws_size) { fprintf(stderr, "workspace too small: need %zu have %zu\n", off, ws_size); return; }
    static int grid = 0;
    if (grid == 0) {
        int dev = 0, cus = 0, per_cu = 0;
        if (hipGetDevice(&dev) != hipSuccess || hipDeviceGetAttribute(&cus, hipDeviceAttributeMultiprocessorCount, dev) != hipSuccess) { fprintf(stderr, "device query failed\n"); grid = -1; return; }
        if (hipFuncSetAttribute((const void*)k_mega, hipFuncAttributeMaxDynamicSharedMemorySize, LDS_BYTES) != hipSuccess) { fprintf(stderr, "hipFuncSetAttribute failed\n"); grid = -1; return; }
        if (hipOccupancyMaxActiveBlocksPerMultiprocessor(&per_cu, (const void*)k_mega, NT, LDS_BYTES) != hipSuccess || per_cu < 1) { fprintf(stderr, "occupancy query: %d blocks per CU\n", per_cu); grid = -1; return; }
        (void)hipGetLastError();
        grid = cus;
    }
    if (grid < 0) return;
    (void)hipMemsetAsync(p.bar, 0, 16384, stream);
    hipLaunchKernelGGL(k_mega, dim3(grid), dim3(NT), LDS_BYTES, stream, p);
}
```

```cpp
#include <hip/hip_runtime.h>
#include <stdint.h>
#include <stdio.h>

namespace {
typedef unsigned short bf16_t;
typedef short bf16x8 __attribute__((ext_vector_type(8)));
typedef float f32x4 __attribute__((ext_vector_type(4)));

constexpr int D_MODEL = 1024, BATCH = 4, SEQ = 4096, DEC_BATCH = 32, PAST = 16384;
constexpr int NPAGES = 128, NPHYS = 5120;
constexpr int TP = BATCH * SEQ;
constexpr int R = TP + DEC_BATCH;
constexpr int RPAD = 16640;
constexpr int D_IN = 3352, NPAD = 3584;
constexpr int C_Q = 0, C_KC = 512, C_KS = 768, C_KW = 1024, C_BR = 1280, C_GA = 1304, C_RQ = 1816, C_RK = 2072, C_RV = 2328, C_GR = 2840;
constexpr float EPS = 1e-6f;
constexpr int NT = 512;
constexpr int LDS_BYTES = 147456 + 64 + 8192 + 256;

struct Params {
    const float *x_prompt, *x_sample, *c_prompt, *c_sample, *cache_cmp, *cache_slc, *state_win, *state_ret;
    const int* page_table;
    const float *g_norm, *w_ada, *b_ada, *w_in, *g_q, *g_kc, *g_ks, *g_kw, *pe_ck, *w_ck1, *w_ck2, *pe_cv, *w_cv1, *w_cv2, *g_ret, *w_out;
    float *y, *p_cmp, *p_slc, *p_win, *p_ret, *s_cmp, *s_slc, *s_win, *s_ret;
    unsigned* bar;
    float* mod;
    bf16_t* bt_in;
    bf16_t* bt_out;
    bf16_t* H;
    float* praw;
    bf16_t* qn;
    bf16_t *kcr, *vcr, *ks, *vs, *kw, *vw;
    float* gates;
    bf16_t *ga, *gr;
    bf16_t *rq, *rk;
    bf16_t* rv;
    bf16_t *kc, *vc;
    bf16_t *kcs, *vcs;
    bf16_t* yar;
    float *sloc, *spre;
    float* oret;
    bf16_t* w1p;
    bf16_t* w2t;
    float* b1;
    float *seamA, *seamB;
    float* attb;
    float *ropec, *ropes;
};

__device__ __forceinline__ int tile_src(int pn) { return pn <= 4 ? pn * 256 : pn == 13 ? 1280 : 1304 + (pn - 5) * 256; }
__device__ __forceinline__ bf16_t f2bf(float f) { unsigned u = __float_as_uint(f); u += 0x7fffu + ((u >> 16) & 1u); return (bf16_t)(u >> 16); }
__device__ __forceinline__ float bf2f(bf16_t h) { return __uint_as_float(((unsigned)h) << 16); }
__device__ __forceinline__ float wave_sum(float v) {
#pragma unroll
    for (int o = 1; o < 64; o <<= 1) v += __shfl_xor(v, o);
    return v;
}
__device__ __forceinline__ float wave_max(float v) {
#pragma unroll
    for (int o = 1; o < 64; o <<= 1) v = fmaxf(v, __shfl_xor(v, o));
    return v;
}
__device__ __forceinline__ float silu(float v) { return v / (1.f + __expf(-v)); }
__device__ __forceinline__ float sigmoidf(float v) { return 1.f / (1.f + __expf(-v)); }
__device__ __forceinline__ int opaque_tid() { int t = threadIdx.x; asm volatile("" : "+v"(t)); return t; }
typedef __bf16 bf16x2_t __attribute__((ext_vector_type(2)));
typedef float f32x2_t __attribute__((ext_vector_type(2)));
__device__ __forceinline__ unsigned cvt_pk_bf16(float lo, float hi) { const f32x2_t v = {lo, hi}; return __builtin_bit_cast(unsigned, __builtin_convertvector(v, bf16x2_t)); }
#define WSYNC() asm volatile("s_waitcnt lgkmcnt(0)" ::: "memory")

__device__ __forceinline__ void load8(const bf16_t* p, float (&f)[8]) {
    uint4 u = *(const uint4*)p;
    f[0] = __uint_as_float(u.x << 16); f[1] = __uint_as_float(u.x & 0xffff0000u);
    f[2] = __uint_as_float(u.y << 16); f[3] = __uint_as_float(u.y & 0xffff0000u);
    f[4] = __uint_as_float(u.z << 16); f[5] = __uint_as_float(u.z & 0xffff0000u);
    f[6] = __uint_as_float(u.w << 16); f[7] = __uint_as_float(u.w & 0xffff0000u);
}
__device__ __forceinline__ void load8(const float* p, float (&f)[8]) {
    float4 a = *(const float4*)p, b = *(const float4*)(p + 4);
    f[0] = a.x; f[1] = a.y; f[2] = a.z; f[3] = a.w; f[4] = b.x; f[5] = b.y; f[6] = b.z; f[7] = b.w;
}
__device__ __forceinline__ float load1(const bf16_t* p) { return bf2f(*p); }
__device__ __forceinline__ float load1(const float* p) { return *p; }


#define XB_TMO      128
#define XB_XCNT(j)  (256  + 64 * (j))
#define XB_XSUB(j)  (1280 + 64 * (j))
#define XB_XGEN(j)  (2304 + 64 * (j))
#define XB_TOP      3328
#define XB_TOPGEN   3392
#define XCD_BAR_WORDS 3456
#define XB_SPIN_CAP (1u << 18)
#define LAS __attribute__((address_space(3)))
__device__ __forceinline__ unsigned xb_ld(unsigned* p)              { return __hip_atomic_load(p, __ATOMIC_RELAXED, __HIP_MEMORY_SCOPE_AGENT); }
__device__ __forceinline__ unsigned xb_add(unsigned* p, unsigned v) { return __hip_atomic_fetch_add(p, v, __ATOMIC_RELAXED, __HIP_MEMORY_SCOPE_AGENT); }
__device__ __forceinline__ unsigned xb_xcc_id() { return (unsigned)__builtin_amdgcn_s_getreg((3 << 11) | 20) & 0xFu; }
#define XB_SPIN(cond, bar) do { unsigned _sp = 0; while (cond) { __builtin_amdgcn_s_sleep(1); \
    if ((++_sp & 255u) == 0u) { if (xb_ld(&(bar)[XB_TMO])) break; if (_sp > XB_SPIN_CAP) { atomicAdd(&(bar)[XB_TMO], 1u); break; } } } } while (0)
struct XcdBarrier { unsigned* bar; unsigned x; volatile LAS unsigned* st; };
__device__ __forceinline__ XcdBarrier xcd_barrier_post(unsigned* bar, volatile LAS unsigned* st) {
    XcdBarrier b; b.bar = bar; b.x = xb_xcc_id(); b.st = st;
    if (threadIdx.x == 0) (void)xb_add(&bar[XB_XCNT(b.x)], 1u);
    return b;
}
__device__ __forceinline__ void xcd_barrier_complete(unsigned* bar, unsigned x, unsigned& nloc, unsigned& nx) {
    const unsigned G = gridDim.x * gridDim.y * gridDim.z;
    unsigned sum, cnt, mine, sp = 0u;
    for (;;) {
        sum = 0u; cnt = 0u; mine = 0u;
#pragma unroll
        for (unsigned j = 0; j < 16; ++j) { const unsigned c = xb_ld(&bar[XB_XCNT(j)]); sum += c; cnt += (c > 0u) ? 1u : 0u; mine = (j == x) ? c : mine; }
        if (sum == G) break;
        __builtin_amdgcn_s_sleep(1);
        if ((++sp & 255u) == 0u) { if (xb_ld(&bar[XB_TMO])) break; if (sp > XB_SPIN_CAP) { atomicAdd(&bar[XB_TMO], 1u); break; } }
    }
    nloc = mine > 0u ? mine : 1u; nx = cnt > 0u ? cnt : 1u;
}
__device__ __forceinline__ void xcd_barrier(const XcdBarrier& b) {
    asm volatile("s_waitcnt vmcnt(0)" ::: "memory");
    __syncthreads();
    if (threadIdx.x == 0) {
        unsigned* bar = b.bar;
        __builtin_amdgcn_s_waitcnt(0);
        unsigned nloc = b.st[0], nx = b.st[1];
        if (nloc == 0u) { xcd_barrier_complete(bar, b.x, nloc, nx); b.st[0] = nloc; b.st[1] = nx; }
        const unsigned old = xb_add(&bar[XB_XSUB(b.x)], 1u);
        const unsigned gen = old / nloc;
        if (old + 1u == (gen + 1u) * nloc) {
            __builtin_amdgcn_fence(__ATOMIC_RELEASE, "agent");
            asm volatile("s_waitcnt vmcnt(0)" ::: "memory");
            const unsigned og = xb_add(&bar[XB_TOP], 1u);
            const unsigned tg = og / nx;
            if (og + 1u == (tg + 1u) * nx) xb_add(&bar[XB_TOPGEN], 1u);
            else XB_SPIN(xb_ld(&bar[XB_TOPGEN]) == tg, bar);
            __builtin_amdgcn_fence(__ATOMIC_ACQUIRE, "agent");
            xb_add(&bar[XB_XGEN(b.x)], 1u);
            asm volatile("s_waitcnt vmcnt(0)" ::: "memory");
        } else {
            XB_SPIN(xb_ld(&bar[XB_XGEN(b.x)]) == gen, bar);
            __builtin_amdgcn_fence(__ATOMIC_ACQUIRE, "agent");
            asm volatile("s_waitcnt vmcnt(0)" ::: "memory");
        }
    }
    __syncthreads();
}


__device__ __forceinline__ void wg_signal(unsigned* ctr, bool need_release) {
    asm volatile("s_waitcnt vmcnt(0)" ::: "memory");
    __syncthreads();
    if (threadIdx.x == 0) {
        if (need_release) { __builtin_amdgcn_fence(__ATOMIC_RELEASE, "agent"); asm volatile("s_waitcnt vmcnt(0)" ::: "memory"); }
        (void)__hip_atomic_fetch_add(ctr, 1u, __ATOMIC_RELAXED, __HIP_MEMORY_SCOPE_AGENT);
    }
}
__device__ __forceinline__ void wg_wait(unsigned* ctr, unsigned target, unsigned* tmo) {
    if (threadIdx.x == 0) {
        unsigned sp = 0;
        while (__hip_atomic_load(ctr, __ATOMIC_RELAXED, __HIP_MEMORY_SCOPE_AGENT) < target) {
            __builtin_amdgcn_s_sleep(2);
            if (++sp > (1u << 22)) { atomicAdd(tmo, 1u); break; }
        }
        __builtin_amdgcn_fence(__ATOMIC_ACQUIRE, "agent");
        asm volatile("s_waitcnt vmcnt(0)" ::: "memory");
    }
    __syncthreads();
}
__device__ __forceinline__ void p0_adaln(const Params& p, char* lds, int bid, int nblk) {
    float* sc = (float*)lds;
    float* red = (float*)(lds + 73728);
    const int tid = opaque_tid(), lane = tid & 63, wave = tid >> 6;
    for (int item = bid; item < 96; item += nblk) {
        const int cb = item >> 1, r0 = (item & 1) * 18;
        __syncthreads();
        for (int i = tid; i < 18 * 1024; i += NT) {
            const int row = r0 + (i >> 10), k = i & 1023;
            sc[i] = silu(row < 4 ? p.c_prompt[row * 1024 + k] : p.c_sample[(row - 4) * 1024 + k]);
        }
        __syncthreads();
        const int j = cb * 64 + lane;
        float acc[18];
#pragma unroll
        for (int r = 0; r < 18; ++r) acc[r] = 0.f;
        const int k0 = wave * 128;
#pragma unroll 8
        for (int k = k0; k < k0 + 128; k += 4) {
            const float w0 = p.w_ada[(size_t)k * 3072 + j], w1 = p.w_ada[(size_t)(k + 1) * 3072 + j], w2 = p.w_ada[(size_t)(k + 2) * 3072 + j], w3 = p.w_ada[(size_t)(k + 3) * 3072 + j];
#pragma unroll
            for (int r = 0; r < 18; ++r) { const float4 s = *(const float4*)(sc + r * 1024 + k); acc[r] += s.x * w0 + s.y * w1 + s.z * w2 + s.w * w3; }
        }
#pragma unroll
        for (int r = 0; r < 18; ++r) red[(wave * 18 + r) * 64 + lane] = acc[r];
        __syncthreads();
        for (int i = tid; i < 18 * 64; i += NT) {
            const int r = i >> 6, l = i & 63;
            float s = 0.f;
#pragma unroll
            for (int w = 0; w < 8; ++w) s += red[(w * 18 + r) * 64 + l];
            __hip_atomic_store(&p.mod[(r0 + r) * 3072 + cb * 64 + l], s + p.b_ada[cb * 64 + l], __ATOMIC_RELAXED, __HIP_MEMORY_SCOPE_AGENT);
        }
        wg_signal(p.bar + 3520, false);
    }
}

__device__ __forceinline__ void transpose_item(const float* W, int K, int N, bf16_t* WT, float* scr, int item, int lane, int nblkN) {
    const int kb = item / nblkN, nb = item % nblkN, k0 = kb * 64, n0 = nb * 64;
    float tv[64];
#pragma unroll
    for (int kk = 0; kk < 64; ++kk) tv[kk] = (n0 + lane < N) ? W[(size_t)(k0 + kk) * N + n0 + lane] : 0.f;
#pragma unroll
    for (int kk = 0; kk < 64; ++kk) scr[kk * 65 + lane] = tv[kk];
    WSYNC();
    for (int nn = 0; nn < 64; ++nn) WT[(size_t)(n0 + nn) * K + k0 + lane] = f2bf(scr[lane * 65 + nn]);
    WSYNC();
}
__device__ __forceinline__ void p0_w1p(const Params& p, int bid, int nblk) {
    const size_t gt = (size_t)bid * NT + opaque_tid(), ngt = (size_t)nblk * NT;
    for (size_t i = gt; i < (size_t)2 * 128 * 1024; i += ngt) {
        const int kv = (int)(i >> 17), n = (int)(i >> 10) & 127, kp = (int)i & 1023;
        const int ks = kp >> 5, G = (kp >> 3) & 3, j = kp & 7;
        const int k = ks * 32 + 16 * (j >> 2) + 4 * G + (j & 3);
        const int l = (k >> 6) + (n >= 64 ? 16 : 0), d = k & 63, f = n & 63;
        p.w1p[i] = f2bf((kv ? p.w_cv1 : p.w_ck1)[(size_t)(l * 64 + d) * 64 + f]);
    }
}
__device__ __forceinline__ void p0_weights(const Params& p, char* lds, int bid, int nblk) {
    const int tid = opaque_tid(), lane = tid & 63, wave = tid >> 6;
    float* scr = (float*)lds + wave * (64 * 65);
    const int gw = bid * 8 + wave, ngw = nblk * 8;
    constexpr int I_IN = 16 * 112, I_OUT = 16 * 16;
    for (int it = gw; it < I_IN + I_OUT; it += ngw) {
        if (it < I_IN) {
            const int kb = it / 112, nb = it % 112, k0 = kb * 64, n0 = nb * 32;
            const int pn = n0 >> 8, pl = n0 & 255, bj = pl >> 7, wc = (pl >> 5) & 3;
            const int cb = tile_src(pn) + wc * 64 + bj * 32;
            const int lim = pn == 13 ? 1304 : D_IN;
            float tv[32];
#pragma unroll
            for (int i = 0; i < 32; ++i) { const int kk = 2 * i + (lane >> 5), c = cb + (lane & 31); tv[i] = c < lim ? p.w_in[(size_t)(k0 + kk) * D_IN + c] : 0.f; }
#pragma unroll
            for (int i = 0; i < 32; ++i) scr[(2 * i + (lane >> 5)) * 33 + (lane & 31)] = tv[i];
            WSYNC();
            const int c8 = lane & 7;
            for (int j = 0; j < 4; ++j) {
                const int n = (lane >> 3) + 8 * j; const float* s = scr + (8 * c8) * 33 + n;
                uint4 o; o.x = cvt_pk_bf16(s[0], s[33]); o.y = cvt_pk_bf16(s[66], s[99]); o.z = cvt_pk_bf16(s[132], s[165]); o.w = cvt_pk_bf16(s[198], s[231]);
                *(uint4*)(p.bt_in + (size_t)(n0 + n) * 1024 + k0 + 8 * c8) = o;
            }
            WSYNC();
        } else transpose_item(p.w_out, 1024, 1024, p.bt_out, scr, it - I_IN, lane, 16);
    }
    const size_t gt = (size_t)bid * NT + tid, ngt = (size_t)nblk * NT;
    for (size_t i = gt; i < (size_t)4097 * 32; i += ngt) {
        const int pi = (int)(i >> 5), fi = (int)i & 31;
        const float ang = (float)(pi < 4096 ? pi : PAST) * powf(10000.f, -(float)fi / 32.f);
        float sn, cs; sincosf(ang, &sn, &cs);
        p.ropec[i] = cs; p.ropes[i] = sn;
    }
    if (bid == (nblk > 200 ? 200 : 0) && wave == 0) {
        const float gq = wave_max(fabsf(p.g_q[lane])), gc = wave_max(fabsf(p.g_kc[lane])), gs = wave_max(fabsf(p.g_ks[lane])), gw = wave_max(fabsf(p.g_kw[lane]));
        if (lane == 0) { const float k = 8.f * 1.03f * 1.44269504088896f * gq; p.attb[0] = k * gc; p.attb[1] = k * gs; p.attb[2] = k * gw; p.attb[3] = 0.f; }
    }
    for (size_t i = gt; i < (size_t)2 * 64 * 64; i += ngt) {
        const int kv = (int)(i >> 12), d = (int)(i >> 6) & 63, f = (int)i & 63;
        p.w2t[i] = f2bf((kv ? p.w_cv2 : p.w_ck2)[f * 64 + d]);
    }
    for (size_t i = gt; i < (size_t)2 * 8 * 64; i += ngt) {
        const int which = (int)(i >> 9), bg = (int)(i >> 6) & 7, d = (int)i & 63;
        (which ? p.vc : p.kc)[((size_t)bg * 256 + 255) * 64 + d] = 0;
    }
    {
        constexpr int NW = 32 * 511 * 64;
        const int gti = (int)gt, ngti = (int)ngt;
#define SW_SRC(i) (p.state_win + (size_t)((i) / (511 * 64)) * 512 * 256 + 256 + (size_t)((i) % (511 * 64)) * 4)
#define SW_DST(i) (p.s_win + (size_t)((i) / (511 * 64)) * 512 * 256 + (size_t)((i) % (511 * 64)) * 4)
#define SW_LD(j) const int ix##j = ib + j * ngti, cx##j = ix##j < NW ? ix##j : NW - 1; const float4 vx##j = *(const float4*)SW_SRC(cx##j);
#define SW_ST(j) if (ix##j < NW) *(float4*)SW_DST(ix##j) = vx##j;
        for (int ib = gti; ib < NW; ib += 8 * ngti) {
            SW_LD(0) SW_LD(1) SW_LD(2) SW_LD(3) SW_LD(4) SW_LD(5) SW_LD(6) SW_LD(7)
            SW_ST(0) SW_ST(1) SW_ST(2) SW_ST(3) SW_ST(4) SW_ST(5) SW_ST(6) SW_ST(7)
        }
#undef SW_SRC
#undef SW_DST
#undef SW_LD
#undef SW_ST
    }
}

__device__ __forceinline__ void p1_norm(const Params& p, char* lds, int bid, int nblk) {
    const int tid = opaque_tid(), lane = tid & 63, wave = tid >> 6;
    volatile int* slot = (volatile int*)(lds + 147456 + 16);
    for (;;) {
        __syncthreads();
        if (tid == 0) *slot = (int)__hip_atomic_fetch_add(p.bar + 3456 + 32, 1u, __ATOMIC_RELAXED, __HIP_MEMORY_SCOPE_AGENT);
        __syncthreads();
        const int chunk = *slot;
        if (chunk * 32 >= R) break;
      for (int r = chunk * 32 + wave; r < R && r < chunk * 32 + 32; r += 8) {
        const float* xr = r < TP ? p.x_prompt + (size_t)r * 1024 : p.x_sample + (size_t)(r - TP) * 1024;
        const int mrow = r < TP ? (r >> 12) : 4 + (r - TP);
        const float* shift = p.mod + mrow * 3072, *scale = shift + 1024;
        float4 v[4]; float ss = 0.f;
#pragma unroll
        for (int j = 0; j < 4; ++j) { v[j] = *(const float4*)(xr + j * 256 + lane * 4); ss += v[j].x * v[j].x + v[j].y * v[j].y + v[j].z * v[j].z + v[j].w * v[j].w; }
        const float rs = rsqrtf(wave_sum(ss) * (1.f / 1024.f) + EPS);
#pragma unroll
        for (int j = 0; j < 4; ++j) {
            const int c = j * 256 + lane * 4;
            const float4 g = *(const float4*)(p.g_norm + c), sc = *(const float4*)(scale + c), sh = *(const float4*)(shift + c);
            ushort4 o;
            o.x = f2bf(v[j].x * rs * g.x * (1.f + sc.x) + sh.x);
            o.y = f2bf(v[j].y * rs * g.y * (1.f + sc.y) + sh.y);
            o.z = f2bf(v[j].z * rs * g.z * (1.f + sc.z) + sh.z);
            o.w = f2bf(v[j].w * rs * g.w * (1.f + sc.w) + sh.w);
            *(ushort4*)(p.H + (size_t)r * 1024 + c) = o;
        }
      }
    }
}

constexpr int BM = 256, BK = 64, HALF = 128, HT = HALF * BK;
__device__ __forceinline__ int lds_byte(int r, int c) {
    int st = (r >> 4) * 2 + (c >> 5), rr = r & 15, cc = c & 31, ob = rr * 64 + cc * 2;
    return st * 1024 + (ob ^ (((ob >> 9) & 1) << 5));
}
__device__ __forceinline__ void stage_rc(int b, int& Rr, int& Cc) {
    int st = b / 1024, sb = b % 1024, swz = sb ^ (((sb >> 9) & 1) << 5);
    Rr = (st >> 1) * 16 + swz / 64; Cc = (st & 1) * 32 + (swz % 64) / 2;
}

template <class Epi>
__device__ __forceinline__ void gemm_phase(const bf16_t* __restrict__ A, const bf16_t* __restrict__ Bt, int nM, int nN, int K, char* lds, int bid, int nblk, const Epi& epi) {
    bf16_t* shm = (bf16_t*)lds;
#define SA(b, h) (shm + ((b) * 2 + (h)) * HT)
#define SB(b, h) (shm + (4 + (b) * 2 + (h)) * HT)
#define STAGE_X(T, P, BASE, br, kt) do { long _g = (long)(br) * K + (long)(kt) * BK; \
    for (int _i = 0; _i < 2; ++_i) { int _b = (T) * 16 + _i * 8192; int _r, _c; stage_rc(_b, _r, _c); \
      __builtin_amdgcn_global_load_lds((const unsigned*)(BASE + _g + (long)_r * K + _c), \
        (__attribute__((address_space(3))) unsigned*)((char*)(P) + _b), 16, 0, 0); } } while (0)
#define STAGE(P, BASE, br, kt) STAGE_X(tz0, P, BASE, br, kt)
#define LDA(dst, b, h) for (int m = 0; m < 4; ++m) for (int k = 0; k < 2; ++k) \
    dst[m][k] = *reinterpret_cast<const bf16x8*>((char*)SA(b, h) + lds_byte(wr * 64 + m * 16 + fr, k * 32 + fq * 8))
#define LDB(dst, b, h) for (int n = 0; n < 2; ++n) for (int k = 0; k < 2; ++k) \
    dst[n][k] = *reinterpret_cast<const bf16x8*>((char*)SB(b, h) + lds_byte(wc * 32 + n * 16 + fr, k * 32 + fq * 8))
#define MMA(ai, bj, At, Bt_) do { __builtin_amdgcn_s_setprio(1); \
    for (int m = 0; m < 4; ++m) for (int n = 0; n < 2; ++n) for (int k = 0; k < 2; ++k) \
      acc[ai][bj][m][n] = __builtin_amdgcn_mfma_f32_16x16x32_bf16(Bt_[n][k], At[m][k], acc[ai][bj][m][n], 0, 0, 0); \
    __builtin_amdgcn_s_setprio(0); } while (0)
#define WAIT_V(n) asm volatile("s_waitcnt vmcnt(" #n ")" ::: "memory")
#define WAIT_L(n) asm volatile("s_waitcnt lgkmcnt(" #n ")" ::: "memory")
#define BAR __builtin_amdgcn_s_barrier()
#define SCHED __builtin_amdgcn_sched_barrier(0)
    const int nwg = nM * nN;
    for (int tile = bid; tile < nwg; tile += nblk) {
        const int pm = tile / nN, pn = tile % nN;
        const int brow = pm * BM, bcol = pn * BM;
        int tz0 = threadIdx.x; asm volatile("" : "+v"(tz0));
        int wid = tz0 >> 6, lane = tz0 & 63, wr = wid >> 2, wc = wid & 3, fr = lane & 15, fq = lane >> 4;
        f32x4 acc[2][2][4][2] = {};
        bf16x8 At[4][2], B0[2][2], B1[2][2];
        const int nt = K / BK;
        STAGE(SB(0, 0), Bt, bcol, 0); STAGE(SA(0, 0), A, brow, 0);
        STAGE(SB(0, 1), Bt, bcol + HALF, 0); STAGE(SA(0, 1), A, brow + HALF, 0);
        if (wr == 1) BAR;
        WAIT_V(4); BAR;
        STAGE(SB(1, 0), Bt, bcol, 1); STAGE(SA(1, 0), A, brow, 1); STAGE(SB(1, 1), Bt, bcol + HALF, 1);
        WAIT_V(6); BAR;
        for (int t = 0; t < nt - 2; t += 2) {
            LDB(B0, 0, 0); SCHED; LDA(At, 0, 0); STAGE(SA(1, 1), A, brow + HALF, t + 1);
            WAIT_L(8); BAR; WAIT_L(0); MMA(0, 0, At, B0); BAR; SCHED;
            LDB(B1, 0, 1); STAGE(SB(0, 0), Bt, bcol, t + 2);
            BAR; WAIT_L(0); MMA(0, 1, At, B1); BAR;
            LDA(At, 0, 1); STAGE(SA(0, 0), A, brow, t + 2);
            BAR; WAIT_L(0); MMA(1, 0, At, B0); BAR; SCHED;
            STAGE(SB(0, 1), Bt, bcol + HALF, t + 2);
            WAIT_V(6); BAR; MMA(1, 1, At, B1); BAR;
            LDB(B0, 1, 0); SCHED; LDA(At, 1, 0); STAGE(SA(0, 1), A, brow + HALF, t + 2);
            WAIT_L(8); BAR; WAIT_L(0); MMA(0, 0, At, B0); BAR; SCHED;
            LDB(B1, 1, 1); STAGE(SB(1, 0), Bt, bcol, t + 3);
            BAR; WAIT_L(0); MMA(0, 1, At, B1); BAR;
            LDA(At, 1, 1); STAGE(SA(1, 0), A, brow, t + 3);
            BAR; WAIT_L(0); MMA(1, 0, At, B0); BAR; SCHED;
            STAGE(SB(1, 1), Bt, bcol + HALF, t + 3);
            WAIT_V(6); BAR; MMA(1, 1, At, B1); BAR;
        }
        int tz = threadIdx.x; asm volatile("" : "+v"(tz)); wid = tz >> 6; lane = tz & 63; wr = wid >> 2; wc = wid & 3; fr = lane & 15; fq = lane >> 4;
        { LDB(B0, 0, 0); WAIT_V(0); LDA(At, 0, 0); STAGE_X(tz, SA(1, 1), A, brow + HALF, nt - 1);
          BAR; WAIT_L(0); MMA(0, 0, At, B0); BAR;
          LDB(B1, 0, 1); BAR; WAIT_L(0); MMA(0, 1, At, B1); BAR;
          LDA(At, 0, 1); WAIT_V(4); BAR; WAIT_L(0); MMA(1, 0, At, B0); MMA(1, 1, At, B1); BAR; }
        { LDB(B0, 1, 0); LDA(At, 1, 0); WAIT_V(2); BAR; WAIT_L(0); MMA(0, 0, At, B0); BAR;
          LDB(B1, 1, 1); WAIT_V(0); BAR; WAIT_L(0); MMA(0, 1, At, B1); BAR;
          LDA(At, 1, 1); BAR; WAIT_L(0); MMA(1, 0, At, B0); MMA(1, 1, At, B1); BAR; }
        if (wr == 0) BAR;
        epi(acc, brow, bcol, wr, wc, fr, fq);
    }
#undef SA
#undef SB
#undef STAGE_X
#undef STAGE
#undef LDA
#undef LDB
#undef MMA
}

struct EpiOut {
    const Params* p;
    __device__ __forceinline__ void operator()(const f32x4 (&acc)[2][2][4][2], int brow, int bcol, int wr, int wc, int fr, int fq) const {
#pragma unroll
        for (int ai = 0; ai < 2; ++ai)
#pragma unroll
            for (int mt = 0; mt < 4; ++mt) {
                const int r = brow + ai * HALF + wr * 64 + mt * 16 + fr;
                if (r < R) {
                    const float* xr = r < TP ? p->x_prompt + (size_t)r * 1024 : p->x_sample + (size_t)(r - TP) * 1024;
                    const float* gate = p->mod + (r < TP ? (r >> 12) : 4 + (r - TP)) * 3072 + 2048;
#pragma unroll
                    for (int bj = 0; bj < 2; ++bj)
#pragma unroll
                        for (int nt = 0; nt < 2; ++nt) {
                            const int c = bcol + bj * HALF + wc * 32 + nt * 16 + 4 * fq;
                            const float4 xv = *(const float4*)(xr + c), gv = *(const float4*)(gate + c);
                            float4 o; o.x = xv.x + gv.x * acc[ai][bj][mt][nt][0]; o.y = xv.y + gv.y * acc[ai][bj][mt][nt][1];
                            o.z = xv.z + gv.z * acc[ai][bj][mt][nt][2]; o.w = xv.w + gv.w * acc[ai][bj][mt][nt][3];
                            *(float4*)(p->y + (size_t)r * 1024 + c) = o;
                        }
                }
            }
    }
};

struct EpiIn {
    const Params* p;
    __device__ __forceinline__ void operator()(const f32x4 (&acc)[2][2][4][2], int brow, int bcol, int wr, int wc, int fr, int fq) const {
        const int pn = bcol >> 8;
        const Params& P = *p;
#pragma unroll
        for (int ai = 0; ai < 2; ++ai)
#pragma unroll
            for (int mt = 0; mt < 4; ++mt) {
                const int r = brow + ai * HALF + wr * 64 + mt * 16 + fr;
                const bool rowok = r < R;
                const bool isp = r < TP;
                const int b = isp ? (r >> 12) : (r - TP), t = isp ? (r & 4095) : 0, pidx = isp ? t : 4096;
                f32x4 v[2][2];
#pragma unroll
                for (int bj = 0; bj < 2; ++bj)
#pragma unroll
                    for (int nt = 0; nt < 2; ++nt) v[bj][nt] = acc[ai][bj][mt][nt];
                if (pn <= 1 || ((pn == 3 || pn == 4) && wc < 2)) {
                    float ss = 0.f;
#pragma unroll
                    for (int bj = 0; bj < 2; ++bj)
#pragma unroll
                        for (int nt = 0; nt < 2; ++nt)
#pragma unroll
                            for (int rg = 0; rg < 4; ++rg) ss += v[bj][nt][rg] * v[bj][nt][rg];
                    ss += __shfl_xor(ss, 16); ss += __shfl_xor(ss, 32);
                    const float rs = rsqrtf(ss * (1.f / 64.f) + EPS);
                    const float* gn = pn <= 1 ? P.g_q : pn == 3 ? P.g_ks : P.g_kw;
#pragma unroll
                    for (int bj = 0; bj < 2; ++bj)
#pragma unroll
                        for (int nt = 0; nt < 2; ++nt) {
                            const float4 g4 = *(const float4*)(gn + bj * 32 + nt * 16 + 4 * fq);
                            v[bj][nt][0] *= rs * g4.x; v[bj][nt][1] *= rs * g4.y; v[bj][nt][2] *= rs * g4.z; v[bj][nt][3] *= rs * g4.w;
                        }
                }
                if (!rowok) continue;
                if (pn == 7 || pn == 8) {
                    const float lgm = __log2f(1.f - exp2f(-5.f - (float)wc)) * (float)((isp ? t : PAST) & 127);
                    const float sc = pn == 7 ? exp2f(lgm) : 0.125f * exp2f(-lgm);
#pragma unroll
                    for (int nt = 0; nt < 2; ++nt) {
                        const float4 c4 = *(const float4*)(P.ropec + (size_t)pidx * 32 + nt * 16 + 4 * fq), s4 = *(const float4*)(P.ropes + (size_t)pidx * 32 + nt * 16 + 4 * fq);
                        const f32x4 x1 = v[0][nt], x2 = v[1][nt];
                        v[0][nt][0] = (x1[0] * c4.x - x2[0] * s4.x) * sc; v[1][nt][0] = (x1[0] * s4.x + x2[0] * c4.x) * sc;
                        v[0][nt][1] = (x1[1] * c4.y - x2[1] * s4.y) * sc; v[1][nt][1] = (x1[1] * s4.y + x2[1] * c4.y) * sc;
                        v[0][nt][2] = (x1[2] * c4.z - x2[2] * s4.z) * sc; v[1][nt][2] = (x1[2] * s4.z + x2[2] * c4.z) * sc;
                        v[0][nt][3] = (x1[3] * c4.w - x2[3] * s4.w) * sc; v[1][nt][3] = (x1[3] * s4.w + x2[3] * c4.w) * sc;
                    }
                }
                if (pn == 5 || pn == 6 || pn == 11 || pn == 12) {
#pragma unroll
                    for (int bj = 0; bj < 2; ++bj)
#pragma unroll
                        for (int nt = 0; nt < 2; ++nt)
#pragma unroll
                            for (int rg = 0; rg < 4; ++rg) v[bj][nt][rg] = silu(v[bj][nt][rg]);
                }
                bf16_t* bdst = nullptr; float* fdst = nullptr;
                if (pn <= 1) bdst = P.qn + (size_t)r * 512 + (pn * 4 + wc) * 64;
                else if (pn == 2) fdst = (isp ? P.p_cmp + (size_t)r * 256 : P.s_cmp + (size_t)b * 256) + wc * 64;
                else if (pn == 3) { fdst = (isp ? P.p_slc + (size_t)r * 256 : P.s_slc + (size_t)b * 256) + wc * 64;
                                    if (isp) bdst = (wc < 2 ? P.ks : P.vs) + ((size_t)(b * 2 + (wc & 1)) * SEQ + t) * 64; }
                else if (pn == 4) { fdst = isp ? (t >= SEQ - 512 ? P.p_win + ((size_t)b * 512 + (t - (SEQ - 512))) * 256 + wc * 64 : nullptr) : P.s_win + ((size_t)b * 512 + 511) * 256 + wc * 64;
                                    if (isp) bdst = (wc < 2 ? P.kw : P.vw) + ((size_t)(b * 2 + (wc & 1)) * SEQ + t) * 64; }
                else if (pn == 5 || pn == 6) bdst = P.ga + (size_t)r * 512 + (pn - 5) * 256 + wc * 64;
                else if (pn == 7) bdst = P.rq + (size_t)r * 256 + wc * 64;
                else if (pn == 8) bdst = P.rk + (size_t)r * 256 + wc * 64;
                else if (pn == 9 || pn == 10) bdst = P.rv + (size_t)r * 512 + (pn - 9) * 256 + wc * 64;
                else if (pn == 11 || pn == 12) bdst = P.gr + (size_t)r * 512 + (pn - 11) * 256 + wc * 64;
                if (pn == 13) {
                    if (wc == 0) {
                        float* gd = P.gates + (size_t)r * 24;
                        { float4 o; o.x = sigmoidf(v[0][0][0]); o.y = sigmoidf(v[0][0][1]); o.z = sigmoidf(v[0][0][2]); o.w = sigmoidf(v[0][0][3]); *(float4*)(gd + 4 * fq) = o; }
                        if (fq < 2) { float4 o; o.x = sigmoidf(v[0][1][0]); o.y = sigmoidf(v[0][1][1]); o.z = sigmoidf(v[0][1][2]); o.w = sigmoidf(v[0][1][3]); *(float4*)(gd + 16 + 4 * fq) = o; }
                    }
                    continue;
                }
#pragma unroll
                for (int bj = 0; bj < 2; ++bj)
#pragma unroll
                    for (int nt = 0; nt < 2; ++nt) {
                        const int cl = bj * 32 + nt * 16 + 4 * fq;
                        if (fdst) { float4 o; o.x = v[bj][nt][0]; o.y = v[bj][nt][1]; o.z = v[bj][nt][2]; o.w = v[bj][nt][3]; *(float4*)(fdst + cl) = o; }
                        if (bdst) { uint2 o; o.x = cvt_pk_bf16(v[bj][nt][0], v[bj][nt][1]); o.y = cvt_pk_bf16(v[bj][nt][2], v[bj][nt][3]); *(uint2*)(bdst + cl) = o; }
                    }
            }
    }
};

__device__ __forceinline__ void p3_rows(const Params& p, int bid, int nblk) {
    const int tid = opaque_tid(), lane = tid & 63, wave = tid >> 6;
    for (int r = bid * 8 + wave; r < R; r += nblk * 8) {
        const float* pr = p.praw + (size_t)r * NPAD;
        const bool isp = r < TP;
        const int b = isp ? (r >> 12) : (r - TP), t = isp ? (r & 4095) : 0;
        const int pos = isp ? t : PAST;
        {
            const float gq = p.g_q[lane];
            for (int hh = 0; hh < 8; ++hh) {
                const float v = pr[C_Q + hh * 64 + lane];
                const float rs = rsqrtf(wave_sum(v * v) * (1.f / 64.f) + EPS);
                p.qn[(size_t)r * 512 + hh * 64 + lane] = f2bf(v * rs * gq);
            }
        }
        float* o_cmp = isp ? p.p_cmp + (size_t)r * 256 : p.s_cmp + (size_t)b * 256;
        float* o_slc = isp ? p.p_slc + (size_t)r * 256 : p.s_slc + (size_t)b * 256;
        float* o_win = isp ? (t >= SEQ - 512 ? p.p_win + ((size_t)b * 512 + (t - (SEQ - 512))) * 256 : nullptr) : p.s_win + ((size_t)b * 512 + 511) * 256;
        for (int j = 0; j < 4; ++j) {
            const int g = j & 1;
            const size_t cidx = ((size_t)(b * 2 + g) * SEQ + t) * 64 + lane;
            {
                const float v = pr[C_KC + j * 64 + lane];
                o_cmp[j * 64 + lane] = v;
                if (isp) { if (j < 2) p.kcr[cidx] = f2bf(v); else p.vcr[cidx] = f2bf(v); }
            }
            {
                float v = pr[C_KS + j * 64 + lane];
                if (j < 2) { const float rs = rsqrtf(wave_sum(v * v) * (1.f / 64.f) + EPS); v = v * rs * p.g_ks[lane]; }
                o_slc[j * 64 + lane] = v;
                if (isp) { if (j < 2) p.ks[cidx] = f2bf(v); else p.vs[cidx] = f2bf(v); }
            }
            {
                float v = pr[C_KW + j * 64 + lane];
                if (j < 2) { const float rs = rsqrtf(wave_sum(v * v) * (1.f / 64.f) + EPS); v = v * rs * p.g_kw[lane]; }
                if (o_win) o_win[j * 64 + lane] = v;
                if (isp) { if (j < 2) p.kw[cidx] = f2bf(v); else p.vw[cidx] = f2bf(v); }
            }
        }
        if (lane < 24) p.gates[(size_t)r * 24 + lane] = sigmoidf(pr[C_BR + lane]);
        for (int i = 0; i < 8; ++i) {
            p.ga[(size_t)r * 512 + i * 64 + lane] = f2bf(silu(pr[C_GA + i * 64 + lane]));
            p.gr[(size_t)r * 512 + i * 64 + lane] = f2bf(silu(pr[C_GR + i * 64 + lane]));
            p.rv[(size_t)r * 512 + i * 64 + lane] = f2bf(pr[C_RV + i * 64 + lane]);
        }
        {
            const int i = lane & 31;
            const float freq = powf(10000.f, -(float)i / 32.f);
            const float ang = (float)pos * freq;
            float sn, cs; sincosf(ang, &sn, &cs);
            for (int hh = 0; hh < 4; ++hh) {
                const float a = pr[C_RQ + hh * 64 + lane], ao = pr[C_RQ + hh * 64 + (lane ^ 32)];
                const float kq = pr[C_RK + hh * 64 + lane], ko = pr[C_RK + hh * 64 + (lane ^ 32)];
                const float oq = lane < 32 ? a * cs - ao * sn : ao * sn + a * cs;
                const float ok = lane < 32 ? kq * cs - ko * sn : ko * sn + kq * cs;
                const float lgm = __log2f(1.f - exp2f(-5.f - (float)hh)) * (float)(pos & 127);
                p.rq[(size_t)r * 256 + hh * 64 + lane] = f2bf(oq * exp2f(lgm));
                p.rk[(size_t)r * 256 + hh * 64 + lane] = f2bf(ok * 0.125f * exp2f(-lgm));
            }
        }
    }
}

typedef unsigned u32x4 __attribute__((ext_vector_type(4)));

struct CmpTile {
    int active;
    int b, c0;
    int seam_idx;
    int is_sample;
};

__device__ __forceinline__ void cmp_second_layer(const Params& p, int kv, const f32x4 (&pre)[4], bf16_t* hb  , const bf16_t* w2s  , bf16_t* dst  , int lane) {
    const int fr = lane & 15, G = lane >> 4;
#pragma unroll
    for (int nt = 0; nt < 4; ++nt)
#pragma unroll
        for (int r = 0; r < 4; ++r) hb[(G * 4 + r) * 64 + nt * 16 + fr] = f2bf(silu(pre[nt][r]));
    WSYNC();
    bf16x8 hf[2];
#pragma unroll
    for (int ks = 0; ks < 2; ++ks) hf[ks] = *(const bf16x8*)(hb + fr * 64 + ks * 32 + G * 8);
    f32x4 out[4];
#pragma unroll
    for (int nt = 0; nt < 4; ++nt) {
        out[nt] = (f32x4){0.f, 0.f, 0.f, 0.f};
#pragma unroll
        for (int ks = 0; ks < 2; ++ks) {
            const bf16x8 wf = *(const bf16x8*)(w2s + (nt * 16 + fr) * 64 + ks * 32 + G * 8);
            out[nt] = __builtin_amdgcn_mfma_f32_16x16x32_bf16(hf[ks], wf, out[nt], 0, 0, 0);
        }
    }
    WSYNC();
    float rs[4] = {1.f, 1.f, 1.f, 1.f};
    if (kv == 0) {
#pragma unroll
        for (int r = 0; r < 4; ++r) {
            float ss = 0.f;
#pragma unroll
            for (int nt = 0; nt < 4; ++nt) ss += out[nt][r] * out[nt][r];
            ss += __shfl_xor(ss, 1); ss += __shfl_xor(ss, 2); ss += __shfl_xor(ss, 4); ss += __shfl_xor(ss, 8);
            rs[r] = rsqrtf(ss * (1.f / 64.f) + EPS);
        }
    }
#pragma unroll
    for (int nt = 0; nt < 4; ++nt) {
        const float gk = kv == 0 ? p.g_kc[nt * 16 + fr] : 1.f;
#pragma unroll
        for (int r = 0; r < 4; ++r) {
            const int row = G * 4 + r;
            if (row < 15) dst[(size_t)row * 64 + nt * 16 + fr] = f2bf(out[nt][r] * rs[r] * gk);
        }
    }
}

constexpr int CMP_HB = 131072, CMP_W2S = 147456 + 64, CMP_B1S = CMP_W2S + 8192;
__device__ __forceinline__ void compress_setup(const Params& p, char* lds, int kv) {
    const int tid = opaque_tid();
    const float* w1 = kv ? p.w_cv1 : p.w_ck1; const float* pe = kv ? p.pe_cv : p.pe_ck; const float* w2 = kv ? p.w_cv2 : p.w_ck2;
    bf16_t* w2s = (bf16_t*)(lds + CMP_W2S); float* b1s = (float*)(lds + CMP_B1S); float* part = (float*)(lds + CMP_HB);
    __syncthreads();
    for (int i = tid; i < 4096; i += NT) { const int f = i >> 6, d = i & 63; w2s[d * 64 + f] = f2bf(w2[i]); }
    {
      const int fq4 = tid & 15, ks32 = tid >> 4;
      const float* wp = w1 + (size_t)ks32 * 64 * 64 + 4 * fq4; const float* pp = pe + ks32 * 64;
      float4 s = {0.f, 0.f, 0.f, 0.f};
#pragma unroll 16
      for (int k = 0; k < 64; ++k) { const float4 w = *(const float4*)(wp + (size_t)k * 64); const float pv = pp[k]; s.x += pv * w.x; s.y += pv * w.y; s.z += pv * w.z; s.w += pv * w.w; }
      *(float4*)(part + ks32 * 64 + 4 * fq4) = s; }
    __syncthreads();
    if (tid < 64) { float s = 0.f; for (int j = 0; j < 32; ++j) s += part[j * 64 + tid]; b1s[tid] = s; p.b1[kv * 64 + tid] = s; }
    __syncthreads();
}
template <int O>
__device__ __forceinline__ void cmp_rd4(unsigned a, bf16x8 (&b)[4]) {
    asm volatile(
        "ds_read_b128 %0, %4 offset:%5\n\t"
        "ds_read_b128 %1, %4 offset:%6\n\t"
        "ds_read_b128 %2, %4 offset:%7\n\t"
        "ds_read_b128 %3, %4 offset:%8\n\t"
        "s_waitcnt lgkmcnt(0)"
        : "=&v"(b[0]), "=&v"(b[1]), "=&v"(b[2]), "=&v"(b[3])
        : "v"(a), "i"(O), "i"(O + 1024), "i"(O + 2048), "i"(O + 3072) : "memory");
}
template <int O0, int O1>
__device__ __forceinline__ void cmp_lda(const float* a0, const float* a1, f32x4 (&q)[2][2]) {
    asm volatile("global_load_dwordx4 %0, %4, off offset:%6 nt\n\t"
                 "global_load_dwordx4 %1, %5, off offset:%6 nt\n\t"
                 "global_load_dwordx4 %2, %4, off offset:%7 nt\n\t"
                 "global_load_dwordx4 %3, %5, off offset:%7 nt"
                 : "=&v"(q[0][0]), "=&v"(q[0][1]), "=&v"(q[1][0]), "=&v"(q[1][1])
                 : "v"(a0), "v"(a1), "i"(O0), "i"(O1) : "memory");
}
template <int N>
__device__ __forceinline__ void cmp_wait(f32x4 (&q)[2][2]) {
    asm volatile("s_waitcnt vmcnt(%4)" : "+v"(q[0][0]), "+v"(q[0][1]), "+v"(q[1][0]), "+v"(q[1][1]) : "n"(N) : "memory");
}
__device__ __forceinline__ void cmp_stage_wq(const Params& p, LAS char* l3, int kv, int q, int tid) {
    const int n = tid >> 2, Gp = (tid & 3) ^ ((n >> 2) & 3);
    const bf16_t* src = p.w1p + ((size_t)kv * 128 + n) * 1024 + q * 256 + Gp * 8;
    LAS char* dst = l3 + (q & 1) * 65536 + tid * 16;
#pragma unroll
    for (int j = 0; j < 8; ++j)
        __builtin_amdgcn_global_load_lds((const unsigned*)(src + j * 32), (LAS unsigned*)(dst + j * 8192), 16, 0, 0);
}
__device__ __forceinline__ void compress_pass_s(const Params& p, char* lds, int kv, int b, int c0w, int seam_idx, bool first, bool more) {
    LAS char* l3 = (LAS char*)lds;
    const int tid = opaque_tid(), lane = tid & 63, wave = tid >> 6, fr = lane & 15, G = lane >> 4;
    bf16_t* hb = (bf16_t*)(lds + CMP_HB) + wave * 1024;
    const bf16_t* w2s = (const bf16_t*)(lds + CMP_W2S); const float* b1s = (const float*)(lds + CMP_B1S);
    const float* abase[2];
#pragma unroll
    for (int i = 0; i < 2; ++i) {
        const int c = c0w + (fr & 7) + 8 * i;
        const int pg = p.page_table[b * NPAGES + (c >> 3)];
        abase[i] = p.cache_cmp + (((size_t)pg * 128 + (c & 7) * 16) * 4 + kv * 2) * 64 + (fr >> 3) * 16 + G * 4;
    }
    const bool lowl = fr < 8;
    const unsigned bl = (unsigned)(unsigned long long)l3 + fr * 64 + ((G ^ (fr >> 2)) * 16);
    f32x4 acc[2][8];
#pragma unroll
    for (int g = 0; g < 2; ++g)
#pragma unroll
        for (int nt = 0; nt < 8; ++nt) acc[g][nt] = (f32x4){0.f, 0.f, 0.f, 0.f};
    f32x4 aq[6][2][2];
#define CMP_LOADA(u, s) do { const float* _a0 = abase[0] + ((s) >> 1) * 256; const float* _a1 = abase[1] + ((s) >> 1) * 256; \
        if ((s) & 1) cmp_lda<128, 384>(_a0, _a1, aq[u]); else cmp_lda<0, 256>(_a0, _a1, aq[u]); } while (0)
#define CMP_WAITA(u, s) do { const int _y = 31 - (s); if (_y >= 5) cmp_wait<20>(aq[u]); else if (_y == 4) cmp_wait<16>(aq[u]); else if (_y == 3) cmp_wait<12>(aq[u]); \
        else if (_y == 2) cmp_wait<8>(aq[u]); else if (_y == 1) cmp_wait<4>(aq[u]); else cmp_wait<0>(aq[u]); } while (0)
#pragma unroll
    for (int u = 0; u < 6; ++u) CMP_LOADA(u, u);
    if (first) { cmp_stage_wq(p, l3, kv, 0, tid); asm volatile("s_waitcnt vmcnt(0)" ::: "memory"); }
#pragma unroll
    for (int s = 0; s < 32; ++s) {
        const int q = s >> 3, u = s % 6;
        if ((s & 7) == 0) {
            asm volatile("" ::: "memory");
            __builtin_amdgcn_s_barrier();
            asm volatile("" ::: "memory");
            if (q < 3 || more) cmp_stage_wq(p, l3, kv, (q + 1) & 3, tid);
            asm volatile("" ::: "memory");
        }
        CMP_WAITA(u, s);
        bf16x8 af[2];
#pragma unroll
        for (int g = 0; g < 2; ++g) {
            u32x4 t;
            f32x4 x0, x1;
#pragma unroll
            for (int e = 0; e < 4; ++e) {
                const float give = lowl ? aq[u][g][1][e] : aq[u][g][0][e];
                const float recv = __builtin_bit_cast(float, __builtin_amdgcn_mov_dpp(__builtin_bit_cast(int, give), 0x128, 0xF, 0xF, true));
                x0[e] = lowl ? aq[u][g][0][e] : recv; x1[e] = lowl ? recv : aq[u][g][1][e];
            }
            t[0] = cvt_pk_bf16(x0[0], x0[1]); t[1] = cvt_pk_bf16(x0[2], x0[3]);
            t[2] = cvt_pk_bf16(x1[0], x1[1]); t[3] = cvt_pk_bf16(x1[2], x1[3]);
            af[g] = __builtin_bit_cast(bf16x8, t);
        }
        if (s + 6 < 32) CMP_LOADA(u, s + 6);
        const unsigned a = bl + (q & 1) * 65536 + (s & 7) * 8192;
        bf16x8 bf[4];
        cmp_rd4<0>(a, bf);
#pragma unroll
        for (int nt = 0; nt < 4; ++nt) {
            acc[0][nt] = __builtin_amdgcn_mfma_f32_16x16x32_bf16(af[0], bf[nt], acc[0][nt], 0, 0, 0);
            acc[1][nt] = __builtin_amdgcn_mfma_f32_16x16x32_bf16(af[1], bf[nt], acc[1][nt], 0, 0, 0);
        }
        cmp_rd4<4096>(a, bf);
#pragma unroll
        for (int nt = 0; nt < 4; ++nt) {
            acc[0][4 + nt] = __builtin_amdgcn_mfma_f32_16x16x32_bf16(af[0], bf[nt], acc[0][4 + nt], 0, 0, 0);
            acc[1][4 + nt] = __builtin_amdgcn_mfma_f32_16x16x32_bf16(af[1], bf[nt], acc[1][4 + nt], 0, 0, 0);
        }
    }
#undef CMP_LOADA
#undef CMP_WAITA
#pragma unroll
    for (int g = 0; g < 2; ++g) {
        f32x4 pre[4];
#pragma unroll
        for (int nt = 0; nt < 4; ++nt) {
            const float bias = b1s[nt * 16 + fr];
            const float nb0 = __shfl_down(acc[g][4 + nt][0], 16);
            pre[nt][0] = acc[g][nt][0] + acc[g][4 + nt][1] + bias;
            pre[nt][1] = acc[g][nt][1] + acc[g][4 + nt][2] + bias;
            pre[nt][2] = acc[g][nt][2] + acc[g][4 + nt][3] + bias;
            pre[nt][3] = acc[g][nt][3] + nb0 + bias;
            if (G == 3) p.seamA[((size_t)seam_idx * 2 + g) * 64 + nt * 16 + fr] = acc[g][nt][3];
            if (G == 0) p.seamB[((size_t)seam_idx * 2 + g) * 64 + nt * 16 + fr] = acc[g][4 + nt][0];
        }
        bf16_t* dst = (kv ? p.vcs : p.kcs) + ((size_t)(b * 2 + g) * 1024 + c0w) * 64;
        cmp_second_layer(p, kv, pre, hb, w2s, dst, lane);
    }
}

__device__ __forceinline__ void compress_sample(const Params& p, char* lds, int bid, int nblk) {
    const int wave = opaque_tid() >> 6;
    int kv_set = -1;
    for (int pass = bid; pass < 512; pass += nblk) {
        const int P = pass & 7, kv = (pass >> 3) & 1, b = pass >> 4;
        const int c0w = P * 128 + wave * 16;
        const bool first = kv != kv_set;
        if (first) { compress_setup(p, lds, kv); kv_set = kv; }
        const int nxt = pass + nblk;
        const bool more = nxt < 512 && ((nxt >> 3) & 1) == kv;
        compress_pass_s(p, lds, kv, b, c0w, (b * 2 + kv) * 64 + (c0w >> 4), first, more);
    }
}

__device__ __forceinline__ void compress_prompt_ksplit_item(const Params& p, char* lds, int item) {
    const int tid = opaque_tid(), lane = tid & 63, wave = tid >> 6, fr = lane & 15, G = lane >> 4;
    f32x4* part = (f32x4*)lds;
    {
        const int kv = item / 68, tile = item % 68, b = tile / 17, c0 = (tile % 17) * 15;
        const float* abase = p.p_cmp + (((size_t)b * SEQ + (size_t)(c0 + fr) * 16) * 4 + kv * 2) * 64 + G * 4;
        const bf16_t* wbase = p.w1p + ((size_t)kv * 128 + fr) * 1024 + G * 8;
        f32x4 acc[2][8];
#pragma unroll
        for (int g = 0; g < 2; ++g)
#pragma unroll
            for (int nt = 0; nt < 8; ++nt) acc[g][nt] = (f32x4){0.f, 0.f, 0.f, 0.f};
#pragma unroll
        for (int u = 0; u < 4; ++u) {
            const int s = wave * 4 + u;
            const float* a = abase + (s >> 1) * 256 + (s & 1) * 32;
            bf16x8 af[2];
#pragma unroll
            for (int g = 0; g < 2; ++g) {
                const f32x4 x0 = *(const f32x4*)(a + g * 64), x1 = *(const f32x4*)(a + g * 64 + 16);
                u32x4 t; t[0] = cvt_pk_bf16(x0[0], x0[1]); t[1] = cvt_pk_bf16(x0[2], x0[3]); t[2] = cvt_pk_bf16(x1[0], x1[1]); t[3] = cvt_pk_bf16(x1[2], x1[3]);
                af[g] = __builtin_bit_cast(bf16x8, t);
            }
#pragma unroll
            for (int nt = 0; nt < 8; ++nt) {
                const bf16x8 wf = *(const bf16x8*)(wbase + (size_t)nt * 16 * 1024 + s * 32);
                acc[0][nt] = __builtin_amdgcn_mfma_f32_16x16x32_bf16(af[0], wf, acc[0][nt], 0, 0, 0);
                acc[1][nt] = __builtin_amdgcn_mfma_f32_16x16x32_bf16(af[1], wf, acc[1][nt], 0, 0, 0);
            }
        }
        __syncthreads();
#pragma unroll
        for (int g = 0; g < 2; ++g)
#pragma unroll
            for (int nt = 0; nt < 8; ++nt) part[((wave * 2 + g) * 8 + nt) * 64 + lane] = acc[g][nt];
        __syncthreads();
        if (wave < 2) {
            const int g = wave;
            f32x4 tot[8];
#pragma unroll
            for (int nt = 0; nt < 8; ++nt) {
                tot[nt] = part[((0 * 2 + g) * 8 + nt) * 64 + lane];
#pragma unroll
                for (int w = 1; w < 8; ++w) tot[nt] += part[((w * 2 + g) * 8 + nt) * 64 + lane];
            }
            f32x4 pre[4];
#pragma unroll
            for (int nt = 0; nt < 4; ++nt) {
                const float bias = p.b1[kv * 64 + nt * 16 + fr];
                const float nb0 = __shfl_down(tot[4 + nt][0], 16);
                pre[nt][0] = tot[nt][0] + tot[4 + nt][1] + bias; pre[nt][1] = tot[nt][1] + tot[4 + nt][2] + bias;
                pre[nt][2] = tot[nt][2] + tot[4 + nt][3] + bias; pre[nt][3] = tot[nt][3] + nb0 + bias;
            }
            bf16_t* hb = (bf16_t*)(lds + 131072) + wave * 1024;
            bf16_t* dst = (kv ? p.vc : p.kc) + ((size_t)(b * 2 + g) * 256 + c0) * 64;
            cmp_second_layer(p, kv, pre, hb, p.w2t + (size_t)kv * 4096, dst, lane);
        }
        __syncthreads();
    }
}
__device__ __forceinline__ void compress_seams(const Params& p, int bid, int nblk) {
    const int tid = opaque_tid(), lane = tid & 63, wave = tid >> 6;
    if (bid < 0) return;
    for (int it = bid * 8 + wave; it < 32 * 2 * 2 * 63; it += nblk * 8) {
        const int Tt = it % 63, rest = it / 63, g = rest & 1, kv = (rest >> 1) & 1, b = rest >> 2;
        const size_t sa = ((size_t)((b * 2 + kv) * 64 + Tt) * 2 + g) * 64 + lane, sb = ((size_t)((b * 2 + kv) * 64 + Tt + 1) * 2 + g) * 64 + lane;
        const float h = silu(p.seamA[sa] + p.seamB[sb] + p.b1[kv * 64 + lane]);
        const float* w2 = kv ? p.w_cv2 : p.w_ck2;
        float o = 0.f;
        for (int f = 0; f < 64; ++f) o += bf2f(f2bf(__shfl(h, f))) * bf2f(f2bf(w2[f * 64 + lane]));
        if (kv == 0) { const float rs = rsqrtf(wave_sum(o * o) * (1.f / 64.f) + EPS); o = o * rs * p.g_kc[lane]; }
        ((kv ? p.vcs : p.kcs) + ((size_t)(b * 2 + g) * 1024 + 16 * Tt + 15) * 64)[lane] = f2bf(o);
    }
}
template <typename T>
__device__ __forceinline__ void attend64(const float* qs, float* pl, const T* kbase, const T* vbase, size_t stride, bool valid, int lane, float (&m)[4], float (&l)[4], float (&o)[4]) {
    float s[4] = {0.f, 0.f, 0.f, 0.f};
    if (valid) {
        const T* kr = kbase + (size_t)lane * stride;
        float kfa[8][8];
#pragma unroll
        for (int c = 0; c < 8; ++c) load8(kr + c * 8, kfa[c]);
#pragma unroll
        for (int c = 0; c < 8; ++c)
#pragma unroll
            for (int h = 0; h < 4; ++h)
#pragma unroll
                for (int j = 0; j < 8; ++j) s[h] += qs[h * 64 + c * 8 + j] * kfa[c][j];
    }
    const unsigned long long vm = __ballot(valid);
    if (vm == 0ull) return;
#pragma unroll
    for (int h = 0; h < 4; ++h) {
        const float sv = valid ? s[h] * 0.125f : -1e30f;
        const float mn = fmaxf(m[h], wave_max(sv));
        const float alpha = __expf(m[h] - mn);
        const float pv = valid ? __expf(sv - mn) : 0.f;
        l[h] = l[h] * alpha + wave_sum(pv); o[h] *= alpha; m[h] = mn;
        pl[h * 64 + lane] = pv;
    }
    WSYNC();
    const int kfirst = __ffsll((long long)vm) - 1;
#pragma unroll 16
    for (int kk = 0; kk < 64; ++kk) {
        const int kr = ((vm >> kk) & 1ull) ? kk : kfirst;
        const float vv = load1(vbase + (size_t)kr * stride + lane);
#pragma unroll
        for (int h = 0; h < 4; ++h) o[h] += pl[h * 64 + kk] * vv;
    }
    WSYNC();
}

__device__ __forceinline__ void cmp_branch(const float* qs, float* pl, float* ps, const bf16_t* kc, const bf16_t* vc, int n_c, int lane, float (&oc)[4]) {
    float m[4] = {-1e30f, -1e30f, -1e30f, -1e30f}, l[4] = {0.f, 0.f, 0.f, 0.f};
    for (int c0 = 0; c0 < n_c; c0 += 64) {
        const bool valid = c0 + lane < n_c;
        float s[4] = {0.f, 0.f, 0.f, 0.f};
        if (valid) {
            const bf16_t* kr = kc + (size_t)(c0 + lane) * 64;
#pragma unroll 2
            for (int c = 0; c < 8; ++c) {
                float kf[8]; load8(kr + c * 8, kf);
#pragma unroll
                for (int h = 0; h < 4; ++h)
#pragma unroll
                    for (int j = 0; j < 8; ++j) s[h] += qs[h * 64 + c * 8 + j] * kf[j];
            }
        }
#pragma unroll
        for (int h = 0; h < 4; ++h) {
            const float sv = valid ? s[h] * 0.125f : -1e30f;
            const float mn = fmaxf(m[h], wave_max(sv));
            const float pv = valid ? __expf(sv - mn) : 0.f;
            l[h] = l[h] * __expf(m[h] - mn) + wave_sum(pv); m[h] = mn;
        }
    }
    for (int c0 = 0; c0 < n_c; c0 += 64) {
        const bool valid = c0 + lane < n_c;
        float s[4] = {0.f, 0.f, 0.f, 0.f};
        if (valid) {
            const bf16_t* kr = kc + (size_t)(c0 + lane) * 64;
#pragma unroll 2
            for (int c = 0; c < 8; ++c) {
                float kf[8]; load8(kr + c * 8, kf);
#pragma unroll
                for (int h = 0; h < 4; ++h)
#pragma unroll
                    for (int j = 0; j < 8; ++j) s[h] += qs[h * 64 + c * 8 + j] * kf[j];
            }
        }
        float psum = 0.f;
#pragma unroll
        for (int h = 0; h < 4; ++h) {
            const float pv = valid ? __expf(s[h] * 0.125f - m[h]) / l[h] : 0.f;
            pl[h * 64 + lane] = pv; psum += pv;
        }
        if (valid) ps[1 + c0 + lane] = psum;
        WSYNC();
        const int nk = min(64, n_c - c0);
        for (int kk = 0; kk < nk; ++kk) {
            const float vv = bf2f(vc[(size_t)(c0 + kk) * 64 + lane]);
#pragma unroll
            for (int h = 0; h < 4; ++h) oc[h] += pl[h * 64 + kk] * vv;
        }
        WSYNC();
    }
}

__device__ __forceinline__ void topk16(float* sc, int* sel, int n_sel, int lane) {
    for (int round = 0; round < 16; ++round) {
        float bv = -3.0e38f; int bi = 0x7fffffff;
        for (int j = lane; j < n_sel; j += 64) { const float v = sc[j]; if (v > bv) { bv = v; bi = j; } }
#pragma unroll
        for (int o = 1; o < 64; o <<= 1) {
            const float ov = __shfl_xor(bv, o); const int oi = __shfl_xor(bi, o);
            if (ov > bv || (ov == bv && oi < bi)) { bv = ov; bi = oi; }
        }
        if (lane == 0) { sel[round] = bi; sc[bi] = -3.4e38f; }
        WSYNC();
    }
}

constexpr int ATT_WLDS = 256 + 256 + 1040 + 272 + 16;
__device__ __forceinline__ void p5_attention(const Params& p, char* lds, int bid, int nblk) {
    const int tid = threadIdx.x, lane = tid & 63, wave = tid >> 6;
    float* wl = (float*)lds + wave * ATT_WLDS;
    float *qs = wl, *pl = wl + 256, *ps = wl + 512, *sc = wl + 1552; int* sel = (int*)(wl + 1824);
    const int gw = bid * 8 + wave, ngw = nblk * 8;
    for (int it = gw; it < R * 2; it += ngw) {
        const int r = it >> 1, g = it & 1;
        const bool isp = r < TP;
        const int b = isp ? (r >> 12) : (r - TP), t = isp ? (r & 4095) : PAST;
        const int n_sel = isp ? 64 : 257;
        const int n_cmax = isp ? 255 : 1023;
#pragma unroll
        for (int h = 0; h < 4; ++h) qs[h * 64 + lane] = bf2f(p.qn[(size_t)r * 512 + (g * 4 + h) * 64 + lane]);
        for (int i = lane; i < 4 * n_sel + 1; i += 64) ps[i] = 0.f;
        WSYNC();
        int n_c = t >= 31 ? (t - 31) / 16 + 1 : 0; if (n_c > n_cmax) n_c = n_cmax;
        float oc[4] = {0.f, 0.f, 0.f, 0.f};
        {
            const bf16_t* kc = isp ? p.kc + (size_t)(b * 2 + g) * 256 * 64 : p.kcs + (size_t)(b * 2 + g) * 1024 * 64;
            const bf16_t* vc = isp ? p.vc + (size_t)(b * 2 + g) * 256 * 64 : p.vcs + (size_t)(b * 2 + g) * 1024 * 64;
            cmp_branch(qs, pl, ps, kc, vc, n_c, lane, oc);
        }
        const int jt = t >> 6;
        for (int j = lane; j < n_sel; j += 64) {
            float imp = 0.f;
#pragma unroll
            for (int rr = 0; rr < 4; ++rr) imp += ps[4 * j + rr + 1] + ps[4 * j + rr];
            const bool valid = j * 64 <= t, forced = (j == 0) || (j == jt) || (j == jt - 1);
            sc[j] = valid ? (forced ? 1e4f : imp) : -1e30f;
        }
        WSYNC();
        topk16(sc, sel, n_sel, lane);
        float ms[4] = {-1e30f, -1e30f, -1e30f, -1e30f}, lsum[4] = {0.f, 0.f, 0.f, 0.f}, os[4] = {0.f, 0.f, 0.f, 0.f};
        for (int k = 0; k < 16; ++k) {
            const int j = sel[k];
            if (j * 64 > t) continue;
            const bool valid = j * 64 + lane <= t;
            if (isp) {
                const size_t base = ((size_t)(b * 2 + g) * SEQ + (size_t)j * 64) * 64;
                attend64<bf16_t>(qs, pl, p.ks + base, p.vs + base, 64, valid, lane, ms, lsum, os);
            } else if (j == 256) {
                attend64<float>(qs, pl, p.s_slc + (size_t)b * 256 + g * 64, p.s_slc + (size_t)b * 256 + 128 + g * 64, 256, valid, lane, ms, lsum, os);
            } else {
                const int pg = p.page_table[b * NPAGES + (j >> 1)];
                const float* base = p.cache_slc + (((size_t)pg * 128 + (j & 1) * 64) * 4 + g) * 64;
                attend64<float>(qs, pl, base, base + 128, 256, valid, lane, ms, lsum, os);
            }
        }
        float mw[4] = {-1e30f, -1e30f, -1e30f, -1e30f}, lw[4] = {0.f, 0.f, 0.f, 0.f}, ow[4] = {0.f, 0.f, 0.f, 0.f};
        if (isp) {
            const int start = t - 511 > 0 ? t - 511 : 0;
            for (int c0 = start; c0 <= t; c0 += 64) {
                const size_t base = ((size_t)(b * 2 + g) * SEQ + c0) * 64;
                attend64<bf16_t>(qs, pl, p.kw + base, p.vw + base, 64, c0 + lane <= t, lane, mw, lw, ow);
            }
        } else {
            for (int c0 = 0; c0 < 512; c0 += 64) {
                const float* base = p.s_win + ((size_t)b * 512 + c0) * 256 + g * 64;
                attend64<float>(qs, pl, base, base + 128, 256, true, lane, mw, lw, ow);
            }
        }
#pragma unroll
        for (int h = 0; h < 4; ++h) {
            const float* gt = p.gates + (size_t)r * 24 + g * 12 + h * 3;
            const float o = gt[0] * oc[h] + gt[1] * (os[h] / lsum[h]) + gt[2] * (ow[h] / lw[h]);
            const int col = (g * 4 + h) * 64 + lane;
            p.yar[(size_t)r * 1024 + col] = f2bf(o * bf2f(p.ga[(size_t)r * 512 + col]));
        }
    }
}


typedef short s16x4 __attribute__((ext_vector_type(4)));
#define ATT_NEG (-__builtin_inff())
constexpr int ATT_KC = 0, ATT_VC = 32768, ATT_KB = 65536, ATT_VB = 98304, ATT_SC = 131072;
constexpr float ATT_CS = 0.125f * 1.44269504088896f;

__device__ __forceinline__ void att_stage(LAS char* dst, const bf16_t* rows, int tid) {
    const int key = tid >> 3, slot = tid & 7;
    __builtin_amdgcn_global_load_lds((const unsigned*)(rows + key * 64 + ((slot ^ (key & 7)) * 8)), (LAS unsigned*)(dst + tid * 16), 16, 0, 0);
}
__device__ __forceinline__ void att_qk(const LAS char* Kb, const bf16x8 (&qf)[2], const int (&koff)[2], f32x4 (&st)[4]) {
#pragma unroll
    for (int tk = 0; tk < 4; ++tk) {
        st[tk] = (f32x4){0.f, 0.f, 0.f, 0.f};
#pragma unroll
        for (int ks = 0; ks < 2; ++ks) {
            const bf16x8 kf = *(const LAS bf16x8*)(Kb + tk * 2048 + koff[ks]);
            st[tk] = __builtin_amdgcn_mfma_f32_16x16x32_bf16(kf, qf[ks], st[tk], 0, 0, 0);
        }
    }
}
template <int O0, int O1>
__device__ __forceinline__ void att_tr8(unsigned a0, unsigned a1, unsigned a2, unsigned a3, s16x4 (&v)[8]) {
    asm volatile(
        "ds_read_b64_tr_b16 %0, %8 offset:%12\n\t"
        "ds_read_b64_tr_b16 %1, %8 offset:%13\n\t"
        "ds_read_b64_tr_b16 %2, %9 offset:%12\n\t"
        "ds_read_b64_tr_b16 %3, %9 offset:%13\n\t"
        "ds_read_b64_tr_b16 %4, %10 offset:%12\n\t"
        "ds_read_b64_tr_b16 %5, %10 offset:%13\n\t"
        "ds_read_b64_tr_b16 %6, %11 offset:%12\n\t"
        "ds_read_b64_tr_b16 %7, %11 offset:%13\n\t"
        "s_waitcnt lgkmcnt(0)"
        : "=&v"(v[0]), "=&v"(v[1]), "=&v"(v[2]), "=&v"(v[3]), "=&v"(v[4]), "=&v"(v[5]), "=&v"(v[6]), "=&v"(v[7])
        : "v"(a0), "v"(a1), "v"(a2), "v"(a3), "i"(O0), "i"(O1) : "memory");
}
__device__ __forceinline__ void att_pv(const LAS char* Vb, const f32x4 (&pt)[4], const int (&voff)[4], f32x4 (&o)[4]) {
    const unsigned vb = (unsigned)(unsigned long long)Vb;
    const unsigned a0 = vb + voff[0], a1 = vb + voff[1], a2 = vb + voff[2], a3 = vb + voff[3];
#pragma unroll
    for (int kst = 0; kst < 2; ++kst) {
        u32x4 pk;
        pk[0] = cvt_pk_bf16(pt[2 * kst][0], pt[2 * kst][1]); pk[1] = cvt_pk_bf16(pt[2 * kst][2], pt[2 * kst][3]);
        pk[2] = cvt_pk_bf16(pt[2 * kst + 1][0], pt[2 * kst + 1][1]); pk[3] = cvt_pk_bf16(pt[2 * kst + 1][2], pt[2 * kst + 1][3]);
        const bf16x8 pf = __builtin_bit_cast(bf16x8, pk);
        s16x4 v[8];
        if (kst == 0) att_tr8<0, 2048>(a0, a1, a2, a3, v); else att_tr8<4096, 6144>(a0, a1, a2, a3, v);
#pragma unroll
        for (int dt = 0; dt < 4; ++dt) {
            const s16x4 x0 = v[2 * dt], x1 = v[2 * dt + 1];
            bf16x8 vf; vf[0] = x0[0]; vf[1] = x0[1]; vf[2] = x0[2]; vf[3] = x0[3]; vf[4] = x1[0]; vf[5] = x1[1]; vf[6] = x1[2]; vf[7] = x1[3];
            o[dt] = __builtin_amdgcn_mfma_f32_16x16x32_bf16(vf, pf, o[dt], 0, 0, 0);
        }
    }
}
__device__ __forceinline__ void att_exp(f32x4 (&st)[4], float nb, float& l) {
    typedef float f32x2 __attribute__((ext_vector_type(2)));
    const f32x2 cs2 = {ATT_CS, ATT_CS}, nb2 = {nb, nb};
    f32x2 ls2 = {0.f, 0.f};
#pragma unroll
    for (int tk = 0; tk < 4; ++tk)
#pragma unroll
        for (int r = 0; r < 4; r += 2) {
            const f32x2 s2 = {st[tk][r], st[tk][r + 1]};
            const f32x2 e2 = __builtin_elementwise_fma(s2, cs2, nb2);
            f32x2 p2; p2.x = __builtin_amdgcn_exp2f(e2.x); p2.y = __builtin_amdgcn_exp2f(e2.y);
            st[tk][r] = p2.x; st[tk][r + 1] = p2.y; ls2 += p2;
        }
    l += ls2.x + ls2.y;
}
__device__ __forceinline__ void att_prompt_unit(const Params& p, char* lds, int b, int g, int qt) {
    LAS char* l3 = (LAS char*)lds;
    const int tid = opaque_tid(), lane = tid & 63, wave = tid >> 6, fr = lane & 15, G = lane >> 4;
    const int qi = fr >> 2, h = fr & 3;
    const int t0 = qt * 32, tq0 = t0 + 4 * wave, t_row = tq0 + qi, jt = t0 >> 6;
    const size_t r = (size_t)b * SEQ + t_row;
    const size_t kvbase = (size_t)(b * 2 + g) * SEQ * 64;
    const float shc = p.attb[0], shs = p.attb[1], shw = p.attb[2];
    int koff[2], voff[4];
#pragma unroll
    for (int ks = 0; ks < 2; ++ks) koff[ks] = fr * 128 + (((ks * 4 + G) ^ (fr & 7)) * 16);
    { const int kq = 4 * G + (fr >> 2);
#pragma unroll
      for (int dt = 0; dt < 4; ++dt) voff[dt] = kq * 128 + (((dt * 2 + ((fr & 3) >> 1)) ^ (kq & 7)) * 16) + (fr & 1) * 8; }
    asm volatile("s_waitcnt lgkmcnt(0)" ::: "memory"); __builtin_amdgcn_s_barrier(); asm volatile("" ::: "memory");
    {
        const bf16_t* kc = p.kc + (size_t)(b * 2 + g) * 256 * 64; const bf16_t* vc = p.vc + (size_t)(b * 2 + g) * 256 * 64;
#pragma unroll
        for (int c = 0; c < 4; ++c) { att_stage(l3 + ATT_KC + c * 8192, kc + c * 4096, tid); att_stage(l3 + ATT_VC + c * 8192, vc + c * 4096, tid); }
    }
    bf16x8 qf[2];
#pragma unroll
    for (int ks = 0; ks < 2; ++ks) qf[ks] = *(const bf16x8*)(p.qn + r * 512 + (g * 4 + h) * 64 + ks * 32 + G * 8);
    const int c_lo = (t0 - 511 > 0 ? t0 - 511 : 0) >> 6;
    const int n_s = jt + 1, n_tot = n_s + (jt - c_lo + 1);
#define ATT_STAGE_CHUNK(idx) do { const int _i = (idx); const bool _w = _i >= n_s; const int _cj = _w ? c_lo + (_i - n_s) : _i; \
        att_stage(l3 + ATT_KB + (_i & 3) * 8192, (_w ? p.kw : p.ks) + kvbase + (size_t)_cj * 4096, tid); \
        att_stage(l3 + ATT_VB + (_i & 3) * 8192, (_w ? p.vw : p.vs) + kvbase + (size_t)_cj * 4096, tid); } while (0)
    ATT_STAGE_CHUNK(0); ATT_STAGE_CHUNK(1);
    if (n_tot > 2) { ATT_STAGE_CHUNK(2); asm volatile("s_waitcnt vmcnt(6)" ::: "memory"); }
    else asm volatile("s_waitcnt vmcnt(4)" ::: "memory");
    asm volatile("s_waitcnt lgkmcnt(0)" ::: "memory"); __builtin_amdgcn_s_barrier(); asm volatile("" ::: "memory");
    f32x4 oc[4];
#pragma unroll
    for (int dt = 0; dt < 4; ++dt) oc[dt] = (f32x4){0.f, 0.f, 0.f, 0.f};
    unsigned long long mymask;
    unsigned long long unionmask;
    {
        f32x4 sr[4][4];
#pragma unroll
        for (int c = 0; c < 4; ++c) att_qk(l3 + ATT_KC + c * 8192, qf, koff, sr[c]);
        const int ncrow = t_row >= 31 ? (t_row - 31) / 16 + 1 : 0;
        float lsum = 0.f;
#pragma unroll
        for (int c = 0; c < 4; ++c)
#pragma unroll
            for (int tk = 0; tk < 4; ++tk)
#pragma unroll
                for (int rg = 0; rg < 4; ++rg) {
                    const int i = c * 64 + tk * 16 + G * 4 + rg;
                    const float pv = i < ncrow ? __builtin_amdgcn_exp2f(sr[c][tk][rg] * ATT_CS - shc) : 0.f;
                    sr[c][tk][rg] = pv; lsum += pv;
                }
        lsum += __shfl_xor(lsum, 16); lsum += __shfl_xor(lsum, 32);
        const float inv = lsum > 0.f ? 1.f / lsum : 0.f;
        float* sc = (float*)(lds + ATT_SC) + wave * 512;
        float* bs = sc + 256;
        float av[4][4];
#pragma unroll
        for (int c = 0; c < 4; ++c)
#pragma unroll
            for (int tk = 0; tk < 4; ++tk) {
#pragma unroll
                for (int rg = 0; rg < 4; ++rg) sr[c][tk][rg] *= inv;
                float a = 2.f * (sr[c][tk][0] + sr[c][tk][1] + sr[c][tk][2]) + sr[c][tk][3], b3 = sr[c][tk][3];
                a += __builtin_bit_cast(float, __builtin_amdgcn_mov_dpp(__builtin_bit_cast(int, a), 0xB1, 0xF, 0xF, true));
                a += __builtin_bit_cast(float, __builtin_amdgcn_mov_dpp(__builtin_bit_cast(int, a), 0x4E, 0xF, 0xF, true));
                b3 += __builtin_bit_cast(float, __builtin_amdgcn_mov_dpp(__builtin_bit_cast(int, b3), 0xB1, 0xF, 0xF, true));
                b3 += __builtin_bit_cast(float, __builtin_amdgcn_mov_dpp(__builtin_bit_cast(int, b3), 0x4E, 0xF, 0xF, true));
                av[c][tk] = a;
                if (h == 0) bs[qi * 64 + (c * 4 + tk) * 4 + G] = b3;
            }
        WSYNC();
#pragma unroll
        for (int c = 0; c < 4; ++c)
#pragma unroll
            for (int tk = 0; tk < 4; ++tk) {
                const int j = (c * 4 + tk) * 4 + G;
                const float pr = j > 0 ? bs[qi * 64 + j - 1] : 0.f;
                const bool valid = j * 64 <= t_row, forced = (j == 0) || (j == jt) || (j == jt - 1);
                if (h == 0) sc[qi * 64 + j] = valid ? (forced ? 1e4f : av[c][tk] + pr) : -1e30f;
            }
#pragma unroll
        for (int c = 0; c < 4; ++c) att_pv(l3 + ATT_VC + c * 8192, sr[c], voff, oc);
        WSYNC();
        unsigned long long mq[4];
        {
            float sj[4]; int rank[4] = {0, 0, 0, 0};
#pragma unroll
            for (int q = 0; q < 4; ++q) sj[q] = sc[q * 64 + lane];
#pragma unroll 2
            for (int jp = 0; jp <= jt; ++jp) {
                const bool lower = jp < lane;
#pragma unroll
                for (int q = 0; q < 4; ++q) {
                    const float v = __builtin_bit_cast(float, __builtin_amdgcn_readlane(__builtin_bit_cast(int, sj[q]), jp));
                    rank[q] += (v > sj[q] || (v == sj[q] && lower)) ? 1 : 0;
                }
            }
#pragma unroll
            for (int q = 0; q < 4; ++q) mq[q] = __ballot(rank[q] < 16 && lane * 64 <= tq0 + q);
        }
        unionmask = mq[0] | mq[1] | mq[2] | mq[3];
        mymask = qi == 0 ? mq[0] : qi == 1 ? mq[1] : qi == 2 ? mq[2] : mq[3];
        WSYNC();
    }
    f32x4 os[4], ow[4];
#pragma unroll
    for (int dt = 0; dt < 4; ++dt) { os[dt] = (f32x4){0.f, 0.f, 0.f, 0.f}; ow[dt] = (f32x4){0.f, 0.f, 0.f, 0.f}; }
    float ls = 0.f, lw = 0.f;
    for (int it = 0; it < n_tot; ++it) {
        if (it + 2 < n_tot) asm volatile("s_waitcnt vmcnt(4)" ::: "memory");
        else if (it + 1 < n_tot) asm volatile("s_waitcnt vmcnt(2)" ::: "memory");
        else asm volatile("s_waitcnt vmcnt(0)" ::: "memory");
        asm volatile("s_waitcnt lgkmcnt(0)" ::: "memory"); __builtin_amdgcn_s_barrier(); asm volatile("" ::: "memory");
        if (it + 3 < n_tot) ATT_STAGE_CHUNK(it + 3);
        const LAS char* Kb = l3 + ATT_KB + (it & 3) * 8192; const LAS char* Vb = l3 + ATT_VB + (it & 3) * 8192;
        if (it < n_s) {
            const int j = it;
            if ((unionmask >> j) & 1ull) {
                f32x4 st[4];
                att_qk(Kb, qf, koff, st);
                const float nb = ((mymask >> j) & 1ull) ? -shs : ATT_NEG;
                if (j == jt) {
                    asm volatile("" ::: "memory");
#pragma unroll
                    for (int tk = 0; tk < 4; ++tk)
#pragma unroll
                        for (int rg = 0; rg < 4; ++rg) { const int pos = j * 64 + tk * 16 + G * 4 + rg; if (pos > t_row) st[tk][rg] = ATT_NEG; }
                }
                att_exp(st, nb, ls);
                att_pv(Vb, st, voff, os);
            }
        } else {
            const int cj = c_lo + (it - n_s);
            f32x4 st[4];
            att_qk(Kb, qf, koff, st);
            if (cj * 64 + 63 > tq0 || cj * 64 <= tq0 + 3 - 512) {
                asm volatile("" ::: "memory");
#pragma unroll
                for (int tk = 0; tk < 4; ++tk)
#pragma unroll
                    for (int rg = 0; rg < 4; ++rg) { const int pos = cj * 64 + tk * 16 + G * 4 + rg; if (!(pos <= t_row && pos > t_row - 512)) st[tk][rg] = ATT_NEG; }
            }
            att_exp(st, -shw, lw);
            att_pv(Vb, st, voff, ow);
        }
    }
#undef ATT_STAGE_CHUNK
    ls += __shfl_xor(ls, 16); ls += __shfl_xor(ls, 32);
    lw += __shfl_xor(lw, 16); lw += __shfl_xor(lw, 32);
    const float* gt = p.gates + r * 24 + g * 12 + h * 3;
    const float g0 = gt[0], g1 = gt[1] / ls, g2 = gt[2] / lw;
    const int colb = (g * 4 + h) * 64;
#pragma unroll
    for (int dt = 0; dt < 4; ++dt) {
        const int d = dt * 16 + G * 4;
        const uint2 gav = *(const uint2*)(p.ga + r * 512 + colb + d);
        float v[4];
#pragma unroll
        for (int rg = 0; rg < 4; ++rg) v[rg] = g0 * oc[dt][rg] + g1 * os[dt][rg] + g2 * ow[dt][rg];
        v[0] *= __uint_as_float(gav.x << 16); v[1] *= __uint_as_float(gav.x & 0xffff0000u);
        v[2] *= __uint_as_float(gav.y << 16); v[3] *= __uint_as_float(gav.y & 0xffff0000u);
        uint2 o; o.x = cvt_pk_bf16(v[0], v[1]); o.y = cvt_pk_bf16(v[2], v[3]);
        *(uint2*)(p.yar + r * 1024 + colb + d) = o;
    }
}

__device__ __forceinline__ void dot4(const float* qs, const bf16_t* kr, float (&s)[4]) {
    uint4 raw[8];
#pragma unroll
    for (int c = 0; c < 8; ++c) raw[c] = *(const uint4*)(kr + c * 8);
#pragma unroll
    for (int c = 0; c < 8; ++c) {
        float kf[8];
        kf[0] = __uint_as_float(raw[c].x << 16); kf[1] = __uint_as_float(raw[c].x & 0xffff0000u); kf[2] = __uint_as_float(raw[c].y << 16); kf[3] = __uint_as_float(raw[c].y & 0xffff0000u);
        kf[4] = __uint_as_float(raw[c].z << 16); kf[5] = __uint_as_float(raw[c].z & 0xffff0000u); kf[6] = __uint_as_float(raw[c].w << 16); kf[7] = __uint_as_float(raw[c].w & 0xffff0000u);
#pragma unroll
        for (int hh = 0; hh < 4; ++hh)
#pragma unroll
            for (int j = 0; j < 8; ++j) s[hh] += qs[hh * 64 + c * 8 + j] * kf[j];
    }
}
__device__ __forceinline__ void att_sample_unit(const Params& p, char* lds, int b, int g) {
    const int tid = opaque_tid(), lane = tid & 63, wave = tid >> 6;
    float* L = (float*)lds;
    float* qs = L;
    float* ps = L + 256;
    float* sc = L + 1296;
    int* sel = (int*)(L + 1568);
    float* red = L + 1600;
    float* part = L + 1664;
    float* pl = L + 1664 + 8 * 3 * 4 * 66 + wave * 256;
    const size_t r = TP + b;
    __syncthreads();
    if (tid < 256) qs[tid] = bf2f(p.qn[r * 512 + g * 256 + tid]);
    for (int i = tid; i < 1040; i += NT) ps[i] = 0.f;
    __syncthreads();
    const bf16_t* kc = p.kcs + (size_t)(b * 2 + g) * 1024 * 64; const bf16_t* vc = p.vcs + (size_t)(b * 2 + g) * 1024 * 64;
    const int n_c = 1023;
    float m1[4] = {-1e30f, -1e30f, -1e30f, -1e30f}, l1[4] = {0.f, 0.f, 0.f, 0.f};
    for (int cc = 0; cc < 2; ++cc) {
        const int i = wave * 128 + cc * 64 + lane; const bool valid = i < n_c;
        float s[4] = {0.f, 0.f, 0.f, 0.f};
        if (valid) dot4(qs, kc + (size_t)i * 64, s);
#pragma unroll
        for (int hh = 0; hh < 4; ++hh) {
            const float sv = valid ? s[hh] * 0.125f : -1e30f;
            const float mn = fmaxf(m1[hh], wave_max(sv));
            l1[hh] = l1[hh] * __expf(m1[hh] - mn) + wave_sum(valid ? __expf(sv - mn) : 0.f); m1[hh] = mn;
        }
    }
    if (lane == 0) {
#pragma unroll
        for (int hh = 0; hh < 4; ++hh) { red[wave * 8 + hh] = m1[hh]; red[wave * 8 + 4 + hh] = l1[hh]; }
    }
    __syncthreads();
    float M[4], Ls[4];
#pragma unroll
    for (int hh = 0; hh < 4; ++hh) {
        float mm = -1e30f;
        for (int w = 0; w < 8; ++w) mm = fmaxf(mm, red[w * 8 + hh]);
        float ll = 0.f;
        for (int w = 0; w < 8; ++w) ll += red[w * 8 + 4 + hh] * __expf(red[w * 8 + hh] - mm);
        M[hh] = mm; Ls[hh] = ll;
    }
    float oc[4] = {0.f, 0.f, 0.f, 0.f};
    for (int cc = 0; cc < 2; ++cc) {
        const int i0 = wave * 128 + cc * 64, i = i0 + lane; const bool valid = i < n_c;
        float s[4] = {0.f, 0.f, 0.f, 0.f};
        if (valid) dot4(qs, kc + (size_t)i * 64, s);
        float psum = 0.f;
#pragma unroll
        for (int hh = 0; hh < 4; ++hh) { const float pv = valid ? __expf(s[hh] * 0.125f - M[hh]) / Ls[hh] : 0.f; pl[hh * 64 + lane] = pv; psum += pv; }
        if (valid) ps[1 + i] = psum;
        WSYNC();
        const int nk = min(64, n_c - i0);
#pragma unroll 16
        for (int kk = 0; kk < 64; ++kk) {
            const float vv = bf2f(vc[(size_t)(i0 + (kk < nk ? kk : 0)) * 64 + lane]);
#pragma unroll
            for (int hh = 0; hh < 4; ++hh) oc[hh] += pl[hh * 64 + kk] * vv;
        }
        WSYNC();
    }
    __syncthreads();
    if (wave == 0) {
        const int t = PAST, jt = t >> 6;
        for (int j = lane; j < 257; j += 64) {
            float imp = 0.f;
#pragma unroll
            for (int rr = 0; rr < 4; ++rr) imp += ps[4 * j + rr + 1] + ps[4 * j + rr];
            const bool valid = j * 64 <= t, forced = (j == 0) || (j == jt) || (j == jt - 1);
            sc[j] = valid ? (forced ? 1e4f : imp) : -1e30f;
        }
        WSYNC();
        topk16(sc, sel, 257, lane);
    }
    __syncthreads();
    float msv[4] = {-1e30f, -1e30f, -1e30f, -1e30f}, lsv[4] = {0.f, 0.f, 0.f, 0.f}, osv[4] = {0.f, 0.f, 0.f, 0.f};
    for (int k = 2 * wave; k < 2 * wave + 2; ++k) {
        const int j = sel[k];
        if (j * 64 > PAST) continue;
        const bool valid = j * 64 + lane <= PAST;
        if (j == 256) attend64<float>(qs, pl, p.s_slc + (size_t)b * 256 + g * 64, p.s_slc + (size_t)b * 256 + 128 + g * 64, 256, valid, lane, msv, lsv, osv);
        else {
            const int pg = p.page_table[b * NPAGES + (j >> 1)];
            const float* base = p.cache_slc + (((size_t)pg * 128 + (j & 1) * 64) * 4 + g) * 64;
            attend64<float>(qs, pl, base, base + 128, 256, valid, lane, msv, lsv, osv);
        }
    }
    float mwv[4] = {-1e30f, -1e30f, -1e30f, -1e30f}, lwv[4] = {0.f, 0.f, 0.f, 0.f}, owv[4] = {0.f, 0.f, 0.f, 0.f};
    {
        const float* base = p.s_win + ((size_t)b * 512 + wave * 64) * 256 + g * 64;
        attend64<float>(qs, pl, base, base + 128, 256, true, lane, mwv, lwv, owv);
    }
#pragma unroll
    for (int hh = 0; hh < 4; ++hh) {
        float* pc = part + ((wave * 3 + 0) * 4 + hh) * 66; pc[lane] = oc[hh];
        float* pS = part + ((wave * 3 + 1) * 4 + hh) * 66; pS[lane] = osv[hh]; if (lane == 0) { pS[64] = msv[hh]; pS[65] = lsv[hh]; }
        float* pw = part + ((wave * 3 + 2) * 4 + hh) * 66; pw[lane] = owv[hh]; if (lane == 0) { pw[64] = mwv[hh]; pw[65] = lwv[hh]; }
    }
    __syncthreads();
    if (tid < 256) {
        const int hh = tid >> 6, d = tid & 63;
        float c = 0.f;
        for (int w = 0; w < 8; ++w) c += part[((w * 3 + 0) * 4 + hh) * 66 + d];
        float res[2];
#pragma unroll
        for (int br = 1; br < 3; ++br) {
            float mm = -1e30f;
            for (int w = 0; w < 8; ++w) mm = fmaxf(mm, part[((w * 3 + br) * 4 + hh) * 66 + 64]);
            float num = 0.f, den = 0.f;
            for (int w = 0; w < 8; ++w) { const float* q = part + ((w * 3 + br) * 4 + hh) * 66; const float e = __expf(q[64] - mm); num += q[d] * e; den += q[65] * e; }
            res[br - 1] = num / den;
        }
        const float* gt = p.gates + r * 24 + g * 12 + hh * 3;
        const int col = (g * 4 + hh) * 64 + d;
        p.yar[r * 1024 + col] = f2bf((gt[0] * c + gt[1] * res[0] + gt[2] * res[1]) * bf2f(p.ga[r * 512 + col]));
    }
    __syncthreads();
}

__device__ __forceinline__ void ret_out_item(const Params& p, char* lds, int it);
__device__ __forceinline__ void att_phase(const Params& p, char* lds, int bid, int nblk) {
    const int x = bid & 7;
    unsigned* ctr = p.bar + 3584 + 64 * x;
    volatile int* slot = (volatile int*)(lds + 147456 + 16);
    const int tid = opaque_tid();
    for (;;) {
        __syncthreads();
        if (tid == 0) *slot = (int)__hip_atomic_fetch_add(ctr, 1u, __ATOMIC_RELAXED, __HIP_MEMORY_SCOPE_AGENT);
        __syncthreads();
        const int w = *slot;
        if (w >= 136) break;
        if (w < 8) att_sample_unit(p, lds, 4 * x + (w >> 1), w & 1);
        else att_prompt_unit(p, lds, x >> 1, x & 1, 127 - (w - 8));
    }
}
__device__ __forceinline__ void ret_out_queue(const Params& p, char* lds, int bid, int nblk) {
    const int x = bid & 7;
    unsigned* ctr = p.bar + 3584 + 64 * x + 16;
    volatile int* slot = (volatile int*)(lds + 147456 + 16);
    const int tid = opaque_tid();
    wg_wait(p.bar + 3456, (unsigned)nblk, p.bar + XB_TMO);
    for (;;) {
        __syncthreads();
        if (tid == 0) *slot = (int)__hip_atomic_fetch_add(ctr, 1u, __ATOMIC_RELAXED, __HIP_MEMORY_SCOPE_AGENT);
        __syncthreads();
        const int w = *slot;
        if (w >= 80) break;
        ret_out_item(p, lds, x + 8 * w);
    }
}

__device__ __forceinline__ float ret_gamma(int h) { return 1.f - exp2f(-5.f - (float)h); }

__device__ __forceinline__ void p6a_local(const Params& p, int bid, int nblk) {
    const int tid = opaque_tid();
    const int e = tid & 127, dg = tid >> 7;
    for (int it = bid; it < 4 * 4 * 32; it += nblk) {
        const int n = it & 31, h = (it >> 5) & 3, b = it >> 7;
        const float lg = __logf(ret_gamma(h));
        float acc[16];
#pragma unroll
        for (int i = 0; i < 16; ++i) acc[i] = 0.f;
        for (int j = 0; j < 128; ++j) {
            const size_t r = (size_t)b * SEQ + n * 128 + j;
            const float z = __expf(lg * (float)(127 - j));
            const float v = bf2f(p.rv[r * 512 + h * 128 + e]) * z;
            const bf16_t* kr = p.rk + r * 256 + h * 64 + dg * 16;
#pragma unroll
            for (int i = 0; i < 16; ++i) acc[i] += bf2f(kr[i]) * v;
        }
        float* out = p.sloc + ((size_t)it * 64 + dg * 16) * 128 + e;
#pragma unroll
        for (int i = 0; i < 16; ++i) out[i * 128] = acc[i];
    }
}
__device__ __forceinline__ void p6b_scan(const Params& p, int bid, int nblk) {
    const size_t gt = (size_t)bid * NT + threadIdx.x, ngt = (size_t)nblk * NT;
    for (size_t i = gt; i < (size_t)16 * 8192; i += ngt) {
        const int bh = (int)(i >> 13), el = (int)(i & 8191), h = bh & 3;
        const float gc = __expf(__logf(ret_gamma(h)) * 128.f);
        float S = 0.f, lv[32];
#pragma unroll
        for (int n = 0; n < 32; ++n) lv[n] = p.sloc[((size_t)bh * 32 + n) * 8192 + el];
#pragma unroll
        for (int n = 0; n < 32; ++n) {
            p.spre[((size_t)bh * 32 + n) * 8192 + el] = S;
            S = S * gc + lv[n];
        }
        p.p_ret[(size_t)bh * 8192 + el] = S;
    }
    for (size_t i = gt; i < (size_t)128 * 8192; i += ngt) {
        const int bh = (int)(i >> 13), el = (int)(i & 8191), h = bh & 3, b = bh >> 2, d = el >> 7, e = el & 127;
        const size_t r = TP + b;
        const float k = bf2f(p.rk[r * 256 + h * 64 + d]), v = bf2f(p.rv[r * 512 + h * 128 + e]);
        p.s_ret[i] = p.state_ret[i] * ret_gamma(h) + k * v;
    }
}
__device__ __forceinline__ void p6c_out(const Params& p, char* lds, int bid, int nblk) {
    float* Am = (float*)lds;
    const int tid = opaque_tid();
    for (int it = bid; it < 4 * 4 * 32 + 128; it += nblk) {
        if (it < 512) {
            const int n = it & 31, h = (it >> 5) & 3, b = it >> 7;
            const float lg = __logf(ret_gamma(h));
            const size_t r0 = (size_t)b * SEQ + n * 128;
            for (int idx = tid; idx < 128 * 128; idx += NT) {
                const int i = idx >> 7, j = idx & 127;
                float a = 0.f;
                if (j <= i) {
                    const bf16_t* qr = p.rq + (r0 + i) * 256 + h * 64; const bf16_t* kr = p.rk + (r0 + j) * 256 + h * 64;
#pragma unroll
                    for (int c = 0; c < 8; ++c) { float qf[8], kf[8]; load8(qr + c * 8, qf); load8(kr + c * 8, kf);
#pragma unroll
                        for (int u = 0; u < 8; ++u) a += qf[u] * kf[u]; }
                    a *= __expf(lg * (float)(i - j));
                }
                Am[i * 129 + j] = a;
            }
            __syncthreads();
            const int e = tid & 127, ig = tid >> 7;
            const float* S = p.spre + (size_t)it * 8192;
            for (int i = ig * 32; i < ig * 32 + 32; ++i) {
                float o = 0.f;
                for (int j = 0; j <= i; ++j) o += Am[i * 129 + j] * bf2f(p.rv[(r0 + j) * 512 + h * 128 + e]);
                float qs = 0.f;
                const bf16_t* qr = p.rq + (r0 + i) * 256 + h * 64;
                for (int d = 0; d < 64; ++d) qs += bf2f(qr[d]) * S[d * 128 + e];
                o += qs * __expf(lg * (float)(i + 1));
                p.oret[(r0 + i) * 512 + h * 128 + e] = o;
            }
            __syncthreads();
        } else {
            const int bh = it - 512, h = bh & 3, b = bh >> 2;
            const size_t r = TP + b;
            if (tid < 128) {
                const int e = tid;
                const bf16_t* qr = p.rq + r * 256 + h * 64; const bf16_t* kr = p.rk + r * 256 + h * 64;
                const float* S0 = p.state_ret + (size_t)bh * 8192;
                float qs = 0.f, qk = 0.f;
                for (int d = 0; d < 64; ++d) { const float q = bf2f(qr[d]); qs += q * S0[d * 128 + e]; qk += q * bf2f(kr[d]); }
                p.oret[r * 512 + h * 128 + e] = qs * ret_gamma(h) + qk * bf2f(p.rv[r * 512 + h * 128 + e]);
            }
        }
    }
}
__device__ __forceinline__ void p6d_norm(const Params& p, int bid, int nblk) {
    const int tid = opaque_tid(), lane = tid & 63, wave = tid >> 6;
    for (int it = bid * 8 + wave; it < R * 4; it += nblk * 8) {
        const int r = it >> 2, h = it & 3;
        const float* o = p.oret + (size_t)r * 512 + h * 128;
        const float v0 = o[lane], v1 = o[lane + 64];
        const float rs = rsqrtf(wave_sum(v0 * v0 + v1 * v1) * (1.f / 128.f) + EPS);
        p.yar[(size_t)r * 1024 + 512 + h * 128 + lane] = f2bf(v0 * rs * p.g_ret[lane] * bf2f(p.gr[(size_t)r * 512 + h * 128 + lane]));
        p.yar[(size_t)r * 1024 + 512 + h * 128 + lane + 64] = f2bf(v1 * rs * p.g_ret[lane + 64] * bf2f(p.gr[(size_t)r * 512 + h * 128 + lane + 64]));
    }
}


__device__ __forceinline__ void ret_stage(LAS char* dst, const bf16_t* src, size_t row_stride, int lg_slots, int npieces, int tid) {
    for (int pc = tid; pc < npieces; pc += NT) {
        const int row = pc >> lg_slots, slot = pc & ((1 << lg_slots) - 1);
        __builtin_amdgcn_global_load_lds((const unsigned*)(src + (size_t)row * row_stride + ((slot ^ (row & 7)) * 8)), (LAS unsigned*)(dst + pc * 16), 16, 0, 0);
    }
}
__device__ __forceinline__ s16x4 ret_tr(const LAS char* img, int RB, int r0, int c0, int fr) {
    const int row = r0 + (fr >> 2), chunk = (c0 >> 3) + ((fr & 3) >> 1);
    return __builtin_amdgcn_ds_read_tr16_b64_v4i16((LAS s16x4*)(img + row * RB + ((chunk ^ (row & 7)) * 16) + (fr & 1) * 8));
}
__device__ __forceinline__ bf16x8 cat8(s16x4 a, s16x4 b) { bf16x8 v; v[0] = a[0]; v[1] = a[1]; v[2] = a[2]; v[3] = a[3]; v[4] = b[0]; v[5] = b[1]; v[6] = b[2]; v[7] = b[3]; return v; }

__device__ __forceinline__ void ret_local_item(const Params& p, char* lds, int it) {
    LAS char* l3 = (LAS char*)lds;
    const int tid = opaque_tid(), lane = tid & 63, wave = tid >> 6, fr = lane & 15, G = lane >> 4;
    {
        const int n = it & 31, h = (it >> 5) & 3, b = it >> 7;
        const size_t r0 = (size_t)b * SEQ + n * 128;
        __syncthreads();
        ret_stage(l3, p.rk + r0 * 256 + h * 64, 256, 3, 1024, tid);
        ret_stage(l3 + 16384, p.rv + r0 * 512 + h * 128, 512, 4, 2048, tid);
        asm volatile("s_waitcnt vmcnt(0)" ::: "memory");
        __syncthreads();
        f32x4 acc[4];
#pragma unroll
        for (int dt = 0; dt < 4; ++dt) acc[dt] = (f32x4){0.f, 0.f, 0.f, 0.f};
#pragma unroll
        for (int js = 0; js < 4; ++js) {
            const int j0 = js * 32 + 4 * G;
            const bf16x8 bfr = cat8(ret_tr(l3 + 16384, 256, j0, wave * 16, fr), ret_tr(l3 + 16384, 256, j0 + 16, wave * 16, fr));
#pragma unroll
            for (int dt = 0; dt < 4; ++dt) {
                const bf16x8 afr = cat8(ret_tr(l3, 128, j0, dt * 16, fr), ret_tr(l3, 128, j0 + 16, dt * 16, fr));
                acc[dt] = __builtin_amdgcn_mfma_f32_16x16x32_bf16(afr, bfr, acc[dt], 0, 0, 0);
            }
        }
        const float sc = exp2f(__log2f(ret_gamma(h)) * 127.f);
        float* out = p.sloc + (size_t)it * 8192 + wave * 16 + fr;
#pragma unroll
        for (int dt = 0; dt < 4; ++dt)
#pragma unroll
            for (int rg = 0; rg < 4; ++rg) out[(dt * 16 + 4 * G + rg) * 128] = acc[dt][rg] * sc;
    }
}

__device__ __forceinline__ void ret_out_item(const Params& p, char* lds, int it) {
    LAS char* l3 = (LAS char*)lds;
    const int tid = opaque_tid(), lane = tid & 63, wave = tid >> 6, fr = lane & 15, G = lane >> 4;
    {
        __syncthreads();
        if (it < 512) {
            const int n = it & 31, h = (it >> 5) & 3, b = it >> 7;
            const size_t r0 = (size_t)b * SEQ + n * 128;
            const float gam = ret_gamma(h);
            ret_stage(l3, p.rk + r0 * 256 + h * 64, 256, 3, 1024, tid);
            ret_stage(l3 + 16384, p.rv + r0 * 512 + h * 128, 512, 4, 2048, tid);
            {
                const float* S = p.spre + (size_t)it * 8192;
                for (int pc = tid; pc < 1024; pc += NT) {
                    const int row = pc >> 4, slot = pc & 15;
                    const float4 a = *(const float4*)(S + row * 128 + slot * 8), c = *(const float4*)(S + row * 128 + slot * 8 + 4);
                    u32x4 v; v[0] = cvt_pk_bf16(a.x * gam, a.y * gam); v[1] = cvt_pk_bf16(a.z * gam, a.w * gam); v[2] = cvt_pk_bf16(c.x * gam, c.y * gam); v[3] = cvt_pk_bf16(c.z * gam, c.w * gam);
                    *(LAS u32x4*)(l3 + 49152 + row * 256 + ((slot ^ (row & 7)) * 16)) = v;
                }
            }
            const size_t ri = r0 + wave * 16 + fr;
            bf16x8 qf[2], qp[2];
#pragma unroll
            for (int ks = 0; ks < 2; ++ks) {
                const bf16_t* qrow = p.rq + ri * 256 + h * 64 + ks * 32;
                qf[ks] = *(const bf16x8*)(qrow + G * 8);
                const s16x4 lo = *(const s16x4*)(qrow + 4 * G), hi = *(const s16x4*)(qrow + 16 + 4 * G);
                qp[ks] = cat8(lo, hi);
            }
            asm volatile("s_waitcnt vmcnt(0)" ::: "memory");
            __syncthreads();
            f32x4 st[8];
#pragma unroll
            for (int jt = 0; jt < 8; ++jt) {
                st[jt] = (f32x4){0.f, 0.f, 0.f, 0.f};
                if (jt <= wave) {
#pragma unroll
                    for (int ks = 0; ks < 2; ++ks) {
                        const int row = jt * 16 + fr;
                        const bf16x8 kf = *(const LAS bf16x8*)(l3 + row * 128 + (((ks * 4 + G) ^ (row & 7)) * 16));
                        st[jt] = __builtin_amdgcn_mfma_f32_16x16x32_bf16(kf, qf[ks], st[jt], 0, 0, 0);
                    }
                    if (jt == wave) {
#pragma unroll
                        for (int rg = 0; rg < 4; ++rg) if (4 * G + rg > fr) st[jt][rg] = 0.f;
                    }
                }
            }
            f32x4 o[8];
#pragma unroll
            for (int et = 0; et < 8; ++et) o[et] = (f32x4){0.f, 0.f, 0.f, 0.f};
#pragma unroll
            for (int js = 0; js < 4; ++js) {
                if (2 * js <= wave) {
                    u32x4 pk;
                    pk[0] = cvt_pk_bf16(st[2 * js][0], st[2 * js][1]); pk[1] = cvt_pk_bf16(st[2 * js][2], st[2 * js][3]);
                    pk[2] = cvt_pk_bf16(st[2 * js + 1][0], st[2 * js + 1][1]); pk[3] = cvt_pk_bf16(st[2 * js + 1][2], st[2 * js + 1][3]);
                    const bf16x8 pf = __builtin_bit_cast(bf16x8, pk);
                    const int j0 = js * 32 + 4 * G;
#pragma unroll
                    for (int et = 0; et < 8; ++et) {
                        const bf16x8 vf = cat8(ret_tr(l3 + 16384, 256, j0, et * 16, fr), ret_tr(l3 + 16384, 256, j0 + 16, et * 16, fr));
                        o[et] = __builtin_amdgcn_mfma_f32_16x16x32_bf16(vf, pf, o[et], 0, 0, 0);
                    }
                }
            }
#pragma unroll
            for (int ks = 0; ks < 2; ++ks) {
                const int d0 = ks * 32 + 4 * G;
#pragma unroll
                for (int et = 0; et < 8; ++et) {
                    const bf16x8 sf = cat8(ret_tr(l3 + 49152, 256, d0, et * 16, fr), ret_tr(l3 + 49152, 256, d0 + 16, et * 16, fr));
                    o[et] = __builtin_amdgcn_mfma_f32_16x16x32_bf16(sf, qp[ks], o[et], 0, 0, 0);
                }
            }
            float ss = 0.f;
#pragma unroll
            for (int et = 0; et < 8; ++et)
#pragma unroll
                for (int rg = 0; rg < 4; ++rg) ss += o[et][rg] * o[et][rg];
            ss += __shfl_xor(ss, 16); ss += __shfl_xor(ss, 32);
            const float rs = rsqrtf(ss * (1.f / 128.f) + EPS);
#pragma unroll
            for (int et = 0; et < 8; ++et) {
                const int e = et * 16 + 4 * G;
                const float4 gr = *(const float4*)(p.g_ret + e);
                const uint2 gv = *(const uint2*)(p.gr + ri * 512 + h * 128 + e);
                uint2 ov;
                ov.x = cvt_pk_bf16(o[et][0] * rs * gr.x * __uint_as_float(gv.x << 16), o[et][1] * rs * gr.y * __uint_as_float(gv.x & 0xffff0000u));
                ov.y = cvt_pk_bf16(o[et][2] * rs * gr.z * __uint_as_float(gv.y << 16), o[et][3] * rs * gr.w * __uint_as_float(gv.y & 0xffff0000u));
                *(uint2*)(p.yar + ri * 1024 + 512 + h * 128 + e) = ov;
            }
        } else {
            const int bh = it - 512, h = bh & 3, b = bh >> 2;
            const size_t r = TP + b;
            float* red = (float*)lds;
            float o = 0.f;
            if (tid < 128) {
                const int e = tid;
                const bf16_t* qr = p.rq + r * 256 + h * 64; const bf16_t* kr = p.rk + r * 256 + h * 64;
                const float* S0 = p.state_ret + (size_t)bh * 8192;
                float qs = 0.f, qk = 0.f;
                for (int d = 0; d < 64; ++d) { const float q = bf2f(qr[d]); qs += q * S0[d * 128 + e]; qk += q * bf2f(kr[d]); }
                o = qs * ret_gamma(h) + qk * bf2f(p.rv[r * 512 + h * 128 + e]);
                const float s2 = wave_sum(o * o);
                if (lane == 0) red[wave] = s2;
            }
            __syncthreads();
            if (tid < 128) {
                const float rs = rsqrtf((red[0] + red[1]) * (1.f / 128.f) + EPS);
                p.yar[r * 1024 + 512 + h * 128 + tid] = f2bf(o * rs * p.g_ret[tid] * bf2f(p.gr[r * 512 + h * 128 + tid]));
            }
        }
    }
}

__device__ __forceinline__ void out_sample(const Params& p, int bid, int nblk) {
    const int tid = opaque_tid(), lane = tid & 63, wave = tid >> 6, fr = lane & 15, G = lane >> 4;
    for (int it = bid * 8 + wave; it < 128; it += nblk * 8) {
        const int mt = it >> 6, nt = it & 63;
        const bf16_t* arow = p.yar + (size_t)(TP + mt * 16 + fr) * 1024 + G * 8;
        const bf16_t* brow = p.bt_out + (size_t)(nt * 16 + fr) * 1024 + G * 8;
        f32x4 acc = {0.f, 0.f, 0.f, 0.f};
#pragma unroll 8
        for (int ks = 0; ks < 32; ++ks) {
            const bf16x8 a = *(const bf16x8*)(arow + ks * 32), b = *(const bf16x8*)(brow + ks * 32);
            acc = __builtin_amdgcn_mfma_f32_16x16x32_bf16(a, b, acc, 0, 0, 0);
        }
        const int c = nt * 16 + fr;
#pragma unroll
        for (int rg = 0; rg < 4; ++rg) {
            const int sb = mt * 16 + 4 * G + rg;
            p.y[(size_t)(TP + sb) * 1024 + c] = p.x_sample[(size_t)sb * 1024 + c] + p.mod[(4 + sb) * 3072 + 2048 + c] * acc[rg];
        }
    }
}
__global__ void __launch_bounds__(NT, 2) k_mega(Params p) {
    extern __shared__ __attribute__((aligned(16))) char lds[];
    const int bid = blockIdx.x, nblk = gridDim.x;
    uint4* xbw = (uint4*)(lds + 147456);
    if (threadIdx.x == 0) *xbw = make_uint4(0u, 0u, 0u, 0u);
    __syncthreads();
    XcdBarrier bar = xcd_barrier_post(p.bar, (volatile LAS unsigned*)xbw);
    p0_w1p(p, bid, nblk); wg_signal(p.bar + 3536, true);
    p0_adaln(p, lds, bid, nblk); __syncthreads(); p0_weights(p, lds, bid, nblk); __syncthreads();
    wg_wait(p.bar + 3536, (unsigned)nblk, p.bar + XB_TMO);
    compress_sample(p, lds, bid, nblk);
    wg_wait(p.bar + 3520, 96u, p.bar + XB_TMO);
    p1_norm(p, lds, bid, nblk);
    xcd_barrier(bar);
    { EpiIn e{&p}; gemm_phase(p.H, p.bt_in, RPAD / 256, NPAD / 256, 1024, lds, bid, nblk, e); }
    if (nblk == 256) compress_seams(p, bid - 142, 114); else compress_seams(p, bid, nblk);
    xcd_barrier(bar);
    {
        volatile int* slot = (volatile int*)(lds + 147456 + 16);
        for (;;) {
            __syncthreads();
            if (threadIdx.x == 0) *slot = (int)__hip_atomic_fetch_add(p.bar + 3456 + 48, 1u, __ATOMIC_RELAXED, __HIP_MEMORY_SCOPE_AGENT);
            __syncthreads();
            const int w = *slot;
            if (w >= 136 + 512) break;
            if (w < 136) compress_prompt_ksplit_item(p, lds, w); else ret_local_item(p, lds, w - 136);
        }
    }
    xcd_barrier(bar);
    p6b_scan(p, bid, nblk); wg_signal(p.bar + 3456, true);
    att_phase(p, lds, bid, nblk);
    ret_out_queue(p, lds, bid, nblk);
    xcd_barrier(bar);
    { EpiOut e{&p}; gemm_phase(p.yar, p.bt_out, TP / 256, 4, 1024, lds, bid, nblk, e); }
    out_sample(p, nblk - 1 - bid, nblk);
}
}

extern "C" void kernel_launch(void* const* d_in, const int* in_sizes, int n_in, void* d_out, int out_size, void* d_ws, size_t ws_size, hipStream_t stream) {
    Params p{};
    p.x_prompt = (const float*)d_in[0]; p.x_sample = (const float*)d_in[1]; p.c_prompt = (const float*)d_in[2]; p.c_sample = (const float*)d_in[3];
    p.cache_cmp = (const float*)d_in[4]; p.cache_slc = (const float*)d_in[5]; p.state_win = (const float*)d_in[6]; p.state_ret = (const float*)d_in[7];
    p.page_table = (const int*)d_in[8];
    p.g_norm = (const float*)d_in[9]; p.w_ada = (const float*)d_in[10]; p.b_ada = (const float*)d_in[11]; p.w_in = (const float*)d_in[12];
    p.g_q = (const float*)d_in[13]; p.g_kc = (const float*)d_in[14]; p.g_ks = (const float*)d_in[15]; p.g_kw = (const float*)d_in[16];
    p.pe_ck = (const float*)d_in[17]; p.w_ck1 = (const float*)d_in[18]; p.w_ck2 = (const float*)d_in[19];
    p.pe_cv = (const float*)d_in[20]; p.w_cv1 = (const float*)d_in[21]; p.w_cv2 = (const float*)d_in[22];
    p.g_ret = (const float*)d_in[23]; p.w_out = (const float*)d_in[24];
    float* o = (float*)d_out;
    p.y = o; o += (size_t)R * 1024;
    p.p_cmp = o; o += (size_t)TP * 256; p.p_slc = o; o += (size_t)TP * 256; p.p_win = o; o += (size_t)4 * 512 * 256; p.p_ret = o; o += (size_t)16 * 8192;
    p.s_cmp = o; o += 32 * 256; p.s_slc = o; o += 32 * 256; p.s_win = o; o += (size_t)32 * 512 * 256; p.s_ret = o; o += (size_t)128 * 8192;
    char* w = (char*)d_ws; size_t off = 0;
    auto take = [&](size_t bytes) { char* q = w + off; off += (bytes + 255) & ~(size_t)255; return q; };
    p.bar = (unsigned*)take(16384);
    p.mod = (float*)take(36 * 3072 * 4);
    p.bt_in = (bf16_t*)take((size_t)NPAD * 1024 * 2);
    p.bt_out = (bf16_t*)take((size_t)1024 * 1024 * 2);
    p.H = (bf16_t*)take((size_t)RPAD * 1024 * 2);
    p.praw = (float*)take((size_t)RPAD * NPAD * 4);
    p.qn = (bf16_t*)take((size_t)R * 512 * 2);
    p.kcr = (bf16_t*)take((size_t)TP * 128 * 2); p.vcr = (bf16_t*)take((size_t)TP * 128 * 2);
    p.ks = (bf16_t*)take((size_t)TP * 128 * 2); p.vs = (bf16_t*)take((size_t)TP * 128 * 2);
    p.kw = (bf16_t*)take((size_t)TP * 128 * 2); p.vw = (bf16_t*)take((size_t)TP * 128 * 2);
    p.gates = (float*)take((size_t)R * 24 * 4);
    p.ga = (bf16_t*)take((size_t)R * 512 * 2); p.gr = (bf16_t*)take((size_t)R * 512 * 2);
    p.rq = (bf16_t*)take((size_t)R * 256 * 2); p.rk = (bf16_t*)take((size_t)R * 256 * 2); p.rv = (bf16_t*)take((size_t)R * 512 * 2);
    p.kc = (bf16_t*)take((size_t)4 * 2 * 256 * 64 * 2); p.vc = (bf16_t*)take((size_t)4 * 2 * 256 * 64 * 2);
    p.kcs = (bf16_t*)take((size_t)32 * 2 * 1024 * 64 * 2); p.vcs = (bf16_t*)take((size_t)32 * 2 * 1024 * 64 * 2);
    p.yar = (bf16_t*)take((size_t)RPAD * 1024 * 2);
    p.sloc = (float*)take((size_t)512 * 8192 * 4); p.spre = (float*)take((size_t)512 * 8192 * 4);
    p.oret = (float*)take((size_t)R * 512 * 4);
    p.w1p = (bf16_t*)take((size_t)2 * 128 * 1024 * 2); p.w2t = (bf16_t*)take((size_t)2 * 64 * 64 * 2); p.b1 = (float*)take(128 * 4);
    p.attb = (float*)take(256);
    p.ropec = (float*)take((size_t)4097 * 32 * 4); p.ropes = (float*)take((size_t)4097 * 32 * 4);
    p.seamA = (float*)take((size_t)32 * 2 * 64 * 2 * 64 * 4); p.seamB = (float*)take((size_t)32 * 2 * 64 * 2 * 64 * 4);
    if (off > ws_size) { fprintf(stderr, "workspace too small: need %zu have %zu\n", off, ws_size); return; }
    static int grid = 0;
    if (grid == 0) {
        int dev = 0, cus = 0, per_cu = 0;
        if (hipGetDevice(&dev) != hipSuccess || hipDeviceGetAttribute(&cus, hipDeviceAttributeMultiprocessorCount, dev) != hipSuccess) { fprintf(stderr, "device query failed\n"); grid = -1; return; }
        if (hipFuncSetAttribute((const void*)k_mega, hipFuncAttributeMaxDynamicSharedMemorySize, LDS_BYTES) != hipSuccess) { fprintf(stderr, "hipFuncSetAttribute failed\n"); grid = -1; return; }
        if (hipOccupancyMaxActiveBlocksPerMultiprocessor(&per_cu, (const void*)k_mega, NT, LDS_BYTES) != hipSuccess || per_cu < 1) { fprintf(stderr, "occupancy query: %d blocks per CU\n", per_cu); grid = -1; return; }
        (void)hipGetLastError();
        grid = cus;
    }
    if (grid < 0) return;
    (void)hipMemsetAsync(p.bar, 0, 16384, stream);
    hipLaunchKernelGGL(k_mega, dim3(grid), dim3(NT), LDS_BYTES, stream, p);
}
```

```cpp
#include <hip/hip_runtime.h>
#include <stdint.h>
#include <stdio.h>

namespace {
typedef unsigned short bf16_t;
typedef short bf16x8 __attribute__((ext_vector_type(8)));
typedef float f32x4 __attribute__((ext_vector_type(4)));

constexpr int D_MODEL = 1024, BATCH = 4, SEQ = 4096, DEC_BATCH = 32, PAST = 16384;
constexpr int NPAGES = 128, NPHYS = 5120;
constexpr int TP = BATCH * SEQ;
constexpr int R = TP + DEC_BATCH;
constexpr int RPAD = 16640;
constexpr int D_IN = 3352, NPAD = 3584;
constexpr int C_Q = 0, C_KC = 512, C_KS = 768, C_KW = 1024, C_BR = 1280, C_GA = 1304, C_RQ = 1816, C_RK = 2072, C_RV = 2328, C_GR = 2840;
constexpr float EPS = 1e-6f;
constexpr int NT = 512;
constexpr int LDS_BYTES = 147456 + 64 + 8192 + 256;

struct Params {
    const float *x_prompt, *x_sample, *c_prompt, *c_sample, *cache_cmp, *cache_slc, *state_win, *state_ret;
    const int* page_table;
    const float *g_norm, *w_ada, *b_ada, *w_in, *g_q, *g_kc, *g_ks, *g_kw, *pe_ck, *w_ck1, *w_ck2, *pe_cv, *w_cv1, *w_cv2, *g_ret, *w_out;
    float *y, *p_cmp, *p_slc, *p_win, *p_ret, *s_cmp, *s_slc, *s_win, *s_ret;
    unsigned* bar;
    float* mod;
    bf16_t* bt_in;
    bf16_t* bt_out;
    bf16_t* H;
    float* praw;
    bf16_t* qn;
    bf16_t *kcr, *vcr, *ks, *vs, *kw, *vw;
    float* gates;
    bf16_t *ga, *gr;
    bf16_t *rq, *rk;
    bf16_t* rv;
    bf16_t *kc, *vc;
    bf16_t *kcs, *vcs;
    bf16_t* yar;
    float *sloc, *spre;
    float* oret;
    bf16_t* w1p;
    bf16_t* w2t;
    float* b1;
    float *seamA, *seamB;
    float* attb;
    float *ropec, *ropes;
};

__device__ __forceinline__ int tile_src(int pn) { return pn <= 4 ? pn * 256 : pn == 13 ? 1280 : 1304 + (pn - 5) * 256; }
__device__ __forceinline__ bf16_t f2bf(float f) { unsigned u = __float_as_uint(f); u += 0x7fffu + ((u >> 16) & 1u); return (bf16_t)(u >> 16); }
__device__ __forceinline__ float bf2f(bf16_t h) { return __uint_as_float(((unsigned)h) << 16); }
__device__ __forceinline__ float wave_sum(float v) {
#pragma unroll
    for (int o = 1; o < 64; o <<= 1) v += __shfl_xor(v, o);
    return v;
}
__device__ __forceinline__ float wave_max(float v) {
#pragma unroll
    for (int o = 1; o < 64; o <<= 1) v = fmaxf(v, __shfl_xor(v, o));
    return v;
}
__device__ __forceinline__ float silu(float v) { return v / (1.f + __expf(-v)); }
__device__ __forceinline__ float sigmoidf(float v) { return 1.f / (1.f + __expf(-v)); }
__device__ __forceinline__ int opaque_tid() { int t = threadIdx.x; asm volatile("" : "+v"(t)); return t; }
typedef __bf16 bf16x2_t __attribute__((ext_vector_type(2)));
typedef float f32x2_t __attribute__((ext_vector_type(2)));
__device__ __forceinline__ unsigned cvt_pk_bf16(float lo, float hi) { const f32x2_t v = {lo, hi}; return __builtin_bit_cast(unsigned, __builtin_convertvector(v, bf16x2_t)); }
#define WSYNC() asm volatile("s_waitcnt lgkmcnt(0)" ::: "memory")

__device__ __forceinline__ void load8(const bf16_t* p, float (&f)[8]) {
    uint4 u = *(const uint4*)p;
    f[0] = __uint_as_float(u.x << 16); f[1] = __uint_as_float(u.x & 0xffff0000u);
    f[2] = __uint_as_float(u.y << 16); f[3] = __uint_as_float(u.y & 0xffff0000u);
    f[4] = __uint_as_float(u.z << 16); f[5] = __uint_as_float(u.z & 0xffff0000u);
    f[6] = __uint_as_float(u.w << 16); f[7] = __uint_as_float(u.w & 0xffff0000u);
}
__device__ __forceinline__ void load8(const float* p, float (&f)[8]) {
    float4 a = *(const float4*)p, b = *(const float4*)(p + 4);
    f[0] = a.x; f[1] = a.y; f[2] = a.z; f[3] = a.w; f[4] = b.x; f[5] = b.y; f[6] = b.z; f[7] = b.w;
}
__device__ __forceinline__ float load1(const bf16_t* p) { return bf2f(*p); }
__device__ __forceinline__ float load1(const float* p) { return *p; }


#define XB_TMO      128
#define XB_XCNT(j)  (256  + 64 * (j))
#define XB_XSUB(j)  (1280 + 64 * (j))
#define XB_XGEN(j)  (2304 + 64 * (j))
#define XB_TOP      3328
#define XB_TOPGEN   3392
#define XCD_BAR_WORDS 3456
#define XB_SPIN_CAP (1u << 18)
#define LAS __attribute__((address_space(3)))
__device__ __forceinline__ unsigned xb_ld(unsigned* p)              { return __hip_atomic_load(p, __ATOMIC_RELAXED, __HIP_MEMORY_SCOPE_AGENT); }
__device__ __forceinline__ unsigned xb_add(unsigned* p, unsigned v) { return __hip_atomic_fetch_add(p, v, __ATOMIC_RELAXED, __HIP_MEMORY_SCOPE_AGENT); }
__device__ __forceinline__ unsigned xb_xcc_id() { return (unsigned)__builtin_amdgcn_s_getreg((3 << 11) | 20) & 0xFu; }
#define XB_SPIN(cond, bar) do { unsigned _sp = 0; while (cond) { __builtin_amdgcn_s_sleep(1); \
    if ((++_sp & 255u) == 0u) { if (xb_ld(&(bar)[XB_TMO])) break; if (_sp > XB_SPIN_CAP) { atomicAdd(&(bar)[XB_TMO], 1u); break; } } } } while (0)
struct XcdBarrier { unsigned* bar; unsigned x; volatile LAS unsigned* st; };
__device__ __forceinline__ XcdBarrier xcd_barrier_post(unsigned* bar, volatile LAS unsigned* st) {
    XcdBarrier b; b.bar = bar; b.x = xb_xcc_id(); b.st = st;
    if (threadIdx.x == 0) (void)xb_add(&bar[XB_XCNT(b.x)], 1u);
    return b;
}
__device__ __forceinline__ void xcd_barrier_complete(unsigned* bar, unsigned x, unsigned& nloc, unsigned& nx) {
    const unsigned G = gridDim.x * gridDim.y * gridDim.z;
    unsigned sum, cnt, mine, sp = 0u;
    for (;;) {
        sum = 0u; cnt = 0u; mine = 0u;
#pragma unroll
        for (unsigned j = 0; j < 16; ++j) { const unsigned c = xb_ld(&bar[XB_XCNT(j)]); sum += c; cnt += (c > 0u) ? 1u : 0u; mine = (j == x) ? c : mine; }
        if (sum == G) break;
        __builtin_amdgcn_s_sleep(1);
        if ((++sp & 255u) == 0u) { if (xb_ld(&bar[XB_TMO])) break; if (sp > XB_SPIN_CAP) { atomicAdd(&bar[XB_TMO], 1u); break; } }
    }
    nloc = mine > 0u ? mine : 1u; nx = cnt > 0u ? cnt : 1u;
}
__device__ __forceinline__ void xcd_barrier(const XcdBarrier& b) {
    asm volatile("s_waitcnt vmcnt(0)" ::: "memory");
    __syncthreads();
    if (threadIdx.x == 0) {
        unsigned* bar = b.bar;
        __builtin_amdgcn_s_waitcnt(0);
        unsigned nloc = b.st[0], nx = b.st[1];
        if (nloc == 0u) { xcd_barrier_complete(bar, b.x, nloc, nx); b.st[0] = nloc; b.st[1] = nx; }
        const unsigned old = xb_add(&bar[XB_XSUB(b.x)], 1u);
        const unsigned gen = old / nloc;
        if (old + 1u == (gen + 1u) * nloc) {
            __builtin_amdgcn_fence(__ATOMIC_RELEASE, "agent");
            asm volatile("s_waitcnt vmcnt(0)" ::: "memory");
            const unsigned og = xb_add(&bar[XB_TOP], 1u);
            const unsigned tg = og / nx;
            if (og + 1u == (tg + 1u) * nx) xb_add(&bar[XB_TOPGEN], 1u);
            else XB_SPIN(xb_ld(&bar[XB_TOPGEN]) == tg, bar);
            __builtin_amdgcn_fence(__ATOMIC_ACQUIRE, "agent");
            xb_add(&bar[XB_XGEN(b.x)], 1u);
            asm volatile("s_waitcnt vmcnt(0)" ::: "memory");
        } else {
            XB_SPIN(xb_ld(&bar[XB_XGEN(b.x)]) == gen, bar);
            __builtin_amdgcn_fence(__ATOMIC_ACQUIRE, "agent");
            asm volatile("s_waitcnt vmcnt(0)" ::: "memory");
        }
    }
    __syncthreads();
}


__device__ __forceinline__ void wg_signal(unsigned* ctr, bool need_release) {
    asm volatile("s_waitcnt vmcnt(0)" ::: "memory");
    __syncthreads();
    if (threadIdx.x == 0) {
        if (need_release) { __builtin_amdgcn_fence(__ATOMIC_RELEASE, "agent"); asm volatile("s_waitcnt vmcnt(0)" ::: "memory"); }
        (void)__hip_atomic_fetch_add(ctr, 1u, __ATOMIC_RELAXED, __HIP_MEMORY_SCOPE_AGENT);
    }
}
__device__ __forceinline__ void wg_wait(unsigned* ctr, unsigned target, unsigned* tmo) {
    if (threadIdx.x == 0) {
        unsigned sp = 0;
        while (__hip_atomic_load(ctr, __ATOMIC_RELAXED, __HIP_MEMORY_SCOPE_AGENT) < target) {
            __builtin_amdgcn_s_sleep(2);
            if (++sp > (1u << 22)) { atomicAdd(tmo, 1u); break; }
        }
        __builtin_amdgcn_fence(__ATOMIC_ACQUIRE, "agent");
        asm volatile("s_waitcnt vmcnt(0)" ::: "memory");
    }
    __syncthreads();
}
__device__ __forceinline__ void p0_adaln(const Params& p, char* lds, int bid, int nblk) {
    float* sc = (float*)lds;
    float* red = (float*)(lds + 73728);
    const int tid = opaque_tid(), lane = tid & 63, wave = tid >> 6;
    for (int item = bid; item < 192; item += nblk) {
        const int cb = item >> 2, r0 = (item & 3) * 9;
        __syncthreads();
        {
            float cv[18];
#pragma unroll
            for (int u = 0; u < 18; ++u) { const int i = tid + u * NT, row = r0 + (i >> 10), k = i & 1023; cv[u] = row < 4 ? p.c_prompt[row * 1024 + k] : p.c_sample[(row - 4) * 1024 + k]; }
#pragma unroll
            for (int u = 0; u < 18; ++u) sc[tid + u * NT] = silu(cv[u]);
        }
        __syncthreads();
        const int j = cb * 64 + lane;
        float acc[9];
#pragma unroll
        for (int r = 0; r < 9; ++r) acc[r] = 0.f;
        const int k0 = wave * 128;
#pragma unroll 8
        for (int k = k0; k < k0 + 128; k += 4) {
            const float w0 = p.w_ada[(size_t)k * 3072 + j], w1 = p.w_ada[(size_t)(k + 1) * 3072 + j], w2 = p.w_ada[(size_t)(k + 2) * 3072 + j], w3 = p.w_ada[(size_t)(k + 3) * 3072 + j];
#pragma unroll
            for (int r = 0; r < 9; ++r) { const float4 s = *(const float4*)(sc + r * 1024 + k); acc[r] += s.x * w0 + s.y * w1 + s.z * w2 + s.w * w3; }
        }
#pragma unroll
        for (int r = 0; r < 9; ++r) red[(wave * 9 + r) * 64 + lane] = acc[r];
        __syncthreads();
        for (int i = tid; i < 9 * 64; i += NT) {
            const int r = i >> 6, l = i & 63;
            float s = 0.f;
#pragma unroll
            for (int w = 0; w < 8; ++w) s += red[(w * 9 + r) * 64 + l];
            __hip_atomic_store(&p.mod[(r0 + r) * 3072 + cb * 64 + l], s + p.b_ada[cb * 64 + l], __ATOMIC_RELAXED, __HIP_MEMORY_SCOPE_AGENT);
        }
        wg_signal(p.bar + 3520, false);
    }
}

__device__ __forceinline__ void transpose_item(const float* W, int K, int N, bf16_t* WT, float* scr, int item, int lane, int nblkN) {
    const int kb = item / nblkN, nb = item % nblkN, k0 = kb * 64, n0 = nb * 64;
    float tv[64];
#pragma unroll
    for (int kk = 0; kk < 64; ++kk) tv[kk] = (n0 + lane < N) ? W[(size_t)(k0 + kk) * N + n0 + lane] : 0.f;
#pragma unroll
    for (int kk = 0; kk < 64; ++kk) scr[kk * 65 + lane] = tv[kk];
    WSYNC();
    for (int nn = 0; nn < 64; ++nn) WT[(size_t)(n0 + nn) * K + k0 + lane] = f2bf(scr[lane * 65 + nn]);
    WSYNC();
}
__device__ __forceinline__ void p0_w1p(const Params& p, int bid, int nblk) {
    const size_t gt = (size_t)bid * NT + opaque_tid(), ngt = (size_t)nblk * NT;
    for (size_t i = gt; i < (size_t)2 * 128 * 1024; i += ngt) {
        const int kv = (int)(i >> 17), n = (int)(i >> 10) & 127, kp = (int)i & 1023;
        const int ks = kp >> 5, G = (kp >> 3) & 3, j = kp & 7;
        const int k = ks * 32 + 16 * (j >> 2) + 4 * G + (j & 3);
        const int l = (k >> 6) + (n >= 64 ? 16 : 0), d = k & 63, f = n & 63;
        p.w1p[i] = f2bf((kv ? p.w_cv1 : p.w_ck1)[(size_t)(l * 64 + d) * 64 + f]);
    }
}
__device__ __forceinline__ void p0_weights(const Params& p, char* lds, int bid, int nblk) {
    const int tid = opaque_tid(), lane = tid & 63, wave = tid >> 6;
    float* scr = (float*)lds + wave * (64 * 65);
    const int gw = bid * 8 + wave, ngw = nblk * 8;
    constexpr int I_IN = 16 * 112, I_OUT = 16 * 16;
    for (int it = gw; it < I_IN + I_OUT; it += ngw) {
        if (it < I_IN) {
            const int kb = it / 112, nb = it % 112, k0 = kb * 64, n0 = nb * 32;
            const int pn = n0 >> 8, pl = n0 & 255, bj = pl >> 7, wc = (pl >> 5) & 3;
            const int cb = tile_src(pn) + wc * 64 + bj * 32;
            const int lim = pn == 13 ? 1304 : D_IN;
            float tv[32];
#pragma unroll
            for (int i = 0; i < 32; ++i) { const int kk = 2 * i + (lane >> 5), c = cb + (lane & 31); tv[i] = c < lim ? p.w_in[(size_t)(k0 + kk) * D_IN + c] : 0.f; }
#pragma unroll
            for (int i = 0; i < 32; ++i) scr[(2 * i + (lane >> 5)) * 33 + (lane & 31)] = tv[i];
            WSYNC();
            const int c8 = lane & 7;
            for (int j = 0; j < 4; ++j) {
                const int n = (lane >> 3) + 8 * j; const float* s = scr + (8 * c8) * 33 + n;
                uint4 o; o.x = cvt_pk_bf16(s[0], s[33]); o.y = cvt_pk_bf16(s[66], s[99]); o.z = cvt_pk_bf16(s[132], s[165]); o.w = cvt_pk_bf16(s[198], s[231]);
                *(uint4*)(p.bt_in + (size_t)(n0 + n) * 1024 + k0 + 8 * c8) = o;
            }
            WSYNC();
        } else transpose_item(p.w_out, 1024, 1024, p.bt_out, scr, it - I_IN, lane, 16);
    }
    const size_t gt = (size_t)bid * NT + tid, ngt = (size_t)nblk * NT;
    for (size_t i = gt; i < (size_t)4097 * 32; i += ngt) {
        const int pi = (int)(i >> 5), fi = (int)i & 31;
        const float ang = (float)(pi < 4096 ? pi : PAST) * powf(10000.f, -(float)fi / 32.f);
        float sn, cs; sincosf(ang, &sn, &cs);
        p.ropec[i] = cs; p.ropes[i] = sn;
    }
    if (bid == (nblk > 200 ? 200 : 0) && wave == 0) {
        const float gq = wave_max(fabsf(p.g_q[lane])), gc = wave_max(fabsf(p.g_kc[lane])), gs = wave_max(fabsf(p.g_ks[lane])), gw = wave_max(fabsf(p.g_kw[lane]));
        if (lane == 0) { const float k = 8.f * 1.03f * 1.44269504088896f * gq; p.attb[0] = k * gc; p.attb[1] = k * gs; p.attb[2] = k * gw; p.attb[3] = 0.f; }
    }
    for (size_t i = gt; i < (size_t)2 * 64 * 64; i += ngt) {
        const int kv = (int)(i >> 12), d = (int)(i >> 6) & 63, f = (int)i & 63;
        p.w2t[i] = f2bf((kv ? p.w_cv2 : p.w_ck2)[f * 64 + d]);
    }
    for (size_t i = gt; i < (size_t)2 * 8 * 64; i += ngt) {
        const int which = (int)(i >> 9), bg = (int)(i >> 6) & 7, d = (int)i & 63;
        (which ? p.vc : p.kc)[((size_t)bg * 256 + 255) * 64 + d] = 0;
    }
    {
        constexpr int NW = 32 * 511 * 64;
        const int gti = (int)gt, ngti = (int)ngt;
#define SW_SRC(i) (p.state_win + (size_t)((i) / (511 * 64)) * 512 * 256 + 256 + (size_t)((i) % (511 * 64)) * 4)
#define SW_DST(i) (p.s_win + (size_t)((i) / (511 * 64)) * 512 * 256 + (size_t)((i) % (511 * 64)) * 4)
#define SW_LD(j) const int ix##j = ib + j * ngti, cx##j = ix##j < NW ? ix##j : NW - 1; const float4 vx##j = *(const float4*)SW_SRC(cx##j);
#define SW_ST(j) if (ix##j < NW) *(float4*)SW_DST(ix##j) = vx##j;
        for (int ib = gti; ib < NW; ib += 8 * ngti) {
            SW_LD(0) SW_LD(1) SW_LD(2) SW_LD(3) SW_LD(4) SW_LD(5) SW_LD(6) SW_LD(7)
            SW_ST(0) SW_ST(1) SW_ST(2) SW_ST(3) SW_ST(4) SW_ST(5) SW_ST(6) SW_ST(7)
        }
#undef SW_SRC
#undef SW_DST
#undef SW_LD
#undef SW_ST
    }
}

__device__ __forceinline__ void p1_norm(const Params& p, char* lds, int bid, int nblk) {
    const int tid = opaque_tid(), lane = tid & 63, wave = tid >> 6;
    volatile int* slot = (volatile int*)(lds + 147456 + 16);
    for (;;) {
        __syncthreads();
        if (tid == 0) *slot = (int)__hip_atomic_fetch_add(p.bar + 3456 + 32, 1u, __ATOMIC_RELAXED, __HIP_MEMORY_SCOPE_AGENT);
        __syncthreads();
        const int chunk = *slot;
        if (chunk * 32 >= R) break;
        if (chunk * 32 < TP) {
            const float* shift = p.mod + (chunk >> 7) * 3072, *scale = shift + 1024;
            const int rw = chunk * 32 + wave;
            float4 v[4][4], g[4], sc[4], sh[4];
#pragma unroll
            for (int q = 0; q < 4; ++q)
#pragma unroll
                for (int j = 0; j < 4; ++j) v[q][j] = *(const float4*)(p.x_prompt + (size_t)(rw + 8 * q) * 1024 + j * 256 + lane * 4);
#pragma unroll
            for (int j = 0; j < 4; ++j) { const int c = j * 256 + lane * 4; g[j] = *(const float4*)(p.g_norm + c); sc[j] = *(const float4*)(scale + c); sh[j] = *(const float4*)(shift + c); }
#pragma unroll
            for (int q = 0; q < 4; ++q) {
                float ss = 0.f;
#pragma unroll
                for (int j = 0; j < 4; ++j) ss += v[q][j].x * v[q][j].x + v[q][j].y * v[q][j].y + v[q][j].z * v[q][j].z + v[q][j].w * v[q][j].w;
                const float rs = rsqrtf(wave_sum(ss) * (1.f / 1024.f) + EPS);
#pragma unroll
                for (int j = 0; j < 4; ++j) {
                    ushort4 o;
                    o.x = f2bf(v[q][j].x * rs * g[j].x * (1.f + sc[j].x) + sh[j].x);
                    o.y = f2bf(v[q][j].y * rs * g[j].y * (1.f + sc[j].y) + sh[j].y);
                    o.z = f2bf(v[q][j].z * rs * g[j].z * (1.f + sc[j].z) + sh[j].z);
                    o.w = f2bf(v[q][j].w * rs * g[j].w * (1.f + sc[j].w) + sh[j].w);
                    *(ushort4*)(p.H + (size_t)(rw + 8 * q) * 1024 + j * 256 + lane * 4) = o;
                }
            }
            continue;
        }
      for (int r = chunk * 32 + wave; r < R && r < chunk * 32 + 32; r += 8) {
        const float* xr = r < TP ? p.x_prompt + (size_t)r * 1024 : p.x_sample + (size_t)(r - TP) * 1024;
        const int mrow = r < TP ? (r >> 12) : 4 + (r - TP);
        const float* shift = p.mod + mrow * 3072, *scale = shift + 1024;
        float4 v[4]; float ss = 0.f;
#pragma unroll
        for (int j = 0; j < 4; ++j) { v[j] = *(const float4*)(xr + j * 256 + lane * 4); ss += v[j].x * v[j].x + v[j].y * v[j].y + v[j].z * v[j].z + v[j].w * v[j].w; }
        const float rs = rsqrtf(wave_sum(ss) * (1.f / 1024.f) + EPS);
#pragma unroll
        for (int j = 0; j < 4; ++j) {
            const int c = j * 256 + lane * 4;
            const float4 g = *(const float4*)(p.g_norm + c), sc = *(const float4*)(scale + c), sh = *(const float4*)(shift + c);
            ushort4 o;
            o.x = f2bf(v[j].x * rs * g.x * (1.f + sc.x) + sh.x);
            o.y = f2bf(v[j].y * rs * g.y * (1.f + sc.y) + sh.y);
            o.z = f2bf(v[j].z * rs * g.z * (1.f + sc.z) + sh.z);
            o.w = f2bf(v[j].w * rs * g.w * (1.f + sc.w) + sh.w);
            *(ushort4*)(p.H + (size_t)r * 1024 + c) = o;
        }
      }
    }
}

constexpr int BM = 256, BK = 64, HALF = 128, HT = HALF * BK;
__device__ __forceinline__ int lds_byte(int r, int c) {
    int st = (r >> 4) * 2 + (c >> 5), rr = r & 15, cc = c & 31, ob = rr * 64 + cc * 2;
    return st * 1024 + (ob ^ (((ob >> 9) & 1) << 5));
}
__device__ __forceinline__ void stage_rc(int b, int& Rr, int& Cc) {
    int st = b / 1024, sb = b % 1024, swz = sb ^ (((sb >> 9) & 1) << 5);
    Rr = (st >> 1) * 16 + swz / 64; Cc = (st & 1) * 32 + (swz % 64) / 2;
}

template <class Epi>
__device__ __forceinline__ void gemm_phase(const bf16_t* __restrict__ A, const bf16_t* __restrict__ Bt, int nM, int nN, int K, char* lds, int bid, int nblk, const Epi& epi) {
    bf16_t* shm = (bf16_t*)lds;
#define SA(b, h) (shm + ((b) * 2 + (h)) * HT)
#define SB(b, h) (shm + (4 + (b) * 2 + (h)) * HT)
#define STAGE_X(T, P, BASE, br, kt) do { long _g = (long)(br) * K + (long)(kt) * BK; \
    for (int _i = 0; _i < 2; ++_i) { int _b = (T) * 16 + _i * 8192; int _r, _c; stage_rc(_b, _r, _c); \
      __builtin_amdgcn_global_load_lds((const unsigned*)(BASE + _g + (long)_r * K + _c), \
        (__attribute__((address_space(3))) unsigned*)((char*)(P) + _b), 16, 0, 0); } } while (0)
#define STAGE(P, BASE, br, kt) STAGE_X(tz0, P, BASE, br, kt)
#define LDA(dst, b, h) for (int m = 0; m < 4; ++m) for (int k = 0; k < 2; ++k) \
    dst[m][k] = *reinterpret_cast<const bf16x8*>((char*)SA(b, h) + lds_byte(wr * 64 + m * 16 + fr, k * 32 + fq * 8))
#define LDB(dst, b, h) for (int n = 0; n < 2; ++n) for (int k = 0; k < 2; ++k) \
    dst[n][k] = *reinterpret_cast<const bf16x8*>((char*)SB(b, h) + lds_byte(wc * 32 + n * 16 + fr, k * 32 + fq * 8))
#define MMA(ai, bj, At, Bt_) do { __builtin_amdgcn_s_setprio(1); \
    for (int m = 0; m < 4; ++m) for (int n = 0; n < 2; ++n) for (int k = 0; k < 2; ++k) \
      acc[ai][bj][m][n] = __builtin_amdgcn_mfma_f32_16x16x32_bf16(Bt_[n][k], At[m][k], acc[ai][bj][m][n], 0, 0, 0); \
    __builtin_amdgcn_s_setprio(0); } while (0)
#define WAIT_V(n) asm volatile("s_waitcnt vmcnt(" #n ")" ::: "memory")
#define WAIT_L(n) asm volatile("s_waitcnt lgkmcnt(" #n ")" ::: "memory")
#define BAR __builtin_amdgcn_s_barrier()
#define SCHED __builtin_amdgcn_sched_barrier(0)
    const int nwg = nM * nN;
    for (int tile = bid; tile < nwg; tile += nblk) {
        const int pm = tile / nN, pn = tile % nN;
        const int brow = pm * BM, bcol = pn * BM;
        int tz0 = threadIdx.x; asm volatile("" : "+v"(tz0));
        int wid = tz0 >> 6, lane = tz0 & 63, wr = wid >> 2, wc = wid & 3, fr = lane & 15, fq = lane >> 4;
        f32x4 acc[2][2][4][2] = {};
        bf16x8 At[4][2], B0[2][2], B1[2][2];
        const int nt = K / BK;
        STAGE(SB(0, 0), Bt, bcol, 0); STAGE(SA(0, 0), A, brow, 0);
        STAGE(SB(0, 1), Bt, bcol + HALF, 0); STAGE(SA(0, 1), A, brow + HALF, 0);
        if (wr == 1) BAR;
        WAIT_V(4); BAR;
        STAGE(SB(1, 0), Bt, bcol, 1); STAGE(SA(1, 0), A, brow, 1); STAGE(SB(1, 1), Bt, bcol + HALF, 1);
        WAIT_V(6); BAR;
        for (int t = 0; t < nt - 2; t += 2) {
            LDB(B0, 0, 0); SCHED; LDA(At, 0, 0); STAGE(SA(1, 1), A, brow + HALF, t + 1);
            WAIT_L(8); BAR; WAIT_L(0); MMA(0, 0, At, B0); BAR; SCHED;
            LDB(B1, 0, 1); STAGE(SB(0, 0), Bt, bcol, t + 2);
            BAR; WAIT_L(0); MMA(0, 1, At, B1); BAR;
            LDA(At, 0, 1); STAGE(SA(0, 0), A, brow, t + 2);
            BAR; WAIT_L(0); MMA(1, 0, At, B0); BAR; SCHED;
            STAGE(SB(0, 1), Bt, bcol + HALF, t + 2);
            WAIT_V(6); BAR; MMA(1, 1, At, B1); BAR;
            LDB(B0, 1, 0); SCHED; LDA(At, 1, 0); STAGE(SA(0, 1), A, brow + HALF, t + 2);
            WAIT_L(8); BAR; WAIT_L(0); MMA(0, 0, At, B0); BAR; SCHED;
            LDB(B1, 1, 1); STAGE(SB(1, 0), Bt, bcol, t + 3);
            BAR; WAIT_L(0); MMA(0, 1, At, B1); BAR;
            LDA(At, 1, 1); STAGE(SA(1, 0), A, brow, t + 3);
            BAR; WAIT_L(0); MMA(1, 0, At, B0); BAR; SCHED;
            STAGE(SB(1, 1), Bt, bcol + HALF, t + 3);
            WAIT_V(6); BAR; MMA(1, 1, At, B1); BAR;
        }
        int tz = threadIdx.x; asm volatile("" : "+v"(tz)); wid = tz >> 6; lane = tz & 63; wr = wid >> 2; wc = wid & 3; fr = lane & 15; fq = lane >> 4;
        { LDB(B0, 0, 0); WAIT_V(0); LDA(At, 0, 0); STAGE_X(tz, SA(1, 1), A, brow + HALF, nt - 1);
          BAR; WAIT_L(0); MMA(0, 0, At, B0); BAR;
          LDB(B1, 0, 1); BAR; WAIT_L(0); MMA(0, 1, At, B1); BAR;
          LDA(At, 0, 1); WAIT_V(4); BAR; WAIT_L(0); MMA(1, 0, At, B0); MMA(1, 1, At, B1); BAR; }
        { LDB(B0, 1, 0); LDA(At, 1, 0); WAIT_V(2); BAR; WAIT_L(0); MMA(0, 0, At, B0); BAR;
          LDB(B1, 1, 1); WAIT_V(0); BAR; WAIT_L(0); MMA(0, 1, At, B1); BAR;
          LDA(At, 1, 1); BAR; WAIT_L(0); MMA(1, 0, At, B0); MMA(1, 1, At, B1); BAR; }
        if (wr == 0) BAR;
        epi(acc, brow, bcol, wr, wc, fr, fq);
    }
#undef SA
#undef SB
#undef STAGE_X
#undef STAGE
#undef LDA
#undef LDB
#undef MMA
}

struct EpiOut {
    const Params* p;
    __device__ __forceinline__ void operator()(const f32x4 (&acc)[2][2][4][2], int brow, int bcol, int wr, int wc, int fr, int fq) const {
#pragma unroll
        for (int ai = 0; ai < 2; ++ai)
#pragma unroll
            for (int mt = 0; mt < 4; ++mt) {
                const int r = brow + ai * HALF + wr * 64 + mt * 16 + fr;
                if (r < R) {
                    const float* xr = r < TP ? p->x_prompt + (size_t)r * 1024 : p->x_sample + (size_t)(r - TP) * 1024;
                    const float* gate = p->mod + (r < TP ? (r >> 12) : 4 + (r - TP)) * 3072 + 2048;
#pragma unroll
                    for (int bj = 0; bj < 2; ++bj)
#pragma unroll
                        for (int nt = 0; nt < 2; ++nt) {
                            const int c = bcol + bj * HALF + wc * 32 + nt * 16 + 4 * fq;
                            const float4 xv = *(const float4*)(xr + c), gv = *(const float4*)(gate + c);
                            float4 o; o.x = xv.x + gv.x * acc[ai][bj][mt][nt][0]; o.y = xv.y + gv.y * acc[ai][bj][mt][nt][1];
                            o.z = xv.z + gv.z * acc[ai][bj][mt][nt][2]; o.w = xv.w + gv.w * acc[ai][bj][mt][nt][3];
                            *(float4*)(p->y + (size_t)r * 1024 + c) = o;
                        }
                }
            }
    }
};

struct EpiIn {
    const Params* p;
    __device__ __forceinline__ void operator()(const f32x4 (&acc)[2][2][4][2], int brow, int bcol, int wr, int wc, int fr, int fq) const {
        const int pn = bcol >> 8;
        const Params& P = *p;
        const bool normt = pn <= 1 || ((pn == 3 || pn == 4) && wc < 2);
        float4 g4h[2][2];
        { const float* gn = pn <= 1 ? P.g_q : pn == 3 ? P.g_ks : P.g_kw;
#pragma unroll
          for (int bj = 0; bj < 2; ++bj)
#pragma unroll
            for (int nt = 0; nt < 2; ++nt) g4h[bj][nt] = normt ? *(const float4*)(gn + bj * 32 + nt * 16 + 4 * fq) : make_float4(1.f, 1.f, 1.f, 1.f); }
#pragma unroll
        for (int ai = 0; ai < 2; ++ai)
#pragma unroll
            for (int mt = 0; mt < 4; ++mt) {
                const int r = brow + ai * HALF + wr * 64 + mt * 16 + fr;
                const bool rowok = r < R;
                const bool isp = r < TP;
                const int b = isp ? (r >> 12) : (r - TP), t = isp ? (r & 4095) : 0, pidx = isp ? t : 4096;
                f32x4 v[2][2];
#pragma unroll
                for (int bj = 0; bj < 2; ++bj)
#pragma unroll
                    for (int nt = 0; nt < 2; ++nt) v[bj][nt] = acc[ai][bj][mt][nt];
                if (normt) {
                    float ss = 0.f;
#pragma unroll
                    for (int bj = 0; bj < 2; ++bj)
#pragma unroll
                        for (int nt = 0; nt < 2; ++nt)
#pragma unroll
                            for (int rg = 0; rg < 4; ++rg) ss += v[bj][nt][rg] * v[bj][nt][rg];
                    ss += __shfl_xor(ss, 16); ss += __shfl_xor(ss, 32);
                    const float rs = rsqrtf(ss * (1.f / 64.f) + EPS);
#pragma unroll
                    for (int bj = 0; bj < 2; ++bj)
#pragma unroll
                        for (int nt = 0; nt < 2; ++nt) {
                            const float4 g4 = g4h[bj][nt];
                            v[bj][nt][0] *= rs * g4.x; v[bj][nt][1] *= rs * g4.y; v[bj][nt][2] *= rs * g4.z; v[bj][nt][3] *= rs * g4.w;
                        }
                }
                if (!rowok) continue;
                if (pn == 7 || pn == 8) {
                    const float lgm = __log2f(1.f - exp2f(-5.f - (float)wc)) * (float)((isp ? t : PAST) & 127);
                    const float sc = pn == 7 ? exp2f(lgm) : 0.125f * exp2f(-lgm);
#pragma unroll
                    for (int nt = 0; nt < 2; ++nt) {
                        const float4 c4 = *(const float4*)(P.ropec + (size_t)pidx * 32 + nt * 16 + 4 * fq), s4 = *(const float4*)(P.ropes + (size_t)pidx * 32 + nt * 16 + 4 * fq);
                        const f32x4 x1 = v[0][nt], x2 = v[1][nt];
                        v[0][nt][0] = (x1[0] * c4.x - x2[0] * s4.x) * sc; v[1][nt][0] = (x1[0] * s4.x + x2[0] * c4.x) * sc;
                        v[0][nt][1] = (x1[1] * c4.y - x2[1] * s4.y) * sc; v[1][nt][1] = (x1[1] * s4.y + x2[1] * c4.y) * sc;
                        v[0][nt][2] = (x1[2] * c4.z - x2[2] * s4.z) * sc; v[1][nt][2] = (x1[2] * s4.z + x2[2] * c4.z) * sc;
                        v[0][nt][3] = (x1[3] * c4.w - x2[3] * s4.w) * sc; v[1][nt][3] = (x1[3] * s4.w + x2[3] * c4.w) * sc;
                    }
                }
                if (pn == 5 || pn == 6 || pn == 11 || pn == 12) {
#pragma unroll
                    for (int bj = 0; bj < 2; ++bj)
#pragma unroll
                        for (int nt = 0; nt < 2; ++nt)
#pragma unroll
                            for (int rg = 0; rg < 4; ++rg) v[bj][nt][rg] = silu(v[bj][nt][rg]);
                }
                bf16_t* bdst = nullptr; float* fdst = nullptr;
                if (pn <= 1) bdst = P.qn + (size_t)r * 512 + (pn * 4 + wc) * 64;
                else if (pn == 2) fdst = (isp ? P.p_cmp + (size_t)r * 256 : P.s_cmp + (size_t)b * 256) + wc * 64;
                else if (pn == 3) { fdst = (isp ? P.p_slc + (size_t)r * 256 : P.s_slc + (size_t)b * 256) + wc * 64;
                                    if (isp) bdst = (wc < 2 ? P.ks : P.vs) + ((size_t)(b * 2 + (wc & 1)) * SEQ + t) * 64; }
                else if (pn == 4) { fdst = isp ? (t >= SEQ - 512 ? P.p_win + ((size_t)b * 512 + (t - (SEQ - 512))) * 256 + wc * 64 : nullptr) : P.s_win + ((size_t)b * 512 + 511) * 256 + wc * 64;
                                    if (isp) bdst = (wc < 2 ? P.kw : P.vw) + ((size_t)(b * 2 + (wc & 1)) * SEQ + t) * 64; }
                else if (pn == 5 || pn == 6) bdst = P.ga + (size_t)r * 512 + (pn - 5) * 256 + wc * 64;
                else if (pn == 7) bdst = P.rq + (size_t)r * 256 + wc * 64;
                else if (pn == 8) bdst = P.rk + (size_t)r * 256 + wc * 64;
                else if (pn == 9 || pn == 10) bdst = P.rv + (size_t)r * 512 + (pn - 9) * 256 + wc * 64;
                else if (pn == 11 || pn == 12) bdst = P.gr + (size_t)r * 512 + (pn - 11) * 256 + wc * 64;
                if (pn == 13) {
                    if (wc == 0) {
                        float* gd = P.gates + (size_t)r * 24;
                        { float4 o; o.x = sigmoidf(v[0][0][0]); o.y = sigmoidf(v[0][0][1]); o.z = sigmoidf(v[0][0][2]); o.w = sigmoidf(v[0][0][3]); *(float4*)(gd + 4 * fq) = o; }
                        if (fq < 2) { float4 o; o.x = sigmoidf(v[0][1][0]); o.y = sigmoidf(v[0][1][1]); o.z = sigmoidf(v[0][1][2]); o.w = sigmoidf(v[0][1][3]); *(float4*)(gd + 16 + 4 * fq) = o; }
                    }
                    continue;
                }
#pragma unroll
                for (int bj = 0; bj < 2; ++bj)
#pragma unroll
                    for (int nt = 0; nt < 2; ++nt) {
                        const int cl = bj * 32 + nt * 16 + 4 * fq;
                        if (fdst) { float4 o; o.x = v[bj][nt][0]; o.y = v[bj][nt][1]; o.z = v[bj][nt][2]; o.w = v[bj][nt][3]; *(float4*)(fdst + cl) = o; }
                        if (bdst) { uint2 o; o.x = cvt_pk_bf16(v[bj][nt][0], v[bj][nt][1]); o.y = cvt_pk_bf16(v[bj][nt][2], v[bj][nt][3]); *(uint2*)(bdst + cl) = o; }
                    }
            }
    }
};

__device__ __forceinline__ void p3_rows(const Params& p, int bid, int nblk) {
    const int tid = opaque_tid(), lane = tid & 63, wave = tid >> 6;
    for (int r = bid * 8 + wave; r < R; r += nblk * 8) {
        const float* pr = p.praw + (size_t)r * NPAD;
        const bool isp = r < TP;
        const int b = isp ? (r >> 12) : (r - TP), t = isp ? (r & 4095) : 0;
        const int pos = isp ? t : PAST;
        {
            const float gq = p.g_q[lane];
            for (int hh = 0; hh < 8; ++hh) {
                const float v = pr[C_Q + hh * 64 + lane];
                const float rs = rsqrtf(wave_sum(v * v) * (1.f / 64.f) + EPS);
                p.qn[(size_t)r * 512 + hh * 64 + lane] = f2bf(v * rs * gq);
            }
        }
        float* o_cmp = isp ? p.p_cmp + (size_t)r * 256 : p.s_cmp + (size_t)b * 256;
        float* o_slc = isp ? p.p_slc + (size_t)r * 256 : p.s_slc + (size_t)b * 256;
        float* o_win = isp ? (t >= SEQ - 512 ? p.p_win + ((size_t)b * 512 + (t - (SEQ - 512))) * 256 : nullptr) : p.s_win + ((size_t)b * 512 + 511) * 256;
        for (int j = 0; j < 4; ++j) {
            const int g = j & 1;
            const size_t cidx = ((size_t)(b * 2 + g) * SEQ + t) * 64 + lane;
            {
                const float v = pr[C_KC + j * 64 + lane];
                o_cmp[j * 64 + lane] = v;
                if (isp) { if (j < 2) p.kcr[cidx] = f2bf(v); else p.vcr[cidx] = f2bf(v); }
            }
            {
                float v = pr[C_KS + j * 64 + lane];
                if (j < 2) { const float rs = rsqrtf(wave_sum(v * v) * (1.f / 64.f) + EPS); v = v * rs * p.g_ks[lane]; }
                o_slc[j * 64 + lane] = v;
                if (isp) { if (j < 2) p.ks[cidx] = f2bf(v); else p.vs[cidx] = f2bf(v); }
            }
            {
                float v = pr[C_KW + j * 64 + lane];
                if (j < 2) { const float rs = rsqrtf(wave_sum(v * v) * (1.f / 64.f) + EPS); v = v * rs * p.g_kw[lane]; }
                if (o_win) o_win[j * 64 + lane] = v;
                if (isp) { if (j < 2) p.kw[cidx] = f2bf(v); else p.vw[cidx] = f2bf(v); }
            }
        }
        if (lane < 24) p.gates[(size_t)r * 24 + lane] = sigmoidf(pr[C_BR + lane]);
        for (int i = 0; i < 8; ++i) {
            p.ga[(size_t)r * 512 + i * 64 + lane] = f2bf(silu(pr[C_GA + i * 64 + lane]));
            p.gr[(size_t)r * 512 + i * 64 + lane] = f2bf(silu(pr[C_GR + i * 64 + lane]));
            p.rv[(size_t)r * 512 + i * 64 + lane] = f2bf(pr[C_RV + i * 64 + lane]);
        }
        {
            const int i = lane & 31;
            const float freq = powf(10000.f, -(float)i / 32.f);
            const float ang = (float)pos * freq;
            float sn, cs; sincosf(ang, &sn, &cs);
            for (int hh = 0; hh < 4; ++hh) {
                const float a = pr[C_RQ + hh * 64 + lane], ao = pr[C_RQ + hh * 64 + (lane ^ 32)];
                const float kq = pr[C_RK + hh * 64 + lane], ko = pr[C_RK + hh * 64 + (lane ^ 32)];
                const float oq = lane < 32 ? a * cs - ao * sn : ao * sn + a * cs;
                const float ok = lane < 32 ? kq * cs - ko * sn : ko * sn + kq * cs;
                const float lgm = __log2f(1.f - exp2f(-5.f - (float)hh)) * (float)(pos & 127);
                p.rq[(size_t)r * 256 + hh * 64 + lane] = f2bf(oq * exp2f(lgm));
                p.rk[(size_t)r * 256 + hh * 64 + lane] = f2bf(ok * 0.125f * exp2f(-lgm));
            }
        }
    }
}

typedef unsigned u32x4 __attribute__((ext_vector_type(4)));

struct CmpTile {
    int active;
    int b, c0;
    int seam_idx;
    int is_sample;
};

__device__ __forceinline__ void cmp_second_layer(const Params& p, int kv, const f32x4 (&pre)[4], bf16_t* hb  , const bf16_t* w2s  , bf16_t* dst  , int lane) {
    const int fr = lane & 15, G = lane >> 4;
#pragma unroll
    for (int nt = 0; nt < 4; ++nt)
#pragma unroll
        for (int r = 0; r < 4; ++r) hb[(G * 4 + r) * 64 + nt * 16 + fr] = f2bf(silu(pre[nt][r]));
    WSYNC();
    bf16x8 hf[2];
#pragma unroll
    for (int ks = 0; ks < 2; ++ks) hf[ks] = *(const bf16x8*)(hb + fr * 64 + ks * 32 + G * 8);
    f32x4 out[4];
#pragma unroll
    for (int nt = 0; nt < 4; ++nt) {
        out[nt] = (f32x4){0.f, 0.f, 0.f, 0.f};
#pragma unroll
        for (int ks = 0; ks < 2; ++ks) {
            const bf16x8 wf = *(const bf16x8*)(w2s + (nt * 16 + fr) * 64 + ks * 32 + G * 8);
            out[nt] = __builtin_amdgcn_mfma_f32_16x16x32_bf16(hf[ks], wf, out[nt], 0, 0, 0);
        }
    }
    WSYNC();
    float rs[4] = {1.f, 1.f, 1.f, 1.f};
    if (kv == 0) {
#pragma unroll
        for (int r = 0; r < 4; ++r) {
            float ss = 0.f;
#pragma unroll
            for (int nt = 0; nt < 4; ++nt) ss += out[nt][r] * out[nt][r];
            ss += __shfl_xor(ss, 1); ss += __shfl_xor(ss, 2); ss += __shfl_xor(ss, 4); ss += __shfl_xor(ss, 8);
            rs[r] = rsqrtf(ss * (1.f / 64.f) + EPS);
        }
    }
#pragma unroll
    for (int nt = 0; nt < 4; ++nt) {
        const float gk = kv == 0 ? p.g_kc[nt * 16 + fr] : 1.f;
#pragma unroll
        for (int r = 0; r < 4; ++r) {
            const int row = G * 4 + r;
            if (row < 15) dst[(size_t)row * 64 + nt * 16 + fr] = f2bf(out[nt][r] * rs[r] * gk);
        }
    }
}

constexpr int CMP_HB = 131072, CMP_W2S = 147456 + 64, CMP_B1S = CMP_W2S + 8192;
__device__ __forceinline__ void compress_setup(const Params& p, char* lds, int kv) {
    const int tid = opaque_tid();
    const float* w1 = kv ? p.w_cv1 : p.w_ck1; const float* pe = kv ? p.pe_cv : p.pe_ck; const float* w2 = kv ? p.w_cv2 : p.w_ck2;
    bf16_t* w2s = (bf16_t*)(lds + CMP_W2S); float* b1s = (float*)(lds + CMP_B1S); float* part = (float*)(lds + CMP_HB);
    __syncthreads();
    for (int i = tid; i < 4096; i += NT) { const int f = i >> 6, d = i & 63; w2s[d * 64 + f] = f2bf(w2[i]); }
    {
      const int fq4 = tid & 15, ks32 = tid >> 4;
      const float* wp = w1 + (size_t)ks32 * 64 * 64 + 4 * fq4; const float* pp = pe + ks32 * 64;
      float4 s = {0.f, 0.f, 0.f, 0.f};
#pragma unroll 16
      for (int k = 0; k < 64; ++k) { const float4 w = *(const float4*)(wp + (size_t)k * 64); const float pv = pp[k]; s.x += pv * w.x; s.y += pv * w.y; s.z += pv * w.z; s.w += pv * w.w; }
      *(float4*)(part + ks32 * 64 + 4 * fq4) = s; }
    __syncthreads();
    if (tid < 64) { float s = 0.f; for (int j = 0; j < 32; ++j) s += part[j * 64 + tid]; b1s[tid] = s; p.b1[kv * 64 + tid] = s; }
    __syncthreads();
}
template <int O>
__device__ __forceinline__ void cmp_rd4(unsigned a, bf16x8 (&b)[4]) {
    asm volatile(
        "ds_read_b128 %0, %4 offset:%5\n\t"
        "ds_read_b128 %1, %4 offset:%6\n\t"
        "ds_read_b128 %2, %4 offset:%7\n\t"
        "ds_read_b128 %3, %4 offset:%8\n\t"
        "s_waitcnt lgkmcnt(0)"
        : "=&v"(b[0]), "=&v"(b[1]), "=&v"(b[2]), "=&v"(b[3])
        : "v"(a), "i"(O), "i"(O + 1024), "i"(O + 2048), "i"(O + 3072) : "memory");
}
template <int O0, int O1>
__device__ __forceinline__ void cmp_lda(const float* a0, const float* a1, f32x4 (&q)[2][2]) {
    asm volatile("global_load_dwordx4 %0, %4, off offset:%6 nt\n\t"
                 "global_load_dwordx4 %1, %5, off offset:%6 nt\n\t"
                 "global_load_dwordx4 %2, %4, off offset:%7 nt\n\t"
                 "global_load_dwordx4 %3, %5, off offset:%7 nt"
                 : "=&v"(q[0][0]), "=&v"(q[0][1]), "=&v"(q[1][0]), "=&v"(q[1][1])
                 : "v"(a0), "v"(a1), "i"(O0), "i"(O1) : "memory");
}
template <int N>
__device__ __forceinline__ void cmp_wait(f32x4 (&q)[2][2]) {
    asm volatile("s_waitcnt vmcnt(%4)" : "+v"(q[0][0]), "+v"(q[0][1]), "+v"(q[1][0]), "+v"(q[1][1]) : "n"(N) : "memory");
}
__device__ __forceinline__ void cmp_stage_wq(const Params& p, LAS char* l3, int kv, int q, int tid) {
    const int n = tid >> 2, Gp = (tid & 3) ^ ((n >> 2) & 3);
    const bf16_t* src = p.w1p + ((size_t)kv * 128 + n) * 1024 + q * 256 + Gp * 8;
    LAS char* dst = l3 + (q & 1) * 65536 + tid * 16;
#pragma unroll
    for (int j = 0; j < 8; ++j)
        __builtin_amdgcn_global_load_lds((const unsigned*)(src + j * 32), (LAS unsigned*)(dst + j * 8192), 16, 0, 0);
}
__device__ __forceinline__ void compress_pass_s(const Params& p, char* lds, int kv, int b, int c0w, int seam_idx, bool first, bool more) {
    LAS char* l3 = (LAS char*)lds;
    const int tid = opaque_tid(), lane = tid & 63, wave = tid >> 6, fr = lane & 15, G = lane >> 4;
    bf16_t* hb = (bf16_t*)(lds + CMP_HB) + wave * 1024;
    const bf16_t* w2s = (const bf16_t*)(lds + CMP_W2S); const float* b1s = (const float*)(lds + CMP_B1S);
    const float* abase[2];
#pragma unroll
    for (int i = 0; i < 2; ++i) {
        const int c = c0w + (fr & 7) + 8 * i;
        const int pg = p.page_table[b * NPAGES + (c >> 3)];
        abase[i] = p.cache_cmp + (((size_t)pg * 128 + (c & 7) * 16) * 4 + kv * 2) * 64 + (fr >> 3) * 16 + G * 4;
    }
    const bool lowl = fr < 8;
    const unsigned bl = (unsigned)(unsigned long long)l3 + fr * 64 + ((G ^ (fr >> 2)) * 16);
    f32x4 acc[2][8];
#pragma unroll
    for (int g = 0; g < 2; ++g)
#pragma unroll
        for (int nt = 0; nt < 8; ++nt) acc[g][nt] = (f32x4){0.f, 0.f, 0.f, 0.f};
    f32x4 aq[6][2][2];
#define CMP_LOADA(u, s) do { const float* _a0 = abase[0] + ((s) >> 1) * 256; const float* _a1 = abase[1] + ((s) >> 1) * 256; \
        if ((s) & 1) cmp_lda<128, 384>(_a0, _a1, aq[u]); else cmp_lda<0, 256>(_a0, _a1, aq[u]); } while (0)
#define CMP_WAITA(u, s) do { const int _y = 31 - (s); if (_y >= 5) cmp_wait<20>(aq[u]); else if (_y == 4) cmp_wait<16>(aq[u]); else if (_y == 3) cmp_wait<12>(aq[u]); \
        else if (_y == 2) cmp_wait<8>(aq[u]); else if (_y == 1) cmp_wait<4>(aq[u]); else cmp_wait<0>(aq[u]); } while (0)
#pragma unroll
    for (int u = 0; u < 6; ++u) CMP_LOADA(u, u);
    if (first) { cmp_stage_wq(p, l3, kv, 0, tid); asm volatile("s_waitcnt vmcnt(0)" ::: "memory"); }
#pragma unroll
    for (int s = 0; s < 32; ++s) {
        const int q = s >> 3, u = s % 6;
        if ((s & 7) == 0) {
            asm volatile("" ::: "memory");
            __builtin_amdgcn_s_barrier();
            asm volatile("" ::: "memory");
            if (q < 3 || more) cmp_stage_wq(p, l3, kv, (q + 1) & 3, tid);
            asm volatile("" ::: "memory");
        }
        CMP_WAITA(u, s);
        bf16x8 af[2];
#pragma unroll
        for (int g = 0; g < 2; ++g) {
            u32x4 t;
            f32x4 x0, x1;
#pragma unroll
            for (int e = 0; e < 4; ++e) {
                const float give = lowl ? aq[u][g][1][e] : aq[u][g][0][e];
                const float recv = __builtin_bit_cast(float, __builtin_amdgcn_mov_dpp(__builtin_bit_cast(int, give), 0x128, 0xF, 0xF, true));
                x0[e] = lowl ? aq[u][g][0][e] : recv; x1[e] = lowl ? recv : aq[u][g][1][e];
            }
            t[0] = cvt_pk_bf16(x0[0], x0[1]); t[1] = cvt_pk_bf16(x0[2], x0[3]);
            t[2] = cvt_pk_bf16(x1[0], x1[1]); t[3] = cvt_pk_bf16(x1[2], x1[3]);
            af[g] = __builtin_bit_cast(bf16x8, t);
        }
        if (s + 6 < 32) CMP_LOADA(u, s + 6);
        const unsigned a = bl + (q & 1) * 65536 + (s & 7) * 8192;
        bf16x8 bf[4];
        cmp_rd4<0>(a, bf);
#pragma unroll
        for (int nt = 0; nt < 4; ++nt) {
            acc[0][nt] = __builtin_amdgcn_mfma_f32_16x16x32_bf16(af[0], bf[nt], acc[0][nt], 0, 0, 0);
            acc[1][nt] = __builtin_amdgcn_mfma_f32_16x16x32_bf16(af[1], bf[nt], acc[1][nt], 0, 0, 0);
        }
        cmp_rd4<4096>(a, bf);
#pragma unroll
        for (int nt = 0; nt < 4; ++nt) {
            acc[0][4 + nt] = __builtin_amdgcn_mfma_f32_16x16x32_bf16(af[0], bf[nt], acc[0][4 + nt], 0, 0, 0);
            acc[1][4 + nt] = __builtin_amdgcn_mfma_f32_16x16x32_bf16(af[1], bf[nt], acc[1][4 + nt], 0, 0, 0);
        }
    }
#undef CMP_LOADA
#undef CMP_WAITA
#pragma unroll
    for (int g = 0; g < 2; ++g) {
        f32x4 pre[4];
#pragma unroll
        for (int nt = 0; nt < 4; ++nt) {
            const float bias = b1s[nt * 16 + fr];
            const float nb0 = __shfl_down(acc[g][4 + nt][0], 16);
            pre[nt][0] = acc[g][nt][0] + acc[g][4 + nt][1] + bias;
            pre[nt][1] = acc[g][nt][1] + acc[g][4 + nt][2] + bias;
            pre[nt][2] = acc[g][nt][2] + acc[g][4 + nt][3] + bias;
            pre[nt][3] = acc[g][nt][3] + nb0 + bias;
            if (G == 3) p.seamA[((size_t)seam_idx * 2 + g) * 64 + nt * 16 + fr] = acc[g][nt][3];
            if (G == 0) p.seamB[((size_t)seam_idx * 2 + g) * 64 + nt * 16 + fr] = acc[g][4 + nt][0];
        }
        bf16_t* dst = (kv ? p.vcs : p.kcs) + ((size_t)(b * 2 + g) * 1024 + c0w) * 64;
        cmp_second_layer(p, kv, pre, hb, w2s, dst, lane);
    }
}

__device__ __forceinline__ void compress_sample(const Params& p, char* lds, int bid, int nblk) {
    const int wave = opaque_tid() >> 6;
    int kv_set = -1;
    for (int pass = bid; pass < 512; pass += nblk) {
        const int P = pass & 7, kv = (pass >> 3) & 1, b = pass >> 4;
        const int c0w = P * 128 + wave * 16;
        const bool first = kv != kv_set;
        if (first) { compress_setup(p, lds, kv); kv_set = kv; }
        const int nxt = pass + nblk;
        const bool more = nxt < 512 && ((nxt >> 3) & 1) == kv;
        compress_pass_s(p, lds, kv, b, c0w, (b * 2 + kv) * 64 + (c0w >> 4), first, more);
    }
}

__device__ __forceinline__ void compress_prompt_ksplit_item(const Params& p, char* lds, int item) {
    const int tid = opaque_tid(), lane = tid & 63, wave = tid >> 6, fr = lane & 15, G = lane >> 4;
    f32x4* part = (f32x4*)lds;
    {
        const int kv = item / 68, tile = item % 68, b = tile / 17, c0 = (tile % 17) * 15;
        const float* abase = p.p_cmp + (((size_t)b * SEQ + (size_t)(c0 + fr) * 16) * 4 + kv * 2) * 64 + G * 4;
        const bf16_t* wbase = p.w1p + ((size_t)kv * 128 + fr) * 1024 + G * 8;
        f32x4 acc[2][8];
#pragma unroll
        for (int g = 0; g < 2; ++g)
#pragma unroll
            for (int nt = 0; nt < 8; ++nt) acc[g][nt] = (f32x4){0.f, 0.f, 0.f, 0.f};
#pragma unroll
        for (int u = 0; u < 4; ++u) {
            const int s = wave * 4 + u;
            const float* a = abase + (s >> 1) * 256 + (s & 1) * 32;
            bf16x8 af[2];
#pragma unroll
            for (int g = 0; g < 2; ++g) {
                const f32x4 x0 = *(const f32x4*)(a + g * 64), x1 = *(const f32x4*)(a + g * 64 + 16);
                u32x4 t; t[0] = cvt_pk_bf16(x0[0], x0[1]); t[1] = cvt_pk_bf16(x0[2], x0[3]); t[2] = cvt_pk_bf16(x1[0], x1[1]); t[3] = cvt_pk_bf16(x1[2], x1[3]);
                af[g] = __builtin_bit_cast(bf16x8, t);
            }
#pragma unroll
            for (int nt = 0; nt < 8; ++nt) {
                const bf16x8 wf = *(const bf16x8*)(wbase + (size_t)nt * 16 * 1024 + s * 32);
                acc[0][nt] = __builtin_amdgcn_mfma_f32_16x16x32_bf16(af[0], wf, acc[0][nt], 0, 0, 0);
                acc[1][nt] = __builtin_amdgcn_mfma_f32_16x16x32_bf16(af[1], wf, acc[1][nt], 0, 0, 0);
            }
        }
        __syncthreads();
#pragma unroll
        for (int g = 0; g < 2; ++g)
#pragma unroll
            for (int nt = 0; nt < 8; ++nt) part[((wave * 2 + g) * 8 + nt) * 64 + lane] = acc[g][nt];
        __syncthreads();
        if (wave < 2) {
            const int g = wave;
            f32x4 tot[8];
#pragma unroll
            for (int nt = 0; nt < 8; ++nt) {
                tot[nt] = part[((0 * 2 + g) * 8 + nt) * 64 + lane];
#pragma unroll
                for (int w = 1; w < 8; ++w) tot[nt] += part[((w * 2 + g) * 8 + nt) * 64 + lane];
            }
            f32x4 pre[4];
#pragma unroll
            for (int nt = 0; nt < 4; ++nt) {
                const float bias = p.b1[kv * 64 + nt * 16 + fr];
                const float nb0 = __shfl_down(tot[4 + nt][0], 16);
                pre[nt][0] = tot[nt][0] + tot[4 + nt][1] + bias; pre[nt][1] = tot[nt][1] + tot[4 + nt][2] + bias;
                pre[nt][2] = tot[nt][2] + tot[4 + nt][3] + bias; pre[nt][3] = tot[nt][3] + nb0 + bias;
            }
            bf16_t* hb = (bf16_t*)(lds + 131072) + wave * 1024;
            bf16_t* dst = (kv ? p.vc : p.kc) + ((size_t)(b * 2 + g) * 256 + c0) * 64;
            cmp_second_layer(p, kv, pre, hb, p.w2t + (size_t)kv * 4096, dst, lane);
        }
        __syncthreads();
    }
}
__device__ __forceinline__ void compress_seams(const Params& p, int bid, int nblk) {
    const int tid = opaque_tid(), lane = tid & 63, wave = tid >> 6;
    if (bid < 0) return;
    for (int it = bid * 8 + wave; it < 32 * 2 * 2 * 63; it += nblk * 8) {
        const int Tt = it % 63, rest = it / 63, g = rest & 1, kv = (rest >> 1) & 1, b = rest >> 2;
        const size_t sa = ((size_t)((b * 2 + kv) * 64 + Tt) * 2 + g) * 64 + lane, sb = ((size_t)((b * 2 + kv) * 64 + Tt + 1) * 2 + g) * 64 + lane;
        const float h = silu(p.seamA[sa] + p.seamB[sb] + p.b1[kv * 64 + lane]);
        const float* w2 = kv ? p.w_cv2 : p.w_ck2;
        float o = 0.f;
        for (int f = 0; f < 64; ++f) o += bf2f(f2bf(__shfl(h, f))) * bf2f(f2bf(w2[f * 64 + lane]));
        if (kv == 0) { const float rs = rsqrtf(wave_sum(o * o) * (1.f / 64.f) + EPS); o = o * rs * p.g_kc[lane]; }
        ((kv ? p.vcs : p.kcs) + ((size_t)(b * 2 + g) * 1024 + 16 * Tt + 15) * 64)[lane] = f2bf(o);
    }
}
template <typename T>
__device__ __forceinline__ void attend64(const float* qs, float* pl, const T* kbase, const T* vbase, size_t stride, bool valid, int lane, float (&m)[4], float (&l)[4], float (&o)[4]) {
    float s[4] = {0.f, 0.f, 0.f, 0.f};
    if (valid) {
        const T* kr = kbase + (size_t)lane * stride;
        float kfa[8][8];
#pragma unroll
        for (int c = 0; c < 8; ++c) load8(kr + c * 8, kfa[c]);
#pragma unroll
        for (int c = 0; c < 8; ++c)
#pragma unroll
            for (int h = 0; h < 4; ++h)
#pragma unroll
                for (int j = 0; j < 8; ++j) s[h] += qs[h * 64 + c * 8 + j] * kfa[c][j];
    }
    const unsigned long long vm = __ballot(valid);
    if (vm == 0ull) return;
#pragma unroll
    for (int h = 0; h < 4; ++h) {
        const float sv = valid ? s[h] * 0.125f : -1e30f;
        const float mn = fmaxf(m[h], wave_max(sv));
        const float alpha = __expf(m[h] - mn);
        const float pv = valid ? __expf(sv - mn) : 0.f;
        l[h] = l[h] * alpha + wave_sum(pv); o[h] *= alpha; m[h] = mn;
        pl[h * 64 + lane] = pv;
    }
    WSYNC();
    const int kfirst = __ffsll((long long)vm) - 1;
#pragma unroll 16
    for (int kk = 0; kk < 64; ++kk) {
        const int kr = ((vm >> kk) & 1ull) ? kk : kfirst;
        const float vv = load1(vbase + (size_t)kr * stride + lane);
#pragma unroll
        for (int h = 0; h < 4; ++h) o[h] += pl[h * 64 + kk] * vv;
    }
    WSYNC();
}

__device__ __forceinline__ void cmp_branch(const float* qs, float* pl, float* ps, const bf16_t* kc, const bf16_t* vc, int n_c, int lane, float (&oc)[4]) {
    float m[4] = {-1e30f, -1e30f, -1e30f, -1e30f}, l[4] = {0.f, 0.f, 0.f, 0.f};
    for (int c0 = 0; c0 < n_c; c0 += 64) {
        const bool valid = c0 + lane < n_c;
        float s[4] = {0.f, 0.f, 0.f, 0.f};
        if (valid) {
            const bf16_t* kr = kc + (size_t)(c0 + lane) * 64;
#pragma unroll 2
            for (int c = 0; c < 8; ++c) {
                float kf[8]; load8(kr + c * 8, kf);
#pragma unroll
                for (int h = 0; h < 4; ++h)
#pragma unroll
                    for (int j = 0; j < 8; ++j) s[h] += qs[h * 64 + c * 8 + j] * kf[j];
            }
        }
#pragma unroll
        for (int h = 0; h < 4; ++h) {
            const float sv = valid ? s[h] * 0.125f : -1e30f;
            const float mn = fmaxf(m[h], wave_max(sv));
            const float pv = valid ? __expf(sv - mn) : 0.f;
            l[h] = l[h] * __expf(m[h] - mn) + wave_sum(pv); m[h] = mn;
        }
    }
    for (int c0 = 0; c0 < n_c; c0 += 64) {
        const bool valid = c0 + lane < n_c;
        float s[4] = {0.f, 0.f, 0.f, 0.f};
        if (valid) {
            const bf16_t* kr = kc + (size_t)(c0 + lane) * 64;
#pragma unroll 2
            for (int c = 0; c < 8; ++c) {
                float kf[8]; load8(kr + c * 8, kf);
#pragma unroll
                for (int h = 0; h < 4; ++h)
#pragma unroll
                    for (int j = 0; j < 8; ++j) s[h] += qs[h * 64 + c * 8 + j] * kf[j];
            }
        }
        float psum = 0.f;
#pragma unroll
        for (int h = 0; h < 4; ++h) {
            const float pv = valid ? __expf(s[h] * 0.125f - m[h]) / l[h] : 0.f;
            pl[h * 64 + lane] = pv; psum += pv;
        }
        if (valid) ps[1 + c0 + lane] = psum;
        WSYNC();
        const int nk = min(64, n_c - c0);
        for (int kk = 0; kk < nk; ++kk) {
            const float vv = bf2f(vc[(size_t)(c0 + kk) * 64 + lane]);
#pragma unroll
            for (int h = 0; h < 4; ++h) oc[h] += pl[h * 64 + kk] * vv;
        }
        WSYNC();
    }
}

__device__ __forceinline__ void topk16(float* sc, int* sel, int n_sel, int lane) {
    for (int round = 0; round < 16; ++round) {
        float bv = -3.0e38f; int bi = 0x7fffffff;
        for (int j = lane; j < n_sel; j += 64) { const float v = sc[j]; if (v > bv) { bv = v; bi = j; } }
#pragma unroll
        for (int o = 1; o < 64; o <<= 1) {
            const float ov = __shfl_xor(bv, o); const int oi = __shfl_xor(bi, o);
            if (ov > bv || (ov == bv && oi < bi)) { bv = ov; bi = oi; }
        }
        if (lane == 0) { sel[round] = bi; sc[bi] = -3.4e38f; }
        WSYNC();
    }
}

constexpr int ATT_WLDS = 256 + 256 + 1040 + 272 + 16;
__device__ __forceinline__ void p5_attention(const Params& p, char* lds, int bid, int nblk) {
    const int tid = threadIdx.x, lane = tid & 63, wave = tid >> 6;
    float* wl = (float*)lds + wave * ATT_WLDS;
    float *qs = wl, *pl = wl + 256, *ps = wl + 512, *sc = wl + 1552; int* sel = (int*)(wl + 1824);
    const int gw = bid * 8 + wave, ngw = nblk * 8;
    for (int it = gw; it < R * 2; it += ngw) {
        const int r = it >> 1, g = it & 1;
        const bool isp = r < TP;
        const int b = isp ? (r >> 12) : (r - TP), t = isp ? (r & 4095) : PAST;
        const int n_sel = isp ? 64 : 257;
        const int n_cmax = isp ? 255 : 1023;
#pragma unroll
        for (int h = 0; h < 4; ++h) qs[h * 64 + lane] = bf2f(p.qn[(size_t)r * 512 + (g * 4 + h) * 64 + lane]);
        for (int i = lane; i < 4 * n_sel + 1; i += 64) ps[i] = 0.f;
        WSYNC();
        int n_c = t >= 31 ? (t - 31) / 16 + 1 : 0; if (n_c > n_cmax) n_c = n_cmax;
        float oc[4] = {0.f, 0.f, 0.f, 0.f};
        {
            const bf16_t* kc = isp ? p.kc + (size_t)(b * 2 + g) * 256 * 64 : p.kcs + (size_t)(b * 2 + g) * 1024 * 64;
            const bf16_t* vc = isp ? p.vc + (size_t)(b * 2 + g) * 256 * 64 : p.vcs + (size_t)(b * 2 + g) * 1024 * 64;
            cmp_branch(qs, pl, ps, kc, vc, n_c, lane, oc);
        }
        const int jt = t >> 6;
        for (int j = lane; j < n_sel; j += 64) {
            float imp = 0.f;
#pragma unroll
            for (int rr = 0; rr < 4; ++rr) imp += ps[4 * j + rr + 1] + ps[4 * j + rr];
            const bool valid = j * 64 <= t, forced = (j == 0) || (j == jt) || (j == jt - 1);
            sc[j] = valid ? (forced ? 1e4f : imp) : -1e30f;
        }
        WSYNC();
        topk16(sc, sel, n_sel, lane);
        float ms[4] = {-1e30f, -1e30f, -1e30f, -1e30f}, lsum[4] = {0.f, 0.f, 0.f, 0.f}, os[4] = {0.f, 0.f, 0.f, 0.f};
        for (int k = 0; k < 16; ++k) {
            const int j = sel[k];
            if (j * 64 > t) continue;
            const bool valid = j * 64 + lane <= t;
            if (isp) {
                const size_t base = ((size_t)(b * 2 + g) * SEQ + (size_t)j * 64) * 64;
                attend64<bf16_t>(qs, pl, p.ks + base, p.vs + base, 64, valid, lane, ms, lsum, os);
            } else if (j == 256) {
                attend64<float>(qs, pl, p.s_slc + (size_t)b * 256 + g * 64, p.s_slc + (size_t)b * 256 + 128 + g * 64, 256, valid, lane, ms, lsum, os);
            } else {
                const int pg = p.page_table[b * NPAGES + (j >> 1)];
                const float* base = p.cache_slc + (((size_t)pg * 128 + (j & 1) * 64) * 4 + g) * 64;
                attend64<float>(qs, pl, base, base + 128, 256, valid, lane, ms, lsum, os);
            }
        }
        float mw[4] = {-1e30f, -1e30f, -1e30f, -1e30f}, lw[4] = {0.f, 0.f, 0.f, 0.f}, ow[4] = {0.f, 0.f, 0.f, 0.f};
        if (isp) {
            const int start = t - 511 > 0 ? t - 511 : 0;
            for (int c0 = start; c0 <= t; c0 += 64) {
                const size_t base = ((size_t)(b * 2 + g) * SEQ + c0) * 64;
                attend64<bf16_t>(qs, pl, p.kw + base, p.vw + base, 64, c0 + lane <= t, lane, mw, lw, ow);
            }
        } else {
            for (int c0 = 0; c0 < 512; c0 += 64) {
                const float* base = p.s_win + ((size_t)b * 512 + c0) * 256 + g * 64;
                attend64<float>(qs, pl, base, base + 128, 256, true, lane, mw, lw, ow);
            }
        }
#pragma unroll
        for (int h = 0; h < 4; ++h) {
            const float* gt = p.gates + (size_t)r * 24 + g * 12 + h * 3;
            const float o = gt[0] * oc[h] + gt[1] * (os[h] / lsum[h]) + gt[2] * (ow[h] / lw[h]);
            const int col = (g * 4 + h) * 64 + lane;
            p.yar[(size_t)r * 1024 + col] = f2bf(o * bf2f(p.ga[(size_t)r * 512 + col]));
        }
    }
}


typedef short s16x4 __attribute__((ext_vector_type(4)));
#define ATT_NEG (-__builtin_inff())
constexpr int ATT_KC = 0, ATT_VC = 32768, ATT_KB = 65536, ATT_VB = 98304, ATT_SC = 131072;
constexpr float ATT_CS = 0.125f * 1.44269504088896f;

__device__ __forceinline__ void att_stage(LAS char* dst, const bf16_t* rows, int tid) {
    const int key = tid >> 3, slot = tid & 7;
    __builtin_amdgcn_global_load_lds((const unsigned*)(rows + key * 64 + ((slot ^ (key & 7)) * 8)), (LAS unsigned*)(dst + tid * 16), 16, 0, 0);
}
__device__ __forceinline__ void att_qk(const LAS char* Kb, const bf16x8 (&qf)[2], const int (&koff)[2], f32x4 (&st)[4]) {
#pragma unroll
    for (int tk = 0; tk < 4; ++tk) {
        st[tk] = (f32x4){0.f, 0.f, 0.f, 0.f};
#pragma unroll
        for (int ks = 0; ks < 2; ++ks) {
            const bf16x8 kf = *(const LAS bf16x8*)(Kb + tk * 2048 + koff[ks]);
            st[tk] = __builtin_amdgcn_mfma_f32_16x16x32_bf16(kf, qf[ks], st[tk], 0, 0, 0);
        }
    }
}
template <int O0, int O1>
__device__ __forceinline__ void att_tr8(unsigned a0, unsigned a1, unsigned a2, unsigned a3, s16x4 (&v)[8]) {
    asm volatile(
        "ds_read_b64_tr_b16 %0, %8 offset:%12\n\t"
        "ds_read_b64_tr_b16 %1, %8 offset:%13\n\t"
        "ds_read_b64_tr_b16 %2, %9 offset:%12\n\t"
        "ds_read_b64_tr_b16 %3, %9 offset:%13\n\t"
        "ds_read_b64_tr_b16 %4, %10 offset:%12\n\t"
        "ds_read_b64_tr_b16 %5, %10 offset:%13\n\t"
        "ds_read_b64_tr_b16 %6, %11 offset:%12\n\t"
        "ds_read_b64_tr_b16 %7, %11 offset:%13\n\t"
        "s_waitcnt lgkmcnt(0)"
        : "=&v"(v[0]), "=&v"(v[1]), "=&v"(v[2]), "=&v"(v[3]), "=&v"(v[4]), "=&v"(v[5]), "=&v"(v[6]), "=&v"(v[7])
        : "v"(a0), "v"(a1), "v"(a2), "v"(a3), "i"(O0), "i"(O1) : "memory");
}
__device__ __forceinline__ void att_pv(const LAS char* Vb, const f32x4 (&pt)[4], const int (&voff)[4], f32x4 (&o)[4]) {
    const unsigned vb = (unsigned)(unsigned long long)Vb;
    const unsigned a0 = vb + voff[0], a1 = vb + voff[1], a2 = vb + voff[2], a3 = vb + voff[3];
#pragma unroll
    for (int kst = 0; kst < 2; ++kst) {
        u32x4 pk;
        pk[0] = cvt_pk_bf16(pt[2 * kst][0], pt[2 * kst][1]); pk[1] = cvt_pk_bf16(pt[2 * kst][2], pt[2 * kst][3]);
        pk[2] = cvt_pk_bf16(pt[2 * kst + 1][0], pt[2 * kst + 1][1]); pk[3] = cvt_pk_bf16(pt[2 * kst + 1][2], pt[2 * kst + 1][3]);
        const bf16x8 pf = __builtin_bit_cast(bf16x8, pk);
        s16x4 v[8];
        if (kst == 0) att_tr8<0, 2048>(a0, a1, a2, a3, v); else att_tr8<4096, 6144>(a0, a1, a2, a3, v);
#pragma unroll
        for (int dt = 0; dt < 4; ++dt) {
            const s16x4 x0 = v[2 * dt], x1 = v[2 * dt + 1];
            bf16x8 vf; vf[0] = x0[0]; vf[1] = x0[1]; vf[2] = x0[2]; vf[3] = x0[3]; vf[4] = x1[0]; vf[5] = x1[1]; vf[6] = x1[2]; vf[7] = x1[3];
            o[dt] = __builtin_amdgcn_mfma_f32_16x16x32_bf16(vf, pf, o[dt], 0, 0, 0);
        }
    }
}
__device__ __forceinline__ void att_exp(f32x4 (&st)[4], float nb, float& l) {
    typedef float f32x2 __attribute__((ext_vector_type(2)));
    const f32x2 cs2 = {ATT_CS, ATT_CS}, nb2 = {nb, nb};
    f32x2 ls2 = {0.f, 0.f};
#pragma unroll
    for (int tk = 0; tk < 4; ++tk)
#pragma unroll
        for (int r = 0; r < 4; r += 2) {
            const f32x2 s2 = {st[tk][r], st[tk][r + 1]};
            const f32x2 e2 = __builtin_elementwise_fma(s2, cs2, nb2);
            f32x2 p2; p2.x = __builtin_amdgcn_exp2f(e2.x); p2.y = __builtin_amdgcn_exp2f(e2.y);
            st[tk][r] = p2.x; st[tk][r + 1] = p2.y; ls2 += p2;
        }
    l += ls2.x + ls2.y;
}
__device__ __forceinline__ void att_prompt_unit(const Params& p, char* lds, int b, int g, int qt) {
    LAS char* l3 = (LAS char*)lds;
    const int tid = opaque_tid(), lane = tid & 63, wave = tid >> 6, fr = lane & 15, G = lane >> 4;
    const int qi = fr >> 2, h = fr & 3;
    const int t0 = qt * 32, tq0 = t0 + 4 * wave, t_row = tq0 + qi, jt = t0 >> 6;
    const size_t r = (size_t)b * SEQ + t_row;
    const size_t kvbase = (size_t)(b * 2 + g) * SEQ * 64;
    const float shc = p.attb[0], shs = p.attb[1], shw = p.attb[2];
    int koff[2], voff[4];
#pragma unroll
    for (int ks = 0; ks < 2; ++ks) koff[ks] = fr * 128 + (((ks * 4 + G) ^ (fr & 7)) * 16);
    { const int kq = 4 * G + (fr >> 2);
#pragma unroll
      for (int dt = 0; dt < 4; ++dt) voff[dt] = kq * 128 + (((dt * 2 + ((fr & 3) >> 1)) ^ (kq & 7)) * 16) + (fr & 1) * 8; }
    asm volatile("s_waitcnt lgkmcnt(0)" ::: "memory"); __builtin_amdgcn_s_barrier(); asm volatile("" ::: "memory");
    {
        const bf16_t* kc = p.kc + (size_t)(b * 2 + g) * 256 * 64; const bf16_t* vc = p.vc + (size_t)(b * 2 + g) * 256 * 64;
#pragma unroll
        for (int c = 0; c < 4; ++c) { att_stage(l3 + ATT_KC + c * 8192, kc + c * 4096, tid); att_stage(l3 + ATT_VC + c * 8192, vc + c * 4096, tid); }
    }
    bf16x8 qf[2];
#pragma unroll
    for (int ks = 0; ks < 2; ++ks) qf[ks] = *(const bf16x8*)(p.qn + r * 512 + (g * 4 + h) * 64 + ks * 32 + G * 8);
    const int c_lo = (t0 - 511 > 0 ? t0 - 511 : 0) >> 6;
    const int n_s = jt + 1, n_tot = n_s + (jt - c_lo + 1);
#define ATT_STAGE_CHUNK(idx) do { const int _i = (idx); const bool _w = _i >= n_s; const int _cj = _w ? c_lo + (_i - n_s) : _i; \
        att_stage(l3 + ATT_KB + (_i & 3) * 8192, (_w ? p.kw : p.ks) + kvbase + (size_t)_cj * 4096, tid); \
        att_stage(l3 + ATT_VB + (_i & 3) * 8192, (_w ? p.vw : p.vs) + kvbase + (size_t)_cj * 4096, tid); } while (0)
    ATT_STAGE_CHUNK(0); ATT_STAGE_CHUNK(1);
    if (n_tot > 2) { ATT_STAGE_CHUNK(2); asm volatile("s_waitcnt vmcnt(6)" ::: "memory"); }
    else asm volatile("s_waitcnt vmcnt(4)" ::: "memory");
    asm volatile("s_waitcnt lgkmcnt(0)" ::: "memory"); __builtin_amdgcn_s_barrier(); asm volatile("" ::: "memory");
    f32x4 oc[4];
#pragma unroll
    for (int dt = 0; dt < 4; ++dt) oc[dt] = (f32x4){0.f, 0.f, 0.f, 0.f};
    unsigned long long mymask;
    unsigned long long unionmask;
    {
        f32x4 sr[4][4];
#pragma unroll
        for (int c = 0; c < 4; ++c) att_qk(l3 + ATT_KC + c * 8192, qf, koff, sr[c]);
        const int ncrow = t_row >= 31 ? (t_row - 31) / 16 + 1 : 0;
        float lsum = 0.f;
#pragma unroll
        for (int c = 0; c < 4; ++c)
#pragma unroll
            for (int tk = 0; tk < 4; ++tk)
#pragma unroll
                for (int rg = 0; rg < 4; ++rg) {
                    const int i = c * 64 + tk * 16 + G * 4 + rg;
                    const float pv = i < ncrow ? __builtin_amdgcn_exp2f(sr[c][tk][rg] * ATT_CS - shc) : 0.f;
                    sr[c][tk][rg] = pv; lsum += pv;
                }
        lsum += __shfl_xor(lsum, 16); lsum += __shfl_xor(lsum, 32);
        const float inv = lsum > 0.f ? 1.f / lsum : 0.f;
        float* sc = (float*)(lds + ATT_SC) + wave * 512;
        float* bs = sc + 256;
        float av[4][4];
#pragma unroll
        for (int c = 0; c < 4; ++c)
#pragma unroll
            for (int tk = 0; tk < 4; ++tk) {
#pragma unroll
                for (int rg = 0; rg < 4; ++rg) sr[c][tk][rg] *= inv;
                float a = 2.f * (sr[c][tk][0] + sr[c][tk][1] + sr[c][tk][2]) + sr[c][tk][3], b3 = sr[c][tk][3];
                a += __builtin_bit_cast(float, __builtin_amdgcn_mov_dpp(__builtin_bit_cast(int, a), 0xB1, 0xF, 0xF, true));
                a += __builtin_bit_cast(float, __builtin_amdgcn_mov_dpp(__builtin_bit_cast(int, a), 0x4E, 0xF, 0xF, true));
                b3 += __builtin_bit_cast(float, __builtin_amdgcn_mov_dpp(__builtin_bit_cast(int, b3), 0xB1, 0xF, 0xF, true));
                b3 += __builtin_bit_cast(float, __builtin_amdgcn_mov_dpp(__builtin_bit_cast(int, b3), 0x4E, 0xF, 0xF, true));
                av[c][tk] = a;
                if (h == 0) bs[qi * 64 + (c * 4 + tk) * 4 + G] = b3;
            }
        WSYNC();
#pragma unroll
        for (int c = 0; c < 4; ++c)
#pragma unroll
            for (int tk = 0; tk < 4; ++tk) {
                const int j = (c * 4 + tk) * 4 + G;
                const float pr = j > 0 ? bs[qi * 64 + j - 1] : 0.f;
                const bool valid = j * 64 <= t_row, forced = (j == 0) || (j == jt) || (j == jt - 1);
                if (h == 0) sc[qi * 64 + j] = valid ? (forced ? 1e4f : av[c][tk] + pr) : -1e30f;
            }
#pragma unroll
        for (int c = 0; c < 4; ++c) att_pv(l3 + ATT_VC + c * 8192, sr[c], voff, oc);
        WSYNC();
        unsigned long long mq[4];
        {
            float sj[4]; int rank[4] = {0, 0, 0, 0};
#pragma unroll
            for (int q = 0; q < 4; ++q) sj[q] = sc[q * 64 + lane];
#pragma unroll 2
            for (int jp = 0; jp <= jt; ++jp) {
                const bool lower = jp < lane;
#pragma unroll
                for (int q = 0; q < 4; ++q) {
                    const float v = __builtin_bit_cast(float, __builtin_amdgcn_readlane(__builtin_bit_cast(int, sj[q]), jp));
                    rank[q] += (v > sj[q] || (v == sj[q] && lower)) ? 1 : 0;
                }
            }
#pragma unroll
            for (int q = 0; q < 4; ++q) mq[q] = __ballot(rank[q] < 16 && lane * 64 <= tq0 + q);
        }
        unionmask = mq[0] | mq[1] | mq[2] | mq[3];
        mymask = qi == 0 ? mq[0] : qi == 1 ? mq[1] : qi == 2 ? mq[2] : mq[3];
        WSYNC();
    }
    f32x4 os[4], ow[4];
#pragma unroll
    for (int dt = 0; dt < 4; ++dt) { os[dt] = (f32x4){0.f, 0.f, 0.f, 0.f}; ow[dt] = (f32x4){0.f, 0.f, 0.f, 0.f}; }
    float ls = 0.f, lw = 0.f;
    for (int it = 0; it < n_tot; ++it) {
        if (it + 2 < n_tot) asm volatile("s_waitcnt vmcnt(4)" ::: "memory");
        else if (it + 1 < n_tot) asm volatile("s_waitcnt vmcnt(2)" ::: "memory");
        else asm volatile("s_waitcnt vmcnt(0)" ::: "memory");
        asm volatile("s_waitcnt lgkmcnt(0)" ::: "memory"); __builtin_amdgcn_s_barrier(); asm volatile("" ::: "memory");
        if (it + 3 < n_tot) ATT_STAGE_CHUNK(it + 3);
        const LAS char* Kb = l3 + ATT_KB + (it & 3) * 8192; const LAS char* Vb = l3 + ATT_VB + (it & 3) * 8192;
        if (it < n_s) {
            const int j = it;
            if ((unionmask >> j) & 1ull) {
                f32x4 st[4];
                att_qk(Kb, qf, koff, st);
                const float nb = ((mymask >> j) & 1ull) ? -shs : ATT_NEG;
                if (j == jt) {
                    asm volatile("" ::: "memory");
#pragma unroll
                    for (int tk = 0; tk < 4; ++tk)
#pragma unroll
                        for (int rg = 0; rg < 4; ++rg) { const int pos = j * 64 + tk * 16 + G * 4 + rg; if (pos > t_row) st[tk][rg] = ATT_NEG; }
                }
                att_exp(st, nb, ls);
                att_pv(Vb, st, voff, os);
            }
        } else {
            const int cj = c_lo + (it - n_s);
            f32x4 st[4];
            att_qk(Kb, qf, koff, st);
            if (cj * 64 + 63 > tq0 || cj * 64 <= tq0 + 3 - 512) {
                asm volatile("" ::: "memory");
#pragma unroll
                for (int tk = 0; tk < 4; ++tk)
#pragma unroll
                    for (int rg = 0; rg < 4; ++rg) { const int pos = cj * 64 + tk * 16 + G * 4 + rg; if (!(pos <= t_row && pos > t_row - 512)) st[tk][rg] = ATT_NEG; }
            }
            att_exp(st, -shw, lw);
            att_pv(Vb, st, voff, ow);
        }
    }
#undef ATT_STAGE_CHUNK
    ls += __shfl_xor(ls, 16); ls += __shfl_xor(ls, 32);
    lw += __shfl_xor(lw, 16); lw += __shfl_xor(lw, 32);
    const float* gt = p.gates + r * 24 + g * 12 + h * 3;
    const float g0 = gt[0], g1 = gt[1] / ls, g2 = gt[2] / lw;
    const int colb = (g * 4 + h) * 64;
    uint2 gavv[4];
#pragma unroll
    for (int dt = 0; dt < 4; ++dt) gavv[dt] = *(const uint2*)(p.ga + r * 512 + colb + dt * 16 + G * 4);
#pragma unroll
    for (int dt = 0; dt < 4; ++dt) {
        const int d = dt * 16 + G * 4;
        const uint2 gav = gavv[dt];
        float v[4];
#pragma unroll
        for (int rg = 0; rg < 4; ++rg) v[rg] = g0 * oc[dt][rg] + g1 * os[dt][rg] + g2 * ow[dt][rg];
        v[0] *= __uint_as_float(gav.x << 16); v[1] *= __uint_as_float(gav.x & 0xffff0000u);
        v[2] *= __uint_as_float(gav.y << 16); v[3] *= __uint_as_float(gav.y & 0xffff0000u);
        uint2 o; o.x = cvt_pk_bf16(v[0], v[1]); o.y = cvt_pk_bf16(v[2], v[3]);
        *(uint2*)(p.yar + r * 1024 + colb + d) = o;
    }
}

__device__ __forceinline__ void dot4(const float* qs, const bf16_t* kr, float (&s)[4]) {
    uint4 raw[8];
#pragma unroll
    for (int c = 0; c < 8; ++c) raw[c] = *(const uint4*)(kr + c * 8);
#pragma unroll
    for (int c = 0; c < 8; ++c) {
        float kf[8];
        kf[0] = __uint_as_float(raw[c].x << 16); kf[1] = __uint_as_float(raw[c].x & 0xffff0000u); kf[2] = __uint_as_float(raw[c].y << 16); kf[3] = __uint_as_float(raw[c].y & 0xffff0000u);
        kf[4] = __uint_as_float(raw[c].z << 16); kf[5] = __uint_as_float(raw[c].z & 0xffff0000u); kf[6] = __uint_as_float(raw[c].w << 16); kf[7] = __uint_as_float(raw[c].w & 0xffff0000u);
#pragma unroll
        for (int hh = 0; hh < 4; ++hh)
#pragma unroll
            for (int j = 0; j < 8; ++j) s[hh] += qs[hh * 64 + c * 8 + j] * kf[j];
    }
}
__device__ __forceinline__ void att_sample_unit(const Params& p, char* lds, int b, int g) {
    const int tid = opaque_tid(), lane = tid & 63, wave = tid >> 6;
    float* L = (float*)lds;
    float* qs = L;
    float* ps = L + 256;
    float* sc = L + 1296;
    int* sel = (int*)(L + 1568);
    float* red = L + 1600;
    float* part = L + 1664;
    float* pl = L + 1664 + 8 * 3 * 4 * 66 + wave * 256;
    const size_t r = TP + b;
    __syncthreads();
    if (tid < 256) qs[tid] = bf2f(p.qn[r * 512 + g * 256 + tid]);
    for (int i = tid; i < 1040; i += NT) ps[i] = 0.f;
    __syncthreads();
    const bf16_t* kc = p.kcs + (size_t)(b * 2 + g) * 1024 * 64; const bf16_t* vc = p.vcs + (size_t)(b * 2 + g) * 1024 * 64;
    const int n_c = 1023;
    float m1[4] = {-1e30f, -1e30f, -1e30f, -1e30f}, l1[4] = {0.f, 0.f, 0.f, 0.f};
    for (int cc = 0; cc < 2; ++cc) {
        const int i = wave * 128 + cc * 64 + lane; const bool valid = i < n_c;
        float s[4] = {0.f, 0.f, 0.f, 0.f};
        if (valid) dot4(qs, kc + (size_t)i * 64, s);
#pragma unroll
        for (int hh = 0; hh < 4; ++hh) {
            const float sv = valid ? s[hh] * 0.125f : -1e30f;
            const float mn = fmaxf(m1[hh], wave_max(sv));
            l1[hh] = l1[hh] * __expf(m1[hh] - mn) + wave_sum(valid ? __expf(sv - mn) : 0.f); m1[hh] = mn;
        }
    }
    if (lane == 0) {
#pragma unroll
        for (int hh = 0; hh < 4; ++hh) { red[wave * 8 + hh] = m1[hh]; red[wave * 8 + 4 + hh] = l1[hh]; }
    }
    __syncthreads();
    float M[4], Ls[4];
#pragma unroll
    for (int hh = 0; hh < 4; ++hh) {
        float mm = -1e30f;
        for (int w = 0; w < 8; ++w) mm = fmaxf(mm, red[w * 8 + hh]);
        float ll = 0.f;
        for (int w = 0; w < 8; ++w) ll += red[w * 8 + 4 + hh] * __expf(red[w * 8 + hh] - mm);
        M[hh] = mm; Ls[hh] = ll;
    }
    float oc[4] = {0.f, 0.f, 0.f, 0.f};
    for (int cc = 0; cc < 2; ++cc) {
        const int i0 = wave * 128 + cc * 64, i = i0 + lane; const bool valid = i < n_c;
        float s[4] = {0.f, 0.f, 0.f, 0.f};
        if (valid) dot4(qs, kc + (size_t)i * 64, s);
        float psum = 0.f;
#pragma unroll
        for (int hh = 0; hh < 4; ++hh) { const float pv = valid ? __expf(s[hh] * 0.125f - M[hh]) / Ls[hh] : 0.f; pl[hh * 64 + lane] = pv; psum += pv; }
        if (valid) ps[1 + i] = psum;
        WSYNC();
        const int nk = min(64, n_c - i0);
#pragma unroll 16
        for (int kk = 0; kk < 64; ++kk) {
            const float vv = bf2f(vc[(size_t)(i0 + (kk < nk ? kk : 0)) * 64 + lane]);
#pragma unroll
            for (int hh = 0; hh < 4; ++hh) oc[hh] += pl[hh * 64 + kk] * vv;
        }
        WSYNC();
    }
    __syncthreads();
    if (wave == 0) {
        const int t = PAST, jt = t >> 6;
        for (int j = lane; j < 257; j += 64) {
            float imp = 0.f;
#pragma unroll
            for (int rr = 0; rr < 4; ++rr) imp += ps[4 * j + rr + 1] + ps[4 * j + rr];
            const bool valid = j * 64 <= t, forced = (j == 0) || (j == jt) || (j == jt - 1);
            sc[j] = valid ? (forced ? 1e4f : imp) : -1e30f;
        }
        WSYNC();
        topk16(sc, sel, 257, lane);
    }
    __syncthreads();
    float msv[4] = {-1e30f, -1e30f, -1e30f, -1e30f}, lsv[4] = {0.f, 0.f, 0.f, 0.f}, osv[4] = {0.f, 0.f, 0.f, 0.f};
    for (int k = 2 * wave; k < 2 * wave + 2; ++k) {
        const int j = sel[k];
        if (j * 64 > PAST) continue;
        const bool valid = j * 64 + lane <= PAST;
        if (j == 256) attend64<float>(qs, pl, p.s_slc + (size_t)b * 256 + g * 64, p.s_slc + (size_t)b * 256 + 128 + g * 64, 256, valid, lane, msv, lsv, osv);
        else {
            const int pg = p.page_table[b * NPAGES + (j >> 1)];
            const float* base = p.cache_slc + (((size_t)pg * 128 + (j & 1) * 64) * 4 + g) * 64;
            attend64<float>(qs, pl, base, base + 128, 256, valid, lane, msv, lsv, osv);
        }
    }
    float mwv[4] = {-1e30f, -1e30f, -1e30f, -1e30f}, lwv[4] = {0.f, 0.f, 0.f, 0.f}, owv[4] = {0.f, 0.f, 0.f, 0.f};
    {
        const float* base = p.s_win + ((size_t)b * 512 + wave * 64) * 256 + g * 64;
        attend64<float>(qs, pl, base, base + 128, 256, true, lane, mwv, lwv, owv);
    }
#pragma unroll
    for (int hh = 0; hh < 4; ++hh) {
        float* pc = part + ((wave * 3 + 0) * 4 + hh) * 66; pc[lane] = oc[hh];
        float* pS = part + ((wave * 3 + 1) * 4 + hh) * 66; pS[lane] = osv[hh]; if (lane == 0) { pS[64] = msv[hh]; pS[65] = lsv[hh]; }
        float* pw = part + ((wave * 3 + 2) * 4 + hh) * 66; pw[lane] = owv[hh]; if (lane == 0) { pw[64] = mwv[hh]; pw[65] = lwv[hh]; }
    }
    __syncthreads();
    if (tid < 256) {
        const int hh = tid >> 6, d = tid & 63;
        float c = 0.f;
        for (int w = 0; w < 8; ++w) c += part[((w * 3 + 0) * 4 + hh) * 66 + d];
        float res[2];
#pragma unroll
        for (int br = 1; br < 3; ++br) {
            float mm = -1e30f;
            for (int w = 0; w < 8; ++w) mm = fmaxf(mm, part[((w * 3 + br) * 4 + hh) * 66 + 64]);
            float num = 0.f, den = 0.f;
            for (int w = 0; w < 8; ++w) { const float* q = part + ((w * 3 + br) * 4 + hh) * 66; const float e = __expf(q[64] - mm); num += q[d] * e; den += q[65] * e; }
            res[br - 1] = num / den;
        }
        const float* gt = p.gates + r * 24 + g * 12 + hh * 3;
        const int col = (g * 4 + hh) * 64 + d;
        p.yar[r * 1024 + col] = f2bf((gt[0] * c + gt[1] * res[0] + gt[2] * res[1]) * bf2f(p.ga[r * 512 + col]));
    }
    __syncthreads();
}

__device__ __forceinline__ void ret_out_item(const Params& p, char* lds, int it);
__device__ __forceinline__ void att_phase(const Params& p, char* lds, int bid, int nblk) {
    const int x = bid & 7;
    unsigned* ctr = p.bar + 3584 + 64 * x;
    volatile int* slot = (volatile int*)(lds + 147456 + 16);
    const int tid = opaque_tid();
    for (;;) {
        __syncthreads();
        if (tid == 0) *slot = (int)__hip_atomic_fetch_add(ctr, 1u, __ATOMIC_RELAXED, __HIP_MEMORY_SCOPE_AGENT);
        __syncthreads();
        const int w = *slot;
        if (w >= 136) break;
        if (w < 8) att_sample_unit(p, lds, 4 * x + (w >> 1), w & 1);
        else att_prompt_unit(p, lds, x >> 1, x & 1, 127 - (w - 8));
    }
}
__device__ __forceinline__ void ret_out_queue(const Params& p, char* lds, int bid, int nblk) {
    const int x = bid & 7;
    unsigned* ctr = p.bar + 3584 + 64 * x + 16;
    volatile int* slot = (volatile int*)(lds + 147456 + 16);
    const int tid = opaque_tid();
    wg_wait(p.bar + 3456, (unsigned)nblk, p.bar + XB_TMO);
    for (;;) {
        __syncthreads();
        if (tid == 0) *slot = (int)__hip_atomic_fetch_add(ctr, 1u, __ATOMIC_RELAXED, __HIP_MEMORY_SCOPE_AGENT);
        __syncthreads();
        const int w = *slot;
        if (w >= 80) break;
        ret_out_item(p, lds, x + 8 * w);
    }
}

__device__ __forceinline__ float ret_gamma(int h) { return 1.f - exp2f(-5.f - (float)h); }

__device__ __forceinline__ void p6a_local(const Params& p, int bid, int nblk) {
    const int tid = opaque_tid();
    const int e = tid & 127, dg = tid >> 7;
    for (int it = bid; it < 4 * 4 * 32; it += nblk) {
        const int n = it & 31, h = (it >> 5) & 3, b = it >> 7;
        const float lg = __logf(ret_gamma(h));
        float acc[16];
#pragma unroll
        for (int i = 0; i < 16; ++i) acc[i] = 0.f;
        for (int j = 0; j < 128; ++j) {
            const size_t r = (size_t)b * SEQ + n * 128 + j;
            const float z = __expf(lg * (float)(127 - j));
            const float v = bf2f(p.rv[r * 512 + h * 128 + e]) * z;
            const bf16_t* kr = p.rk + r * 256 + h * 64 + dg * 16;
#pragma unroll
            for (int i = 0; i < 16; ++i) acc[i] += bf2f(kr[i]) * v;
        }
        float* out = p.sloc + ((size_t)it * 64 + dg * 16) * 128 + e;
#pragma unroll
        for (int i = 0; i < 16; ++i) out[i * 128] = acc[i];
    }
}
__device__ __forceinline__ void p6b_scan(const Params& p, int bid, int nblk) {
    const size_t gt = (size_t)bid * NT + threadIdx.x, ngt = (size_t)nblk * NT;
    for (size_t i = gt; i < (size_t)16 * 8192; i += ngt) {
        const int bh = (int)(i >> 13), el = (int)(i & 8191), h = bh & 3;
        const float gc = __expf(__logf(ret_gamma(h)) * 128.f);
        float S = 0.f, lv[32];
#pragma unroll
        for (int n = 0; n < 32; ++n) lv[n] = p.sloc[((size_t)bh * 32 + n) * 8192 + el];
#pragma unroll
        for (int n = 0; n < 32; ++n) {
            p.spre[((size_t)bh * 32 + n) * 8192 + el] = S;
            S = S * gc + lv[n];
        }
        p.p_ret[(size_t)bh * 8192 + el] = S;
    }
    {
        constexpr int NS = 128 * 8192;
        const int gti = (int)gt, ngti = (int)ngt;
#define SR_LD(j) const int sx##j = ib + j * ngti, sc##j = sx##j < NS ? sx##j : NS - 1, bh##j = sc##j >> 13, el##j = sc##j & 8191; const float st##j = p.state_ret[sc##j]; \
        const bf16_t kk##j = p.rk[(size_t)(TP + (bh##j >> 2)) * 256 + (bh##j & 3) * 64 + (el##j >> 7)], vv##j = p.rv[(size_t)(TP + (bh##j >> 2)) * 512 + (bh##j & 3) * 128 + (el##j & 127)];
#define SR_ST(j) if (sx##j < NS) p.s_ret[sx##j] = st##j * ret_gamma(bh##j & 3) + bf2f(kk##j) * bf2f(vv##j);
        for (int ib = gti; ib < NS; ib += 8 * ngti) {
            SR_LD(0) SR_LD(1) SR_LD(2) SR_LD(3) SR_LD(4) SR_LD(5) SR_LD(6) SR_LD(7)
            SR_ST(0) SR_ST(1) SR_ST(2) SR_ST(3) SR_ST(4) SR_ST(5) SR_ST(6) SR_ST(7)
        }
#undef SR_LD
#undef SR_ST
    }
}
__device__ __forceinline__ void p6c_out(const Params& p, char* lds, int bid, int nblk) {
    float* Am = (float*)lds;
    const int tid = opaque_tid();
    for (int it = bid; it < 4 * 4 * 32 + 128; it += nblk) {
        if (it < 512) {
            const int n = it & 31, h = (it >> 5) & 3, b = it >> 7;
            const float lg = __logf(ret_gamma(h));
            const size_t r0 = (size_t)b * SEQ + n * 128;
            for (int idx = tid; idx < 128 * 128; idx += NT) {
                const int i = idx >> 7, j = idx & 127;
                float a = 0.f;
                if (j <= i) {
                    const bf16_t* qr = p.rq + (r0 + i) * 256 + h * 64; const bf16_t* kr = p.rk + (r0 + j) * 256 + h * 64;
#pragma unroll
                    for (int c = 0; c < 8; ++c) { float qf[8], kf[8]; load8(qr + c * 8, qf); load8(kr + c * 8, kf);
#pragma unroll
                        for (int u = 0; u < 8; ++u) a += qf[u] * kf[u]; }
                    a *= __expf(lg * (float)(i - j));
                }
                Am[i * 129 + j] = a;
            }
            __syncthreads();
            const int e = tid & 127, ig = tid >> 7;
            const float* S = p.spre + (size_t)it * 8192;
            for (int i = ig * 32; i < ig * 32 + 32; ++i) {
                float o = 0.f;
                for (int j = 0; j <= i; ++j) o += Am[i * 129 + j] * bf2f(p.rv[(r0 + j) * 512 + h * 128 + e]);
                float qs = 0.f;
                const bf16_t* qr = p.rq + (r0 + i) * 256 + h * 64;
                for (int d = 0; d < 64; ++d) qs += bf2f(qr[d]) * S[d * 128 + e];
                o += qs * __expf(lg * (float)(i + 1));
                p.oret[(r0 + i) * 512 + h * 128 + e] = o;
            }
            __syncthreads();
        } else {
            const int bh = it - 512, h = bh & 3, b = bh >> 2;
            const size_t r = TP + b;
            if (tid < 128) {
                const int e = tid;
                const bf16_t* qr = p.rq + r * 256 + h * 64; const bf16_t* kr = p.rk + r * 256 + h * 64;
                const float* S0 = p.state_ret + (size_t)bh * 8192;
                float qs = 0.f, qk = 0.f;
                for (int d = 0; d < 64; ++d) { const float q = bf2f(qr[d]); qs += q * S0[d * 128 + e]; qk += q * bf2f(kr[d]); }
                p.oret[r * 512 + h * 128 + e] = qs * ret_gamma(h) + qk * bf2f(p.rv[r * 512 + h * 128 + e]);
            }
        }
    }
}
__device__ __forceinline__ void p6d_norm(const Params& p, int bid, int nblk) {
    const int tid = opaque_tid(), lane = tid & 63, wave = tid >> 6;
    for (int it = bid * 8 + wave; it < R * 4; it += nblk * 8) {
        const int r = it >> 2, h = it & 3;
        const float* o = p.oret + (size_t)r * 512 + h * 128;
        const float v0 = o[lane], v1 = o[lane + 64];
        const float rs = rsqrtf(wave_sum(v0 * v0 + v1 * v1) * (1.f / 128.f) + EPS);
        p.yar[(size_t)r * 1024 + 512 + h * 128 + lane] = f2bf(v0 * rs * p.g_ret[lane] * bf2f(p.gr[(size_t)r * 512 + h * 128 + lane]));
        p.yar[(size_t)r * 1024 + 512 + h * 128 + lane + 64] = f2bf(v1 * rs * p.g_ret[lane + 64] * bf2f(p.gr[(size_t)r * 512 + h * 128 + lane + 64]));
    }
}


__device__ __forceinline__ void ret_stage(LAS char* dst, const bf16_t* src, size_t row_stride, int lg_slots, int npieces, int tid) {
    for (int pc = tid; pc < npieces; pc += NT) {
        const int row = pc >> lg_slots, slot = pc & ((1 << lg_slots) - 1);
        __builtin_amdgcn_global_load_lds((const unsigned*)(src + (size_t)row * row_stride + ((slot ^ (row & 7)) * 8)), (LAS unsigned*)(dst + pc * 16), 16, 0, 0);
    }
}
__device__ __forceinline__ s16x4 ret_tr(const LAS char* img, int RB, int r0, int c0, int fr) {
    const int row = r0 + (fr >> 2), chunk = (c0 >> 3) + ((fr & 3) >> 1);
    return __builtin_amdgcn_ds_read_tr16_b64_v4i16((LAS s16x4*)(img + row * RB + ((chunk ^ (row & 7)) * 16) + (fr & 1) * 8));
}
__device__ __forceinline__ bf16x8 cat8(s16x4 a, s16x4 b) { bf16x8 v; v[0] = a[0]; v[1] = a[1]; v[2] = a[2]; v[3] = a[3]; v[4] = b[0]; v[5] = b[1]; v[6] = b[2]; v[7] = b[3]; return v; }

__device__ __forceinline__ void ret_local_item(const Params& p, char* lds, int it) {
    LAS char* l3 = (LAS char*)lds;
    const int tid = opaque_tid(), lane = tid & 63, wave = tid >> 6, fr = lane & 15, G = lane >> 4;
    {
        const int n = it & 31, h = (it >> 5) & 3, b = it >> 7;
        const size_t r0 = (size_t)b * SEQ + n * 128;
        __syncthreads();
        ret_stage(l3, p.rk + r0 * 256 + h * 64, 256, 3, 1024, tid);
        ret_stage(l3 + 16384, p.rv + r0 * 512 + h * 128, 512, 4, 2048, tid);
        asm volatile("s_waitcnt vmcnt(0)" ::: "memory");
        __syncthreads();
        f32x4 acc[4];
#pragma unroll
        for (int dt = 0; dt < 4; ++dt) acc[dt] = (f32x4){0.f, 0.f, 0.f, 0.f};
#pragma unroll
        for (int js = 0; js < 4; ++js) {
            const int j0 = js * 32 + 4 * G;
            const bf16x8 bfr = cat8(ret_tr(l3 + 16384, 256, j0, wave * 16, fr), ret_tr(l3 + 16384, 256, j0 + 16, wave * 16, fr));
#pragma unroll
            for (int dt = 0; dt < 4; ++dt) {
                const bf16x8 afr = cat8(ret_tr(l3, 128, j0, dt * 16, fr), ret_tr(l3, 128, j0 + 16, dt * 16, fr));
                acc[dt] = __builtin_amdgcn_mfma_f32_16x16x32_bf16(afr, bfr, acc[dt], 0, 0, 0);
            }
        }
        const float sc = exp2f(__log2f(ret_gamma(h)) * 127.f);
        float* out = p.sloc + (size_t)it * 8192 + wave * 16 + fr;
#pragma unroll
        for (int dt = 0; dt < 4; ++dt)
#pragma unroll
            for (int rg = 0; rg < 4; ++rg) out[(dt * 16 + 4 * G + rg) * 128] = acc[dt][rg] * sc;
    }
}

__device__ __forceinline__ void ret_out_item(const Params& p, char* lds, int it) {
    LAS char* l3 = (LAS char*)lds;
    const int tid = opaque_tid(), lane = tid & 63, wave = tid >> 6, fr = lane & 15, G = lane >> 4;
    {
        __syncthreads();
        if (it < 512) {
            const int n = it & 31, h = (it >> 5) & 3, b = it >> 7;
            const size_t r0 = (size_t)b * SEQ + n * 128;
            const float gam = ret_gamma(h);
            ret_stage(l3, p.rk + r0 * 256 + h * 64, 256, 3, 1024, tid);
            ret_stage(l3 + 16384, p.rv + r0 * 512 + h * 128, 512, 4, 2048, tid);
            {
                const float* S = p.spre + (size_t)it * 8192;
                for (int pc = tid; pc < 1024; pc += NT) {
                    const int row = pc >> 4, slot = pc & 15;
                    const float4 a = *(const float4*)(S + row * 128 + slot * 8), c = *(const float4*)(S + row * 128 + slot * 8 + 4);
                    u32x4 v; v[0] = cvt_pk_bf16(a.x * gam, a.y * gam); v[1] = cvt_pk_bf16(a.z * gam, a.w * gam); v[2] = cvt_pk_bf16(c.x * gam, c.y * gam); v[3] = cvt_pk_bf16(c.z * gam, c.w * gam);
                    *(LAS u32x4*)(l3 + 49152 + row * 256 + ((slot ^ (row & 7)) * 16)) = v;
                }
            }
            const size_t ri = r0 + wave * 16 + fr;
            bf16x8 qf[2], qp[2];
#pragma unroll
            for (int ks = 0; ks < 2; ++ks) {
                const bf16_t* qrow = p.rq + ri * 256 + h * 64 + ks * 32;
                qf[ks] = *(const bf16x8*)(qrow + G * 8);
                const s16x4 lo = *(const s16x4*)(qrow + 4 * G), hi = *(const s16x4*)(qrow + 16 + 4 * G);
                qp[ks] = cat8(lo, hi);
            }
            asm volatile("s_waitcnt vmcnt(0)" ::: "memory");
            __syncthreads();
            f32x4 st[8];
#pragma unroll
            for (int jt = 0; jt < 8; ++jt) {
                st[jt] = (f32x4){0.f, 0.f, 0.f, 0.f};
                if (jt <= wave) {
#pragma unroll
                    for (int ks = 0; ks < 2; ++ks) {
                        const int row = jt * 16 + fr;
                        const bf16x8 kf = *(const LAS bf16x8*)(l3 + row * 128 + (((ks * 4 + G) ^ (row & 7)) * 16));
                        st[jt] = __builtin_amdgcn_mfma_f32_16x16x32_bf16(kf, qf[ks], st[jt], 0, 0, 0);
                    }
                    if (jt == wave) {
#pragma unroll
                        for (int rg = 0; rg < 4; ++rg) if (4 * G + rg > fr) st[jt][rg] = 0.f;
                    }
                }
            }
            f32x4 o[8];
#pragma unroll
            for (int et = 0; et < 8; ++et) o[et] = (f32x4){0.f, 0.f, 0.f, 0.f};
#pragma unroll
            for (int js = 0; js < 4; ++js) {
                if (2 * js <= wave) {
                    u32x4 pk;
                    pk[0] = cvt_pk_bf16(st[2 * js][0], st[2 * js][1]); pk[1] = cvt_pk_bf16(st[2 * js][2], st[2 * js][3]);
                    pk[2] = cvt_pk_bf16(st[2 * js + 1][0], st[2 * js + 1][1]); pk[3] = cvt_pk_bf16(st[2 * js + 1][2], st[2 * js + 1][3]);
                    const bf16x8 pf = __builtin_bit_cast(bf16x8, pk);
                    const int j0 = js * 32 + 4 * G;
#pragma unroll
                    for (int et = 0; et < 8; ++et) {
                        const bf16x8 vf = cat8(ret_tr(l3 + 16384, 256, j0, et * 16, fr), ret_tr(l3 + 16384, 256, j0 + 16, et * 16, fr));
                        o[et] = __builtin_amdgcn_mfma_f32_16x16x32_bf16(vf, pf, o[et], 0, 0, 0);
                    }
                }
            }
#pragma unroll
            for (int ks = 0; ks < 2; ++ks) {
                const int d0 = ks * 32 + 4 * G;
#pragma unroll
                for (int et = 0; et < 8; ++et) {
                    const bf16x8 sf = cat8(ret_tr(l3 + 49152, 256, d0, et * 16, fr), ret_tr(l3 + 49152, 256, d0 + 16, et * 16, fr));
                    o[et] = __builtin_amdgcn_mfma_f32_16x16x32_bf16(sf, qp[ks], o[et], 0, 0, 0);
                }
            }
            float ss = 0.f;
#pragma unroll
            for (int et = 0; et < 8; ++et)
#pragma unroll
                for (int rg = 0; rg < 4; ++rg) ss += o[et][rg] * o[et][rg];
            ss += __shfl_xor(ss, 16); ss += __shfl_xor(ss, 32);
            const float rs = rsqrtf(ss * (1.f / 128.f) + EPS);
            float4 grv[8]; uint2 gvv[8];
#pragma unroll
            for (int et = 0; et < 8; ++et) { const int e = et * 16 + 4 * G; grv[et] = *(const float4*)(p.g_ret + e); gvv[et] = *(const uint2*)(p.gr + ri * 512 + h * 128 + e); }
#pragma unroll
            for (int et = 0; et < 8; ++et) {
                const int e = et * 16 + 4 * G;
                const float4 gr = grv[et];
                const uint2 gv = gvv[et];
                uint2 ov;
                ov.x = cvt_pk_bf16(o[et][0] * rs * gr.x * __uint_as_float(gv.x << 16), o[et][1] * rs * gr.y * __uint_as_float(gv.x & 0xffff0000u));
                ov.y = cvt_pk_bf16(o[et][2] * rs * gr.z * __uint_as_float(gv.y << 16), o[et][3] * rs * gr.w * __uint_as_float(gv.y & 0xffff0000u));
                *(uint2*)(p.yar + ri * 1024 + 512 + h * 128 + e) = ov;
            }
        } else {
            const int bh = it - 512, h = bh & 3, b = bh >> 2;
            const size_t r = TP + b;
            float* red = (float*)lds;
            float o = 0.f;
            if (tid < 128) {
                const int e = tid;
                const bf16_t* qr = p.rq + r * 256 + h * 64; const bf16_t* kr = p.rk + r * 256 + h * 64;
                const float* S0 = p.state_ret + (size_t)bh * 8192;
                float qs = 0.f, qk = 0.f;
                for (int d = 0; d < 64; ++d) { const float q = bf2f(qr[d]); qs += q * S0[d * 128 + e]; qk += q * bf2f(kr[d]); }
                o = qs * ret_gamma(h) + qk * bf2f(p.rv[r * 512 + h * 128 + e]);
                const float s2 = wave_sum(o * o);
                if (lane == 0) red[wave] = s2;
            }
            __syncthreads();
            if (tid < 128) {
                const float rs = rsqrtf((red[0] + red[1]) * (1.f / 128.f) + EPS);
                p.yar[r * 1024 + 512 + h * 128 + tid] = f2bf(o * rs * p.g_ret[tid] * bf2f(p.gr[r * 512 + h * 128 + tid]));
            }
        }
    }
}

__device__ __forceinline__ void out_sample(const Params& p, int bid, int nblk) {
    const int tid = opaque_tid(), lane = tid & 63, wave = tid >> 6, fr = lane & 15, G = lane >> 4;
    for (int it = bid * 8 + wave; it < 128; it += nblk * 8) {
        const int mt = it >> 6, nt = it & 63;
        const bf16_t* arow = p.yar + (size_t)(TP + mt * 16 + fr) * 1024 + G * 8;
        const bf16_t* brow = p.bt_out + (size_t)(nt * 16 + fr) * 1024 + G * 8;
        f32x4 acc = {0.f, 0.f, 0.f, 0.f};
#pragma unroll 8
        for (int ks = 0; ks < 32; ++ks) {
            const bf16x8 a = *(const bf16x8*)(arow + ks * 32), b = *(const bf16x8*)(brow + ks * 32);
            acc = __builtin_amdgcn_mfma_f32_16x16x32_bf16(a, b, acc, 0, 0, 0);
        }
        const int c = nt * 16 + fr;
#pragma unroll
        for (int rg = 0; rg < 4; ++rg) {
            const int sb = mt * 16 + 4 * G + rg;
            p.y[(size_t)(TP + sb) * 1024 + c] = p.x_sample[(size_t)sb * 1024 + c] + p.mod[(4 + sb) * 3072 + 2048 + c] * acc[rg];
        }
    }
}
__global__ void __launch_bounds__(NT, 2) k_mega(Params p) {
    extern __shared__ __attribute__((aligned(16))) char lds[];
    const int bid = blockIdx.x, nblk = gridDim.x;
    uint4* xbw = (uint4*)(lds + 147456);
    if (threadIdx.x == 0) *xbw = make_uint4(0u, 0u, 0u, 0u);
    __syncthreads();
    XcdBarrier bar = xcd_barrier_post(p.bar, (volatile LAS unsigned*)xbw);
    p0_w1p(p, bid, nblk); wg_signal(p.bar + 3536, true);
    p0_adaln(p, lds, bid, nblk); __syncthreads(); p0_weights(p, lds, bid, nblk); __syncthreads();
    wg_wait(p.bar + 3536, (unsigned)nblk, p.bar + XB_TMO);
    compress_sample(p, lds, bid, nblk);
    wg_wait(p.bar + 3520, 192u, p.bar + XB_TMO);
    p1_norm(p, lds, bid, nblk);
    xcd_barrier(bar);
    { EpiIn e{&p}; gemm_phase(p.H, p.bt_in, RPAD / 256, NPAD / 256, 1024, lds, bid, nblk, e); }
    if (nblk == 256) compress_seams(p, bid - 142, 114); else compress_seams(p, bid, nblk);
    xcd_barrier(bar);
    {
        volatile int* slot = (volatile int*)(lds + 147456 + 16);
        for (;;) {
            __syncthreads();
            if (threadIdx.x == 0) *slot = (int)__hip_atomic_fetch_add(p.bar + 3456 + 48, 1u, __ATOMIC_RELAXED, __HIP_MEMORY_SCOPE_AGENT);
            __syncthreads();
            const int w = *slot;
            if (w >= 136 + 512) break;
            if (w < 136) compress_prompt_ksplit_item(p, lds, w); else ret_local_item(p, lds, w - 136);
        }
    }
    xcd_barrier(bar);
    p6b_scan(p, bid, nblk); wg_signal(p.bar + 3456, true);
    att_phase(p, lds, bid, nblk);
    ret_out_queue(p, lds, bid, nblk);
    xcd_barrier(bar);
    { EpiOut e{&p}; gemm_phase(p.yar, p.bt_out, TP / 256, 4, 1024, lds, bid, nblk, e); }
    out_sample(p, nblk - 1 - bid, nblk);
}
}

extern "C" void kernel_launch(void* const* d_in, const int* in_sizes, int n_in, void* d_out, int out_size, void* d_ws, size_t ws_size, hipStream_t stream) {
    Params p{};
    p.x_prompt = (const float*)d_in[0]; p.x_sample = (const float*)d_in[1]; p.c_prompt = (const float*)d_in[2]; p.c_sample = (const float*)d_in[3];
    p.cache_cmp = (const float*)d_in[4]; p.cache_slc = (const float*)d_in[5]; p.state_win = (const float*)d_in[6]; p.state_ret = (const float*)d_in[7];
    p.page_table = (const int*)d_in[8];
    p.g_norm = (const float*)d_in[9]; p.w_ada = (const float*)d_in[10]; p.b_ada = (const float*)d_in[11]; p.w_in = (const float*)d_in[12];
    p.g_q = (const float*)d_in[13]; p.g_kc = (const float*)d_in[14]; p.g_ks = (const float*)d_in[15]; p.g_kw = (const float*)d_in[16];
    p.pe_ck = (const float*)d_in[17]; p.w_ck1 = (const float*)d_in[18]; p.w_ck2 = (const float*)d_in[19];
    p.pe_cv = (const float*)d_in[20]; p.w_cv1 = (const float*)d_in[21]; p.w_cv2 = (const float*)d_in[22];
    p.g_ret = (const float*)d_in[23]; p.w_out = (const float*)d_in[24];
    float* o = (float*)d_out;
    p.y = o; o += (size_t)R * 1024;
    p.p_cmp = o; o += (size_t)TP * 256; p.p_slc = o; o += (size_t)TP * 256; p.p_win = o; o += (size_t)4 * 512 * 256; p.p_ret = o; o += (size_t)16 * 8192;
    p.s_cmp = o; o += 32 * 256; p.s_slc = o; o += 32 * 256; p.s_win = o; o += (size_t)32 * 512 * 256; p.s_ret = o; o += (size_t)128 * 8192;
    char* w = (char*)d_ws; size_t off = 0;
    auto take = [&](size_t bytes) { char* q = w + off; off += (bytes + 255) & ~(size_t)255; return q; };
    p.bar = (unsigned*)take(16384);
    p.mod = (float*)take(36 * 3072 * 4);
    p.bt_in = (bf16_t*)take((size_t)NPAD * 1024 * 2);
    p.bt_out = (bf16_t*)take((size_t)1024 * 1024 * 2);
    p.H = (bf16_t*)take((size_t)RPAD * 1024 * 2);
    p.praw = (float*)take((size_t)RPAD * NPAD * 4);
    p.qn = (bf16_t*)take((size_t)R * 512 * 2);
    p.kcr = (bf16_t*)take((size_t)TP * 128 * 2); p.vcr = (bf16_t*)take((size_t)TP * 128 * 2);
    p.ks = (bf16_t*)take((size_t)TP * 128 * 2); p.vs = (bf16_t*)take((size_t)TP * 128 * 2);
    p.kw = (bf16_t*)take((size_t)TP * 128 * 2); p.vw = (bf16_t*)take((size_t)TP * 128 * 2);
    p.gates = (float*)take((size_t)R * 24 * 4);
    p.ga = (bf16_t*)take((size_t)R * 512 * 2); p.gr = (bf16_t*)take((size_t)R * 512 * 2);
    p.rq = (bf16_t*)take((size_t)R * 256 * 2); p.rk = (bf16_t*)take((size_t)R * 256 * 2); p.rv = (bf16_t*)take((size_t)R * 512 * 2);
    p.kc = (bf16_t*)take((size_t)4 * 2 * 256 * 64 * 2); p.vc = (bf16_t*)take((size_t)4 * 2 * 256 * 64 * 2);
    p.kcs = (bf16_t*)take((size_t)32 * 2 * 1024 * 64 * 2); p.vcs = (bf16_t*)take((size_t)32 * 2 * 1024 * 64 * 2);
    p.yar = (bf16_t*)take((size_t)RPAD * 1024 * 2);
    p.sloc = (float*)take((size_t)512 * 8192 * 4); p.spre = (float*)take((size_t)512 * 8192 * 4);
    p.oret = (float*)take((size_t)R * 512 * 4);
    p.w1p = (bf16_t*)take((size_t)2 * 128 * 1024 * 2); p.w2t = (bf16_t*)take((size_t)2 * 64 * 64 * 2); p.b1 = (float*)take(128 * 4);
    p.attb = (float*)take(256);
    p.ropec = (float*)take((size_t)4097 * 32 * 4); p.ropes = (float*)take((size_t)4097 * 32 * 4);
    p.seamA = (float*)take((size_t)32 * 2 * 64 * 2 * 64 * 4); p.seamB = (float*)take((size_t)32 * 2 * 64 * 2 * 64 * 4);
    if (off > ws_size) { fprintf(stderr, "workspace too small: need %zu have %zu\n", off, ws_size); return; }
    static int grid = 0;
    if (grid == 0) {
        int dev = 0, cus = 0, per_cu = 0;
        if (hipGetDevice(&dev) != hipSuccess || hipDeviceGetAttribute(&cus, hipDeviceAttributeMultiprocessorCount, dev) != hipSuccess) { fprintf(stderr, "device query failed\n"); grid = -1; return; }
        if (hipFuncSetAttribute((const void*)k_mega, hipFuncAttributeMaxDynamicSharedMemorySize, LDS_BYTES) != hipSuccess) { fprintf(stderr, "hipFuncSetAttribute failed\n"); grid = -1; return; }
        if (hipOccupancyMaxActiveBlocksPerMultiprocessor(&per_cu, (const void*)k_mega, NT, LDS_BYTES) != hipSuccess || per_cu < 1) { fprintf(stderr, "occupancy query: %d blocks per CU\n", per_cu); grid = -1; return; }
        (void)hipGetLastError();
        grid = cus;
    }
    if (grid < 0) return;
    (void)hipMemsetAsync(p.bar, 0, 16384, stream);
    hipLaunchKernelGGL(k_mega, dim3(grid), dim3(NT), LDS_BYTES, stream, p);
}
```

```cpp
#include <hip/hip_runtime.h>
#include <stdint.h>
#include <stdio.h>

namespace {
typedef unsigned short bf16_t;
typedef short bf16x8 __attribute__((ext_vector_type(8)));
typedef float f32x4 __attribute__((ext_vector_type(4)));

constexpr int D_MODEL = 1024, BATCH = 4, SEQ = 4096, DEC_BATCH = 32, PAST = 16384;
constexpr int NPAGES = 128, NPHYS = 5120;
constexpr int TP = BATCH * SEQ;
constexpr int R = TP + DEC_BATCH;
constexpr int RPAD = 16640;
constexpr int D_IN = 3352, NPAD = 3584;
constexpr int C_Q = 0, C_KC = 512, C_KS = 768, C_KW = 1024, C_BR = 1280, C_GA = 1304, C_RQ = 1816, C_RK = 2072, C_RV = 2328, C_GR = 2840;
constexpr float EPS = 1e-6f;
constexpr int NT = 512;
constexpr int LDS_BYTES = 147456 + 64 + 8192 + 256;

struct Params {
    const float *x_prompt, *x_sample, *c_prompt, *c_sample, *cache_cmp, *cache_slc, *state_win, *state_ret;
    const int* page_table;
    const float *g_norm, *w_ada, *b_ada, *w_in, *g_q, *g_kc, *g_ks, *g_kw, *pe_ck, *w_ck1, *w_ck2, *pe_cv, *w_cv1, *w_cv2, *g_ret, *w_out;
    float *y, *p_cmp, *p_slc, *p_win, *p_ret, *s_cmp, *s_slc, *s_win, *s_ret;
    unsigned* bar;
    float* mod;
    bf16_t* bt_in;
    bf16_t* bt_out;
    bf16_t* H;
    float* praw;
    bf16_t* qn;
    bf16_t *kcr, *vcr, *ks, *vs, *kw, *vw;
    float* gates;
    bf16_t *ga, *gr;
    bf16_t *rq, *rk;
    bf16_t* rv;
    bf16_t *kc, *vc;
    bf16_t *kcs, *vcs;
    bf16_t* yar;
    float *sloc, *spre;
    float* oret;
    bf16_t* w1p;
    bf16_t* w2t;
    float* b1;
    float *seamA, *seamB;
    float* attb;
    float *ropec, *ropes;
};

__device__ __forceinline__ int tile_src(int pn) { return pn <= 4 ? pn * 256 : pn == 13 ? 1280 : 1304 + (pn - 5) * 256; }
__device__ __forceinline__ bf16_t f2bf(float f) { unsigned u = __float_as_uint(f); u += 0x7fffu + ((u >> 16) & 1u); return (bf16_t)(u >> 16); }
__device__ __forceinline__ float bf2f(bf16_t h) { return __uint_as_float(((unsigned)h) << 16); }
__device__ __forceinline__ float wave_sum(float v) {
#pragma unroll
    for (int o = 1; o < 64; o <<= 1) v += __shfl_xor(v, o);
    return v;
}
__device__ __forceinline__ float wave_max(float v) {
#pragma unroll
    for (int o = 1; o < 64; o <<= 1) v = fmaxf(v, __shfl_xor(v, o));
    return v;
}
__device__ __forceinline__ float silu(float v) { return v / (1.f + __expf(-v)); }
__device__ __forceinline__ float sigmoidf(float v) { return 1.f / (1.f + __expf(-v)); }
__device__ __forceinline__ int opaque_tid() { int t = threadIdx.x; asm volatile("" : "+v"(t)); return t; }
typedef __bf16 bf16x2_t __attribute__((ext_vector_type(2)));
typedef float f32x2_t __attribute__((ext_vector_type(2)));
__device__ __forceinline__ unsigned cvt_pk_bf16(float lo, float hi) { const f32x2_t v = {lo, hi}; return __builtin_bit_cast(unsigned, __builtin_convertvector(v, bf16x2_t)); }
#define WSYNC() asm volatile("s_waitcnt lgkmcnt(0)" ::: "memory")

__device__ __forceinline__ void load8(const bf16_t* p, float (&f)[8]) {
    uint4 u = *(const uint4*)p;
    f[0] = __uint_as_float(u.x << 16); f[1] = __uint_as_float(u.x & 0xffff0000u);
    f[2] = __uint_as_float(u.y << 16); f[3] = __uint_as_float(u.y & 0xffff0000u);
    f[4] = __uint_as_float(u.z << 16); f[5] = __uint_as_float(u.z & 0xffff0000u);
    f[6] = __uint_as_float(u.w << 16); f[7] = __uint_as_float(u.w & 0xffff0000u);
}
__device__ __forceinline__ void load8(const float* p, float (&f)[8]) {
    float4 a = *(const float4*)p, b = *(const float4*)(p + 4);
    f[0] = a.x; f[1] = a.y; f[2] = a.z; f[3] = a.w; f[4] = b.x; f[5] = b.y; f[6] = b.z; f[7] = b.w;
}
__device__ __forceinline__ float load1(const bf16_t* p) { return bf2f(*p); }
__device__ __forceinline__ float load1(const float* p) { return *p; }


#define XB_TMO      128
#define XB_XCNT(j)  (256  + 64 * (j))
#define XB_XSUB(j)  (1280 + 64 * (j))
#define XB_XGEN(j)  (2304 + 64 * (j))
#define XB_TOP      3328
#define XB_TOPGEN   3392
#define XCD_BAR_WORDS 3456
#define XB_SPIN_CAP (1u << 18)
#define LAS __attribute__((address_space(3)))
__device__ __forceinline__ unsigned xb_ld(unsigned* p)              { return __hip_atomic_load(p, __ATOMIC_RELAXED, __HIP_MEMORY_SCOPE_AGENT); }
__device__ __forceinline__ unsigned xb_add(unsigned* p, unsigned v) { return __hip_atomic_fetch_add(p, v, __ATOMIC_RELAXED, __HIP_MEMORY_SCOPE_AGENT); }
__device__ __forceinline__ unsigned xb_xcc_id() { return (unsigned)__builtin_amdgcn_s_getreg((3 << 11) | 20) & 0xFu; }
#define XB_SPIN(cond, bar) do { unsigned _sp = 0; while (cond) { __builtin_amdgcn_s_sleep(1); \
    if ((++_sp & 255u) == 0u) { if (xb_ld(&(bar)[XB_TMO])) break; if (_sp > XB_SPIN_CAP) { atomicAdd(&(bar)[XB_TMO], 1u); break; } } } } while (0)
struct XcdBarrier { unsigned* bar; unsigned x; volatile LAS unsigned* st; };
__device__ __forceinline__ XcdBarrier xcd_barrier_post(unsigned* bar, volatile LAS unsigned* st) {
    XcdBarrier b; b.bar = bar; b.x = xb_xcc_id(); b.st = st;
    if (threadIdx.x == 0) (void)xb_add(&bar[XB_XCNT(b.x)], 1u);
    return b;
}
__device__ __forceinline__ void xcd_barrier_complete(unsigned* bar, unsigned x, unsigned& nloc, unsigned& nx) {
    const unsigned G = gridDim.x * gridDim.y * gridDim.z;
    unsigned sum, cnt, mine, sp = 0u;
    for (;;) {
        sum = 0u; cnt = 0u; mine = 0u;
#pragma unroll
        for (unsigned j = 0; j < 16; ++j) { const unsigned c = xb_ld(&bar[XB_XCNT(j)]); sum += c; cnt += (c > 0u) ? 1u : 0u; mine = (j == x) ? c : mine; }
        if (sum == G) break;
        __builtin_amdgcn_s_sleep(1);
        if ((++sp & 255u) == 0u) { if (xb_ld(&bar[XB_TMO])) break; if (sp > XB_SPIN_CAP) { atomicAdd(&bar[XB_TMO], 1u); break; } }
    }
    nloc = mine > 0u ? mine : 1u; nx = cnt > 0u ? cnt : 1u;
}
__device__ __forceinline__ void xcd_barrier(const XcdBarrier& b) {
    asm volatile("s_waitcnt vmcnt(0)" ::: "memory");
    __syncthreads();
    if (threadIdx.x == 0) {
        unsigned* bar = b.bar;
        __builtin_amdgcn_s_waitcnt(0);
        unsigned nloc = b.st[0], nx = b.st[1];
        if (nloc == 0u) { xcd_barrier_complete(bar, b.x, nloc, nx); b.st[0] = nloc; b.st[1] = nx; }
        const unsigned old = xb_add(&bar[XB_XSUB(b.x)], 1u);
        const unsigned gen = old / nloc;
        if (old + 1u == (gen + 1u) * nloc) {
            __builtin_amdgcn_fence(__ATOMIC_RELEASE, "agent");
            asm volatile("s_waitcnt vmcnt(0)" ::: "memory");
            const unsigned og = xb_add(&bar[XB_TOP], 1u);
            const unsigned tg = og / nx;
            if (og + 1u == (tg + 1u) * nx) xb_add(&bar[XB_TOPGEN], 1u);
            else XB_SPIN(xb_ld(&bar[XB_TOPGEN]) == tg, bar);
            __builtin_amdgcn_fence(__ATOMIC_ACQUIRE, "agent");
            xb_add(&bar[XB_XGEN(b.x)], 1u);
            asm volatile("s_waitcnt vmcnt(0)" ::: "memory");
        } else {
            XB_SPIN(xb_ld(&bar[XB_XGEN(b.x)]) == gen, bar);
            __builtin_amdgcn_fence(__ATOMIC_ACQUIRE, "agent");
            asm volatile("s_waitcnt vmcnt(0)" ::: "memory");
        }
    }
    __syncthreads();
}


__device__ __forceinline__ void wg_signal(unsigned* ctr, bool need_release) {
    asm volatile("s_waitcnt vmcnt(0)" ::: "memory");
    __syncthreads();
    if (threadIdx.x == 0) {
        if (need_release) { __builtin_amdgcn_fence(__ATOMIC_RELEASE, "agent"); asm volatile("s_waitcnt vmcnt(0)" ::: "memory"); }
        (void)__hip_atomic_fetch_add(ctr, 1u, __ATOMIC_RELAXED, __HIP_MEMORY_SCOPE_AGENT);
    }
}
__device__ __forceinline__ void wg_wait(unsigned* ctr, unsigned target, unsigned* tmo) {
    if (threadIdx.x == 0) {
        unsigned sp = 0;
        while (__hip_atomic_load(ctr, __ATOMIC_RELAXED, __HIP_MEMORY_SCOPE_AGENT) < target) {
            __builtin_amdgcn_s_sleep(2);
            if (++sp > (1u << 22)) { atomicAdd(tmo, 1u); break; }
        }
        __builtin_amdgcn_fence(__ATOMIC_ACQUIRE, "agent");
        asm volatile("s_waitcnt vmcnt(0)" ::: "memory");
    }
    __syncthreads();
}
__device__ __forceinline__ void p0_adaln(const Params& p, char* lds, int bid, int nblk) {
    float* sc = (float*)lds;
    float* red = (float*)(lds + 73728);
    const int tid = opaque_tid(), lane = tid & 63, wave = tid >> 6;
    for (int item = bid; item < 192; item += nblk) {
        const int cb = item >> 2, r0 = (item & 3) * 9;
        __syncthreads();
        {
            float cv[18];
#pragma unroll
            for (int u = 0; u < 18; ++u) { const int i = tid + u * NT, row = r0 + (i >> 10), k = i & 1023; cv[u] = row < 4 ? p.c_prompt[row * 1024 + k] : p.c_sample[(row - 4) * 1024 + k]; }
#pragma unroll
            for (int u = 0; u < 18; ++u) sc[tid + u * NT] = silu(cv[u]);
        }
        __syncthreads();
        const int j = cb * 64 + lane;
        float acc[9];
#pragma unroll
        for (int r = 0; r < 9; ++r) acc[r] = 0.f;
        const int k0 = wave * 128;
#pragma unroll 8
        for (int k = k0; k < k0 + 128; k += 4) {
            const float w0 = p.w_ada[(size_t)k * 3072 + j], w1 = p.w_ada[(size_t)(k + 1) * 3072 + j], w2 = p.w_ada[(size_t)(k + 2) * 3072 + j], w3 = p.w_ada[(size_t)(k + 3) * 3072 + j];
#pragma unroll
            for (int r = 0; r < 9; ++r) { const float4 s = *(const float4*)(sc + r * 1024 + k); acc[r] += s.x * w0 + s.y * w1 + s.z * w2 + s.w * w3; }
        }
#pragma unroll
        for (int r = 0; r < 9; ++r) red[(wave * 9 + r) * 64 + lane] = acc[r];
        __syncthreads();
        for (int i = tid; i < 9 * 64; i += NT) {
            const int r = i >> 6, l = i & 63;
            float s = 0.f;
#pragma unroll
            for (int w = 0; w < 8; ++w) s += red[(w * 9 + r) * 64 + l];
            __hip_atomic_store(&p.mod[(r0 + r) * 3072 + cb * 64 + l], s + p.b_ada[cb * 64 + l], __ATOMIC_RELAXED, __HIP_MEMORY_SCOPE_AGENT);
        }
        wg_signal(p.bar + 3520, false);
    }
}

__device__ __forceinline__ void transpose_item(const float* W, int K, int N, bf16_t* WT, float* scr, int item, int lane, int nblkN) {
    const int kb = item / nblkN, nb = item % nblkN, k0 = kb * 64, n0 = nb * 64;
    float tv[64];
#pragma unroll
    for (int kk = 0; kk < 64; ++kk) tv[kk] = (n0 + lane < N) ? W[(size_t)(k0 + kk) * N + n0 + lane] : 0.f;
#pragma unroll
    for (int kk = 0; kk < 64; ++kk) scr[kk * 65 + lane] = tv[kk];
    WSYNC();
    for (int nn = 0; nn < 64; ++nn) WT[(size_t)(n0 + nn) * K + k0 + lane] = f2bf(scr[lane * 65 + nn]);
    WSYNC();
}
__device__ __forceinline__ void p0_w1p(const Params& p, int bid, int nblk) {
    const size_t gt = (size_t)bid * NT + opaque_tid(), ngt = (size_t)nblk * NT;
    for (size_t i = gt; i < (size_t)2 * 128 * 1024; i += ngt) {
        const int kv = (int)(i >> 17), n = (int)(i >> 10) & 127, kp = (int)i & 1023;
        const int ks = kp >> 5, G = (kp >> 3) & 3, j = kp & 7;
        const int k = ks * 32 + 16 * (j >> 2) + 4 * G + (j & 3);
        const int l = (k >> 6) + (n >= 64 ? 16 : 0), d = k & 63, f = n & 63;
        p.w1p[i] = f2bf((kv ? p.w_cv1 : p.w_ck1)[(size_t)(l * 64 + d) * 64 + f]);
    }
}
__device__ __forceinline__ void p0_weights(const Params& p, char* lds, int bid, int nblk) {
    const int tid = opaque_tid(), lane = tid & 63, wave = tid >> 6;
    float* scr = (float*)lds + wave * (64 * 65);
    const int gw = bid * 8 + wave, ngw = nblk * 8;
    constexpr int I_IN = 16 * 112, I_OUT = 16 * 16;
    for (int it = gw; it < I_IN + I_OUT; it += ngw) {
        if (it < I_IN) {
            const int kb = it / 112, nb = it % 112, k0 = kb * 64, n0 = nb * 32;
            const int pn = n0 >> 8, pl = n0 & 255, bj = pl >> 7, wc = (pl >> 5) & 3;
            const int cb = tile_src(pn) + wc * 64 + bj * 32;
            const int lim = pn == 13 ? 1304 : D_IN;
            float tv[32];
#pragma unroll
            for (int i = 0; i < 32; ++i) { const int kk = 2 * i + (lane >> 5), c = cb + (lane & 31); tv[i] = c < lim ? p.w_in[(size_t)(k0 + kk) * D_IN + c] : 0.f; }
#pragma unroll
            for (int i = 0; i < 32; ++i) scr[(2 * i + (lane >> 5)) * 33 + (lane & 31)] = tv[i];
            WSYNC();
            const int c8 = lane & 7;
            for (int j = 0; j < 4; ++j) {
                const int n = (lane >> 3) + 8 * j; const float* s = scr + (8 * c8) * 33 + n;
                uint4 o; o.x = cvt_pk_bf16(s[0], s[33]); o.y = cvt_pk_bf16(s[66], s[99]); o.z = cvt_pk_bf16(s[132], s[165]); o.w = cvt_pk_bf16(s[198], s[231]);
                *(uint4*)(p.bt_in + (size_t)(n0 + n) * 1024 + k0 + 8 * c8) = o;
            }
            WSYNC();
        } else transpose_item(p.w_out, 1024, 1024, p.bt_out, scr, it - I_IN, lane, 16);
    }
    const size_t gt = (size_t)bid * NT + tid, ngt = (size_t)nblk * NT;
    for (size_t i = gt; i < (size_t)4097 * 32; i += ngt) {
        const int pi = (int)(i >> 5), fi = (int)i & 31;
        const float ang = (float)(pi < 4096 ? pi : PAST) * powf(10000.f, -(float)fi / 32.f);
        float sn, cs; sincosf(ang, &sn, &cs);
        p.ropec[i] = cs; p.ropes[i] = sn;
    }
    if (bid == (nblk > 200 ? 200 : 0) && wave == 0) {
        const float gq = wave_max(fabsf(p.g_q[lane])), gc = wave_max(fabsf(p.g_kc[lane])), gs = wave_max(fabsf(p.g_ks[lane])), gw = wave_max(fabsf(p.g_kw[lane]));
        if (lane == 0) { const float k = 8.f * 1.03f * 1.44269504088896f * gq; p.attb[0] = k * gc; p.attb[1] = k * gs; p.attb[2] = k * gw; p.attb[3] = 0.f; }
    }
    for (size_t i = gt; i < (size_t)2 * 64 * 64; i += ngt) {
        const int kv = (int)(i >> 12), d = (int)(i >> 6) & 63, f = (int)i & 63;
        p.w2t[i] = f2bf((kv ? p.w_cv2 : p.w_ck2)[f * 64 + d]);
    }
    for (size_t i = gt; i < (size_t)2 * 8 * 64; i += ngt) {
        const int which = (int)(i >> 9), bg = (int)(i >> 6) & 7, d = (int)i & 63;
        (which ? p.vc : p.kc)[((size_t)bg * 256 + 255) * 64 + d] = 0;
    }
    {
        constexpr int NW = 32 * 511 * 64;
        const int gti = (int)gt, ngti = (int)ngt;
#define SW_SRC(i) (p.state_win + (size_t)((i) / (511 * 64)) * 512 * 256 + 256 + (size_t)((i) % (511 * 64)) * 4)
#define SW_DST(i) (p.s_win + (size_t)((i) / (511 * 64)) * 512 * 256 + (size_t)((i) % (511 * 64)) * 4)
#define SW_LD(j) const int ix##j = ib + j * ngti, cx##j = ix##j < NW ? ix##j : NW - 1; const float4 vx##j = *(const float4*)SW_SRC(cx##j);
#define SW_ST(j) if (ix##j < NW) *(float4*)SW_DST(ix##j) = vx##j;
        for (int ib = gti; ib < NW; ib += 8 * ngti) {
            SW_LD(0) SW_LD(1) SW_LD(2) SW_LD(3) SW_LD(4) SW_LD(5) SW_LD(6) SW_LD(7)
            SW_ST(0) SW_ST(1) SW_ST(2) SW_ST(3) SW_ST(4) SW_ST(5) SW_ST(6) SW_ST(7)
        }
#undef SW_SRC
#undef SW_DST
#undef SW_LD
#undef SW_ST
    }
}

__device__ __forceinline__ void p1_norm(const Params& p, char* lds, int bid, int nblk) {
    const int tid = opaque_tid(), lane = tid & 63, wave = tid >> 6;
    volatile int* slot = (volatile int*)(lds + 147456 + 16);
    for (;;) {
        __syncthreads();
        if (tid == 0) *slot = (int)__hip_atomic_fetch_add(p.bar + 3456 + 32, 1u, __ATOMIC_RELAXED, __HIP_MEMORY_SCOPE_AGENT);
        __syncthreads();
        const int pulled = *slot;
        if (pulled * 32 >= R) break;
        const int chunk = pulled == 0 ? TP / 32 : pulled - 1;
        if (chunk * 32 < TP) {
            const float* shift = p.mod + (chunk >> 7) * 3072, *scale = shift + 1024;
            const int rw = chunk * 32 + wave;
            float4 v[4][4], g[4], sc[4], sh[4];
#pragma unroll
            for (int q = 0; q < 4; ++q)
#pragma unroll
                for (int j = 0; j < 4; ++j) v[q][j] = *(const float4*)(p.x_prompt + (size_t)(rw + 8 * q) * 1024 + j * 256 + lane * 4);
#pragma unroll
            for (int j = 0; j < 4; ++j) { const int c = j * 256 + lane * 4; g[j] = *(const float4*)(p.g_norm + c); sc[j] = *(const float4*)(scale + c); sh[j] = *(const float4*)(shift + c); }
#pragma unroll
            for (int q = 0; q < 4; ++q) {
                float ss = 0.f;
#pragma unroll
                for (int j = 0; j < 4; ++j) ss += v[q][j].x * v[q][j].x + v[q][j].y * v[q][j].y + v[q][j].z * v[q][j].z + v[q][j].w * v[q][j].w;
                const float rs = rsqrtf(wave_sum(ss) * (1.f / 1024.f) + EPS);
#pragma unroll
                for (int j = 0; j < 4; ++j) {
                    ushort4 o;
                    o.x = f2bf(v[q][j].x * rs * g[j].x * (1.f + sc[j].x) + sh[j].x);
                    o.y = f2bf(v[q][j].y * rs * g[j].y * (1.f + sc[j].y) + sh[j].y);
                    o.z = f2bf(v[q][j].z * rs * g[j].z * (1.f + sc[j].z) + sh[j].z);
                    o.w = f2bf(v[q][j].w * rs * g[j].w * (1.f + sc[j].w) + sh[j].w);
                    *(ushort4*)(p.H + (size_t)(rw + 8 * q) * 1024 + j * 256 + lane * 4) = o;
                }
            }
            continue;
        }
      for (int r = chunk * 32 + wave; r < R && r < chunk * 32 + 32; r += 8) {
        const float* xr = r < TP ? p.x_prompt + (size_t)r * 1024 : p.x_sample + (size_t)(r - TP) * 1024;
        const int mrow = r < TP ? (r >> 12) : 4 + (r - TP);
        const float* shift = p.mod + mrow * 3072, *scale = shift + 1024;
        float4 v[4]; float ss = 0.f;
#pragma unroll
        for (int j = 0; j < 4; ++j) { v[j] = *(const float4*)(xr + j * 256 + lane * 4); ss += v[j].x * v[j].x + v[j].y * v[j].y + v[j].z * v[j].z + v[j].w * v[j].w; }
        const float rs = rsqrtf(wave_sum(ss) * (1.f / 1024.f) + EPS);
#pragma unroll
        for (int j = 0; j < 4; ++j) {
            const int c = j * 256 + lane * 4;
            const float4 g = *(const float4*)(p.g_norm + c), sc = *(const float4*)(scale + c), sh = *(const float4*)(shift + c);
            ushort4 o;
            o.x = f2bf(v[j].x * rs * g.x * (1.f + sc.x) + sh.x);
            o.y = f2bf(v[j].y * rs * g.y * (1.f + sc.y) + sh.y);
            o.z = f2bf(v[j].z * rs * g.z * (1.f + sc.z) + sh.z);
            o.w = f2bf(v[j].w * rs * g.w * (1.f + sc.w) + sh.w);
            *(ushort4*)(p.H + (size_t)r * 1024 + c) = o;
        }
      }
    }
}

constexpr int BM = 256, BK = 64, HALF = 128, HT = HALF * BK;
__device__ __forceinline__ int lds_byte(int r, int c) {
    int st = (r >> 4) * 2 + (c >> 5), rr = r & 15, cc = c & 31, ob = rr * 64 + cc * 2;
    return st * 1024 + (ob ^ (((ob >> 9) & 1) << 5));
}
__device__ __forceinline__ void stage_rc(int b, int& Rr, int& Cc) {
    int st = b / 1024, sb = b % 1024, swz = sb ^ (((sb >> 9) & 1) << 5);
    Rr = (st >> 1) * 16 + swz / 64; Cc = (st & 1) * 32 + (swz % 64) / 2;
}

template <class Epi>
__device__ __forceinline__ void gemm_phase(const bf16_t* __restrict__ A, const bf16_t* __restrict__ Bt, int nM, int nN, int K, char* lds, int bid, int nblk, const Epi& epi) {
    bf16_t* shm = (bf16_t*)lds;
#define SA(b, h) (shm + ((b) * 2 + (h)) * HT)
#define SB(b, h) (shm + (4 + (b) * 2 + (h)) * HT)
#define STAGE_X(T, P, BASE, br, kt) do { long _g = (long)(br) * K + (long)(kt) * BK; \
    for (int _i = 0; _i < 2; ++_i) { int _b = (T) * 16 + _i * 8192; int _r, _c; stage_rc(_b, _r, _c); \
      __builtin_amdgcn_global_load_lds((const unsigned*)(BASE + _g + (long)_r * K + _c), \
        (__attribute__((address_space(3))) unsigned*)((char*)(P) + _b), 16, 0, 0); } } while (0)
#define STAGE(P, BASE, br, kt) STAGE_X(tz0, P, BASE, br, kt)
#define LDA(dst, b, h) for (int m = 0; m < 4; ++m) for (int k = 0; k < 2; ++k) \
    dst[m][k] = *reinterpret_cast<const bf16x8*>((char*)SA(b, h) + lds_byte(wr * 64 + m * 16 + fr, k * 32 + fq * 8))
#define LDB(dst, b, h) for (int n = 0; n < 2; ++n) for (int k = 0; k < 2; ++k) \
    dst[n][k] = *reinterpret_cast<const bf16x8*>((char*)SB(b, h) + lds_byte(wc * 32 + n * 16 + fr, k * 32 + fq * 8))
#define MMA(ai, bj, At, Bt_) do { __builtin_amdgcn_s_setprio(1); \
    for (int m = 0; m < 4; ++m) for (int n = 0; n < 2; ++n) for (int k = 0; k < 2; ++k) \
      acc[ai][bj][m][n] = __builtin_amdgcn_mfma_f32_16x16x32_bf16(Bt_[n][k], At[m][k], acc[ai][bj][m][n], 0, 0, 0); \
    __builtin_amdgcn_s_setprio(0); } while (0)
#define WAIT_V(n) asm volatile("s_waitcnt vmcnt(" #n ")" ::: "memory")
#define WAIT_L(n) asm volatile("s_waitcnt lgkmcnt(" #n ")" ::: "memory")
#define BAR __builtin_amdgcn_s_barrier()
#define SCHED __builtin_amdgcn_sched_barrier(0)
    const int nwg = nM * nN;
    for (int tile = bid; tile < nwg; tile += nblk) {
        const int pm = tile / nN, pn = tile % nN;
        const int brow = pm * BM, bcol = pn * BM;
        int tz0 = threadIdx.x; asm volatile("" : "+v"(tz0));
        int wid = tz0 >> 6, lane = tz0 & 63, wr = wid >> 2, wc = wid & 3, fr = lane & 15, fq = lane >> 4;
        f32x4 acc[2][2][4][2] = {};
        bf16x8 At[4][2], B0[2][2], B1[2][2];
        const int nt = K / BK;
        STAGE(SB(0, 0), Bt, bcol, 0); STAGE(SA(0, 0), A, brow, 0);
        STAGE(SB(0, 1), Bt, bcol + HALF, 0); STAGE(SA(0, 1), A, brow + HALF, 0);
        if (wr == 1) BAR;
        WAIT_V(4); BAR;
        STAGE(SB(1, 0), Bt, bcol, 1); STAGE(SA(1, 0), A, brow, 1); STAGE(SB(1, 1), Bt, bcol + HALF, 1);
        WAIT_V(6); BAR;
        for (int t = 0; t < nt - 2; t += 2) {
            LDB(B0, 0, 0); SCHED; LDA(At, 0, 0); STAGE(SA(1, 1), A, brow + HALF, t + 1);
            WAIT_L(8); BAR; WAIT_L(0); MMA(0, 0, At, B0); BAR; SCHED;
            LDB(B1, 0, 1); STAGE(SB(0, 0), Bt, bcol, t + 2);
            BAR; WAIT_L(0); MMA(0, 1, At, B1); BAR;
            LDA(At, 0, 1); STAGE(SA(0, 0), A, brow, t + 2);
            BAR; WAIT_L(0); MMA(1, 0, At, B0); BAR; SCHED;
            STAGE(SB(0, 1), Bt, bcol + HALF, t + 2);
            WAIT_V(6); BAR; MMA(1, 1, At, B1); BAR;
            LDB(B0, 1, 0); SCHED; LDA(At, 1, 0); STAGE(SA(0, 1), A, brow + HALF, t + 2);
            WAIT_L(8); BAR; WAIT_L(0); MMA(0, 0, At, B0); BAR; SCHED;
            LDB(B1, 1, 1); STAGE(SB(1, 0), Bt, bcol, t + 3);
            BAR; WAIT_L(0); MMA(0, 1, At, B1); BAR;
            LDA(At, 1, 1); STAGE(SA(1, 0), A, brow, t + 3);
            BAR; WAIT_L(0); MMA(1, 0, At, B0); BAR; SCHED;
            STAGE(SB(1, 1), Bt, bcol + HALF, t + 3);
            WAIT_V(6); BAR; MMA(1, 1, At, B1); BAR;
        }
        int tz = threadIdx.x; asm volatile("" : "+v"(tz)); wid = tz >> 6; lane = tz & 63; wr = wid >> 2; wc = wid & 3; fr = lane & 15; fq = lane >> 4;
        { LDB(B0, 0, 0); WAIT_V(0); LDA(At, 0, 0); STAGE_X(tz, SA(1, 1), A, brow + HALF, nt - 1);
          BAR; WAIT_L(0); MMA(0, 0, At, B0); BAR;
          LDB(B1, 0, 1); BAR; WAIT_L(0); MMA(0, 1, At, B1); BAR;
          LDA(At, 0, 1); WAIT_V(4); BAR; WAIT_L(0); MMA(1, 0, At, B0); MMA(1, 1, At, B1); BAR; }
        { LDB(B0, 1, 0); LDA(At, 1, 0); WAIT_V(2); BAR; WAIT_L(0); MMA(0, 0, At, B0); BAR;
          LDB(B1, 1, 1); WAIT_V(0); BAR; WAIT_L(0); MMA(0, 1, At, B1); BAR;
          LDA(At, 1, 1); BAR; WAIT_L(0); MMA(1, 0, At, B0); MMA(1, 1, At, B1); BAR; }
        if (wr == 0) BAR;
        epi(acc, brow, bcol, wr, wc, fr, fq);
    }
#undef SA
#undef SB
#undef STAGE_X
#undef STAGE
#undef LDA
#undef LDB
#undef MMA
}

struct EpiOut {
    const Params* p;
    __device__ __forceinline__ void operator()(const f32x4 (&acc)[2][2][4][2], int brow, int bcol, int wr, int wc, int fr, int fq) const {
#pragma unroll
        for (int ai = 0; ai < 2; ++ai)
#pragma unroll
            for (int mt = 0; mt < 4; ++mt) {
                const int r = brow + ai * HALF + wr * 64 + mt * 16 + fr;
                if (r < R) {
                    const float* xr = r < TP ? p->x_prompt + (size_t)r * 1024 : p->x_sample + (size_t)(r - TP) * 1024;
                    const float* gate = p->mod + (r < TP ? (r >> 12) : 4 + (r - TP)) * 3072 + 2048;
#pragma unroll
                    for (int bj = 0; bj < 2; ++bj)
#pragma unroll
                        for (int nt = 0; nt < 2; ++nt) {
                            const int c = bcol + bj * HALF + wc * 32 + nt * 16 + 4 * fq;
                            const float4 xv = *(const float4*)(xr + c), gv = *(const float4*)(gate + c);
                            float4 o; o.x = xv.x + gv.x * acc[ai][bj][mt][nt][0]; o.y = xv.y + gv.y * acc[ai][bj][mt][nt][1];
                            o.z = xv.z + gv.z * acc[ai][bj][mt][nt][2]; o.w = xv.w + gv.w * acc[ai][bj][mt][nt][3];
                            *(float4*)(p->y + (size_t)r * 1024 + c) = o;
                        }
                }
            }
    }
};

struct EpiIn {
    const Params* p;
    __device__ __forceinline__ void operator()(const f32x4 (&acc)[2][2][4][2], int brow, int bcol, int wr, int wc, int fr, int fq) const {
        const int pn = bcol >> 8;
        const Params& P = *p;
        const bool normt = pn <= 1 || ((pn == 3 || pn == 4) && wc < 2);
        float4 g4h[2][2];
        { const float* gn = pn <= 1 ? P.g_q : pn == 3 ? P.g_ks : P.g_kw;
#pragma unroll
          for (int bj = 0; bj < 2; ++bj)
#pragma unroll
            for (int nt = 0; nt < 2; ++nt) g4h[bj][nt] = normt ? *(const float4*)(gn + bj * 32 + nt * 16 + 4 * fq) : make_float4(1.f, 1.f, 1.f, 1.f); }
#pragma unroll
        for (int ai = 0; ai < 2; ++ai)
#pragma unroll
            for (int mt = 0; mt < 4; ++mt) {
                const int r = brow + ai * HALF + wr * 64 + mt * 16 + fr;
                const bool rowok = r < R;
                const bool isp = r < TP;
                const int b = isp ? (r >> 12) : (r - TP), t = isp ? (r & 4095) : 0, pidx = isp ? t : 4096;
                f32x4 v[2][2];
#pragma unroll
                for (int bj = 0; bj < 2; ++bj)
#pragma unroll
                    for (int nt = 0; nt < 2; ++nt) v[bj][nt] = acc[ai][bj][mt][nt];
                if (normt) {
                    float ss = 0.f;
#pragma unroll
                    for (int bj = 0; bj < 2; ++bj)
#pragma unroll
                        for (int nt = 0; nt < 2; ++nt)
#pragma unroll
                            for (int rg = 0; rg < 4; ++rg) ss += v[bj][nt][rg] * v[bj][nt][rg];
                    ss += __shfl_xor(ss, 16); ss += __shfl_xor(ss, 32);
                    const float rs = rsqrtf(ss * (1.f / 64.f) + EPS);
#pragma unroll
                    for (int bj = 0; bj < 2; ++bj)
#pragma unroll
                        for (int nt = 0; nt < 2; ++nt) {
                            const float4 g4 = g4h[bj][nt];
                            v[bj][nt][0] *= rs * g4.x; v[bj][nt][1] *= rs * g4.y; v[bj][nt][2] *= rs * g4.z; v[bj][nt][3] *= rs * g4.w;
                        }
                }
                if (!rowok) continue;
                if (pn == 7 || pn == 8) {
                    const float lgm = __log2f(1.f - exp2f(-5.f - (float)wc)) * (float)((isp ? t : PAST) & 127);
                    const float sc = pn == 7 ? exp2f(lgm) : 0.125f * exp2f(-lgm);
#pragma unroll
                    for (int nt = 0; nt < 2; ++nt) {
                        const float4 c4 = *(const float4*)(P.ropec + (size_t)pidx * 32 + nt * 16 + 4 * fq), s4 = *(const float4*)(P.ropes + (size_t)pidx * 32 + nt * 16 + 4 * fq);
                        const f32x4 x1 = v[0][nt], x2 = v[1][nt];
                        v[0][nt][0] = (x1[0] * c4.x - x2[0] * s4.x) * sc; v[1][nt][0] = (x1[0] * s4.x + x2[0] * c4.x) * sc;
                        v[0][nt][1] = (x1[1] * c4.y - x2[1] * s4.y) * sc; v[1][nt][1] = (x1[1] * s4.y + x2[1] * c4.y) * sc;
                        v[0][nt][2] = (x1[2] * c4.z - x2[2] * s4.z) * sc; v[1][nt][2] = (x1[2] * s4.z + x2[2] * c4.z) * sc;
                        v[0][nt][3] = (x1[3] * c4.w - x2[3] * s4.w) * sc; v[1][nt][3] = (x1[3] * s4.w + x2[3] * c4.w) * sc;
                    }
                }
                if (pn == 5 || pn == 6 || pn == 11 || pn == 12) {
#pragma unroll
                    for (int bj = 0; bj < 2; ++bj)
#pragma unroll
                        for (int nt = 0; nt < 2; ++nt)
#pragma unroll
                            for (int rg = 0; rg < 4; ++rg) v[bj][nt][rg] = silu(v[bj][nt][rg]);
                }
                bf16_t* bdst = nullptr; float* fdst = nullptr;
                if (pn <= 1) bdst = P.qn + (size_t)r * 512 + (pn * 4 + wc) * 64;
                else if (pn == 2) fdst = (isp ? P.p_cmp + (size_t)r * 256 : P.s_cmp + (size_t)b * 256) + wc * 64;
                else if (pn == 3) { fdst = (isp ? P.p_slc + (size_t)r * 256 : P.s_slc + (size_t)b * 256) + wc * 64;
                                    if (isp) bdst = (wc < 2 ? P.ks : P.vs) + ((size_t)(b * 2 + (wc & 1)) * SEQ + t) * 64; }
                else if (pn == 4) { fdst = isp ? (t >= SEQ - 512 ? P.p_win + ((size_t)b * 512 + (t - (SEQ - 512))) * 256 + wc * 64 : nullptr) : P.s_win + ((size_t)b * 512 + 511) * 256 + wc * 64;
                                    if (isp) bdst = (wc < 2 ? P.kw : P.vw) + ((size_t)(b * 2 + (wc & 1)) * SEQ + t) * 64; }
                else if (pn == 5 || pn == 6) bdst = P.ga + (size_t)r * 512 + (pn - 5) * 256 + wc * 64;
                else if (pn == 7) bdst = P.rq + (size_t)r * 256 + wc * 64;
                else if (pn == 8) bdst = P.rk + (size_t)r * 256 + wc * 64;
                else if (pn == 9 || pn == 10) bdst = P.rv + (size_t)r * 512 + (pn - 9) * 256 + wc * 64;
                else if (pn == 11 || pn == 12) bdst = P.gr + (size_t)r * 512 + (pn - 11) * 256 + wc * 64;
                if (pn == 13) {
                    if (wc == 0) {
                        float* gd = P.gates + (size_t)r * 24;
                        { float4 o; o.x = sigmoidf(v[0][0][0]); o.y = sigmoidf(v[0][0][1]); o.z = sigmoidf(v[0][0][2]); o.w = sigmoidf(v[0][0][3]); *(float4*)(gd + 4 * fq) = o; }
                        if (fq < 2) { float4 o; o.x = sigmoidf(v[0][1][0]); o.y = sigmoidf(v[0][1][1]); o.z = sigmoidf(v[0][1][2]); o.w = sigmoidf(v[0][1][3]); *(float4*)(gd + 16 + 4 * fq) = o; }
                    }
                    continue;
                }
#pragma unroll
                for (int bj = 0; bj < 2; ++bj)
#pragma unroll
                    for (int nt = 0; nt < 2; ++nt) {
                        const int cl = bj * 32 + nt * 16 + 4 * fq;
                        if (fdst) { float4 o; o.x = v[bj][nt][0]; o.y = v[bj][nt][1]; o.z = v[bj][nt][2]; o.w = v[bj][nt][3]; *(float4*)(fdst + cl) = o; }
                        if (bdst) { uint2 o; o.x = cvt_pk_bf16(v[bj][nt][0], v[bj][nt][1]); o.y = cvt_pk_bf16(v[bj][nt][2], v[bj][nt][3]); *(uint2*)(bdst + cl) = o; }
                    }
            }
    }
};

__device__ __forceinline__ void p3_rows(const Params& p, int bid, int nblk) {
    const int tid = opaque_tid(), lane = tid & 63, wave = tid >> 6;
    for (int r = bid * 8 + wave; r < R; r += nblk * 8) {
        const float* pr = p.praw + (size_t)r * NPAD;
        const bool isp = r < TP;
        const int b = isp ? (r >> 12) : (r - TP), t = isp ? (r & 4095) : 0;
        const int pos = isp ? t : PAST;
        {
            const float gq = p.g_q[lane];
            for (int hh = 0; hh < 8; ++hh) {
                const float v = pr[C_Q + hh * 64 + lane];
                const float rs = rsqrtf(wave_sum(v * v) * (1.f / 64.f) + EPS);
                p.qn[(size_t)r * 512 + hh * 64 + lane] = f2bf(v * rs * gq);
            }
        }
        float* o_cmp = isp ? p.p_cmp + (size_t)r * 256 : p.s_cmp + (size_t)b * 256;
        float* o_slc = isp ? p.p_slc + (size_t)r * 256 : p.s_slc + (size_t)b * 256;
        float* o_win = isp ? (t >= SEQ - 512 ? p.p_win + ((size_t)b * 512 + (t - (SEQ - 512))) * 256 : nullptr) : p.s_win + ((size_t)b * 512 + 511) * 256;
        for (int j = 0; j < 4; ++j) {
            const int g = j & 1;
            const size_t cidx = ((size_t)(b * 2 + g) * SEQ + t) * 64 + lane;
            {
                const float v = pr[C_KC + j * 64 + lane];
                o_cmp[j * 64 + lane] = v;
                if (isp) { if (j < 2) p.kcr[cidx] = f2bf(v); else p.vcr[cidx] = f2bf(v); }
            }
            {
                float v = pr[C_KS + j * 64 + lane];
                if (j < 2) { const float rs = rsqrtf(wave_sum(v * v) * (1.f / 64.f) + EPS); v = v * rs * p.g_ks[lane]; }
                o_slc[j * 64 + lane] = v;
                if (isp) { if (j < 2) p.ks[cidx] = f2bf(v); else p.vs[cidx] = f2bf(v); }
            }
            {
                float v = pr[C_KW + j * 64 + lane];
                if (j < 2) { const float rs = rsqrtf(wave_sum(v * v) * (1.f / 64.f) + EPS); v = v * rs * p.g_kw[lane]; }
                if (o_win) o_win[j * 64 + lane] = v;
                if (isp) { if (j < 2) p.kw[cidx] = f2bf(v); else p.vw[cidx] = f2bf(v); }
            }
        }
        if (lane < 24) p.gates[(size_t)r * 24 + lane] = sigmoidf(pr[C_BR + lane]);
        for (int i = 0; i < 8; ++i) {
            p.ga[(size_t)r * 512 + i * 64 + lane] = f2bf(silu(pr[C_GA + i * 64 + lane]));
            p.gr[(size_t)r * 512 + i * 64 + lane] = f2bf(silu(pr[C_GR + i * 64 + lane]));
            p.rv[(size_t)r * 512 + i * 64 + lane] = f2bf(pr[C_RV + i * 64 + lane]);
        }
        {
            const int i = lane & 31;
            const float freq = powf(10000.f, -(float)i / 32.f);
            const float ang = (float)pos * freq;
            float sn, cs; sincosf(ang, &sn, &cs);
            for (int hh = 0; hh < 4; ++hh) {
                const float a = pr[C_RQ + hh * 64 + lane], ao = pr[C_RQ + hh * 64 + (lane ^ 32)];
                const float kq = pr[C_RK + hh * 64 + lane], ko = pr[C_RK + hh * 64 + (lane ^ 32)];
                const float oq = lane < 32 ? a * cs - ao * sn : ao * sn + a * cs;
                const float ok = lane < 32 ? kq * cs - ko * sn : ko * sn + kq * cs;
                const float lgm = __log2f(1.f - exp2f(-5.f - (float)hh)) * (float)(pos & 127);
                p.rq[(size_t)r * 256 + hh * 64 + lane] = f2bf(oq * exp2f(lgm));
                p.rk[(size_t)r * 256 + hh * 64 + lane] = f2bf(ok * 0.125f * exp2f(-lgm));
            }
        }
    }
}

typedef unsigned u32x4 __attribute__((ext_vector_type(4)));

struct CmpTile {
    int active;
    int b, c0;
    int seam_idx;
    int is_sample;
};

__device__ __forceinline__ void cmp_second_layer(const Params& p, int kv, const f32x4 (&pre)[4], bf16_t* hb  , const bf16_t* w2s  , bf16_t* dst  , int lane) {
    const int fr = lane & 15, G = lane >> 4;
#pragma unroll
    for (int nt = 0; nt < 4; ++nt)
#pragma unroll
        for (int r = 0; r < 4; ++r) hb[(G * 4 + r) * 64 + nt * 16 + fr] = f2bf(silu(pre[nt][r]));
    WSYNC();
    bf16x8 hf[2];
#pragma unroll
    for (int ks = 0; ks < 2; ++ks) hf[ks] = *(const bf16x8*)(hb + fr * 64 + ks * 32 + G * 8);
    f32x4 out[4];
#pragma unroll
    for (int nt = 0; nt < 4; ++nt) {
        out[nt] = (f32x4){0.f, 0.f, 0.f, 0.f};
#pragma unroll
        for (int ks = 0; ks < 2; ++ks) {
            const bf16x8 wf = *(const bf16x8*)(w2s + (nt * 16 + fr) * 64 + ks * 32 + G * 8);
            out[nt] = __builtin_amdgcn_mfma_f32_16x16x32_bf16(hf[ks], wf, out[nt], 0, 0, 0);
        }
    }
    WSYNC();
    float rs[4] = {1.f, 1.f, 1.f, 1.f};
    if (kv == 0) {
#pragma unroll
        for (int r = 0; r < 4; ++r) {
            float ss = 0.f;
#pragma unroll
            for (int nt = 0; nt < 4; ++nt) ss += out[nt][r] * out[nt][r];
            ss += __shfl_xor(ss, 1); ss += __shfl_xor(ss, 2); ss += __shfl_xor(ss, 4); ss += __shfl_xor(ss, 8);
            rs[r] = rsqrtf(ss * (1.f / 64.f) + EPS);
        }
    }
#pragma unroll
    for (int nt = 0; nt < 4; ++nt) {
        const float gk = kv == 0 ? p.g_kc[nt * 16 + fr] : 1.f;
#pragma unroll
        for (int r = 0; r < 4; ++r) {
            const int row = G * 4 + r;
            if (row < 15) dst[(size_t)row * 64 + nt * 16 + fr] = f2bf(out[nt][r] * rs[r] * gk);
        }
    }
}

constexpr int CMP_HB = 131072, CMP_W2S = 147456 + 64, CMP_B1S = CMP_W2S + 8192;
__device__ __forceinline__ void compress_setup(const Params& p, char* lds, int kv) {
    const int tid = opaque_tid();
    const float* w1 = kv ? p.w_cv1 : p.w_ck1; const float* pe = kv ? p.pe_cv : p.pe_ck; const float* w2 = kv ? p.w_cv2 : p.w_ck2;
    bf16_t* w2s = (bf16_t*)(lds + CMP_W2S); float* b1s = (float*)(lds + CMP_B1S); float* part = (float*)(lds + CMP_HB);
    __syncthreads();
    for (int i = tid; i < 4096; i += NT) { const int f = i >> 6, d = i & 63; w2s[d * 64 + f] = f2bf(w2[i]); }
    {
      const int fq4 = tid & 15, ks32 = tid >> 4;
      const float* wp = w1 + (size_t)ks32 * 64 * 64 + 4 * fq4; const float* pp = pe + ks32 * 64;
      float4 s = {0.f, 0.f, 0.f, 0.f};
#pragma unroll 16
      for (int k = 0; k < 64; ++k) { const float4 w = *(const float4*)(wp + (size_t)k * 64); const float pv = pp[k]; s.x += pv * w.x; s.y += pv * w.y; s.z += pv * w.z; s.w += pv * w.w; }
      *(float4*)(part + ks32 * 64 + 4 * fq4) = s; }
    __syncthreads();
    if (tid < 64) { float s = 0.f; for (int j = 0; j < 32; ++j) s += part[j * 64 + tid]; b1s[tid] = s; p.b1[kv * 64 + tid] = s; }
    __syncthreads();
}
template <int O>
__device__ __forceinline__ void cmp_rd4(unsigned a, bf16x8 (&b)[4]) {
    asm volatile(
        "ds_read_b128 %0, %4 offset:%5\n\t"
        "ds_read_b128 %1, %4 offset:%6\n\t"
        "ds_read_b128 %2, %4 offset:%7\n\t"
        "ds_read_b128 %3, %4 offset:%8\n\t"
        "s_waitcnt lgkmcnt(0)"
        : "=&v"(b[0]), "=&v"(b[1]), "=&v"(b[2]), "=&v"(b[3])
        : "v"(a), "i"(O), "i"(O + 1024), "i"(O + 2048), "i"(O + 3072) : "memory");
}
template <int O0, int O1>
__device__ __forceinline__ void cmp_lda(const float* a0, const float* a1, f32x4 (&q)[2][2]) {
    asm volatile("global_load_dwordx4 %0, %4, off offset:%6 nt\n\t"
                 "global_load_dwordx4 %1, %5, off offset:%6 nt\n\t"
                 "global_load_dwordx4 %2, %4, off offset:%7 nt\n\t"
                 "global_load_dwordx4 %3, %5, off offset:%7 nt"
                 : "=&v"(q[0][0]), "=&v"(q[0][1]), "=&v"(q[1][0]), "=&v"(q[1][1])
                 : "v"(a0), "v"(a1), "i"(O0), "i"(O1) : "memory");
}
template <int N>
__device__ __forceinline__ void cmp_wait(f32x4 (&q)[2][2]) {
    asm volatile("s_waitcnt vmcnt(%4)" : "+v"(q[0][0]), "+v"(q[0][1]), "+v"(q[1][0]), "+v"(q[1][1]) : "n"(N) : "memory");
}
__device__ __forceinline__ void cmp_stage_wq(const Params& p, LAS char* l3, int kv, int q, int tid) {
    const int n = tid >> 2, Gp = (tid & 3) ^ ((n >> 2) & 3);
    const bf16_t* src = p.w1p + ((size_t)kv * 128 + n) * 1024 + q * 256 + Gp * 8;
    LAS char* dst = l3 + (q & 1) * 65536 + tid * 16;
#pragma unroll
    for (int j = 0; j < 8; ++j)
        __builtin_amdgcn_global_load_lds((const unsigned*)(src + j * 32), (LAS unsigned*)(dst + j * 8192), 16, 0, 0);
}
__device__ __forceinline__ void compress_pass_s(const Params& p, char* lds, int kv, int b, int c0w, int seam_idx, bool first, bool more) {
    LAS char* l3 = (LAS char*)lds;
    const int tid = opaque_tid(), lane = tid & 63, wave = tid >> 6, fr = lane & 15, G = lane >> 4;
    bf16_t* hb = (bf16_t*)(lds + CMP_HB) + wave * 1024;
    const bf16_t* w2s = (const bf16_t*)(lds + CMP_W2S); const float* b1s = (const float*)(lds + CMP_B1S);
    const float* abase[2];
#pragma unroll
    for (int i = 0; i < 2; ++i) {
        const int c = c0w + (fr & 7) + 8 * i;
        const int pg = p.page_table[b * NPAGES + (c >> 3)];
        abase[i] = p.cache_cmp + (((size_t)pg * 128 + (c & 7) * 16) * 4 + kv * 2) * 64 + (fr >> 3) * 16 + G * 4;
    }
    const bool lowl = fr < 8;
    const unsigned bl = (unsigned)(unsigned long long)l3 + fr * 64 + ((G ^ (fr >> 2)) * 16);
    f32x4 acc[2][8];
#pragma unroll
    for (int g = 0; g < 2; ++g)
#pragma unroll
        for (int nt = 0; nt < 8; ++nt) acc[g][nt] = (f32x4){0.f, 0.f, 0.f, 0.f};
    f32x4 aq[6][2][2];
#define CMP_LOADA(u, s) do { const float* _a0 = abase[0] + ((s) >> 1) * 256; const float* _a1 = abase[1] + ((s) >> 1) * 256; \
        if ((s) & 1) cmp_lda<128, 384>(_a0, _a1, aq[u]); else cmp_lda<0, 256>(_a0, _a1, aq[u]); } while (0)
#define CMP_WAITA(u, s) do { const int _y = 31 - (s); if (_y >= 5) cmp_wait<20>(aq[u]); else if (_y == 4) cmp_wait<16>(aq[u]); else if (_y == 3) cmp_wait<12>(aq[u]); \
        else if (_y == 2) cmp_wait<8>(aq[u]); else if (_y == 1) cmp_wait<4>(aq[u]); else cmp_wait<0>(aq[u]); } while (0)
#pragma unroll
    for (int u = 0; u < 6; ++u) CMP_LOADA(u, u);
    if (first) { cmp_stage_wq(p, l3, kv, 0, tid); asm volatile("s_waitcnt vmcnt(0)" ::: "memory"); }
#pragma unroll
    for (int s = 0; s < 32; ++s) {
        const int q = s >> 3, u = s % 6;
        if ((s & 7) == 0) {
            asm volatile("" ::: "memory");
            __builtin_amdgcn_s_barrier();
            asm volatile("" ::: "memory");
            if (q < 3 || more) cmp_stage_wq(p, l3, kv, (q + 1) & 3, tid);
            asm volatile("" ::: "memory");
        }
        CMP_WAITA(u, s);
        bf16x8 af[2];
#pragma unroll
        for (int g = 0; g < 2; ++g) {
            u32x4 t;
            f32x4 x0, x1;
#pragma unroll
            for (int e = 0; e < 4; ++e) {
                const float give = lowl ? aq[u][g][1][e] : aq[u][g][0][e];
                const float recv = __builtin_bit_cast(float, __builtin_amdgcn_mov_dpp(__builtin_bit_cast(int, give), 0x128, 0xF, 0xF, true));
                x0[e] = lowl ? aq[u][g][0][e] : recv; x1[e] = lowl ? recv : aq[u][g][1][e];
            }
            t[0] = cvt_pk_bf16(x0[0], x0[1]); t[1] = cvt_pk_bf16(x0[2], x0[3]);
            t[2] = cvt_pk_bf16(x1[0], x1[1]); t[3] = cvt_pk_bf16(x1[2], x1[3]);
            af[g] = __builtin_bit_cast(bf16x8, t);
        }
        if (s + 6 < 32) CMP_LOADA(u, s + 6);
        const unsigned a = bl + (q & 1) * 65536 + (s & 7) * 8192;
        bf16x8 bf[4];
        cmp_rd4<0>(a, bf);
#pragma unroll
        for (int nt = 0; nt < 4; ++nt) {
            acc[0][nt] = __builtin_amdgcn_mfma_f32_16x16x32_bf16(af[0], bf[nt], acc[0][nt], 0, 0, 0);
            acc[1][nt] = __builtin_amdgcn_mfma_f32_16x16x32_bf16(af[1], bf[nt], acc[1][nt], 0, 0, 0);
        }
        cmp_rd4<4096>(a, bf);
#pragma unroll
        for (int nt = 0; nt < 4; ++nt) {
            acc[0][4 + nt] = __builtin_amdgcn_mfma_f32_16x16x32_bf16(af[0], bf[nt], acc[0][4 + nt], 0, 0, 0);
            acc[1][4 + nt] = __builtin_amdgcn_mfma_f32_16x16x32_bf16(af[1], bf[nt], acc[1][4 + nt], 0, 0, 0);
        }
    }
#undef CMP_LOADA
#undef CMP_WAITA
#pragma unroll
    for (int g = 0; g < 2; ++g) {
        f32x4 pre[4];
#pragma unroll
        for (int nt = 0; nt < 4; ++nt) {
            const float bias = b1s[nt * 16 + fr];
            const float nb0 = __shfl_down(acc[g][4 + nt][0], 16);
            pre[nt][0] = acc[g][nt][0] + acc[g][4 + nt][1] + bias;
            pre[nt][1] = acc[g][nt][1] + acc[g][4 + nt][2] + bias;
            pre[nt][2] = acc[g][nt][2] + acc[g][4 + nt][3] + bias;
            pre[nt][3] = acc[g][nt][3] + nb0 + bias;
            if (G == 3) p.seamA[((size_t)seam_idx * 2 + g) * 64 + nt * 16 + fr] = acc[g][nt][3];
            if (G == 0) p.seamB[((size_t)seam_idx * 2 + g) * 64 + nt * 16 + fr] = acc[g][4 + nt][0];
        }
        bf16_t* dst = (kv ? p.vcs : p.kcs) + ((size_t)(b * 2 + g) * 1024 + c0w) * 64;
        cmp_second_layer(p, kv, pre, hb, w2s, dst, lane);
    }
}

__device__ __forceinline__ void compress_sample(const Params& p, char* lds, int bid, int nblk) {
    const int wave = opaque_tid() >> 6;
    int kv_set = -1;
    for (int pass = bid; pass < 512; pass += nblk) {
        const int P = pass & 7, kv = (pass >> 3) & 1, b = pass >> 4;
        const int c0w = P * 128 + wave * 16;
        const bool first = kv != kv_set;
        if (first) { compress_setup(p, lds, kv); kv_set = kv; }
        const int nxt = pass + nblk;
        const bool more = nxt < 512 && ((nxt >> 3) & 1) == kv;
        compress_pass_s(p, lds, kv, b, c0w, (b * 2 + kv) * 64 + (c0w >> 4), first, more);
    }
}

__device__ __forceinline__ void compress_prompt_ksplit_item(const Params& p, char* lds, int item) {
    const int tid = opaque_tid(), lane = tid & 63, wave = tid >> 6, fr = lane & 15, G = lane >> 4;
    f32x4* part = (f32x4*)lds;
    {
        const int kv = item / 68, tile = item % 68, b = tile / 17, c0 = (tile % 17) * 15;
        const float* abase = p.p_cmp + (((size_t)b * SEQ + (size_t)(c0 + fr) * 16) * 4 + kv * 2) * 64 + G * 4;
        const bf16_t* wbase = p.w1p + ((size_t)kv * 128 + fr) * 1024 + G * 8;
        f32x4 acc[2][8];
#pragma unroll
        for (int g = 0; g < 2; ++g)
#pragma unroll
            for (int nt = 0; nt < 8; ++nt) acc[g][nt] = (f32x4){0.f, 0.f, 0.f, 0.f};
#pragma unroll
        for (int u = 0; u < 4; ++u) {
            const int s = wave * 4 + u;
            const float* a = abase + (s >> 1) * 256 + (s & 1) * 32;
            bf16x8 af[2];
#pragma unroll
            for (int g = 0; g < 2; ++g) {
                const f32x4 x0 = *(const f32x4*)(a + g * 64), x1 = *(const f32x4*)(a + g * 64 + 16);
                u32x4 t; t[0] = cvt_pk_bf16(x0[0], x0[1]); t[1] = cvt_pk_bf16(x0[2], x0[3]); t[2] = cvt_pk_bf16(x1[0], x1[1]); t[3] = cvt_pk_bf16(x1[2], x1[3]);
                af[g] = __builtin_bit_cast(bf16x8, t);
            }
#pragma unroll
            for (int nt = 0; nt < 8; ++nt) {
                const bf16x8 wf = *(const bf16x8*)(wbase + (size_t)nt * 16 * 1024 + s * 32);
                acc[0][nt] = __builtin_amdgcn_mfma_f32_16x16x32_bf16(af[0], wf, acc[0][nt], 0, 0, 0);
                acc[1][nt] = __builtin_amdgcn_mfma_f32_16x16x32_bf16(af[1], wf, acc[1][nt], 0, 0, 0);
            }
        }
        __syncthreads();
#pragma unroll
        for (int g = 0; g < 2; ++g)
#pragma unroll
            for (int nt = 0; nt < 8; ++nt) part[((wave * 2 + g) * 8 + nt) * 64 + lane] = acc[g][nt];
        __syncthreads();
        if (wave < 2) {
            const int g = wave;
            f32x4 tot[8];
#pragma unroll
            for (int nt = 0; nt < 8; ++nt) {
                tot[nt] = part[((0 * 2 + g) * 8 + nt) * 64 + lane];
#pragma unroll
                for (int w = 1; w < 8; ++w) tot[nt] += part[((w * 2 + g) * 8 + nt) * 64 + lane];
            }
            f32x4 pre[4];
#pragma unroll
            for (int nt = 0; nt < 4; ++nt) {
                const float bias = p.b1[kv * 64 + nt * 16 + fr];
                const float nb0 = __shfl_down(tot[4 + nt][0], 16);
                pre[nt][0] = tot[nt][0] + tot[4 + nt][1] + bias; pre[nt][1] = tot[nt][1] + tot[4 + nt][2] + bias;
                pre[nt][2] = tot[nt][2] + tot[4 + nt][3] + bias; pre[nt][3] = tot[nt][3] + nb0 + bias;
            }
            bf16_t* hb = (bf16_t*)(lds + 131072) + wave * 1024;
            bf16_t* dst = (kv ? p.vc : p.kc) + ((size_t)(b * 2 + g) * 256 + c0) * 64;
            cmp_second_layer(p, kv, pre, hb, p.w2t + (size_t)kv * 4096, dst, lane);
        }
        __syncthreads();
    }
}
__device__ __forceinline__ void compress_seams(const Params& p, int bid, int nblk) {
    const int tid = opaque_tid(), lane = tid & 63, wave = tid >> 6;
    if (bid < 0) return;
    for (int it = bid * 8 + wave; it < 32 * 2 * 2 * 63; it += nblk * 8) {
        const int Tt = it % 63, rest = it / 63, g = rest & 1, kv = (rest >> 1) & 1, b = rest >> 2;
        const size_t sa = ((size_t)((b * 2 + kv) * 64 + Tt) * 2 + g) * 64 + lane, sb = ((size_t)((b * 2 + kv) * 64 + Tt + 1) * 2 + g) * 64 + lane;
        const float h = silu(p.seamA[sa] + p.seamB[sb] + p.b1[kv * 64 + lane]);
        const float* w2 = kv ? p.w_cv2 : p.w_ck2;
        float o = 0.f;
        for (int f = 0; f < 64; ++f) o += bf2f(f2bf(__shfl(h, f))) * bf2f(f2bf(w2[f * 64 + lane]));
        if (kv == 0) { const float rs = rsqrtf(wave_sum(o * o) * (1.f / 64.f) + EPS); o = o * rs * p.g_kc[lane]; }
        ((kv ? p.vcs : p.kcs) + ((size_t)(b * 2 + g) * 1024 + 16 * Tt + 15) * 64)[lane] = f2bf(o);
    }
}
template <typename T>
__device__ __forceinline__ void attend64(const float* qs, float* pl, const T* kbase, const T* vbase, size_t stride, bool valid, int lane, float (&m)[4], float (&l)[4], float (&o)[4]) {
    float s[4] = {0.f, 0.f, 0.f, 0.f};
    if (valid) {
        const T* kr = kbase + (size_t)lane * stride;
        float kfa[8][8];
#pragma unroll
        for (int c = 0; c < 8; ++c) load8(kr + c * 8, kfa[c]);
#pragma unroll
        for (int c = 0; c < 8; ++c)
#pragma unroll
            for (int h = 0; h < 4; ++h)
#pragma unroll
                for (int j = 0; j < 8; ++j) s[h] += qs[h * 64 + c * 8 + j] * kfa[c][j];
    }
    const unsigned long long vm = __ballot(valid);
    if (vm == 0ull) return;
#pragma unroll
    for (int h = 0; h < 4; ++h) {
        const float sv = valid ? s[h] * 0.125f : -1e30f;
        const float mn = fmaxf(m[h], wave_max(sv));
        const float alpha = __expf(m[h] - mn);
        const float pv = valid ? __expf(sv - mn) : 0.f;
        l[h] = l[h] * alpha + wave_sum(pv); o[h] *= alpha; m[h] = mn;
        pl[h * 64 + lane] = pv;
    }
    WSYNC();
    const int kfirst = __ffsll((long long)vm) - 1;
#pragma unroll 32
    for (int kk = 0; kk < 64; ++kk) {
        const int kr = ((vm >> kk) & 1ull) ? kk : kfirst;
        const float vv = load1(vbase + (size_t)kr * stride + lane);
#pragma unroll
        for (int h = 0; h < 4; ++h) o[h] += pl[h * 64 + kk] * vv;
    }
    WSYNC();
}

__device__ __forceinline__ void cmp_branch(const float* qs, float* pl, float* ps, const bf16_t* kc, const bf16_t* vc, int n_c, int lane, float (&oc)[4]) {
    float m[4] = {-1e30f, -1e30f, -1e30f, -1e30f}, l[4] = {0.f, 0.f, 0.f, 0.f};
    for (int c0 = 0; c0 < n_c; c0 += 64) {
        const bool valid = c0 + lane < n_c;
        float s[4] = {0.f, 0.f, 0.f, 0.f};
        if (valid) {
            const bf16_t* kr = kc + (size_t)(c0 + lane) * 64;
#pragma unroll 2
            for (int c = 0; c < 8; ++c) {
                float kf[8]; load8(kr + c * 8, kf);
#pragma unroll
                for (int h = 0; h < 4; ++h)
#pragma unroll
                    for (int j = 0; j < 8; ++j) s[h] += qs[h * 64 + c * 8 + j] * kf[j];
            }
        }
#pragma unroll
        for (int h = 0; h < 4; ++h) {
            const float sv = valid ? s[h] * 0.125f : -1e30f;
            const float mn = fmaxf(m[h], wave_max(sv));
            const float pv = valid ? __expf(sv - mn) : 0.f;
            l[h] = l[h] * __expf(m[h] - mn) + wave_sum(pv); m[h] = mn;
        }
    }
    for (int c0 = 0; c0 < n_c; c0 += 64) {
        const bool valid = c0 + lane < n_c;
        float s[4] = {0.f, 0.f, 0.f, 0.f};
        if (valid) {
            const bf16_t* kr = kc + (size_t)(c0 + lane) * 64;
#pragma unroll 2
            for (int c = 0; c < 8; ++c) {
                float kf[8]; load8(kr + c * 8, kf);
#pragma unroll
                for (int h = 0; h < 4; ++h)
#pragma unroll
                    for (int j = 0; j < 8; ++j) s[h] += qs[h * 64 + c * 8 + j] * kf[j];
            }
        }
        float psum = 0.f;
#pragma unroll
        for (int h = 0; h < 4; ++h) {
            const float pv = valid ? __expf(s[h] * 0.125f - m[h]) / l[h] : 0.f;
            pl[h * 64 + lane] = pv; psum += pv;
        }
        if (valid) ps[1 + c0 + lane] = psum;
        WSYNC();
        const int nk = min(64, n_c - c0);
        for (int kk = 0; kk < nk; ++kk) {
            const float vv = bf2f(vc[(size_t)(c0 + kk) * 64 + lane]);
#pragma unroll
            for (int h = 0; h < 4; ++h) oc[h] += pl[h * 64 + kk] * vv;
        }
        WSYNC();
    }
}

__device__ __forceinline__ void topk16(float* sc, int* sel, int n_sel, int lane) {
    for (int round = 0; round < 16; ++round) {
        float bv = -3.0e38f; int bi = 0x7fffffff;
        for (int j = lane; j < n_sel; j += 64) { const float v = sc[j]; if (v > bv) { bv = v; bi = j; } }
#pragma unroll
        for (int o = 1; o < 64; o <<= 1) {
            const float ov = __shfl_xor(bv, o); const int oi = __shfl_xor(bi, o);
            if (ov > bv || (ov == bv && oi < bi)) { bv = ov; bi = oi; }
        }
        if (lane == 0) { sel[round] = bi; sc[bi] = -3.4e38f; }
        WSYNC();
    }
}

constexpr int ATT_WLDS = 256 + 256 + 1040 + 272 + 16;
__device__ __forceinline__ void p5_attention(const Params& p, char* lds, int bid, int nblk) {
    const int tid = threadIdx.x, lane = tid & 63, wave = tid >> 6;
    float* wl = (float*)lds + wave * ATT_WLDS;
    float *qs = wl, *pl = wl + 256, *ps = wl + 512, *sc = wl + 1552; int* sel = (int*)(wl + 1824);
    const int gw = bid * 8 + wave, ngw = nblk * 8;
    for (int it = gw; it < R * 2; it += ngw) {
        const int r = it >> 1, g = it & 1;
        const bool isp = r < TP;
        const int b = isp ? (r >> 12) : (r - TP), t = isp ? (r & 4095) : PAST;
        const int n_sel = isp ? 64 : 257;
        const int n_cmax = isp ? 255 : 1023;
#pragma unroll
        for (int h = 0; h < 4; ++h) qs[h * 64 + lane] = bf2f(p.qn[(size_t)r * 512 + (g * 4 + h) * 64 + lane]);
        for (int i = lane; i < 4 * n_sel + 1; i += 64) ps[i] = 0.f;
        WSYNC();
        int n_c = t >= 31 ? (t - 31) / 16 + 1 : 0; if (n_c > n_cmax) n_c = n_cmax;
        float oc[4] = {0.f, 0.f, 0.f, 0.f};
        {
            const bf16_t* kc = isp ? p.kc + (size_t)(b * 2 + g) * 256 * 64 : p.kcs + (size_t)(b * 2 + g) * 1024 * 64;
            const bf16_t* vc = isp ? p.vc + (size_t)(b * 2 + g) * 256 * 64 : p.vcs + (size_t)(b * 2 + g) * 1024 * 64;
            cmp_branch(qs, pl, ps, kc, vc, n_c, lane, oc);
        }
        const int jt = t >> 6;
        for (int j = lane; j < n_sel; j += 64) {
            float imp = 0.f;
#pragma unroll
            for (int rr = 0; rr < 4; ++rr) imp += ps[4 * j + rr + 1] + ps[4 * j + rr];
            const bool valid = j * 64 <= t, forced = (j == 0) || (j == jt) || (j == jt - 1);
            sc[j] = valid ? (forced ? 1e4f : imp) : -1e30f;
        }
        WSYNC();
        topk16(sc, sel, n_sel, lane);
        float ms[4] = {-1e30f, -1e30f, -1e30f, -1e30f}, lsum[4] = {0.f, 0.f, 0.f, 0.f}, os[4] = {0.f, 0.f, 0.f, 0.f};
        for (int k = 0; k < 16; ++k) {
            const int j = sel[k];
            if (j * 64 > t) continue;
            const bool valid = j * 64 + lane <= t;
            if (isp) {
                const size_t base = ((size_t)(b * 2 + g) * SEQ + (size_t)j * 64) * 64;
                attend64<bf16_t>(qs, pl, p.ks + base, p.vs + base, 64, valid, lane, ms, lsum, os);
            } else if (j == 256) {
                attend64<float>(qs, pl, p.s_slc + (size_t)b * 256 + g * 64, p.s_slc + (size_t)b * 256 + 128 + g * 64, 256, valid, lane, ms, lsum, os);
            } else {
                const int pg = p.page_table[b * NPAGES + (j >> 1)];
                const float* base = p.cache_slc + (((size_t)pg * 128 + (j & 1) * 64) * 4 + g) * 64;
                attend64<float>(qs, pl, base, base + 128, 256, valid, lane, ms, lsum, os);
            }
        }
        float mw[4] = {-1e30f, -1e30f, -1e30f, -1e30f}, lw[4] = {0.f, 0.f, 0.f, 0.f}, ow[4] = {0.f, 0.f, 0.f, 0.f};
        if (isp) {
            const int start = t - 511 > 0 ? t - 511 : 0;
            for (int c0 = start; c0 <= t; c0 += 64) {
                const size_t base = ((size_t)(b * 2 + g) * SEQ + c0) * 64;
                attend64<bf16_t>(qs, pl, p.kw + base, p.vw + base, 64, c0 + lane <= t, lane, mw, lw, ow);
            }
        } else {
            for (int c0 = 0; c0 < 512; c0 += 64) {
                const float* base = p.s_win + ((size_t)b * 512 + c0) * 256 + g * 64;
                attend64<float>(qs, pl, base, base + 128, 256, true, lane, mw, lw, ow);
            }
        }
#pragma unroll
        for (int h = 0; h < 4; ++h) {
            const float* gt = p.gates + (size_t)r * 24 + g * 12 + h * 3;
            const float o = gt[0] * oc[h] + gt[1] * (os[h] / lsum[h]) + gt[2] * (ow[h] / lw[h]);
            const int col = (g * 4 + h) * 64 + lane;
            p.yar[(size_t)r * 1024 + col] = f2bf(o * bf2f(p.ga[(size_t)r * 512 + col]));
        }
    }
}


typedef short s16x4 __attribute__((ext_vector_type(4)));
#define ATT_NEG (-__builtin_inff())
constexpr int ATT_KC = 0, ATT_VC = 32768, ATT_KB = 65536, ATT_VB = 98304, ATT_SC = 131072;
constexpr float ATT_CS = 0.125f * 1.44269504088896f;

__device__ __forceinline__ void att_stage(LAS char* dst, const bf16_t* rows, int tid) {
    const int key = tid >> 3, slot = tid & 7;
    __builtin_amdgcn_global_load_lds((const unsigned*)(rows + key * 64 + ((slot ^ (key & 7)) * 8)), (LAS unsigned*)(dst + tid * 16), 16, 0, 0);
}
__device__ __forceinline__ void att_qk(const LAS char* Kb, const bf16x8 (&qf)[2], const int (&koff)[2], f32x4 (&st)[4]) {
#pragma unroll
    for (int tk = 0; tk < 4; ++tk) {
        st[tk] = (f32x4){0.f, 0.f, 0.f, 0.f};
#pragma unroll
        for (int ks = 0; ks < 2; ++ks) {
            const bf16x8 kf = *(const LAS bf16x8*)(Kb + tk * 2048 + koff[ks]);
            st[tk] = __builtin_amdgcn_mfma_f32_16x16x32_bf16(kf, qf[ks], st[tk], 0, 0, 0);
        }
    }
}
template <int O0, int O1>
__device__ __forceinline__ void att_tr8(unsigned a0, unsigned a1, unsigned a2, unsigned a3, s16x4 (&v)[8]) {
    asm volatile(
        "ds_read_b64_tr_b16 %0, %8 offset:%12\n\t"
        "ds_read_b64_tr_b16 %1, %8 offset:%13\n\t"
        "ds_read_b64_tr_b16 %2, %9 offset:%12\n\t"
        "ds_read_b64_tr_b16 %3, %9 offset:%13\n\t"
        "ds_read_b64_tr_b16 %4, %10 offset:%12\n\t"
        "ds_read_b64_tr_b16 %5, %10 offset:%13\n\t"
        "ds_read_b64_tr_b16 %6, %11 offset:%12\n\t"
        "ds_read_b64_tr_b16 %7, %11 offset:%13\n\t"
        "s_waitcnt lgkmcnt(0)"
        : "=&v"(v[0]), "=&v"(v[1]), "=&v"(v[2]), "=&v"(v[3]), "=&v"(v[4]), "=&v"(v[5]), "=&v"(v[6]), "=&v"(v[7])
        : "v"(a0), "v"(a1), "v"(a2), "v"(a3), "i"(O0), "i"(O1) : "memory");
}
__device__ __forceinline__ void att_pv(const LAS char* Vb, const f32x4 (&pt)[4], const int (&voff)[4], f32x4 (&o)[4]) {
    const unsigned vb = (unsigned)(unsigned long long)Vb;
    const unsigned a0 = vb + voff[0], a1 = vb + voff[1], a2 = vb + voff[2], a3 = vb + voff[3];
#pragma unroll
    for (int kst = 0; kst < 2; ++kst) {
        u32x4 pk;
        pk[0] = cvt_pk_bf16(pt[2 * kst][0], pt[2 * kst][1]); pk[1] = cvt_pk_bf16(pt[2 * kst][2], pt[2 * kst][3]);
        pk[2] = cvt_pk_bf16(pt[2 * kst + 1][0], pt[2 * kst + 1][1]); pk[3] = cvt_pk_bf16(pt[2 * kst + 1][2], pt[2 * kst + 1][3]);
        const bf16x8 pf = __builtin_bit_cast(bf16x8, pk);
        s16x4 v[8];
        if (kst == 0) att_tr8<0, 2048>(a0, a1, a2, a3, v); else att_tr8<4096, 6144>(a0, a1, a2, a3, v);
#pragma unroll
        for (int dt = 0; dt < 4; ++dt) {
            const s16x4 x0 = v[2 * dt], x1 = v[2 * dt + 1];
            bf16x8 vf; vf[0] = x0[0]; vf[1] = x0[1]; vf[2] = x0[2]; vf[3] = x0[3]; vf[4] = x1[0]; vf[5] = x1[1]; vf[6] = x1[2]; vf[7] = x1[3];
            o[dt] = __builtin_amdgcn_mfma_f32_16x16x32_bf16(vf, pf, o[dt], 0, 0, 0);
        }
    }
}
__device__ __forceinline__ void att_exp(f32x4 (&st)[4], float nb, float& l) {
    typedef float f32x2 __attribute__((ext_vector_type(2)));
    const f32x2 cs2 = {ATT_CS, ATT_CS}, nb2 = {nb, nb};
    f32x2 ls2 = {0.f, 0.f};
#pragma unroll
    for (int tk = 0; tk < 4; ++tk)
#pragma unroll
        for (int r = 0; r < 4; r += 2) {
            const f32x2 s2 = {st[tk][r], st[tk][r + 1]};
            const f32x2 e2 = __builtin_elementwise_fma(s2, cs2, nb2);
            f32x2 p2; p2.x = __builtin_amdgcn_exp2f(e2.x); p2.y = __builtin_amdgcn_exp2f(e2.y);
            st[tk][r] = p2.x; st[tk][r + 1] = p2.y; ls2 += p2;
        }
    l += ls2.x + ls2.y;
}
__device__ __forceinline__ void att_prompt_unit(const Params& p, char* lds, int b, int g, int qt) {
    LAS char* l3 = (LAS char*)lds;
    const int tid = opaque_tid(), lane = tid & 63, wave = tid >> 6, fr = lane & 15, G = lane >> 4;
    const int qi = fr >> 2, h = fr & 3;
    const int t0 = qt * 32, tq0 = t0 + 4 * wave, t_row = tq0 + qi, jt = t0 >> 6;
    const size_t r = (size_t)b * SEQ + t_row;
    const size_t kvbase = (size_t)(b * 2 + g) * SEQ * 64;
    const float shc = p.attb[0], shs = p.attb[1], shw = p.attb[2];
    int koff[2], voff[4];
#pragma unroll
    for (int ks = 0; ks < 2; ++ks) koff[ks] = fr * 128 + (((ks * 4 + G) ^ (fr & 7)) * 16);
    { const int kq = 4 * G + (fr >> 2);
#pragma unroll
      for (int dt = 0; dt < 4; ++dt) voff[dt] = kq * 128 + (((dt * 2 + ((fr & 3) >> 1)) ^ (kq & 7)) * 16) + (fr & 1) * 8; }
    asm volatile("s_waitcnt lgkmcnt(0)" ::: "memory"); __builtin_amdgcn_s_barrier(); asm volatile("" ::: "memory");
    {
        const bf16_t* kc = p.kc + (size_t)(b * 2 + g) * 256 * 64; const bf16_t* vc = p.vc + (size_t)(b * 2 + g) * 256 * 64;
#pragma unroll
        for (int c = 0; c < 4; ++c) { att_stage(l3 + ATT_KC + c * 8192, kc + c * 4096, tid); att_stage(l3 + ATT_VC + c * 8192, vc + c * 4096, tid); }
    }
    bf16x8 qf[2];
#pragma unroll
    for (int ks = 0; ks < 2; ++ks) qf[ks] = *(const bf16x8*)(p.qn + r * 512 + (g * 4 + h) * 64 + ks * 32 + G * 8);
    const int c_lo = (t0 - 511 > 0 ? t0 - 511 : 0) >> 6;
    const int n_s = jt + 1, n_tot = n_s + (jt - c_lo + 1);
#define ATT_STAGE_CHUNK(idx) do { const int _i = (idx); const bool _w = _i >= n_s; const int _cj = _w ? c_lo + (_i - n_s) : _i; \
        att_stage(l3 + ATT_KB + (_i & 3) * 8192, (_w ? p.kw : p.ks) + kvbase + (size_t)_cj * 4096, tid); \
        att_stage(l3 + ATT_VB + (_i & 3) * 8192, (_w ? p.vw : p.vs) + kvbase + (size_t)_cj * 4096, tid); } while (0)
    ATT_STAGE_CHUNK(0); ATT_STAGE_CHUNK(1);
    if (n_tot > 2) { ATT_STAGE_CHUNK(2); asm volatile("s_waitcnt vmcnt(6)" ::: "memory"); }
    else asm volatile("s_waitcnt vmcnt(4)" ::: "memory");
    asm volatile("s_waitcnt lgkmcnt(0)" ::: "memory"); __builtin_amdgcn_s_barrier(); asm volatile("" ::: "memory");
    f32x4 oc[4];
#pragma unroll
    for (int dt = 0; dt < 4; ++dt) oc[dt] = (f32x4){0.f, 0.f, 0.f, 0.f};
    unsigned long long mymask;
    unsigned long long unionmask;
    {
        f32x4 sr[4][4];
#pragma unroll
        for (int c = 0; c < 4; ++c) att_qk(l3 + ATT_KC + c * 8192, qf, koff, sr[c]);
        const int ncrow = t_row >= 31 ? (t_row - 31) / 16 + 1 : 0;
        float lsum = 0.f;
#pragma unroll
        for (int c = 0; c < 4; ++c)
#pragma unroll
            for (int tk = 0; tk < 4; ++tk)
#pragma unroll
                for (int rg = 0; rg < 4; ++rg) {
                    const int i = c * 64 + tk * 16 + G * 4 + rg;
                    const float pv = i < ncrow ? __builtin_amdgcn_exp2f(sr[c][tk][rg] * ATT_CS - shc) : 0.f;
                    sr[c][tk][rg] = pv; lsum += pv;
                }
        lsum += __shfl_xor(lsum, 16); lsum += __shfl_xor(lsum, 32);
        const float inv = lsum > 0.f ? 1.f / lsum : 0.f;
        float* sc = (float*)(lds + ATT_SC) + wave * 512;
        float* bs = sc + 256;
        float av[4][4];
#pragma unroll
        for (int c = 0; c < 4; ++c)
#pragma unroll
            for (int tk = 0; tk < 4; ++tk) {
#pragma unroll
                for (int rg = 0; rg < 4; ++rg) sr[c][tk][rg] *= inv;
                float a = 2.f * (sr[c][tk][0] + sr[c][tk][1] + sr[c][tk][2]) + sr[c][tk][3], b3 = sr[c][tk][3];
                a += __builtin_bit_cast(float, __builtin_amdgcn_mov_dpp(__builtin_bit_cast(int, a), 0xB1, 0xF, 0xF, true));
                a += __builtin_bit_cast(float, __builtin_amdgcn_mov_dpp(__builtin_bit_cast(int, a), 0x4E, 0xF, 0xF, true));
                b3 += __builtin_bit_cast(float, __builtin_amdgcn_mov_dpp(__builtin_bit_cast(int, b3), 0xB1, 0xF, 0xF, true));
                b3 += __builtin_bit_cast(float, __builtin_amdgcn_mov_dpp(__builtin_bit_cast(int, b3), 0x4E, 0xF, 0xF, true));
                av[c][tk] = a;
                if (h == 0) bs[qi * 64 + (c * 4 + tk) * 4 + G] = b3;
            }
        WSYNC();
#pragma unroll
        for (int c = 0; c < 4; ++c)
#pragma unroll
            for (int tk = 0; tk < 4; ++tk) {
                const int j = (c * 4 + tk) * 4 + G;
                const float pr = j > 0 ? bs[qi * 64 + j - 1] : 0.f;
                const bool valid = j * 64 <= t_row, forced = (j == 0) || (j == jt) || (j == jt - 1);
                if (h == 0) sc[qi * 64 + j] = valid ? (forced ? 1e4f : av[c][tk] + pr) : -1e30f;
            }
#pragma unroll
        for (int c = 0; c < 4; ++c) att_pv(l3 + ATT_VC + c * 8192, sr[c], voff, oc);
        WSYNC();
        unsigned long long mq[4];
        {
            float sj[4]; int rank[4] = {0, 0, 0, 0};
#pragma unroll
            for (int q = 0; q < 4; ++q) sj[q] = sc[q * 64 + lane];
#pragma unroll 2
            for (int jp = 0; jp <= jt; ++jp) {
                const bool lower = jp < lane;
#pragma unroll
                for (int q = 0; q < 4; ++q) {
                    const float v = __builtin_bit_cast(float, __builtin_amdgcn_readlane(__builtin_bit_cast(int, sj[q]), jp));
                    rank[q] += (v > sj[q] || (v == sj[q] && lower)) ? 1 : 0;
                }
            }
#pragma unroll
            for (int q = 0; q < 4; ++q) mq[q] = __ballot(rank[q] < 16 && lane * 64 <= tq0 + q);
        }
        unionmask = mq[0] | mq[1] | mq[2] | mq[3];
        mymask = qi == 0 ? mq[0] : qi == 1 ? mq[1] : qi == 2 ? mq[2] : mq[3];
        WSYNC();
    }
    f32x4 os[4], ow[4];
#pragma unroll
    for (int dt = 0; dt < 4; ++dt) { os[dt] = (f32x4){0.f, 0.f, 0.f, 0.f}; ow[dt] = (f32x4){0.f, 0.f, 0.f, 0.f}; }
    float ls = 0.f, lw = 0.f;
    for (int it = 0; it < n_tot; ++it) {
        if (it + 2 < n_tot) asm volatile("s_waitcnt vmcnt(4)" ::: "memory");
        else if (it + 1 < n_tot) asm volatile("s_waitcnt vmcnt(2)" ::: "memory");
        else asm volatile("s_waitcnt vmcnt(0)" ::: "memory");
        asm volatile("s_waitcnt lgkmcnt(0)" ::: "memory"); __builtin_amdgcn_s_barrier(); asm volatile("" ::: "memory");
        if (it + 3 < n_tot) ATT_STAGE_CHUNK(it + 3);
        const LAS char* Kb = l3 + ATT_KB + (it & 3) * 8192; const LAS char* Vb = l3 + ATT_VB + (it & 3) * 8192;
        if (it < n_s) {
            const int j = it;
            if ((unionmask >> j) & 1ull) {
                f32x4 st[4];
                att_qk(Kb, qf, koff, st);
                const float nb = ((mymask >> j) & 1ull) ? -shs : ATT_NEG;
                if (j == jt) {
                    asm volatile("" ::: "memory");
#pragma unroll
                    for (int tk = 0; tk < 4; ++tk)
#pragma unroll
                        for (int rg = 0; rg < 4; ++rg) { const int pos = j * 64 + tk * 16 + G * 4 + rg; if (pos > t_row) st[tk][rg] = ATT_NEG; }
                }
                att_exp(st, nb, ls);
                att_pv(Vb, st, voff, os);
            }
        } else {
            const int cj = c_lo + (it - n_s);
            f32x4 st[4];
            att_qk(Kb, qf, koff, st);
            if (cj * 64 + 63 > tq0 || cj * 64 <= tq0 + 3 - 512) {
                asm volatile("" ::: "memory");
#pragma unroll
                for (int tk = 0; tk < 4; ++tk)
#pragma unroll
                    for (int rg = 0; rg < 4; ++rg) { const int pos = cj * 64 + tk * 16 + G * 4 + rg; if (!(pos <= t_row && pos > t_row - 512)) st[tk][rg] = ATT_NEG; }
            }
            att_exp(st, -shw, lw);
            att_pv(Vb, st, voff, ow);
        }
    }
#undef ATT_STAGE_CHUNK
    ls += __shfl_xor(ls, 16); ls += __shfl_xor(ls, 32);
    lw += __shfl_xor(lw, 16); lw += __shfl_xor(lw, 32);
    const float* gt = p.gates + r * 24 + g * 12 + h * 3;
    const float g0 = gt[0], g1 = gt[1] / ls, g2 = gt[2] / lw;
    const int colb = (g * 4 + h) * 64;
    uint2 gavv[4];
#pragma unroll
    for (int dt = 0; dt < 4; ++dt) gavv[dt] = *(const uint2*)(p.ga + r * 512 + colb + dt * 16 + G * 4);
#pragma unroll
    for (int dt = 0; dt < 4; ++dt) {
        const int d = dt * 16 + G * 4;
        const uint2 gav = gavv[dt];
        float v[4];
#pragma unroll
        for (int rg = 0; rg < 4; ++rg) v[rg] = g0 * oc[dt][rg] + g1 * os[dt][rg] + g2 * ow[dt][rg];
        v[0] *= __uint_as_float(gav.x << 16); v[1] *= __uint_as_float(gav.x & 0xffff0000u);
        v[2] *= __uint_as_float(gav.y << 16); v[3] *= __uint_as_float(gav.y & 0xffff0000u);
        uint2 o; o.x = cvt_pk_bf16(v[0], v[1]); o.y = cvt_pk_bf16(v[2], v[3]);
        *(uint2*)(p.yar + r * 1024 + colb + d) = o;
    }
}

__device__ __forceinline__ void dot4(const float* qs, const bf16_t* kr, float (&s)[4]) {
    uint4 raw[8];
#pragma unroll
    for (int c = 0; c < 8; ++c) raw[c] = *(const uint4*)(kr + c * 8);
#pragma unroll
    for (int c = 0; c < 8; ++c) {
        float kf[8];
        kf[0] = __uint_as_float(raw[c].x << 16); kf[1] = __uint_as_float(raw[c].x & 0xffff0000u); kf[2] = __uint_as_float(raw[c].y << 16); kf[3] = __uint_as_float(raw[c].y & 0xffff0000u);
        kf[4] = __uint_as_float(raw[c].z << 16); kf[5] = __uint_as_float(raw[c].z & 0xffff0000u); kf[6] = __uint_as_float(raw[c].w << 16); kf[7] = __uint_as_float(raw[c].w & 0xffff0000u);
#pragma unroll
        for (int hh = 0; hh < 4; ++hh)
#pragma unroll
            for (int j = 0; j < 8; ++j) s[hh] += qs[hh * 64 + c * 8 + j] * kf[j];
    }
}
__device__ __forceinline__ void att_sample_unit(const Params& p, char* lds, int b, int g) {
    const int tid = opaque_tid(), lane = tid & 63, wave = tid >> 6;
    float* L = (float*)lds;
    float* qs = L;
    float* ps = L + 256;
    float* sc = L + 1296;
    int* sel = (int*)(L + 1568);
    float* red = L + 1600;
    float* part = L + 1664;
    float* pl = L + 1664 + 8 * 3 * 4 * 66 + wave * 256;
    const size_t r = TP + b;
    __syncthreads();
    if (tid < 256) qs[tid] = bf2f(p.qn[r * 512 + g * 256 + tid]);
    for (int i = tid; i < 1040; i += NT) ps[i] = 0.f;
    __syncthreads();
    const bf16_t* kc = p.kcs + (size_t)(b * 2 + g) * 1024 * 64; const bf16_t* vc = p.vcs + (size_t)(b * 2 + g) * 1024 * 64;
    const int n_c = 1023;
    float m1[4] = {-1e30f, -1e30f, -1e30f, -1e30f}, l1[4] = {0.f, 0.f, 0.f, 0.f};
    for (int cc = 0; cc < 2; ++cc) {
        const int i = wave * 128 + cc * 64 + lane; const bool valid = i < n_c;
        float s[4] = {0.f, 0.f, 0.f, 0.f};
        if (valid) dot4(qs, kc + (size_t)i * 64, s);
#pragma unroll
        for (int hh = 0; hh < 4; ++hh) {
            const float sv = valid ? s[hh] * 0.125f : -1e30f;
            const float mn = fmaxf(m1[hh], wave_max(sv));
            l1[hh] = l1[hh] * __expf(m1[hh] - mn) + wave_sum(valid ? __expf(sv - mn) : 0.f); m1[hh] = mn;
        }
    }
    if (lane == 0) {
#pragma unroll
        for (int hh = 0; hh < 4; ++hh) { red[wave * 8 + hh] = m1[hh]; red[wave * 8 + 4 + hh] = l1[hh]; }
    }
    __syncthreads();
    float M[4], Ls[4];
#pragma unroll
    for (int hh = 0; hh < 4; ++hh) {
        float mm = -1e30f;
        for (int w = 0; w < 8; ++w) mm = fmaxf(mm, red[w * 8 + hh]);
        float ll = 0.f;
        for (int w = 0; w < 8; ++w) ll += red[w * 8 + 4 + hh] * __expf(red[w * 8 + hh] - mm);
        M[hh] = mm; Ls[hh] = ll;
    }
    float oc[4] = {0.f, 0.f, 0.f, 0.f};
    for (int cc = 0; cc < 2; ++cc) {
        const int i0 = wave * 128 + cc * 64, i = i0 + lane; const bool valid = i < n_c;
        float s[4] = {0.f, 0.f, 0.f, 0.f};
        if (valid) dot4(qs, kc + (size_t)i * 64, s);
        float psum = 0.f;
#pragma unroll
        for (int hh = 0; hh < 4; ++hh) { const float pv = valid ? __expf(s[hh] * 0.125f - M[hh]) / Ls[hh] : 0.f; pl[hh * 64 + lane] = pv; psum += pv; }
        if (valid) ps[1 + i] = psum;
        WSYNC();
        const int nk = min(64, n_c - i0);
#pragma unroll 32
        for (int kk = 0; kk < 64; ++kk) {
            const float vv = bf2f(vc[(size_t)(i0 + (kk < nk ? kk : 0)) * 64 + lane]);
#pragma unroll
            for (int hh = 0; hh < 4; ++hh) oc[hh] += pl[hh * 64 + kk] * vv;
        }
        WSYNC();
    }
    __syncthreads();
    if (wave == 0) {
        const int t = PAST, jt = t >> 6;
        for (int j = lane; j < 257; j += 64) {
            float imp = 0.f;
#pragma unroll
            for (int rr = 0; rr < 4; ++rr) imp += ps[4 * j + rr + 1] + ps[4 * j + rr];
            const bool valid = j * 64 <= t, forced = (j == 0) || (j == jt) || (j == jt - 1);
            sc[j] = valid ? (forced ? 1e4f : imp) : -1e30f;
        }
        WSYNC();
        topk16(sc, sel, 257, lane);
    }
    __syncthreads();
    float msv[4] = {-1e30f, -1e30f, -1e30f, -1e30f}, lsv[4] = {0.f, 0.f, 0.f, 0.f}, osv[4] = {0.f, 0.f, 0.f, 0.f};
    for (int k = 2 * wave; k < 2 * wave + 2; ++k) {
        const int j = sel[k];
        if (j * 64 > PAST) continue;
        const bool valid = j * 64 + lane <= PAST;
        if (j == 256) attend64<float>(qs, pl, p.s_slc + (size_t)b * 256 + g * 64, p.s_slc + (size_t)b * 256 + 128 + g * 64, 256, valid, lane, msv, lsv, osv);
        else {
            const int pg = p.page_table[b * NPAGES + (j >> 1)];
            const float* base = p.cache_slc + (((size_t)pg * 128 + (j & 1) * 64) * 4 + g) * 64;
            attend64<float>(qs, pl, base, base + 128, 256, valid, lane, msv, lsv, osv);
        }
    }
    float mwv[4] = {-1e30f, -1e30f, -1e30f, -1e30f}, lwv[4] = {0.f, 0.f, 0.f, 0.f}, owv[4] = {0.f, 0.f, 0.f, 0.f};
    {
        const float* base = p.s_win + ((size_t)b * 512 + wave * 64) * 256 + g * 64;
        attend64<float>(qs, pl, base, base + 128, 256, true, lane, mwv, lwv, owv);
    }
#pragma unroll
    for (int hh = 0; hh < 4; ++hh) {
        float* pc = part + ((wave * 3 + 0) * 4 + hh) * 66; pc[lane] = oc[hh];
        float* pS = part + ((wave * 3 + 1) * 4 + hh) * 66; pS[lane] = osv[hh]; if (lane == 0) { pS[64] = msv[hh]; pS[65] = lsv[hh]; }
        float* pw = part + ((wave * 3 + 2) * 4 + hh) * 66; pw[lane] = owv[hh]; if (lane == 0) { pw[64] = mwv[hh]; pw[65] = lwv[hh]; }
    }
    __syncthreads();
    if (tid < 256) {
        const int hh = tid >> 6, d = tid & 63;
        float c = 0.f;
        for (int w = 0; w < 8; ++w) c += part[((w * 3 + 0) * 4 + hh) * 66 + d];
        float res[2];
#pragma unroll
        for (int br = 1; br < 3; ++br) {
            float mm = -1e30f;
            for (int w = 0; w < 8; ++w) mm = fmaxf(mm, part[((w * 3 + br) * 4 + hh) * 66 + 64]);
            float num = 0.f, den = 0.f;
            for (int w = 0; w < 8; ++w) { const float* q = part + ((w * 3 + br) * 4 + hh) * 66; const float e = __expf(q[64] - mm); num += q[d] * e; den += q[65] * e; }
            res[br - 1] = num / den;
        }
        const float* gt = p.gates + r * 24 + g * 12 + hh * 3;
        const int col = (g * 4 + hh) * 64 + d;
        p.yar[r * 1024 + col] = f2bf((gt[0] * c + gt[1] * res[0] + gt[2] * res[1]) * bf2f(p.ga[r * 512 + col]));
    }
    __syncthreads();
}

__device__ __forceinline__ void ret_out_item(const Params& p, char* lds, int it);
__device__ __forceinline__ void att_phase(const Params& p, char* lds, int bid, int nblk) {
    const int x = bid & 7;
    unsigned* ctr = p.bar + 3584 + 64 * x;
    volatile int* slot = (volatile int*)(lds + 147456 + 16);
    const int tid = opaque_tid();
    for (;;) {
        __syncthreads();
        if (tid == 0) *slot = (int)__hip_atomic_fetch_add(ctr, 1u, __ATOMIC_RELAXED, __HIP_MEMORY_SCOPE_AGENT);
        __syncthreads();
        const int w = *slot;
        if (w >= 136) break;
        if (w < 8) att_sample_unit(p, lds, 4 * x + (w >> 1), w & 1);
        else att_prompt_unit(p, lds, x >> 1, x & 1, 127 - (w - 8));
    }
}
__device__ __forceinline__ void ret_out_queue(const Params& p, char* lds, int bid, int nblk) {
    const int x = bid & 7;
    unsigned* ctr = p.bar + 3584 + 64 * x + 16;
    volatile int* slot = (volatile int*)(lds + 147456 + 16);
    const int tid = opaque_tid();
    wg_wait(p.bar + 3456, (unsigned)nblk, p.bar + XB_TMO);
    for (;;) {
        __syncthreads();
        if (tid == 0) *slot = (int)__hip_atomic_fetch_add(ctr, 1u, __ATOMIC_RELAXED, __HIP_MEMORY_SCOPE_AGENT);
        __syncthreads();
        const int w = *slot;
        if (w >= 80) break;
        ret_out_item(p, lds, x + 8 * w);
    }
}

__device__ __forceinline__ float ret_gamma(int h) { return 1.f - exp2f(-5.f - (float)h); }

__device__ __forceinline__ void p6a_local(const Params& p, int bid, int nblk) {
    const int tid = opaque_tid();
    const int e = tid & 127, dg = tid >> 7;
    for (int it = bid; it < 4 * 4 * 32; it += nblk) {
        const int n = it & 31, h = (it >> 5) & 3, b = it >> 7;
        const float lg = __logf(ret_gamma(h));
        float acc[16];
#pragma unroll
        for (int i = 0; i < 16; ++i) acc[i] = 0.f;
        for (int j = 0; j < 128; ++j) {
            const size_t r = (size_t)b * SEQ + n * 128 + j;
            const float z = __expf(lg * (float)(127 - j));
            const float v = bf2f(p.rv[r * 512 + h * 128 + e]) * z;
            const bf16_t* kr = p.rk + r * 256 + h * 64 + dg * 16;
#pragma unroll
            for (int i = 0; i < 16; ++i) acc[i] += bf2f(kr[i]) * v;
        }
        float* out = p.sloc + ((size_t)it * 64 + dg * 16) * 128 + e;
#pragma unroll
        for (int i = 0; i < 16; ++i) out[i * 128] = acc[i];
    }
}
__device__ __forceinline__ void p6b_scan(const Params& p, int bid, int nblk) {
    const size_t gt = (size_t)bid * NT + threadIdx.x, ngt = (size_t)nblk * NT;
    for (size_t i = gt; i < (size_t)16 * 8192; i += ngt) {
        const int bh = (int)(i >> 13), el = (int)(i & 8191), h = bh & 3;
        const float gc = __expf(__logf(ret_gamma(h)) * 128.f);
        float S = 0.f, lv[32];
#pragma unroll
        for (int n = 0; n < 32; ++n) lv[n] = p.sloc[((size_t)bh * 32 + n) * 8192 + el];
#pragma unroll
        for (int n = 0; n < 32; ++n) {
            p.spre[((size_t)bh * 32 + n) * 8192 + el] = S;
            S = S * gc + lv[n];
        }
        p.p_ret[(size_t)bh * 8192 + el] = S;
    }
    {
        constexpr int NS = 128 * 8192;
        const int gti = (int)gt, ngti = (int)ngt;
#define SR_LD(j) const int sx##j = ib + j * ngti, sc##j = sx##j < NS ? sx##j : NS - 1, bh##j = sc##j >> 13, el##j = sc##j & 8191; const float st##j = p.state_ret[sc##j]; \
        const bf16_t kk##j = p.rk[(size_t)(TP + (bh##j >> 2)) * 256 + (bh##j & 3) * 64 + (el##j >> 7)], vv##j = p.rv[(size_t)(TP + (bh##j >> 2)) * 512 + (bh##j & 3) * 128 + (el##j & 127)];
#define SR_ST(j) if (sx##j < NS) p.s_ret[sx##j] = st##j * ret_gamma(bh##j & 3) + bf2f(kk##j) * bf2f(vv##j);
        for (int ib = gti; ib < NS; ib += 8 * ngti) {
            SR_LD(0) SR_LD(1) SR_LD(2) SR_LD(3) SR_LD(4) SR_LD(5) SR_LD(6) SR_LD(7)
            SR_ST(0) SR_ST(1) SR_ST(2) SR_ST(3) SR_ST(4) SR_ST(5) SR_ST(6) SR_ST(7)
        }
#undef SR_LD
#undef SR_ST
    }
}
__device__ __forceinline__ void p6c_out(const Params& p, char* lds, int bid, int nblk) {
    float* Am = (float*)lds;
    const int tid = opaque_tid();
    for (int it = bid; it < 4 * 4 * 32 + 128; it += nblk) {
        if (it < 512) {
            const int n = it & 31, h = (it >> 5) & 3, b = it >> 7;
            const float lg = __logf(ret_gamma(h));
            const size_t r0 = (size_t)b * SEQ + n * 128;
            for (int idx = tid; idx < 128 * 128; idx += NT) {
                const int i = idx >> 7, j = idx & 127;
                float a = 0.f;
                if (j <= i) {
                    const bf16_t* qr = p.rq + (r0 + i) * 256 + h * 64; const bf16_t* kr = p.rk + (r0 + j) * 256 + h * 64;
#pragma unroll
                    for (int c = 0; c < 8; ++c) { float qf[8], kf[8]; load8(qr + c * 8, qf); load8(kr + c * 8, kf);
#pragma unroll
                        for (int u = 0; u < 8; ++u) a += qf[u] * kf[u]; }
                    a *= __expf(lg * (float)(i - j));
                }
                Am[i * 129 + j] = a;
            }
            __syncthreads();
            const int e = tid & 127, ig = tid >> 7;
            const float* S = p.spre + (size_t)it * 8192;
            for (int i = ig * 32; i < ig * 32 + 32; ++i) {
                float o = 0.f;
                for (int j = 0; j <= i; ++j) o += Am[i * 129 + j] * bf2f(p.rv[(r0 + j) * 512 + h * 128 + e]);
                float qs = 0.f;
                const bf16_t* qr = p.rq + (r0 + i) * 256 + h * 64;
                for (int d = 0; d < 64; ++d) qs += bf2f(qr[d]) * S[d * 128 + e];
                o += qs * __expf(lg * (float)(i + 1));
                p.oret[(r0 + i) * 512 + h * 128 + e] = o;
            }
            __syncthreads();
        } else {
            const int bh = it - 512, h = bh & 3, b = bh >> 2;
            const size_t r = TP + b;
            if (tid < 128) {
                const int e = tid;
                const bf16_t* qr = p.rq + r * 256 + h * 64; const bf16_t* kr = p.rk + r * 256 + h * 64;
                const float* S0 = p.state_ret + (size_t)bh * 8192;
                float qs = 0.f, qk = 0.f;
                for (int d = 0; d < 64; ++d) { const float q = bf2f(qr[d]); qs += q * S0[d * 128 + e]; qk += q * bf2f(kr[d]); }
                p.oret[r * 512 + h * 128 + e] = qs * ret_gamma(h) + qk * bf2f(p.rv[r * 512 + h * 128 + e]);
            }
        }
    }
}
__device__ __forceinline__ void p6d_norm(const Params& p, int bid, int nblk) {
    const int tid = opaque_tid(), lane = tid & 63, wave = tid >> 6;
    for (int it = bid * 8 + wave; it < R * 4; it += nblk * 8) {
        const int r = it >> 2, h = it & 3;
        const float* o = p.oret + (size_t)r * 512 + h * 128;
        const float v0 = o[lane], v1 = o[lane + 64];
        const float rs = rsqrtf(wave_sum(v0 * v0 + v1 * v1) * (1.f / 128.f) + EPS);
        p.yar[(size_t)r * 1024 + 512 + h * 128 + lane] = f2bf(v0 * rs * p.g_ret[lane] * bf2f(p.gr[(size_t)r * 512 + h * 128 + lane]));
        p.yar[(size_t)r * 1024 + 512 + h * 128 + lane + 64] = f2bf(v1 * rs * p.g_ret[lane + 64] * bf2f(p.gr[(size_t)r * 512 + h * 128 + lane + 64]));
    }
}


__device__ __forceinline__ void ret_stage(LAS char* dst, const bf16_t* src, size_t row_stride, int lg_slots, int npieces, int tid) {
    for (int pc = tid; pc < npieces; pc += NT) {
        const int row = pc >> lg_slots, slot = pc & ((1 << lg_slots) - 1);
        __builtin_amdgcn_global_load_lds((const unsigned*)(src + (size_t)row * row_stride + ((slot ^ (row & 7)) * 8)), (LAS unsigned*)(dst + pc * 16), 16, 0, 0);
    }
}
__device__ __forceinline__ s16x4 ret_tr(const LAS char* img, int RB, int r0, int c0, int fr) {
    const int row = r0 + (fr >> 2), chunk = (c0 >> 3) + ((fr & 3) >> 1);
    return __builtin_amdgcn_ds_read_tr16_b64_v4i16((LAS s16x4*)(img + row * RB + ((chunk ^ (row & 7)) * 16) + (fr & 1) * 8));
}
__device__ __forceinline__ bf16x8 cat8(s16x4 a, s16x4 b) { bf16x8 v; v[0] = a[0]; v[1] = a[1]; v[2] = a[2]; v[3] = a[3]; v[4] = b[0]; v[5] = b[1]; v[6] = b[2]; v[7] = b[3]; return v; }

__device__ __forceinline__ void ret_local_item(const Params& p, char* lds, int it) {
    LAS char* l3 = (LAS char*)lds;
    const int tid = opaque_tid(), lane = tid & 63, wave = tid >> 6, fr = lane & 15, G = lane >> 4;
    {
        const int n = it & 31, h = (it >> 5) & 3, b = it >> 7;
        const size_t r0 = (size_t)b * SEQ + n * 128;
        __syncthreads();
        ret_stage(l3, p.rk + r0 * 256 + h * 64, 256, 3, 1024, tid);
        ret_stage(l3 + 16384, p.rv + r0 * 512 + h * 128, 512, 4, 2048, tid);
        asm volatile("s_waitcnt vmcnt(0)" ::: "memory");
        __syncthreads();
        f32x4 acc[4];
#pragma unroll
        for (int dt = 0; dt < 4; ++dt) acc[dt] = (f32x4){0.f, 0.f, 0.f, 0.f};
#pragma unroll
        for (int js = 0; js < 4; ++js) {
            const int j0 = js * 32 + 4 * G;
            const bf16x8 bfr = cat8(ret_tr(l3 + 16384, 256, j0, wave * 16, fr), ret_tr(l3 + 16384, 256, j0 + 16, wave * 16, fr));
#pragma unroll
            for (int dt = 0; dt < 4; ++dt) {
                const bf16x8 afr = cat8(ret_tr(l3, 128, j0, dt * 16, fr), ret_tr(l3, 128, j0 + 16, dt * 16, fr));
                acc[dt] = __builtin_amdgcn_mfma_f32_16x16x32_bf16(afr, bfr, acc[dt], 0, 0, 0);
            }
        }
        const float sc = exp2f(__log2f(ret_gamma(h)) * 127.f);
        float* out = p.sloc + (size_t)it * 8192 + wave * 16 + fr;
#pragma unroll
        for (int dt = 0; dt < 4; ++dt)
#pragma unroll
            for (int rg = 0; rg < 4; ++rg) out[(dt * 16 + 4 * G + rg) * 128] = acc[dt][rg] * sc;
    }
}

__device__ __forceinline__ void ret_out_item(const Params& p, char* lds, int it) {
    LAS char* l3 = (LAS char*)lds;
    const int tid = opaque_tid(), lane = tid & 63, wave = tid >> 6, fr = lane & 15, G = lane >> 4;
    {
        __syncthreads();
        if (it < 512) {
            const int n = it & 31, h = (it >> 5) & 3, b = it >> 7;
            const size_t r0 = (size_t)b * SEQ + n * 128;
            const float gam = ret_gamma(h);
            ret_stage(l3, p.rk + r0 * 256 + h * 64, 256, 3, 1024, tid);
            ret_stage(l3 + 16384, p.rv + r0 * 512 + h * 128, 512, 4, 2048, tid);
            {
                const float* S = p.spre + (size_t)it * 8192;
                for (int pc = tid; pc < 1024; pc += NT) {
                    const int row = pc >> 4, slot = pc & 15;
                    const float4 a = *(const float4*)(S + row * 128 + slot * 8), c = *(const float4*)(S + row * 128 + slot * 8 + 4);
                    u32x4 v; v[0] = cvt_pk_bf16(a.x * gam, a.y * gam); v[1] = cvt_pk_bf16(a.z * gam, a.w * gam); v[2] = cvt_pk_bf16(c.x * gam, c.y * gam); v[3] = cvt_pk_bf16(c.z * gam, c.w * gam);
                    *(LAS u32x4*)(l3 + 49152 + row * 256 + ((slot ^ (row & 7)) * 16)) = v;
                }
            }
            const size_t ri = r0 + wave * 16 + fr;
            bf16x8 qf[2], qp[2];
#pragma unroll
            for (int ks = 0; ks < 2; ++ks) {
                const bf16_t* qrow = p.rq + ri * 256 + h * 64 + ks * 32;
                qf[ks] = *(const bf16x8*)(qrow + G * 8);
                const s16x4 lo = *(const s16x4*)(qrow + 4 * G), hi = *(const s16x4*)(qrow + 16 + 4 * G);
                qp[ks] = cat8(lo, hi);
            }
            asm volatile("s_waitcnt vmcnt(0)" ::: "memory");
            __syncthreads();
            f32x4 st[8];
#pragma unroll
            for (int jt = 0; jt < 8; ++jt) {
                st[jt] = (f32x4){0.f, 0.f, 0.f, 0.f};
                if (jt <= wave) {
#pragma unroll
                    for (int ks = 0; ks < 2; ++ks) {
                        const int row = jt * 16 + fr;
                        const bf16x8 kf = *(const LAS bf16x8*)(l3 + row * 128 + (((ks * 4 + G) ^ (row & 7)) * 16));
                        st[jt] = __builtin_amdgcn_mfma_f32_16x16x32_bf16(kf, qf[ks], st[jt], 0, 0, 0);
                    }
                    if (jt == wave) {
#pragma unroll
                        for (int rg = 0; rg < 4; ++rg) if (4 * G + rg > fr) st[jt][rg] = 0.f;
                    }
                }
            }
            f32x4 o[8];
#pragma unroll
            for (int et = 0; et < 8; ++et) o[et] = (f32x4){0.f, 0.f, 0.f, 0.f};
#pragma unroll
            for (int js = 0; js < 4; ++js) {
                if (2 * js <= wave) {
                    u32x4 pk;
                    pk[0] = cvt_pk_bf16(st[2 * js][0], st[2 * js][1]); pk[1] = cvt_pk_bf16(st[2 * js][2], st[2 * js][3]);
                    pk[2] = cvt_pk_bf16(st[2 * js + 1][0], st[2 * js + 1][1]); pk[3] = cvt_pk_bf16(st[2 * js + 1][2], st[2 * js + 1][3]);
                    const bf16x8 pf = __builtin_bit_cast(bf16x8, pk);
                    const int j0 = js * 32 + 4 * G;
#pragma unroll
                    for (int et = 0; et < 8; ++et) {
                        const bf16x8 vf = cat8(ret_tr(l3 + 16384, 256, j0, et * 16, fr), ret_tr(l3 + 16384, 256, j0 + 16, et * 16, fr));
                        o[et] = __builtin_amdgcn_mfma_f32_16x16x32_bf16(vf, pf, o[et], 0, 0, 0);
                    }
                }
            }
#pragma unroll
            for (int ks = 0; ks < 2; ++ks) {
                const int d0 = ks * 32 + 4 * G;
#pragma unroll
                for (int et = 0; et < 8; ++et) {
                    const bf16x8 sf = cat8(ret_tr(l3 + 49152, 256, d0, et * 16, fr), ret_tr(l3 + 49152, 256, d0 + 16, et * 16, fr));
                    o[et] = __builtin_amdgcn_mfma_f32_16x16x32_bf16(sf, qp[ks], o[et], 0, 0, 0);
                }
            }
            float ss = 0.f;
#pragma unroll
            for (int et = 0; et < 8; ++et)
#pragma unroll
                for (int rg = 0; rg < 4; ++rg) ss += o[et][rg] * o[et][rg];
            ss += __shfl_xor(ss, 16); ss += __shfl_xor(ss, 32);
            const float rs = rsqrtf(ss * (1.f / 128.f) + EPS);
            float4 grv[8]; uint2 gvv[8];
#pragma unroll
            for (int et = 0; et < 8; ++et) { const int e = et * 16 + 4 * G; grv[et] = *(const float4*)(p.g_ret + e); gvv[et] = *(const uint2*)(p.gr + ri * 512 + h * 128 + e); }
#pragma unroll
            for (int et = 0; et < 8; ++et) {
                const int e = et * 16 + 4 * G;
                const float4 gr = grv[et];
                const uint2 gv = gvv[et];
                uint2 ov;
                ov.x = cvt_pk_bf16(o[et][0] * rs * gr.x * __uint_as_float(gv.x << 16), o[et][1] * rs * gr.y * __uint_as_float(gv.x & 0xffff0000u));
                ov.y = cvt_pk_bf16(o[et][2] * rs * gr.z * __uint_as_float(gv.y << 16), o[et][3] * rs * gr.w * __uint_as_float(gv.y & 0xffff0000u));
                *(uint2*)(p.yar + ri * 1024 + 512 + h * 128 + e) = ov;
            }
        } else {
            const int bh = it - 512, h = bh & 3, b = bh >> 2;
            const size_t r = TP + b;
            float* red = (float*)lds;
            float o = 0.f;
            if (tid < 128) {
                const int e = tid;
                const bf16_t* qr = p.rq + r * 256 + h * 64; const bf16_t* kr = p.rk + r * 256 + h * 64;
                const float* S0 = p.state_ret + (size_t)bh * 8192;
                float qs = 0.f, qk = 0.f;
                for (int d = 0; d < 64; ++d) { const float q = bf2f(qr[d]); qs += q * S0[d * 128 + e]; qk += q * bf2f(kr[d]); }
                o = qs * ret_gamma(h) + qk * bf2f(p.rv[r * 512 + h * 128 + e]);
                const float s2 = wave_sum(o * o);
                if (lane == 0) red[wave] = s2;
            }
            __syncthreads();
            if (tid < 128) {
                const float rs = rsqrtf((red[0] + red[1]) * (1.f / 128.f) + EPS);
                p.yar[r * 1024 + 512 + h * 128 + tid] = f2bf(o * rs * p.g_ret[tid] * bf2f(p.gr[r * 512 + h * 128 + tid]));
            }
        }
    }
}

__device__ __forceinline__ void out_sample(const Params& p, char* lds, int bid, int nblk) {
    const int tid = opaque_tid(), lane = tid & 63, wave = tid >> 6, fr = lane & 15, G = lane >> 4;
    f32x4* part = (f32x4*)lds;
    for (int it = bid; it < 128; it += nblk) {
        const int mt = it >> 6, nt = it & 63;
        const bf16_t* arow = p.yar + (size_t)(TP + mt * 16 + fr) * 1024 + wave * 128 + G * 8;
        const bf16_t* brow = p.bt_out + (size_t)(nt * 16 + fr) * 1024 + wave * 128 + G * 8;
        bf16x8 a[4], b[4];
#pragma unroll
        for (int ks = 0; ks < 4; ++ks) { a[ks] = *(const bf16x8*)(arow + ks * 32); b[ks] = *(const bf16x8*)(brow + ks * 32); }
        const int c = nt * 16 + fr;
        float xv[4], gv[4];
        if (wave == 0) {
#pragma unroll
            for (int rg = 0; rg < 4; ++rg) { const int sb = mt * 16 + 4 * G + rg; xv[rg] = p.x_sample[(size_t)sb * 1024 + c]; gv[rg] = p.mod[(4 + sb) * 3072 + 2048 + c]; }
        }
        f32x4 acc = {0.f, 0.f, 0.f, 0.f};
#pragma unroll
        for (int ks = 0; ks < 4; ++ks) acc = __builtin_amdgcn_mfma_f32_16x16x32_bf16(a[ks], b[ks], acc, 0, 0, 0);
        __syncthreads();
        part[wave * 64 + lane] = acc;
        __syncthreads();
        if (wave == 0) {
            f32x4 tot = part[lane];
#pragma unroll
            for (int w = 1; w < 8; ++w) tot += part[w * 64 + lane];
#pragma unroll
            for (int rg = 0; rg < 4; ++rg) {
                const int sb = mt * 16 + 4 * G + rg;
                p.y[(size_t)(TP + sb) * 1024 + c] = xv[rg] + gv[rg] * tot[rg];
            }
        }
    }
}
__global__ void __launch_bounds__(NT, 2) k_mega(Params p) {
    extern __shared__ __attribute__((aligned(16))) char lds[];
    const int bid = blockIdx.x, nblk = gridDim.x;
    uint4* xbw = (uint4*)(lds + 147456);
    if (threadIdx.x == 0) *xbw = make_uint4(0u, 0u, 0u, 0u);
    __syncthreads();
    XcdBarrier bar = xcd_barrier_post(p.bar, (volatile LAS unsigned*)xbw);
    p0_w1p(p, bid, nblk); wg_signal(p.bar + 3536, true);
    p0_adaln(p, lds, bid, nblk); __syncthreads(); p0_weights(p, lds, bid, nblk); __syncthreads();
    wg_wait(p.bar + 3536, (unsigned)nblk, p.bar + XB_TMO);
    compress_sample(p, lds, bid, nblk);
    wg_wait(p.bar + 3520, 192u, p.bar + XB_TMO);
    p1_norm(p, lds, bid, nblk);
    xcd_barrier(bar);
    { EpiIn e{&p}; gemm_phase(p.H, p.bt_in, RPAD / 256, NPAD / 256, 1024, lds, bid, nblk, e); }
    if (nblk == 256) compress_seams(p, bid - 142, 114); else compress_seams(p, bid, nblk);
    xcd_barrier(bar);
    {
        volatile int* slot = (volatile int*)(lds + 147456 + 16);
        for (;;) {
            __syncthreads();
            if (threadIdx.x == 0) *slot = (int)__hip_atomic_fetch_add(p.bar + 3456 + 48, 1u, __ATOMIC_RELAXED, __HIP_MEMORY_SCOPE_AGENT);
            __syncthreads();
            const int w = *slot;
            if (w >= 136 + 512) break;
            if (w < 136) compress_prompt_ksplit_item(p, lds, w); else ret_local_item(p, lds, w - 136);
        }
    }
    xcd_barrier(bar);
    p6b_scan(p, bid, nblk); wg_signal(p.bar + 3456, true);
    att_phase(p, lds, bid, nblk);
    ret_out_queue(p, lds, bid, nblk);
    xcd_barrier(bar);
    { EpiOut e{&p}; gemm_phase(p.yar, p.bt_out, TP / 256, 4, 1024, lds, bid, nblk, e); }
    out_sample(p, lds, bid, nblk);
}
}

extern "C" void kernel_launch(void* const* d_in, const int* in_sizes, int n_in, void* d_out, int out_size, void* d_ws, size_t ws_size, hipStream_t stream) {
    Params p{};
    p.x_prompt = (const float*)d_in[0]; p.x_sample = (const float*)d_in[1]; p.c_prompt = (const float*)d_in[2]; p.c_sample = (const float*)d_in[3];
    p.cache_cmp = (const float*)d_in[4]; p.cache_slc = (const float*)d_in[5]; p.state_win = (const float*)d_in[6]; p.state_ret = (const float*)d_in[7];
    p.page_table = (const int*)d_in[8];
    p.g_norm = (const float*)d_in[9]; p.w_ada = (const float*)d_in[10]; p.b_ada = (const float*)d_in[11]; p.w_in = (const float*)d_in[12];
    p.g_q = (const float*)d_in[13]; p.g_kc = (const float*)d_in[14]; p.g_ks = (const float*)d_in[15]; p.g_kw = (const float*)d_in[16];
    p.pe_ck = (const float*)d_in[17]; p.w_ck1 = (const float*)d_in[18]; p.w_ck2 = (const float*)d_in[19];
    p.pe_cv = (const float*)d_in[20]; p.w_cv1 = (const float*)d_in[21]; p.w_cv2 = (const float*)d_in[22];
    p.g_ret = (const float*)d_in[23]; p.w_out = (const float*)d_in[24];
    float* o = (float*)d_out;
    p.y = o; o += (size_t)R * 1024;
    p.p_cmp = o; o += (size_t)TP * 256; p.p_slc = o; o += (size_t)TP * 256; p.p_win = o; o += (size_t)4 * 512 * 256; p.p_ret = o; o += (size_t)16 * 8192;
    p.s_cmp = o; o += 32 * 256; p.s_slc = o; o += 32 * 256; p.s_win = o; o += (size_t)32 * 512 * 256; p.s_ret = o; o += (size_t)128 * 8192;
    char* w = (char*)d_ws; size_t off = 0;
    auto take = [&](size_t bytes) { char* q = w + off; off += (bytes + 255) & ~(size_t)255; return q; };
    p.bar = (unsigned*)take(16384);
    p.mod = (float*)take(36 * 3072 * 4);
    p.bt_in = (bf16_t*)take((size_t)NPAD * 1024 * 2);
    p.bt_out = (bf16_t*)take((size_t)1024 * 1024 * 2);
    p.H = (bf16_t*)take((size_t)RPAD * 1024 * 2);
    p.praw = (float*)take((size_t)RPAD * NPAD * 4);
    p.qn = (bf16_t*)take((size_t)R * 512 * 2);
    p.kcr = (bf16_t*)take((size_t)TP * 128 * 2); p.vcr = (bf16_t*)take((size_t)TP * 128 * 2);
    p.ks = (bf16_t*)take((size_t)TP * 128 * 2); p.vs = (bf16_t*)take((size_t)TP * 128 * 2);
    p.kw = (bf16_t*)take((size_t)TP * 128 * 2); p.vw = (bf16_t*)take((size_t)TP * 128 * 2);
    p.gates = (float*)take((size_t)R * 24 * 4);
    p.ga = (bf16_t*)take((size_t)R * 512 * 2); p.gr = (bf16_t*)take((size_t)R * 512 * 2);
    p.rq = (bf16_t*)take((size_t)R * 256 * 2); p.rk = (bf16_t*)take((size_t)R * 256 * 2); p.rv = (bf16_t*)take((size_t)R * 512 * 2);
    p.kc = (bf16_t*)take((size_t)4 * 2 * 256 * 64 * 2); p.vc = (bf16_t*)take((size_t)4 * 2 * 256 * 64 * 2);
    p.kcs = (bf16_t*)take((size_t)32 * 2 * 1024 * 64 * 2); p.vcs = (bf16_t*)take((size_t)32 * 2 * 1024 * 64 * 2);
    p.yar = (bf16_t*)take((size_t)RPAD * 1024 * 2);
    p.sloc = (float*)take((size_t)512 * 8192 * 4); p.spre = (float*)take((size_t)512 * 8192 * 4);
    p.oret = (float*)take((size_t)R * 512 * 4);
    p.w1p = (bf16_t*)take((size_t)2 * 128 * 1024 * 2); p.w2t = (bf16_t*)take((size_t)2 * 64 * 64 * 2); p.b1 = (float*)take(128 * 4);
    p.attb = (float*)take(256);
    p.ropec = (float*)take((size_t)4097 * 32 * 4); p.ropes = (float*)take((size_t)4097 * 32 * 4);
    p.seamA = (float*)take((size_t)32 * 2 * 64 * 2 * 64 * 4); p.seamB = (float*)take((size_t)32 * 2 * 64 * 2 * 64 * 4);
    if (off > ws_size) { fprintf(stderr, "workspace too small: need %zu have %zu\n", off, ws_size); return; }
    static int grid = 0;
    if (grid == 0) {
        int dev = 0, cus = 0, per_cu = 0;
        if (hipGetDevice(&dev) != hipSuccess || hipDeviceGetAttribute(&cus, hipDeviceAttributeMultiprocessorCount, dev) != hipSuccess) { fprintf(stderr, "device query failed\n"); grid = -1; return; }
        if (hipFuncSetAttribute((const void*)k_mega, hipFuncAttributeMaxDynamicSharedMemorySize, LDS_BYTES) != hipSuccess) { fprintf(stderr, "hipFuncSetAttribute failed\n"); grid = -1; return; }
        if (hipOccupancyMaxActiveBlocksPerMultiprocessor(&per_cu, (const void*)k_mega, NT, LDS_BYTES) != hipSuccess || per_cu < 1) { fprintf(stderr, "occupancy query: %d blocks per CU\n", per_cu); grid = -1; return; }
        (void)hipGetLastError();
        grid = cus;
    }
    if (grid < 0) return;
    (void)hipMemsetAsync(p.bar, 0, 16384, stream);
    hipLaunchKernelGGL(k_mega, dim3(grid), dim3(NT), LDS_BYTES, stream, p);
}
```

```cpp
#include <hip/hip_runtime.h>
#include <stdint.h>
#include <stdio.h>

namespace {
typedef unsigned short bf16_t;
typedef short bf16x8 __attribute__((ext_vector_type(8)));
typedef float f32x4 __attribute__((ext_vector_type(4)));

constexpr int D_MODEL = 1024, BATCH = 4, SEQ = 4096, DEC_BATCH = 32, PAST = 16384;
constexpr int NPAGES = 128, NPHYS = 5120;
constexpr int TP = BATCH * SEQ;
constexpr int R = TP + DEC_BATCH;
constexpr int RPAD = 16640;
constexpr int D_IN = 3352, NPAD = 3584;
constexpr int C_Q = 0, C_KC = 512, C_KS = 768, C_KW = 1024, C_BR = 1280, C_GA = 1304, C_RQ = 1816, C_RK = 2072, C_RV = 2328, C_GR = 2840;
constexpr float EPS = 1e-6f;
constexpr int NT = 512;
constexpr int LDS_BYTES = 147456 + 64 + 8192 + 256;

struct Params {
    const float *x_prompt, *x_sample, *c_prompt, *c_sample, *cache_cmp, *cache_slc, *state_win, *state_ret;
    const int* page_table;
    const float *g_norm, *w_ada, *b_ada, *w_in, *g_q, *g_kc, *g_ks, *g_kw, *pe_ck, *w_ck1, *w_ck2, *pe_cv, *w_cv1, *w_cv2, *g_ret, *w_out;
    float *y, *p_cmp, *p_slc, *p_win, *p_ret, *s_cmp, *s_slc, *s_win, *s_ret;
    unsigned* bar;
    float* mod;
    bf16_t* bt_in;
    bf16_t* bt_out;
    bf16_t* H;
    float* praw;
    bf16_t* qn;
    bf16_t *kcr, *vcr, *ks, *vs, *kw, *vw;
    float* gates;
    bf16_t *ga, *gr;
    bf16_t *rq, *rk;
    bf16_t* rv;
    bf16_t *kc, *vc;
    bf16_t *kcs, *vcs;
    bf16_t* yar;
    float *sloc, *spre;
    float* oret;
    bf16_t* w1p;
    bf16_t* w2t;
    float* b1;
    float *seamA, *seamB;
    float* attb;
    float *ropec, *ropes;
};

__device__ __forceinline__ int tile_src(int pn) { return pn <= 4 ? pn * 256 : pn == 13 ? 1280 : 1304 + (pn - 5) * 256; }
__device__ __forceinline__ bf16_t f2bf(float f) { unsigned u = __float_as_uint(f); u += 0x7fffu + ((u >> 16) & 1u); return (bf16_t)(u >> 16); }
__device__ __forceinline__ float bf2f(bf16_t h) { return __uint_as_float(((unsigned)h) << 16); }
__device__ __forceinline__ float wave_sum(float v) {
#pragma unroll
    for (int o = 1; o < 64; o <<= 1) v += __shfl_xor(v, o);
    return v;
}
__device__ __forceinline__ float wave_max(float v) {
#pragma unroll
    for (int o = 1; o < 64; o <<= 1) v = fmaxf(v, __shfl_xor(v, o));
    return v;
}
__device__ __forceinline__ float silu(float v) { return v / (1.f + __expf(-v)); }
__device__ __forceinline__ float sigmoidf(float v) { return 1.f / (1.f + __expf(-v)); }
__device__ __forceinline__ int opaque_tid() { int t = threadIdx.x; asm volatile("" : "+v"(t)); return t; }
typedef __bf16 bf16x2_t __attribute__((ext_vector_type(2)));
typedef float f32x2_t __attribute__((ext_vector_type(2)));
__device__ __forceinline__ unsigned cvt_pk_bf16(float lo, float hi) { const f32x2_t v = {lo, hi}; return __builtin_bit_cast(unsigned, __builtin_convertvector(v, bf16x2_t)); }
#define WSYNC() asm volatile("s_waitcnt lgkmcnt(0)" ::: "memory")

__device__ __forceinline__ void load8(const bf16_t* p, float (&f)[8]) {
    uint4 u = *(const uint4*)p;
    f[0] = __uint_as_float(u.x << 16); f[1] = __uint_as_float(u.x & 0xffff0000u);
    f[2] = __uint_as_float(u.y << 16); f[3] = __uint_as_float(u.y & 0xffff0000u);
    f[4] = __uint_as_float(u.z << 16); f[5] = __uint_as_float(u.z & 0xffff0000u);
    f[6] = __uint_as_float(u.w << 16); f[7] = __uint_as_float(u.w & 0xffff0000u);
}
__device__ __forceinline__ void load8(const float* p, float (&f)[8]) {
    float4 a = *(const float4*)p, b = *(const float4*)(p + 4);
    f[0] = a.x; f[1] = a.y; f[2] = a.z; f[3] = a.w; f[4] = b.x; f[5] = b.y; f[6] = b.z; f[7] = b.w;
}
__device__ __forceinline__ float load1(const bf16_t* p) { return bf2f(*p); }
__device__ __forceinline__ float load1(const float* p) { return *p; }


#define XB_TMO      128
#define XB_XCNT(j)  (256  + 64 * (j))
#define XB_XSUB(j)  (1280 + 64 * (j))
#define XB_XGEN(j)  (2304 + 64 * (j))
#define XB_TOP      3328
#define XB_TOPGEN   3392
#define XCD_BAR_WORDS 3456
#define XB_SPIN_CAP (1u << 18)
#define LAS __attribute__((address_space(3)))
__device__ __forceinline__ unsigned xb_ld(unsigned* p)              { return __hip_atomic_load(p, __ATOMIC_RELAXED, __HIP_MEMORY_SCOPE_AGENT); }
__device__ __forceinline__ unsigned xb_add(unsigned* p, unsigned v) { return __hip_atomic_fetch_add(p, v, __ATOMIC_RELAXED, __HIP_MEMORY_SCOPE_AGENT); }
__device__ __forceinline__ unsigned xb_xcc_id() { return (unsigned)__builtin_amdgcn_s_getreg((3 << 11) | 20) & 0xFu; }
#define XB_SPIN(cond, bar) do { unsigned _sp = 0; while (cond) { __builtin_amdgcn_s_sleep(1); \
    if ((++_sp & 255u) == 0u) { if (xb_ld(&(bar)[XB_TMO])) break; if (_sp > XB_SPIN_CAP) { atomicAdd(&(bar)[XB_TMO], 1u); break; } } } } while (0)
struct XcdBarrier { unsigned* bar; unsigned x; volatile LAS unsigned* st; };
__device__ __forceinline__ XcdBarrier xcd_barrier_post(unsigned* bar, volatile LAS unsigned* st) {
    XcdBarrier b; b.bar = bar; b.x = xb_xcc_id(); b.st = st;
    if (threadIdx.x == 0) (void)xb_add(&bar[XB_XCNT(b.x)], 1u);
    return b;
}
__device__ __forceinline__ void xcd_barrier_complete(unsigned* bar, unsigned x, unsigned& nloc, unsigned& nx) {
    const unsigned G = gridDim.x * gridDim.y * gridDim.z;
    unsigned sum, cnt, mine, sp = 0u;
    for (;;) {
        sum = 0u; cnt = 0u; mine = 0u;
#pragma unroll
        for (unsigned j = 0; j < 16; ++j) { const unsigned c = xb_ld(&bar[XB_XCNT(j)]); sum += c; cnt += (c > 0u) ? 1u : 0u; mine = (j == x) ? c : mine; }
        if (sum == G) break;
        __builtin_amdgcn_s_sleep(1);
        if ((++sp & 255u) == 0u) { if (xb_ld(&bar[XB_TMO])) break; if (sp > XB_SPIN_CAP) { atomicAdd(&bar[XB_TMO], 1u); break; } }
    }
    nloc = mine > 0u ? mine : 1u; nx = cnt > 0u ? cnt : 1u;
}
__device__ __forceinline__ void xcd_barrier(const XcdBarrier& b) {
    asm volatile("s_waitcnt vmcnt(0)" ::: "memory");
    __syncthreads();
    if (threadIdx.x == 0) {
        unsigned* bar = b.bar;
        __builtin_amdgcn_s_waitcnt(0);
        unsigned nloc = b.st[0], nx = b.st[1];
        if (nloc == 0u) { xcd_barrier_complete(bar, b.x, nloc, nx); b.st[0] = nloc; b.st[1] = nx; }
        const unsigned old = xb_add(&bar[XB_XSUB(b.x)], 1u);
        const unsigned gen = old / nloc;
        if (old + 1u == (gen + 1u) * nloc) {
            __builtin_amdgcn_fence(__ATOMIC_RELEASE, "agent");
            asm volatile("s_waitcnt vmcnt(0)" ::: "memory");
            const unsigned og = xb_add(&bar[XB_TOP], 1u);
            const unsigned tg = og / nx;
            if (og + 1u == (tg + 1u) * nx) xb_add(&bar[XB_TOPGEN], 1u);
            else XB_SPIN(xb_ld(&bar[XB_TOPGEN]) == tg, bar);
            __builtin_amdgcn_fence(__ATOMIC_ACQUIRE, "agent");
            xb_add(&bar[XB_XGEN(b.x)], 1u);
            asm volatile("s_waitcnt vmcnt(0)" ::: "memory");
        } else {
            XB_SPIN(xb_ld(&bar[XB_XGEN(b.x)]) == gen, bar);
            __builtin_amdgcn_fence(__ATOMIC_ACQUIRE, "agent");
            asm volatile("s_waitcnt vmcnt(0)" ::: "memory");
        }
    }
    __syncthreads();
}


__device__ __forceinline__ void wg_signal(unsigned* ctr, bool need_release) {
    asm volatile("s_waitcnt vmcnt(0)" ::: "memory");
    __syncthreads();
    if (threadIdx.x == 0) {
        if (need_release) { __builtin_amdgcn_fence(__ATOMIC_RELEASE, "agent"); asm volatile("s_waitcnt vmcnt(0)" ::: "memory"); }
        (void)__hip_atomic_fetch_add(ctr, 1u, __ATOMIC_RELAXED, __HIP_MEMORY_SCOPE_AGENT);
    }
}
__device__ __forceinline__ void wg_wait(unsigned* ctr, unsigned target, unsigned* tmo) {
    if (threadIdx.x == 0) {
        unsigned sp = 0;
        while (__hip_atomic_load(ctr, __ATOMIC_RELAXED, __HIP_MEMORY_SCOPE_AGENT) < target) {
            __builtin_amdgcn_s_sleep(2);
            if (++sp > (1u << 22)) { atomicAdd(tmo, 1u); break; }
        }
        __builtin_amdgcn_fence(__ATOMIC_ACQUIRE, "agent");
        asm volatile("s_waitcnt vmcnt(0)" ::: "memory");
    }
    __syncthreads();
}
__device__ __forceinline__ void p0_adaln(const Params& p, char* lds, int bid, int nblk) {
    float* sc = (float*)lds;
    float* red = (float*)(lds + 73728);
    const int tid = opaque_tid(), lane = tid & 63, wave = tid >> 6;
    for (int item = bid; item < 192; item += nblk) {
        const int cb = item >> 2, r0 = (item & 3) * 9;
        __syncthreads();
        {
            float cv[18];
#pragma unroll
            for (int u = 0; u < 18; ++u) { const int i = tid + u * NT, row = r0 + (i >> 10), k = i & 1023; cv[u] = row < 4 ? p.c_prompt[row * 1024 + k] : p.c_sample[(row - 4) * 1024 + k]; }
#pragma unroll
            for (int u = 0; u < 18; ++u) sc[tid + u * NT] = silu(cv[u]);
        }
        __syncthreads();
        const int j = cb * 64 + lane;
        float acc[9];
#pragma unroll
        for (int r = 0; r < 9; ++r) acc[r] = 0.f;
        const int k0 = wave * 128;
#pragma unroll 8
        for (int k = k0; k < k0 + 128; k += 4) {
            const float w0 = p.w_ada[(size_t)k * 3072 + j], w1 = p.w_ada[(size_t)(k + 1) * 3072 + j], w2 = p.w_ada[(size_t)(k + 2) * 3072 + j], w3 = p.w_ada[(size_t)(k + 3) * 3072 + j];
#pragma unroll
            for (int r = 0; r < 9; ++r) { const float4 s = *(const float4*)(sc + r * 1024 + k); acc[r] += s.x * w0 + s.y * w1 + s.z * w2 + s.w * w3; }
        }
#pragma unroll
        for (int r = 0; r < 9; ++r) red[(wave * 9 + r) * 64 + lane] = acc[r];
        __syncthreads();
        for (int i = tid; i < 9 * 64; i += NT) {
            const int r = i >> 6, l = i & 63;
            float s = 0.f;
#pragma unroll
            for (int w = 0; w < 8; ++w) s += red[(w * 9 + r) * 64 + l];
            __hip_atomic_store(&p.mod[(r0 + r) * 3072 + cb * 64 + l], s + p.b_ada[cb * 64 + l], __ATOMIC_RELAXED, __HIP_MEMORY_SCOPE_AGENT);
        }
        wg_signal(p.bar + 3520, false);
    }
}

__device__ __forceinline__ void transpose_item(const float* W, int K, int N, bf16_t* WT, float* scr, int item, int lane, int nblkN) {
    const int kb = item / nblkN, nb = item % nblkN, k0 = kb * 64, n0 = nb * 64;
    float tv[64];
#pragma unroll
    for (int kk = 0; kk < 64; ++kk) tv[kk] = (n0 + lane < N) ? W[(size_t)(k0 + kk) * N + n0 + lane] : 0.f;
#pragma unroll
    for (int kk = 0; kk < 64; ++kk) scr[kk * 65 + lane] = tv[kk];
    WSYNC();
    for (int nn = 0; nn < 64; ++nn) WT[(size_t)(n0 + nn) * K + k0 + lane] = f2bf(scr[lane * 65 + nn]);
    WSYNC();
}
__device__ __forceinline__ void p0_w1p(const Params& p, int bid, int nblk) {
    const size_t gt = (size_t)bid * NT + opaque_tid(), ngt = (size_t)nblk * NT;
    for (size_t i = gt; i < (size_t)2 * 128 * 1024; i += ngt) {
        const int kv = (int)(i >> 17), n = (int)(i >> 10) & 127, kp = (int)i & 1023;
        const int ks = kp >> 5, G = (kp >> 3) & 3, j = kp & 7;
        const int k = ks * 32 + 16 * (j >> 2) + 4 * G + (j & 3);
        const int l = (k >> 6) + (n >= 64 ? 16 : 0), d = k & 63, f = n & 63;
        p.w1p[i] = f2bf((kv ? p.w_cv1 : p.w_ck1)[(size_t)(l * 64 + d) * 64 + f]);
    }
}
__device__ __forceinline__ void p0_weights(const Params& p, char* lds, int bid, int nblk) {
    const int tid = opaque_tid(), lane = tid & 63, wave = tid >> 6;
    float* scr = (float*)lds + wave * (64 * 65);
    const int gw = bid * 8 + wave, ngw = nblk * 8;
    constexpr int I_IN = 16 * 112, I_OUT = 16 * 16;
    for (int it = gw; it < I_IN + I_OUT; it += ngw) {
        if (it < I_IN) {
            const int kb = it / 112, nb = it % 112, k0 = kb * 64, n0 = nb * 32;
            const int pn = n0 >> 8, pl = n0 & 255, bj = pl >> 7, wc = (pl >> 5) & 3;
            const int cb = tile_src(pn) + wc * 64 + bj * 32;
            const int lim = pn == 13 ? 1304 : D_IN;
            float tv[32];
#pragma unroll
            for (int i = 0; i < 32; ++i) { const int kk = 2 * i + (lane >> 5), c = cb + (lane & 31); tv[i] = c < lim ? p.w_in[(size_t)(k0 + kk) * D_IN + c] : 0.f; }
#pragma unroll
            for (int i = 0; i < 32; ++i) scr[(2 * i + (lane >> 5)) * 33 + (lane & 31)] = tv[i];
            WSYNC();
            const int c8 = lane & 7;
            for (int j = 0; j < 4; ++j) {
                const int n = (lane >> 3) + 8 * j; const float* s = scr + (8 * c8) * 33 + n;
                uint4 o; o.x = cvt_pk_bf16(s[0], s[33]); o.y = cvt_pk_bf16(s[66], s[99]); o.z = cvt_pk_bf16(s[132], s[165]); o.w = cvt_pk_bf16(s[198], s[231]);
                *(uint4*)(p.bt_in + (size_t)(n0 + n) * 1024 + k0 + 8 * c8) = o;
            }
            WSYNC();
        } else transpose_item(p.w_out, 1024, 1024, p.bt_out, scr, it - I_IN, lane, 16);
    }
    const size_t gt = (size_t)bid * NT + tid, ngt = (size_t)nblk * NT;
    for (size_t i = gt; i < (size_t)4097 * 32; i += ngt) {
        const int pi = (int)(i >> 5), fi = (int)i & 31;
        const float ang = (float)(pi < 4096 ? pi : PAST) * powf(10000.f, -(float)fi / 32.f);
        float sn, cs; sincosf(ang, &sn, &cs);
        p.ropec[i] = cs; p.ropes[i] = sn;
    }
    if (bid == (nblk > 200 ? 200 : 0) && wave == 0) {
        const float gq = wave_max(fabsf(p.g_q[lane])), gc = wave_max(fabsf(p.g_kc[lane])), gs = wave_max(fabsf(p.g_ks[lane])), gw = wave_max(fabsf(p.g_kw[lane]));
        if (lane == 0) { const float k = 8.f * 1.03f * 1.44269504088896f * gq; p.attb[0] = k * gc; p.attb[1] = k * gs; p.attb[2] = k * gw; p.attb[3] = 0.f; }
    }
    for (size_t i = gt; i < (size_t)2 * 64 * 64; i += ngt) {
        const int kv = (int)(i >> 12), d = (int)(i >> 6) & 63, f = (int)i & 63;
        p.w2t[i] = f2bf((kv ? p.w_cv2 : p.w_ck2)[f * 64 + d]);
    }
    for (size_t i = gt; i < (size_t)2 * 8 * 64; i += ngt) {
        const int which = (int)(i >> 9), bg = (int)(i >> 6) & 7, d = (int)i & 63;
        (which ? p.vc : p.kc)[((size_t)bg * 256 + 255) * 64 + d] = 0;
    }
    {
        constexpr int NW = 32 * 511 * 64;
        const int gti = (int)gt, ngti = (int)ngt;
#define SW_SRC(i) (p.state_win + (size_t)((i) / (511 * 64)) * 512 * 256 + 256 + (size_t)((i) % (511 * 64)) * 4)
#define SW_DST(i) (p.s_win + (size_t)((i) / (511 * 64)) * 512 * 256 + (size_t)((i) % (511 * 64)) * 4)
#define SW_LD(j) const int ix##j = ib + j * ngti, cx##j = ix##j < NW ? ix##j : NW - 1; const float4 vx##j = *(const float4*)SW_SRC(cx##j);
#define SW_ST(j) if (ix##j < NW) *(float4*)SW_DST(ix##j) = vx##j;
        for (int ib = gti; ib < NW; ib += 8 * ngti) {
            SW_LD(0) SW_LD(1) SW_LD(2) SW_LD(3) SW_LD(4) SW_LD(5) SW_LD(6) SW_LD(7)
            SW_ST(0) SW_ST(1) SW_ST(2) SW_ST(3) SW_ST(4) SW_ST(5) SW_ST(6) SW_ST(7)
        }
#undef SW_SRC
#undef SW_DST
#undef SW_LD
#undef SW_ST
    }
}

__device__ __forceinline__ void p1_norm(const Params& p, char* lds, int bid, int nblk) {
    const int tid = opaque_tid(), lane = tid & 63, wave = tid >> 6;
    volatile int* slot = (volatile int*)(lds + 147456 + 16);
    for (;;) {
        __syncthreads();
        if (tid == 0) *slot = (int)__hip_atomic_fetch_add(p.bar + 3456 + 32, 1u, __ATOMIC_RELAXED, __HIP_MEMORY_SCOPE_AGENT);
        __syncthreads();
        const int pulled = *slot;
        if (pulled * 32 >= R) break;
        const int chunk = pulled == 0 ? TP / 32 : pulled - 1;
        if (chunk * 32 < TP) {
            const float* shift = p.mod + (chunk >> 7) * 3072, *scale = shift + 1024;
            const int rw = chunk * 32 + wave;
            float4 v[4][4], g[4], sc[4], sh[4];
#pragma unroll
            for (int q = 0; q < 4; ++q)
#pragma unroll
                for (int j = 0; j < 4; ++j) v[q][j] = *(const float4*)(p.x_prompt + (size_t)(rw + 8 * q) * 1024 + j * 256 + lane * 4);
#pragma unroll
            for (int j = 0; j < 4; ++j) { const int c = j * 256 + lane * 4; g[j] = *(const float4*)(p.g_norm + c); sc[j] = *(const float4*)(scale + c); sh[j] = *(const float4*)(shift + c); }
#pragma unroll
            for (int q = 0; q < 4; ++q) {
                float ss = 0.f;
#pragma unroll
                for (int j = 0; j < 4; ++j) ss += v[q][j].x * v[q][j].x + v[q][j].y * v[q][j].y + v[q][j].z * v[q][j].z + v[q][j].w * v[q][j].w;
                const float rs = rsqrtf(wave_sum(ss) * (1.f / 1024.f) + EPS);
#pragma unroll
                for (int j = 0; j < 4; ++j) {
                    ushort4 o;
                    o.x = f2bf(v[q][j].x * rs * g[j].x * (1.f + sc[j].x) + sh[j].x);
                    o.y = f2bf(v[q][j].y * rs * g[j].y * (1.f + sc[j].y) + sh[j].y);
                    o.z = f2bf(v[q][j].z * rs * g[j].z * (1.f + sc[j].z) + sh[j].z);
                    o.w = f2bf(v[q][j].w * rs * g[j].w * (1.f + sc[j].w) + sh[j].w);
                    *(ushort4*)(p.H + (size_t)(rw + 8 * q) * 1024 + j * 256 + lane * 4) = o;
                }
            }
            continue;
        }
      for (int r = chunk * 32 + wave; r < R && r < chunk * 32 + 32; r += 8) {
        const float* xr = r < TP ? p.x_prompt + (size_t)r * 1024 : p.x_sample + (size_t)(r - TP) * 1024;
        const int mrow = r < TP ? (r >> 12) : 4 + (r - TP);
        const float* shift = p.mod + mrow * 3072, *scale = shift + 1024;
        float4 v[4]; float ss = 0.f;
#pragma unroll
        for (int j = 0; j < 4; ++j) { v[j] = *(const float4*)(xr + j * 256 + lane * 4); ss += v[j].x * v[j].x + v[j].y * v[j].y + v[j].z * v[j].z + v[j].w * v[j].w; }
        const float rs = rsqrtf(wave_sum(ss) * (1.f / 1024.f) + EPS);
#pragma unroll
        for (int j = 0; j < 4; ++j) {
            const int c = j * 256 + lane * 4;
            const float4 g = *(const float4*)(p.g_norm + c), sc = *(const float4*)(scale + c), sh = *(const float4*)(shift + c);
            ushort4 o;
            o.x = f2bf(v[j].x * rs * g.x * (1.f + sc.x) + sh.x);
            o.y = f2bf(v[j].y * rs * g.y * (1.f + sc.y) + sh.y);
            o.z = f2bf(v[j].z * rs * g.z * (1.f + sc.z) + sh.z);
            o.w = f2bf(v[j].w * rs * g.w * (1.f + sc.w) + sh.w);
            *(ushort4*)(p.H + (size_t)r * 1024 + c) = o;
        }
      }
    }
}

constexpr int BM = 256, BK = 64, HALF = 128, HT = HALF * BK;
__device__ __forceinline__ int lds_byte(int r, int c) {
    int st = (r >> 4) * 2 + (c >> 5), rr = r & 15, cc = c & 31, ob = rr * 64 + cc * 2;
    return st * 1024 + (ob ^ (((ob >> 9) & 1) << 5));
}
__device__ __forceinline__ void stage_rc(int b, int& Rr, int& Cc) {
    int st = b / 1024, sb = b % 1024, swz = sb ^ (((sb >> 9) & 1) << 5);
    Rr = (st >> 1) * 16 + swz / 64; Cc = (st & 1) * 32 + (swz % 64) / 2;
}

template <class Epi>
__device__ __forceinline__ void gemm_phase(const bf16_t* __restrict__ A, const bf16_t* __restrict__ Bt, int nM, int nN, int K, char* lds, int bid, int nblk, const Epi& epi) {
    bf16_t* shm = (bf16_t*)lds;
#define SA(b, h) (shm + ((b) * 2 + (h)) * HT)
#define SB(b, h) (shm + (4 + (b) * 2 + (h)) * HT)
#define STAGE_X(T, P, BASE, br, kt) do { long _g = (long)(br) * K + (long)(kt) * BK; \
    for (int _i = 0; _i < 2; ++_i) { int _b = (T) * 16 + _i * 8192; int _r, _c; stage_rc(_b, _r, _c); \
      __builtin_amdgcn_global_load_lds((const unsigned*)(BASE + _g + (long)_r * K + _c), \
        (__attribute__((address_space(3))) unsigned*)((char*)(P) + _b), 16, 0, 0); } } while (0)
#define STAGE(P, BASE, br, kt) STAGE_X(tz0, P, BASE, br, kt)
#define LDA(dst, b, h) for (int m = 0; m < 4; ++m) for (int k = 0; k < 2; ++k) \
    dst[m][k] = *reinterpret_cast<const bf16x8*>((char*)SA(b, h) + lds_byte(wr * 64 + m * 16 + fr, k * 32 + fq * 8))
#define LDB(dst, b, h) for (int n = 0; n < 2; ++n) for (int k = 0; k < 2; ++k) \
    dst[n][k] = *reinterpret_cast<const bf16x8*>((char*)SB(b, h) + lds_byte(wc * 32 + n * 16 + fr, k * 32 + fq * 8))
#define MMA(ai, bj, At, Bt_) do { __builtin_amdgcn_s_setprio(1); \
    for (int m = 0; m < 4; ++m) for (int n = 0; n < 2; ++n) for (int k = 0; k < 2; ++k) \
      acc[ai][bj][m][n] = __builtin_amdgcn_mfma_f32_16x16x32_bf16(Bt_[n][k], At[m][k], acc[ai][bj][m][n], 0, 0, 0); \
    __builtin_amdgcn_s_setprio(0); } while (0)
#define WAIT_V(n) asm volatile("s_waitcnt vmcnt(" #n ")" ::: "memory")
#define WAIT_L(n) asm volatile("s_waitcnt lgkmcnt(" #n ")" ::: "memory")
#define BAR __builtin_amdgcn_s_barrier()
#define SCHED __builtin_amdgcn_sched_barrier(0)
    const int nwg = nM * nN;
    for (int tile = bid; tile < nwg; tile += nblk) {
        const int pm = tile / nN, pn = tile % nN;
        const int brow = pm * BM, bcol = pn * BM;
        int tz0 = threadIdx.x; asm volatile("" : "+v"(tz0));
        int wid = tz0 >> 6, lane = tz0 & 63, wr = wid >> 2, wc = wid & 3, fr = lane & 15, fq = lane >> 4;
        f32x4 acc[2][2][4][2] = {};
        bf16x8 At[4][2], B0[2][2], B1[2][2];
        const int nt = K / BK;
        STAGE(SB(0, 0), Bt, bcol, 0); STAGE(SA(0, 0), A, brow, 0);
        STAGE(SB(0, 1), Bt, bcol + HALF, 0); STAGE(SA(0, 1), A, brow + HALF, 0);
        if (wr == 1) BAR;
        WAIT_V(4); BAR;
        STAGE(SB(1, 0), Bt, bcol, 1); STAGE(SA(1, 0), A, brow, 1); STAGE(SB(1, 1), Bt, bcol + HALF, 1);
        WAIT_V(6); BAR;
        for (int t = 0; t < nt - 2; t += 2) {
            LDB(B0, 0, 0); SCHED; LDA(At, 0, 0); STAGE(SA(1, 1), A, brow + HALF, t + 1);
            WAIT_L(8); BAR; WAIT_L(0); MMA(0, 0, At, B0); BAR; SCHED;
            LDB(B1, 0, 1); STAGE(SB(0, 0), Bt, bcol, t + 2);
            BAR; WAIT_L(0); MMA(0, 1, At, B1); BAR;
            LDA(At, 0, 1); STAGE(SA(0, 0), A, brow, t + 2);
            BAR; WAIT_L(0); MMA(1, 0, At, B0); BAR; SCHED;
            STAGE(SB(0, 1), Bt, bcol + HALF, t + 2);
            WAIT_V(6); BAR; MMA(1, 1, At, B1); BAR;
            LDB(B0, 1, 0); SCHED; LDA(At, 1, 0); STAGE(SA(0, 1), A, brow + HALF, t + 2);
            WAIT_L(8); BAR; WAIT_L(0); MMA(0, 0, At, B0); BAR; SCHED;
            LDB(B1, 1, 1); STAGE(SB(1, 0), Bt, bcol, t + 3);
            BAR; WAIT_L(0); MMA(0, 1, At, B1); BAR;
            LDA(At, 1, 1); STAGE(SA(1, 0), A, brow, t + 3);
            BAR; WAIT_L(0); MMA(1, 0, At, B0); BAR; SCHED;
            STAGE(SB(1, 1), Bt, bcol + HALF, t + 3);
            WAIT_V(6); BAR; MMA(1, 1, At, B1); BAR;
        }
        int tz = threadIdx.x; asm volatile("" : "+v"(tz)); wid = tz >> 6; lane = tz & 63; wr = wid >> 2; wc = wid & 3; fr = lane & 15; fq = lane >> 4;
        { LDB(B0, 0, 0); WAIT_V(0); LDA(At, 0, 0); STAGE_X(tz, SA(1, 1), A, brow + HALF, nt - 1);
          BAR; WAIT_L(0); MMA(0, 0, At, B0); BAR;
          LDB(B1, 0, 1); BAR; WAIT_L(0); MMA(0, 1, At, B1); BAR;
          LDA(At, 0, 1); WAIT_V(4); BAR; WAIT_L(0); MMA(1, 0, At, B0); MMA(1, 1, At, B1); BAR; }
        { LDB(B0, 1, 0); LDA(At, 1, 0); WAIT_V(2); BAR; WAIT_L(0); MMA(0, 0, At, B0); BAR;
          LDB(B1, 1, 1); WAIT_V(0); BAR; WAIT_L(0); MMA(0, 1, At, B1); BAR;
          LDA(At, 1, 1); BAR; WAIT_L(0); MMA(1, 0, At, B0); MMA(1, 1, At, B1); BAR; }
        if (wr == 0) BAR;
        epi(acc, brow, bcol, wr, wc, fr, fq);
    }
#undef SA
#undef SB
#undef STAGE_X
#undef STAGE
#undef LDA
#undef LDB
#undef MMA
}

struct EpiOut {
    const Params* p;
    __device__ __forceinline__ void operator()(const f32x4 (&acc)[2][2][4][2], int brow, int bcol, int wr, int wc, int fr, int fq) const {
#pragma unroll
        for (int ai = 0; ai < 2; ++ai)
#pragma unroll
            for (int mt = 0; mt < 4; ++mt) {
                const int r = brow + ai * HALF + wr * 64 + mt * 16 + fr;
                if (r < R) {
                    const float* xr = r < TP ? p->x_prompt + (size_t)r * 1024 : p->x_sample + (size_t)(r - TP) * 1024;
                    const float* gate = p->mod + (r < TP ? (r >> 12) : 4 + (r - TP)) * 3072 + 2048;
#pragma unroll
                    for (int bj = 0; bj < 2; ++bj)
#pragma unroll
                        for (int nt = 0; nt < 2; ++nt) {
                            const int c = bcol + bj * HALF + wc * 32 + nt * 16 + 4 * fq;
                            const float4 xv = *(const float4*)(xr + c), gv = *(const float4*)(gate + c);
                            float4 o; o.x = xv.x + gv.x * acc[ai][bj][mt][nt][0]; o.y = xv.y + gv.y * acc[ai][bj][mt][nt][1];
                            o.z = xv.z + gv.z * acc[ai][bj][mt][nt][2]; o.w = xv.w + gv.w * acc[ai][bj][mt][nt][3];
                            *(float4*)(p->y + (size_t)r * 1024 + c) = o;
                        }
                }
            }
    }
};

struct EpiIn {
    const Params* p;
    __device__ __forceinline__ void operator()(const f32x4 (&acc)[2][2][4][2], int brow, int bcol, int wr, int wc, int fr, int fq) const {
        const int pn = bcol >> 8;
        const Params& P = *p;
        const bool normt = pn <= 1 || ((pn == 3 || pn == 4) && wc < 2);
        float4 g4h[2][2];
        { const float* gn = pn <= 1 ? P.g_q : pn == 3 ? P.g_ks : P.g_kw;
#pragma unroll
          for (int bj = 0; bj < 2; ++bj)
#pragma unroll
            for (int nt = 0; nt < 2; ++nt) g4h[bj][nt] = normt ? *(const float4*)(gn + bj * 32 + nt * 16 + 4 * fq) : make_float4(1.f, 1.f, 1.f, 1.f); }
#pragma unroll
        for (int ai = 0; ai < 2; ++ai)
#pragma unroll
            for (int mt = 0; mt < 4; ++mt) {
                const int r = brow + ai * HALF + wr * 64 + mt * 16 + fr;
                const bool rowok = r < R;
                const bool isp = r < TP;
                const int b = isp ? (r >> 12) : (r - TP), t = isp ? (r & 4095) : 0, pidx = isp ? t : 4096;
                f32x4 v[2][2];
#pragma unroll
                for (int bj = 0; bj < 2; ++bj)
#pragma unroll
                    for (int nt = 0; nt < 2; ++nt) v[bj][nt] = acc[ai][bj][mt][nt];
                if (normt) {
                    float ss = 0.f;
#pragma unroll
                    for (int bj = 0; bj < 2; ++bj)
#pragma unroll
                        for (int nt = 0; nt < 2; ++nt)
#pragma unroll
                            for (int rg = 0; rg < 4; ++rg) ss += v[bj][nt][rg] * v[bj][nt][rg];
                    ss += __shfl_xor(ss, 16); ss += __shfl_xor(ss, 32);
                    const float rs = rsqrtf(ss * (1.f / 64.f) + EPS);
#pragma unroll
                    for (int bj = 0; bj < 2; ++bj)
#pragma unroll
                        for (int nt = 0; nt < 2; ++nt) {
                            const float4 g4 = g4h[bj][nt];
                            v[bj][nt][0] *= rs * g4.x; v[bj][nt][1] *= rs * g4.y; v[bj][nt][2] *= rs * g4.z; v[bj][nt][3] *= rs * g4.w;
                        }
                }
                if (!rowok) continue;
                if (pn == 7 || pn == 8) {
                    const float lgm = __log2f(1.f - exp2f(-5.f - (float)wc)) * (float)((isp ? t : PAST) & 127);
                    const float sc = pn == 7 ? exp2f(lgm) : 0.125f * exp2f(-lgm);
#pragma unroll
                    for (int nt = 0; nt < 2; ++nt) {
                        const float4 c4 = *(const float4*)(P.ropec + (size_t)pidx * 32 + nt * 16 + 4 * fq), s4 = *(const float4*)(P.ropes + (size_t)pidx * 32 + nt * 16 + 4 * fq);
                        const f32x4 x1 = v[0][nt], x2 = v[1][nt];
                        v[0][nt][0] = (x1[0] * c4.x - x2[0] * s4.x) * sc; v[1][nt][0] = (x1[0] * s4.x + x2[0] * c4.x) * sc;
                        v[0][nt][1] = (x1[1] * c4.y - x2[1] * s4.y) * sc; v[1][nt][1] = (x1[1] * s4.y + x2[1] * c4.y) * sc;
                        v[0][nt][2] = (x1[2] * c4.z - x2[2] * s4.z) * sc; v[1][nt][2] = (x1[2] * s4.z + x2[2] * c4.z) * sc;
                        v[0][nt][3] = (x1[3] * c4.w - x2[3] * s4.w) * sc; v[1][nt][3] = (x1[3] * s4.w + x2[3] * c4.w) * sc;
                    }
                }
                if (pn == 5 || pn == 6 || pn == 11 || pn == 12) {
#pragma unroll
                    for (int bj = 0; bj < 2; ++bj)
#pragma unroll
                        for (int nt = 0; nt < 2; ++nt)
#pragma unroll
                            for (int rg = 0; rg < 4; ++rg) v[bj][nt][rg] = silu(v[bj][nt][rg]);
                }
                bf16_t* bdst = nullptr; float* fdst = nullptr;
                if (pn <= 1) bdst = P.qn + (size_t)r * 512 + (pn * 4 + wc) * 64;
                else if (pn == 2) fdst = (isp ? P.p_cmp + (size_t)r * 256 : P.s_cmp + (size_t)b * 256) + wc * 64;
                else if (pn == 3) { fdst = (isp ? P.p_slc + (size_t)r * 256 : P.s_slc + (size_t)b * 256) + wc * 64;
                                    if (isp) bdst = (wc < 2 ? P.ks : P.vs) + ((size_t)(b * 2 + (wc & 1)) * SEQ + t) * 64; }
                else if (pn == 4) { fdst = isp ? (t >= SEQ - 512 ? P.p_win + ((size_t)b * 512 + (t - (SEQ - 512))) * 256 + wc * 64 : nullptr) : P.s_win + ((size_t)b * 512 + 511) * 256 + wc * 64;
                                    if (isp) bdst = (wc < 2 ? P.kw : P.vw) + ((size_t)(b * 2 + (wc & 1)) * SEQ + t) * 64; }
                else if (pn == 5 || pn == 6) bdst = P.ga + (size_t)r * 512 + (pn - 5) * 256 + wc * 64;
                else if (pn == 7) bdst = P.rq + (size_t)r * 256 + wc * 64;
                else if (pn == 8) bdst = P.rk + (size_t)r * 256 + wc * 64;
                else if (pn == 9 || pn == 10) bdst = P.rv + (size_t)r * 512 + (pn - 9) * 256 + wc * 64;
                else if (pn == 11 || pn == 12) bdst = P.gr + (size_t)r * 512 + (pn - 11) * 256 + wc * 64;
                if (pn == 13) {
                    if (wc == 0) {
                        float* gd = P.gates + (size_t)r * 24;
                        { float4 o; o.x = sigmoidf(v[0][0][0]); o.y = sigmoidf(v[0][0][1]); o.z = sigmoidf(v[0][0][2]); o.w = sigmoidf(v[0][0][3]); *(float4*)(gd + 4 * fq) = o; }
                        if (fq < 2) { float4 o; o.x = sigmoidf(v[0][1][0]); o.y = sigmoidf(v[0][1][1]); o.z = sigmoidf(v[0][1][2]); o.w = sigmoidf(v[0][1][3]); *(float4*)(gd + 16 + 4 * fq) = o; }
                    }
                    continue;
                }
#pragma unroll
                for (int bj = 0; bj < 2; ++bj)
#pragma unroll
                    for (int nt = 0; nt < 2; ++nt) {
                        const int cl = bj * 32 + nt * 16 + 4 * fq;
                        if (fdst) { float4 o; o.x = v[bj][nt][0]; o.y = v[bj][nt][1]; o.z = v[bj][nt][2]; o.w = v[bj][nt][3]; *(float4*)(fdst + cl) = o; }
                        if (bdst) { uint2 o; o.x = cvt_pk_bf16(v[bj][nt][0], v[bj][nt][1]); o.y = cvt_pk_bf16(v[bj][nt][2], v[bj][nt][3]); *(uint2*)(bdst + cl) = o; }
                    }
            }
    }
};

__device__ __forceinline__ void p3_rows(const Params& p, int bid, int nblk) {
    const int tid = opaque_tid(), lane = tid & 63, wave = tid >> 6;
    for (int r = bid * 8 + wave; r < R; r += nblk * 8) {
        const float* pr = p.praw + (size_t)r * NPAD;
        const bool isp = r < TP;
        const int b = isp ? (r >> 12) : (r - TP), t = isp ? (r & 4095) : 0;
        const int pos = isp ? t : PAST;
        {
            const float gq = p.g_q[lane];
            for (int hh = 0; hh < 8; ++hh) {
                const float v = pr[C_Q + hh * 64 + lane];
                const float rs = rsqrtf(wave_sum(v * v) * (1.f / 64.f) + EPS);
                p.qn[(size_t)r * 512 + hh * 64 + lane] = f2bf(v * rs * gq);
            }
        }
        float* o_cmp = isp ? p.p_cmp + (size_t)r * 256 : p.s_cmp + (size_t)b * 256;
        float* o_slc = isp ? p.p_slc + (size_t)r * 256 : p.s_slc + (size_t)b * 256;
        float* o_win = isp ? (t >= SEQ - 512 ? p.p_win + ((size_t)b * 512 + (t - (SEQ - 512))) * 256 : nullptr) : p.s_win + ((size_t)b * 512 + 511) * 256;
        for (int j = 0; j < 4; ++j) {
            const int g = j & 1;
            const size_t cidx = ((size_t)(b * 2 + g) * SEQ + t) * 64 + lane;
            {
                const float v = pr[C_KC + j * 64 + lane];
                o_cmp[j * 64 + lane] = v;
                if (isp) { if (j < 2) p.kcr[cidx] = f2bf(v); else p.vcr[cidx] = f2bf(v); }
            }
            {
                float v = pr[C_KS + j * 64 + lane];
                if (j < 2) { const float rs = rsqrtf(wave_sum(v * v) * (1.f / 64.f) + EPS); v = v * rs * p.g_ks[lane]; }
                o_slc[j * 64 + lane] = v;
                if (isp) { if (j < 2) p.ks[cidx] = f2bf(v); else p.vs[cidx] = f2bf(v); }
            }
            {
                float v = pr[C_KW + j * 64 + lane];
                if (j < 2) { const float rs = rsqrtf(wave_sum(v * v) * (1.f / 64.f) + EPS); v = v * rs * p.g_kw[lane]; }
                if (o_win) o_win[j * 64 + lane] = v;
                if (isp) { if (j < 2) p.kw[cidx] = f2bf(v); else p.vw[cidx] = f2bf(v); }
            }
        }
        if (lane < 24) p.gates[(size_t)r * 24 + lane] = sigmoidf(pr[C_BR + lane]);
        for (int i = 0; i < 8; ++i) {
            p.ga[(size_t)r * 512 + i * 64 + lane] = f2bf(silu(pr[C_GA + i * 64 + lane]));
            p.gr[(size_t)r * 512 + i * 64 + lane] = f2bf(silu(pr[C_GR + i * 64 + lane]));
            p.rv[(size_t)r * 512 + i * 64 + lane] = f2bf(pr[C_RV + i * 64 + lane]);
        }
        {
            const int i = lane & 31;
            const float freq = powf(10000.f, -(float)i / 32.f);
            const float ang = (float)pos * freq;
            float sn, cs; sincosf(ang, &sn, &cs);
            for (int hh = 0; hh < 4; ++hh) {
                const float a = pr[C_RQ + hh * 64 + lane], ao = pr[C_RQ + hh * 64 + (lane ^ 32)];
                const float kq = pr[C_RK + hh * 64 + lane], ko = pr[C_RK + hh * 64 + (lane ^ 32)];
                const float oq = lane < 32 ? a * cs - ao * sn : ao * sn + a * cs;
                const float ok = lane < 32 ? kq * cs - ko * sn : ko * sn + kq * cs;
                const float lgm = __log2f(1.f - exp2f(-5.f - (float)hh)) * (float)(pos & 127);
                p.rq[(size_t)r * 256 + hh * 64 + lane] = f2bf(oq * exp2f(lgm));
                p.rk[(size_t)r * 256 + hh * 64 + lane] = f2bf(ok * 0.125f * exp2f(-lgm));
            }
        }
    }
}

typedef unsigned u32x4 __attribute__((ext_vector_type(4)));

struct CmpTile {
    int active;
    int b, c0;
    int seam_idx;
    int is_sample;
};

__device__ __forceinline__ void cmp_second_layer(const Params& p, int kv, const f32x4 (&pre)[4], bf16_t* hb  , const bf16_t* w2s  , bf16_t* dst  , int lane) {
    const int fr = lane & 15, G = lane >> 4;
#pragma unroll
    for (int nt = 0; nt < 4; ++nt)
#pragma unroll
        for (int r = 0; r < 4; ++r) hb[(G * 4 + r) * 64 + nt * 16 + fr] = f2bf(silu(pre[nt][r]));
    WSYNC();
    bf16x8 hf[2];
#pragma unroll
    for (int ks = 0; ks < 2; ++ks) hf[ks] = *(const bf16x8*)(hb + fr * 64 + ks * 32 + G * 8);
    f32x4 out[4];
#pragma unroll
    for (int nt = 0; nt < 4; ++nt) {
        out[nt] = (f32x4){0.f, 0.f, 0.f, 0.f};
#pragma unroll
        for (int ks = 0; ks < 2; ++ks) {
            const bf16x8 wf = *(const bf16x8*)(w2s + (nt * 16 + fr) * 64 + ks * 32 + G * 8);
            out[nt] = __builtin_amdgcn_mfma_f32_16x16x32_bf16(hf[ks], wf, out[nt], 0, 0, 0);
        }
    }
    WSYNC();
    float rs[4] = {1.f, 1.f, 1.f, 1.f};
    if (kv == 0) {
#pragma unroll
        for (int r = 0; r < 4; ++r) {
            float ss = 0.f;
#pragma unroll
            for (int nt = 0; nt < 4; ++nt) ss += out[nt][r] * out[nt][r];
            ss += __shfl_xor(ss, 1); ss += __shfl_xor(ss, 2); ss += __shfl_xor(ss, 4); ss += __shfl_xor(ss, 8);
            rs[r] = rsqrtf(ss * (1.f / 64.f) + EPS);
        }
    }
#pragma unroll
    for (int nt = 0; nt < 4; ++nt) {
        const float gk = kv == 0 ? p.g_kc[nt * 16 + fr] : 1.f;
#pragma unroll
        for (int r = 0; r < 4; ++r) {
            const int row = G * 4 + r;
            if (row < 15) dst[(size_t)row * 64 + nt * 16 + fr] = f2bf(out[nt][r] * rs[r] * gk);
        }
    }
}

constexpr int CMP_HB = 131072, CMP_W2S = 147456 + 64, CMP_B1S = CMP_W2S + 8192;
__device__ __forceinline__ void compress_setup(const Params& p, char* lds, int kv) {
    const int tid = opaque_tid();
    const float* w1 = kv ? p.w_cv1 : p.w_ck1; const float* pe = kv ? p.pe_cv : p.pe_ck; const float* w2 = kv ? p.w_cv2 : p.w_ck2;
    bf16_t* w2s = (bf16_t*)(lds + CMP_W2S); float* b1s = (float*)(lds + CMP_B1S); float* part = (float*)(lds + CMP_HB);
    __syncthreads();
    for (int i = tid; i < 4096; i += NT) { const int f = i >> 6, d = i & 63; w2s[d * 64 + f] = f2bf(w2[i]); }
    {
      const int fq4 = tid & 15, ks32 = tid >> 4;
      const float* wp = w1 + (size_t)ks32 * 64 * 64 + 4 * fq4; const float* pp = pe + ks32 * 64;
      float4 s = {0.f, 0.f, 0.f, 0.f};
#pragma unroll 16
      for (int k = 0; k < 64; ++k) { const float4 w = *(const float4*)(wp + (size_t)k * 64); const float pv = pp[k]; s.x += pv * w.x; s.y += pv * w.y; s.z += pv * w.z; s.w += pv * w.w; }
      *(float4*)(part + ks32 * 64 + 4 * fq4) = s; }
    __syncthreads();
    if (tid < 64) { float s = 0.f; for (int j = 0; j < 32; ++j) s += part[j * 64 + tid]; b1s[tid] = s; p.b1[kv * 64 + tid] = s; }
    __syncthreads();
}
template <int O>
__device__ __forceinline__ void cmp_rd4(unsigned a, bf16x8 (&b)[4]) {
    asm volatile(
        "ds_read_b128 %0, %4 offset:%5\n\t"
        "ds_read_b128 %1, %4 offset:%6\n\t"
        "ds_read_b128 %2, %4 offset:%7\n\t"
        "ds_read_b128 %3, %4 offset:%8\n\t"
        "s_waitcnt lgkmcnt(0)"
        : "=&v"(b[0]), "=&v"(b[1]), "=&v"(b[2]), "=&v"(b[3])
        : "v"(a), "i"(O), "i"(O + 1024), "i"(O + 2048), "i"(O + 3072) : "memory");
}
template <int O0, int O1>
__device__ __forceinline__ void cmp_lda(const float* a0, const float* a1, f32x4 (&q)[2][2]) {
    asm volatile("global_load_dwordx4 %0, %4, off offset:%6 nt\n\t"
                 "global_load_dwordx4 %1, %5, off offset:%6 nt\n\t"
                 "global_load_dwordx4 %2, %4, off offset:%7 nt\n\t"
                 "global_load_dwordx4 %3, %5, off offset:%7 nt"
                 : "=&v"(q[0][0]), "=&v"(q[0][1]), "=&v"(q[1][0]), "=&v"(q[1][1])
                 : "v"(a0), "v"(a1), "i"(O0), "i"(O1) : "memory");
}
template <int N>
__device__ __forceinline__ void cmp_wait(f32x4 (&q)[2][2]) {
    asm volatile("s_waitcnt vmcnt(%4)" : "+v"(q[0][0]), "+v"(q[0][1]), "+v"(q[1][0]), "+v"(q[1][1]) : "n"(N) : "memory");
}
__device__ __forceinline__ void cmp_stage_wq(const Params& p, LAS char* l3, int kv, int q, int tid) {
    const int n = tid >> 2, Gp = (tid & 3) ^ ((n >> 2) & 3);
    const bf16_t* src = p.w1p + ((size_t)kv * 128 + n) * 1024 + q * 256 + Gp * 8;
    LAS char* dst = l3 + (q & 1) * 65536 + tid * 16;
#pragma unroll
    for (int j = 0; j < 8; ++j)
        __builtin_amdgcn_global_load_lds((const unsigned*)(src + j * 32), (LAS unsigned*)(dst + j * 8192), 16, 0, 0);
}
__device__ __forceinline__ void compress_pass_s(const Params& p, char* lds, int kv, int b, int c0w, int seam_idx, bool first, bool more) {
    LAS char* l3 = (LAS char*)lds;
    const int tid = opaque_tid(), lane = tid & 63, wave = tid >> 6, fr = lane & 15, G = lane >> 4;
    bf16_t* hb = (bf16_t*)(lds + CMP_HB) + wave * 1024;
    const bf16_t* w2s = (const bf16_t*)(lds + CMP_W2S); const float* b1s = (const float*)(lds + CMP_B1S);
    const float* abase[2];
#pragma unroll
    for (int i = 0; i < 2; ++i) {
        const int c = c0w + (fr & 7) + 8 * i;
        const int pg = p.page_table[b * NPAGES + (c >> 3)];
        abase[i] = p.cache_cmp + (((size_t)pg * 128 + (c & 7) * 16) * 4 + kv * 2) * 64 + (fr >> 3) * 16 + G * 4;
    }
    const bool lowl = fr < 8;
    const unsigned bl = (unsigned)(unsigned long long)l3 + fr * 64 + ((G ^ (fr >> 2)) * 16);
    f32x4 acc[2][8];
#pragma unroll
    for (int g = 0; g < 2; ++g)
#pragma unroll
        for (int nt = 0; nt < 8; ++nt) acc[g][nt] = (f32x4){0.f, 0.f, 0.f, 0.f};
    f32x4 aq[6][2][2];
#define CMP_LOADA(u, s) do { const float* _a0 = abase[0] + ((s) >> 1) * 256; const float* _a1 = abase[1] + ((s) >> 1) * 256; \
        if ((s) & 1) cmp_lda<128, 384>(_a0, _a1, aq[u]); else cmp_lda<0, 256>(_a0, _a1, aq[u]); } while (0)
#define CMP_WAITA(u, s) do { const int _y = 31 - (s); if (_y >= 5) cmp_wait<20>(aq[u]); else if (_y == 4) cmp_wait<16>(aq[u]); else if (_y == 3) cmp_wait<12>(aq[u]); \
        else if (_y == 2) cmp_wait<8>(aq[u]); else if (_y == 1) cmp_wait<4>(aq[u]); else cmp_wait<0>(aq[u]); } while (0)
#pragma unroll
    for (int u = 0; u < 6; ++u) CMP_LOADA(u, u);
    if (first) { cmp_stage_wq(p, l3, kv, 0, tid); asm volatile("s_waitcnt vmcnt(0)" ::: "memory"); }
#pragma unroll
    for (int s = 0; s < 32; ++s) {
        const int q = s >> 3, u = s % 6;
        if ((s & 7) == 0) {
            asm volatile("" ::: "memory");
            __builtin_amdgcn_s_barrier();
            asm volatile("" ::: "memory");
            if (q < 3 || more) cmp_stage_wq(p, l3, kv, (q + 1) & 3, tid);
            asm volatile("" ::: "memory");
        }
        CMP_WAITA(u, s);
        bf16x8 af[2];
#pragma unroll
        for (int g = 0; g < 2; ++g) {
            u32x4 t;
            f32x4 x0, x1;
#pragma unroll
            for (int e = 0; e < 4; ++e) {
                const float give = lowl ? aq[u][g][1][e] : aq[u][g][0][e];
                const float recv = __builtin_bit_cast(float, __builtin_amdgcn_mov_dpp(__builtin_bit_cast(int, give), 0x128, 0xF, 0xF, true));
                x0[e] = lowl ? aq[u][g][0][e] : recv; x1[e] = lowl ? recv : aq[u][g][1][e];
            }
            t[0] = cvt_pk_bf16(x0[0], x0[1]); t[1] = cvt_pk_bf16(x0[2], x0[3]);
            t[2] = cvt_pk_bf16(x1[0], x1[1]); t[3] = cvt_pk_bf16(x1[2], x1[3]);
            af[g] = __builtin_bit_cast(bf16x8, t);
        }
        if (s + 6 < 32) CMP_LOADA(u, s + 6);
        const unsigned a = bl + (q & 1) * 65536 + (s & 7) * 8192;
        bf16x8 bf[4];
        cmp_rd4<0>(a, bf);
#pragma unroll
        for (int nt = 0; nt < 4; ++nt) {
            acc[0][nt] = __builtin_amdgcn_mfma_f32_16x16x32_bf16(af[0], bf[nt], acc[0][nt], 0, 0, 0);
            acc[1][nt] = __builtin_amdgcn_mfma_f32_16x16x32_bf16(af[1], bf[nt], acc[1][nt], 0, 0, 0);
        }
        cmp_rd4<4096>(a, bf);
#pragma unroll
        for (int nt = 0; nt < 4; ++nt) {
            acc[0][4 + nt] = __builtin_amdgcn_mfma_f32_16x16x32_bf16(af[0], bf[nt], acc[0][4 + nt], 0, 0, 0);
            acc[1][4 + nt] = __builtin_amdgcn_mfma_f32_16x16x32_bf16(af[1], bf[nt], acc[1][4 + nt], 0, 0, 0);
        }
    }
#undef CMP_LOADA
#undef CMP_WAITA
#pragma unroll
    for (int g = 0; g < 2; ++g) {
        f32x4 pre[4];
#pragma unroll
        for (int nt = 0; nt < 4; ++nt) {
            const float bias = b1s[nt * 16 + fr];
            const float nb0 = __shfl_down(acc[g][4 + nt][0], 16);
            pre[nt][0] = acc[g][nt][0] + acc[g][4 + nt][1] + bias;
            pre[nt][1] = acc[g][nt][1] + acc[g][4 + nt][2] + bias;
            pre[nt][2] = acc[g][nt][2] + acc[g][4 + nt][3] + bias;
            pre[nt][3] = acc[g][nt][3] + nb0 + bias;
            if (G == 3) p.seamA[((size_t)seam_idx * 2 + g) * 64 + nt * 16 + fr] = acc[g][nt][3];
            if (G == 0) p.seamB[((size_t)seam_idx * 2 + g) * 64 + nt * 16 + fr] = acc[g][4 + nt][0];
        }
        bf16_t* dst = (kv ? p.vcs : p.kcs) + ((size_t)(b * 2 + g) * 1024 + c0w) * 64;
        cmp_second_layer(p, kv, pre, hb, w2s, dst, lane);
    }
}

__device__ __forceinline__ void compress_sample(const Params& p, char* lds, int bid, int nblk) {
    const int wave = opaque_tid() >> 6;
    int kv_set = -1;
    for (int pass = bid; pass < 512; pass += nblk) {
        const int P = pass & 7, kv = (pass >> 3) & 1, b = pass >> 4;
        const int c0w = P * 128 + wave * 16;
        const bool first = kv != kv_set;
        if (first) { compress_setup(p, lds, kv); kv_set = kv; }
        const int nxt = pass + nblk;
        const bool more = nxt < 512 && ((nxt >> 3) & 1) == kv;
        compress_pass_s(p, lds, kv, b, c0w, (b * 2 + kv) * 64 + (c0w >> 4), first, more);
    }
}

__device__ __forceinline__ void compress_prompt_ksplit_item(const Params& p, char* lds, int item) {
    const int tid = opaque_tid(), lane = tid & 63, wave = tid >> 6, fr = lane & 15, G = lane >> 4;
    f32x4* part = (f32x4*)lds;
    {
        const int kv = item / 68, tile = item % 68, b = tile / 17, c0 = (tile % 17) * 15;
        const float* abase = p.p_cmp + (((size_t)b * SEQ + (size_t)(c0 + fr) * 16) * 4 + kv * 2) * 64 + G * 4;
        const bf16_t* wbase = p.w1p + ((size_t)kv * 128 + fr) * 1024 + G * 8;
        f32x4 acc[2][8];
#pragma unroll
        for (int g = 0; g < 2; ++g)
#pragma unroll
            for (int nt = 0; nt < 8; ++nt) acc[g][nt] = (f32x4){0.f, 0.f, 0.f, 0.f};
#pragma unroll
        for (int u = 0; u < 4; ++u) {
            const int s = wave * 4 + u;
            const float* a = abase + (s >> 1) * 256 + (s & 1) * 32;
            bf16x8 af[2];
#pragma unroll
            for (int g = 0; g < 2; ++g) {
                const f32x4 x0 = *(const f32x4*)(a + g * 64), x1 = *(const f32x4*)(a + g * 64 + 16);
                u32x4 t; t[0] = cvt_pk_bf16(x0[0], x0[1]); t[1] = cvt_pk_bf16(x0[2], x0[3]); t[2] = cvt_pk_bf16(x1[0], x1[1]); t[3] = cvt_pk_bf16(x1[2], x1[3]);
                af[g] = __builtin_bit_cast(bf16x8, t);
            }
#pragma unroll
            for (int nt = 0; nt < 8; ++nt) {
                const bf16x8 wf = *(const bf16x8*)(wbase + (size_t)nt * 16 * 1024 + s * 32);
                acc[0][nt] = __builtin_amdgcn_mfma_f32_16x16x32_bf16(af[0], wf, acc[0][nt], 0, 0, 0);
                acc[1][nt] = __builtin_amdgcn_mfma_f32_16x16x32_bf16(af[1], wf, acc[1][nt], 0, 0, 0);
            }
        }
        __syncthreads();
#pragma unroll
        for (int g = 0; g < 2; ++g)
#pragma unroll
            for (int nt = 0; nt < 8; ++nt) part[((wave * 2 + g) * 8 + nt) * 64 + lane] = acc[g][nt];
        __syncthreads();
        if (wave < 2) {
            const int g = wave;
            f32x4 tot[8];
#pragma unroll
            for (int nt = 0; nt < 8; ++nt) {
                tot[nt] = part[((0 * 2 + g) * 8 + nt) * 64 + lane];
#pragma unroll
                for (int w = 1; w < 8; ++w) tot[nt] += part[((w * 2 + g) * 8 + nt) * 64 + lane];
            }
            f32x4 pre[4];
#pragma unroll
            for (int nt = 0; nt < 4; ++nt) {
                const float bias = p.b1[kv * 64 + nt * 16 + fr];
                const float nb0 = __shfl_down(tot[4 + nt][0], 16);
                pre[nt][0] = tot[nt][0] + tot[4 + nt][1] + bias; pre[nt][1] = tot[nt][1] + tot[4 + nt][2] + bias;
                pre[nt][2] = tot[nt][2] + tot[4 + nt][3] + bias; pre[nt][3] = tot[nt][3] + nb0 + bias;
            }
            bf16_t* hb = (bf16_t*)(lds + 131072) + wave * 1024;
            bf16_t* dst = (kv ? p.vc : p.kc) + ((size_t)(b * 2 + g) * 256 + c0) * 64;
            cmp_second_layer(p, kv, pre, hb, p.w2t + (size_t)kv * 4096, dst, lane);
        }
        __syncthreads();
    }
}
__device__ __forceinline__ void compress_seams(const Params& p, int bid, int nblk) {
    const int tid = opaque_tid(), lane = tid & 63, wave = tid >> 6;
    if (bid < 0) return;
    for (int it = bid * 8 + wave; it < 32 * 2 * 2 * 63; it += nblk * 8) {
        const int Tt = it % 63, rest = it / 63, g = rest & 1, kv = (rest >> 1) & 1, b = rest >> 2;
        const size_t sa = ((size_t)((b * 2 + kv) * 64 + Tt) * 2 + g) * 64 + lane, sb = ((size_t)((b * 2 + kv) * 64 + Tt + 1) * 2 + g) * 64 + lane;
        const float h = silu(p.seamA[sa] + p.seamB[sb] + p.b1[kv * 64 + lane]);
        const float* w2 = kv ? p.w_cv2 : p.w_ck2;
        float o = 0.f;
        for (int f = 0; f < 64; ++f) o += bf2f(f2bf(__shfl(h, f))) * bf2f(f2bf(w2[f * 64 + lane]));
        if (kv == 0) { const float rs = rsqrtf(wave_sum(o * o) * (1.f / 64.f) + EPS); o = o * rs * p.g_kc[lane]; }
        ((kv ? p.vcs : p.kcs) + ((size_t)(b * 2 + g) * 1024 + 16 * Tt + 15) * 64)[lane] = f2bf(o);
    }
}
template <typename T>
__device__ __forceinline__ void attend64(const float* qs, float* pl, const T* kbase, const T* vbase, size_t stride, bool valid, int lane, float (&m)[4], float (&l)[4], float (&o)[4]) {
    float s[4] = {0.f, 0.f, 0.f, 0.f};
    if (valid) {
        const T* kr = kbase + (size_t)lane * stride;
        float kfa[8][8];
#pragma unroll
        for (int c = 0; c < 8; ++c) load8(kr + c * 8, kfa[c]);
#pragma unroll
        for (int c = 0; c < 8; ++c)
#pragma unroll
            for (int h = 0; h < 4; ++h)
#pragma unroll
                for (int j = 0; j < 8; ++j) s[h] += qs[h * 64 + c * 8 + j] * kfa[c][j];
    }
    const unsigned long long vm = __ballot(valid);
    if (vm == 0ull) return;
#pragma unroll
    for (int h = 0; h < 4; ++h) {
        const float sv = valid ? s[h] * 0.125f : -1e30f;
        const float mn = fmaxf(m[h], wave_max(sv));
        const float alpha = __expf(m[h] - mn);
        const float pv = valid ? __expf(sv - mn) : 0.f;
        l[h] = l[h] * alpha + wave_sum(pv); o[h] *= alpha; m[h] = mn;
        pl[h * 64 + lane] = pv;
    }
    WSYNC();
    const int kfirst = __ffsll((long long)vm) - 1;
#pragma unroll 64
    for (int kk = 0; kk < 64; ++kk) {
        const int kr = ((vm >> kk) & 1ull) ? kk : kfirst;
        const float vv = load1(vbase + (size_t)kr * stride + lane);
#pragma unroll
        for (int h = 0; h < 4; ++h) o[h] += pl[h * 64 + kk] * vv;
    }
    WSYNC();
}

__device__ __forceinline__ void cmp_branch(const float* qs, float* pl, float* ps, const bf16_t* kc, const bf16_t* vc, int n_c, int lane, float (&oc)[4]) {
    float m[4] = {-1e30f, -1e30f, -1e30f, -1e30f}, l[4] = {0.f, 0.f, 0.f, 0.f};
    for (int c0 = 0; c0 < n_c; c0 += 64) {
        const bool valid = c0 + lane < n_c;
        float s[4] = {0.f, 0.f, 0.f, 0.f};
        if (valid) {
            const bf16_t* kr = kc + (size_t)(c0 + lane) * 64;
#pragma unroll 2
            for (int c = 0; c < 8; ++c) {
                float kf[8]; load8(kr + c * 8, kf);
#pragma unroll
                for (int h = 0; h < 4; ++h)
#pragma unroll
                    for (int j = 0; j < 8; ++j) s[h] += qs[h * 64 + c * 8 + j] * kf[j];
            }
        }
#pragma unroll
        for (int h = 0; h < 4; ++h) {
            const float sv = valid ? s[h] * 0.125f : -1e30f;
            const float mn = fmaxf(m[h], wave_max(sv));
            const float pv = valid ? __expf(sv - mn) : 0.f;
            l[h] = l[h] * __expf(m[h] - mn) + wave_sum(pv); m[h] = mn;
        }
    }
    for (int c0 = 0; c0 < n_c; c0 += 64) {
        const bool valid = c0 + lane < n_c;
        float s[4] = {0.f, 0.f, 0.f, 0.f};
        if (valid) {
            const bf16_t* kr = kc + (size_t)(c0 + lane) * 64;
#pragma unroll 2
            for (int c = 0; c < 8; ++c) {
                float kf[8]; load8(kr + c * 8, kf);
#pragma unroll
                for (int h = 0; h < 4; ++h)
#pragma unroll
                    for (int j = 0; j < 8; ++j) s[h] += qs[h * 64 + c * 8 + j] * kf[j];
            }
        }
        float psum = 0.f;
#pragma unroll
        for (int h = 0; h < 4; ++h) {
            const float pv = valid ? __expf(s[h] * 0.125f - m[h]) / l[h] : 0.f;
            pl[h * 64 + lane] = pv; psum += pv;
        }
        if (valid) ps[1 + c0 + lane] = psum;
        WSYNC();
        const int nk = min(64, n_c - c0);
        for (int kk = 0; kk < nk; ++kk) {
            const float vv = bf2f(vc[(size_t)(c0 + kk) * 64 + lane]);
#pragma unroll
            for (int h = 0; h < 4; ++h) oc[h] += pl[h * 64 + kk] * vv;
        }
        WSYNC();
    }
}

__device__ __forceinline__ void topk16(float* sc, int* sel, int n_sel, int lane) {
    for (int round = 0; round < 16; ++round) {
        float bv = -3.0e38f; int bi = 0x7fffffff;
        for (int j = lane; j < n_sel; j += 64) { const float v = sc[j]; if (v > bv) { bv = v; bi = j; } }
#pragma unroll
        for (int o = 1; o < 64; o <<= 1) {
            const float ov = __shfl_xor(bv, o); const int oi = __shfl_xor(bi, o);
            if (ov > bv || (ov == bv && oi < bi)) { bv = ov; bi = oi; }
        }
        if (lane == 0) { sel[round] = bi; sc[bi] = -3.4e38f; }
        WSYNC();
    }
}

constexpr int ATT_WLDS = 256 + 256 + 1040 + 272 + 16;
__device__ __forceinline__ void p5_attention(const Params& p, char* lds, int bid, int nblk) {
    const int tid = threadIdx.x, lane = tid & 63, wave = tid >> 6;
    float* wl = (float*)lds + wave * ATT_WLDS;
    float *qs = wl, *pl = wl + 256, *ps = wl + 512, *sc = wl + 1552; int* sel = (int*)(wl + 1824);
    const int gw = bid * 8 + wave, ngw = nblk * 8;
    for (int it = gw; it < R * 2; it += ngw) {
        const int r = it >> 1, g = it & 1;
        const bool isp = r < TP;
        const int b = isp ? (r >> 12) : (r - TP), t = isp ? (r & 4095) : PAST;
        const int n_sel = isp ? 64 : 257;
        const int n_cmax = isp ? 255 : 1023;
#pragma unroll
        for (int h = 0; h < 4; ++h) qs[h * 64 + lane] = bf2f(p.qn[(size_t)r * 512 + (g * 4 + h) * 64 + lane]);
        for (int i = lane; i < 4 * n_sel + 1; i += 64) ps[i] = 0.f;
        WSYNC();
        int n_c = t >= 31 ? (t - 31) / 16 + 1 : 0; if (n_c > n_cmax) n_c = n_cmax;
        float oc[4] = {0.f, 0.f, 0.f, 0.f};
        {
            const bf16_t* kc = isp ? p.kc + (size_t)(b * 2 + g) * 256 * 64 : p.kcs + (size_t)(b * 2 + g) * 1024 * 64;
            const bf16_t* vc = isp ? p.vc + (size_t)(b * 2 + g) * 256 * 64 : p.vcs + (size_t)(b * 2 + g) * 1024 * 64;
            cmp_branch(qs, pl, ps, kc, vc, n_c, lane, oc);
        }
        const int jt = t >> 6;
        for (int j = lane; j < n_sel; j += 64) {
            float imp = 0.f;
#pragma unroll
            for (int rr = 0; rr < 4; ++rr) imp += ps[4 * j + rr + 1] + ps[4 * j + rr];
            const bool valid = j * 64 <= t, forced = (j == 0) || (j == jt) || (j == jt - 1);
            sc[j] = valid ? (forced ? 1e4f : imp) : -1e30f;
        }
        WSYNC();
        topk16(sc, sel, n_sel, lane);
        float ms[4] = {-1e30f, -1e30f, -1e30f, -1e30f}, lsum[4] = {0.f, 0.f, 0.f, 0.f}, os[4] = {0.f, 0.f, 0.f, 0.f};
        for (int k = 0; k < 16; ++k) {
            const int j = sel[k];
            if (j * 64 > t) continue;
            const bool valid = j * 64 + lane <= t;
            if (isp) {
                const size_t base = ((size_t)(b * 2 + g) * SEQ + (size_t)j * 64) * 64;
                attend64<bf16_t>(qs, pl, p.ks + base, p.vs + base, 64, valid, lane, ms, lsum, os);
            } else if (j == 256) {
                attend64<float>(qs, pl, p.s_slc + (size_t)b * 256 + g * 64, p.s_slc + (size_t)b * 256 + 128 + g * 64, 256, valid, lane, ms, lsum, os);
            } else {
                const int pg = p.page_table[b * NPAGES + (j >> 1)];
                const float* base = p.cache_slc + (((size_t)pg * 128 + (j & 1) * 64) * 4 + g) * 64;
                attend64<float>(qs, pl, base, base + 128, 256, valid, lane, ms, lsum, os);
            }
        }
        float mw[4] = {-1e30f, -1e30f, -1e30f, -1e30f}, lw[4] = {0.f, 0.f, 0.f, 0.f}, ow[4] = {0.f, 0.f, 0.f, 0.f};
        if (isp) {
            const int start = t - 511 > 0 ? t - 511 : 0;
            for (int c0 = start; c0 <= t; c0 += 64) {
                const size_t base = ((size_t)(b * 2 + g) * SEQ + c0) * 64;
                attend64<bf16_t>(qs, pl, p.kw + base, p.vw + base, 64, c0 + lane <= t, lane, mw, lw, ow);
            }
        } else {
            for (int c0 = 0; c0 < 512; c0 += 64) {
                const float* base = p.s_win + ((size_t)b * 512 + c0) * 256 + g * 64;
                attend64<float>(qs, pl, base, base + 128, 256, true, lane, mw, lw, ow);
            }
        }
#pragma unroll
        for (int h = 0; h < 4; ++h) {
            const float* gt = p.gates + (size_t)r * 24 + g * 12 + h * 3;
            const float o = gt[0] * oc[h] + gt[1] * (os[h] / lsum[h]) + gt[2] * (ow[h] / lw[h]);
            const int col = (g * 4 + h) * 64 + lane;
            p.yar[(size_t)r * 1024 + col] = f2bf(o * bf2f(p.ga[(size_t)r * 512 + col]));
        }
    }
}


typedef short s16x4 __attribute__((ext_vector_type(4)));
#define ATT_NEG (-__builtin_inff())
constexpr int ATT_KC = 0, ATT_VC = 32768, ATT_KB = 65536, ATT_VB = 98304, ATT_SC = 131072;
constexpr float ATT_CS = 0.125f * 1.44269504088896f;

__device__ __forceinline__ void att_stage(LAS char* dst, const bf16_t* rows, int tid) {
    const int key = tid >> 3, slot = tid & 7;
    __builtin_amdgcn_global_load_lds((const unsigned*)(rows + key * 64 + ((slot ^ (key & 7)) * 8)), (LAS unsigned*)(dst + tid * 16), 16, 0, 0);
}
__device__ __forceinline__ void att_qk(const LAS char* Kb, const bf16x8 (&qf)[2], const int (&koff)[2], f32x4 (&st)[4]) {
#pragma unroll
    for (int tk = 0; tk < 4; ++tk) {
        st[tk] = (f32x4){0.f, 0.f, 0.f, 0.f};
#pragma unroll
        for (int ks = 0; ks < 2; ++ks) {
            const bf16x8 kf = *(const LAS bf16x8*)(Kb + tk * 2048 + koff[ks]);
            st[tk] = __builtin_amdgcn_mfma_f32_16x16x32_bf16(kf, qf[ks], st[tk], 0, 0, 0);
        }
    }
}
template <int O0, int O1>
__device__ __forceinline__ void att_tr8(unsigned a0, unsigned a1, unsigned a2, unsigned a3, s16x4 (&v)[8]) {
    asm volatile(
        "ds_read_b64_tr_b16 %0, %8 offset:%12\n\t"
        "ds_read_b64_tr_b16 %1, %8 offset:%13\n\t"
        "ds_read_b64_tr_b16 %2, %9 offset:%12\n\t"
        "ds_read_b64_tr_b16 %3, %9 offset:%13\n\t"
        "ds_read_b64_tr_b16 %4, %10 offset:%12\n\t"
        "ds_read_b64_tr_b16 %5, %10 offset:%13\n\t"
        "ds_read_b64_tr_b16 %6, %11 offset:%12\n\t"
        "ds_read_b64_tr_b16 %7, %11 offset:%13\n\t"
        "s_waitcnt lgkmcnt(0)"
        : "=&v"(v[0]), "=&v"(v[1]), "=&v"(v[2]), "=&v"(v[3]), "=&v"(v[4]), "=&v"(v[5]), "=&v"(v[6]), "=&v"(v[7])
        : "v"(a0), "v"(a1), "v"(a2), "v"(a3), "i"(O0), "i"(O1) : "memory");
}
__device__ __forceinline__ void att_pv(const LAS char* Vb, const f32x4 (&pt)[4], const int (&voff)[4], f32x4 (&o)[4]) {
    const unsigned vb = (unsigned)(unsigned long long)Vb;
    const unsigned a0 = vb + voff[0], a1 = vb + voff[1], a2 = vb + voff[2], a3 = vb + voff[3];
#pragma unroll
    for (int kst = 0; kst < 2; ++kst) {
        u32x4 pk;
        pk[0] = cvt_pk_bf16(pt[2 * kst][0], pt[2 * kst][1]); pk[1] = cvt_pk_bf16(pt[2 * kst][2], pt[2 * kst][3]);
        pk[2] = cvt_pk_bf16(pt[2 * kst + 1][0], pt[2 * kst + 1][1]); pk[3] = cvt_pk_bf16(pt[2 * kst + 1][2], pt[2 * kst + 1][3]);
        const bf16x8 pf = __builtin_bit_cast(bf16x8, pk);
        s16x4 v[8];
        if (kst == 0) att_tr8<0, 2048>(a0, a1, a2, a3, v); else att_tr8<4096, 6144>(a0, a1, a2, a3, v);
#pragma unroll
        for (int dt = 0; dt < 4; ++dt) {
            const s16x4 x0 = v[2 * dt], x1 = v[2 * dt + 1];
            bf16x8 vf; vf[0] = x0[0]; vf[1] = x0[1]; vf[2] = x0[2]; vf[3] = x0[3]; vf[4] = x1[0]; vf[5] = x1[1]; vf[6] = x1[2]; vf[7] = x1[3];
            o[dt] = __builtin_amdgcn_mfma_f32_16x16x32_bf16(vf, pf, o[dt], 0, 0, 0);
        }
    }
}
__device__ __forceinline__ void att_exp(f32x4 (&st)[4], float nb, float& l) {
    typedef float f32x2 __attribute__((ext_vector_type(2)));
    const f32x2 cs2 = {ATT_CS, ATT_CS}, nb2 = {nb, nb};
    f32x2 ls2 = {0.f, 0.f};
#pragma unroll
    for (int tk = 0; tk < 4; ++tk)
#pragma unroll
        for (int r = 0; r < 4; r += 2) {
            const f32x2 s2 = {st[tk][r], st[tk][r + 1]};
            const f32x2 e2 = __builtin_elementwise_fma(s2, cs2, nb2);
            f32x2 p2; p2.x = __builtin_amdgcn_exp2f(e2.x); p2.y = __builtin_amdgcn_exp2f(e2.y);
            st[tk][r] = p2.x; st[tk][r + 1] = p2.y; ls2 += p2;
        }
    l += ls2.x + ls2.y;
}
__device__ __forceinline__ void att_prompt_unit(const Params& p, char* lds, int b, int g, int qt) {
    LAS char* l3 = (LAS char*)lds;
    const int tid = opaque_tid(), lane = tid & 63, wave = tid >> 6, fr = lane & 15, G = lane >> 4;
    const int qi = fr >> 2, h = fr & 3;
    const int t0 = qt * 32, tq0 = t0 + 4 * wave, t_row = tq0 + qi, jt = t0 >> 6;
    const size_t r = (size_t)b * SEQ + t_row;
    const size_t kvbase = (size_t)(b * 2 + g) * SEQ * 64;
    const float shc = p.attb[0], shs = p.attb[1], shw = p.attb[2];
    int koff[2], voff[4];
#pragma unroll
    for (int ks = 0; ks < 2; ++ks) koff[ks] = fr * 128 + (((ks * 4 + G) ^ (fr & 7)) * 16);
    { const int kq = 4 * G + (fr >> 2);
#pragma unroll
      for (int dt = 0; dt < 4; ++dt) voff[dt] = kq * 128 + (((dt * 2 + ((fr & 3) >> 1)) ^ (kq & 7)) * 16) + (fr & 1) * 8; }
    asm volatile("s_waitcnt lgkmcnt(0)" ::: "memory"); __builtin_amdgcn_s_barrier(); asm volatile("" ::: "memory");
    {
        const bf16_t* kc = p.kc + (size_t)(b * 2 + g) * 256 * 64; const bf16_t* vc = p.vc + (size_t)(b * 2 + g) * 256 * 64;
#pragma unroll
        for (int c = 0; c < 4; ++c) { att_stage(l3 + ATT_KC + c * 8192, kc + c * 4096, tid); att_stage(l3 + ATT_VC + c * 8192, vc + c * 4096, tid); }
    }
    bf16x8 qf[2];
#pragma unroll
    for (int ks = 0; ks < 2; ++ks) qf[ks] = *(const bf16x8*)(p.qn + r * 512 + (g * 4 + h) * 64 + ks * 32 + G * 8);
    const int c_lo = (t0 - 511 > 0 ? t0 - 511 : 0) >> 6;
    const int n_s = jt + 1, n_tot = n_s + (jt - c_lo + 1);
#define ATT_STAGE_CHUNK(idx) do { const int _i = (idx); const bool _w = _i >= n_s; const int _cj = _w ? c_lo + (_i - n_s) : _i; \
        att_stage(l3 + ATT_KB + (_i & 3) * 8192, (_w ? p.kw : p.ks) + kvbase + (size_t)_cj * 4096, tid); \
        att_stage(l3 + ATT_VB + (_i & 3) * 8192, (_w ? p.vw : p.vs) + kvbase + (size_t)_cj * 4096, tid); } while (0)
    ATT_STAGE_CHUNK(0); ATT_STAGE_CHUNK(1);
    if (n_tot > 2) { ATT_STAGE_CHUNK(2); asm volatile("s_waitcnt vmcnt(6)" ::: "memory"); }
    else asm volatile("s_waitcnt vmcnt(4)" ::: "memory");
    asm volatile("s_waitcnt lgkmcnt(0)" ::: "memory"); __builtin_amdgcn_s_barrier(); asm volatile("" ::: "memory");
    f32x4 oc[4];
#pragma unroll
    for (int dt = 0; dt < 4; ++dt) oc[dt] = (f32x4){0.f, 0.f, 0.f, 0.f};
    unsigned long long mymask;
    unsigned long long unionmask;
    {
        f32x4 sr[4][4];
#pragma unroll
        for (int c = 0; c < 4; ++c) att_qk(l3 + ATT_KC + c * 8192, qf, koff, sr[c]);
        const int ncrow = t_row >= 31 ? (t_row - 31) / 16 + 1 : 0;
        float lsum = 0.f;
#pragma unroll
        for (int c = 0; c < 4; ++c)
#pragma unroll
            for (int tk = 0; tk < 4; ++tk)
#pragma unroll
                for (int rg = 0; rg < 4; ++rg) {
                    const int i = c * 64 + tk * 16 + G * 4 + rg;
                    const float pv = i < ncrow ? __builtin_amdgcn_exp2f(sr[c][tk][rg] * ATT_CS - shc) : 0.f;
                    sr[c][tk][rg] = pv; lsum += pv;
                }
        lsum += __shfl_xor(lsum, 16); lsum += __shfl_xor(lsum, 32);
        const float inv = lsum > 0.f ? 1.f / lsum : 0.f;
        float* sc = (float*)(lds + ATT_SC) + wave * 512;
        float* bs = sc + 256;
        float av[4][4];
#pragma unroll
        for (int c = 0; c < 4; ++c)
#pragma unroll
            for (int tk = 0; tk < 4; ++tk) {
#pragma unroll
                for (int rg = 0; rg < 4; ++rg) sr[c][tk][rg] *= inv;
                float a = 2.f * (sr[c][tk][0] + sr[c][tk][1] + sr[c][tk][2]) + sr[c][tk][3], b3 = sr[c][tk][3];
                a += __builtin_bit_cast(float, __builtin_amdgcn_mov_dpp(__builtin_bit_cast(int, a), 0xB1, 0xF, 0xF, true));
                a += __builtin_bit_cast(float, __builtin_amdgcn_mov_dpp(__builtin_bit_cast(int, a), 0x4E, 0xF, 0xF, true));
                b3 += __builtin_bit_cast(float, __builtin_amdgcn_mov_dpp(__builtin_bit_cast(int, b3), 0xB1, 0xF, 0xF, true));
                b3 += __builtin_bit_cast(float, __builtin_amdgcn_mov_dpp(__builtin_bit_cast(int, b3), 0x4E, 0xF, 0xF, true));
                av[c][tk] = a;
                if (h == 0) bs[qi * 64 + (c * 4 + tk) * 4 + G] = b3;
            }
        WSYNC();
#pragma unroll
        for (int c = 0; c < 4; ++c)
#pragma unroll
            for (int tk = 0; tk < 4; ++tk) {
                const int j = (c * 4 + tk) * 4 + G;
                const float pr = j > 0 ? bs[qi * 64 + j - 1] : 0.f;
                const bool valid = j * 64 <= t_row, forced = (j == 0) || (j == jt) || (j == jt - 1);
                if (h == 0) sc[qi * 64 + j] = valid ? (forced ? 1e4f : av[c][tk] + pr) : -1e30f;
            }
#pragma unroll
        for (int c = 0; c < 4; ++c) att_pv(l3 + ATT_VC + c * 8192, sr[c], voff, oc);
        WSYNC();
        unsigned long long mq[4];
        {
            float sj[4]; int rank[4] = {0, 0, 0, 0};
#pragma unroll
            for (int q = 0; q < 4; ++q) sj[q] = sc[q * 64 + lane];
#pragma unroll 2
            for (int jp = 0; jp <= jt; ++jp) {
                const bool lower = jp < lane;
#pragma unroll
                for (int q = 0; q < 4; ++q) {
                    const float v = __builtin_bit_cast(float, __builtin_amdgcn_readlane(__builtin_bit_cast(int, sj[q]), jp));
                    rank[q] += (v > sj[q] || (v == sj[q] && lower)) ? 1 : 0;
                }
            }
#pragma unroll
            for (int q = 0; q < 4; ++q) mq[q] = __ballot(rank[q] < 16 && lane * 64 <= tq0 + q);
        }
        unionmask = mq[0] | mq[1] | mq[2] | mq[3];
        mymask = qi == 0 ? mq[0] : qi == 1 ? mq[1] : qi == 2 ? mq[2] : mq[3];
        WSYNC();
    }
    f32x4 os[4], ow[4];
#pragma unroll
    for (int dt = 0; dt < 4; ++dt) { os[dt] = (f32x4){0.f, 0.f, 0.f, 0.f}; ow[dt] = (f32x4){0.f, 0.f, 0.f, 0.f}; }
    float ls = 0.f, lw = 0.f;
    for (int it = 0; it < n_tot; ++it) {
        if (it + 2 < n_tot) asm volatile("s_waitcnt vmcnt(4)" ::: "memory");
        else if (it + 1 < n_tot) asm volatile("s_waitcnt vmcnt(2)" ::: "memory");
        else asm volatile("s_waitcnt vmcnt(0)" ::: "memory");
        asm volatile("s_waitcnt lgkmcnt(0)" ::: "memory"); __builtin_amdgcn_s_barrier(); asm volatile("" ::: "memory");
        if (it + 3 < n_tot) ATT_STAGE_CHUNK(it + 3);
        const LAS char* Kb = l3 + ATT_KB + (it & 3) * 8192; const LAS char* Vb = l3 + ATT_VB + (it & 3) * 8192;
        if (it < n_s) {
            const int j = it;
            if ((unionmask >> j) & 1ull) {
                f32x4 st[4];
                att_qk(Kb, qf, koff, st);
                const float nb = ((mymask >> j) & 1ull) ? -shs : ATT_NEG;
                if (j == jt) {
                    asm volatile("" ::: "memory");
#pragma unroll
                    for (int tk = 0; tk < 4; ++tk)
#pragma unroll
                        for (int rg = 0; rg < 4; ++rg) { const int pos = j * 64 + tk * 16 + G * 4 + rg; if (pos > t_row) st[tk][rg] = ATT_NEG; }
                }
                att_exp(st, nb, ls);
                att_pv(Vb, st, voff, os);
            }
        } else {
            const int cj = c_lo + (it - n_s);
            f32x4 st[4];
            att_qk(Kb, qf, koff, st);
            if (cj * 64 + 63 > tq0 || cj * 64 <= tq0 + 3 - 512) {
                asm volatile("" ::: "memory");
#pragma unroll
                for (int tk = 0; tk < 4; ++tk)
#pragma unroll
                    for (int rg = 0; rg < 4; ++rg) { const int pos = cj * 64 + tk * 16 + G * 4 + rg; if (!(pos <= t_row && pos > t_row - 512)) st[tk][rg] = ATT_NEG; }
            }
            att_exp(st, -shw, lw);
            att_pv(Vb, st, voff, ow);
        }
    }
#undef ATT_STAGE_CHUNK
    ls += __shfl_xor(ls, 16); ls += __shfl_xor(ls, 32);
    lw += __shfl_xor(lw, 16); lw += __shfl_xor(lw, 32);
    const float* gt = p.gates + r * 24 + g * 12 + h * 3;
    const float g0 = gt[0], g1 = gt[1] / ls, g2 = gt[2] / lw;
    const int colb = (g * 4 + h) * 64;
    uint2 gavv[4];
#pragma unroll
    for (int dt = 0; dt < 4; ++dt) gavv[dt] = *(const uint2*)(p.ga + r * 512 + colb + dt * 16 + G * 4);
#pragma unroll
    for (int dt = 0; dt < 4; ++dt) {
        const int d = dt * 16 + G * 4;
        const uint2 gav = gavv[dt];
        float v[4];
#pragma unroll
        for (int rg = 0; rg < 4; ++rg) v[rg] = g0 * oc[dt][rg] + g1 * os[dt][rg] + g2 * ow[dt][rg];
        v[0] *= __uint_as_float(gav.x << 16); v[1] *= __uint_as_float(gav.x & 0xffff0000u);
        v[2] *= __uint_as_float(gav.y << 16); v[3] *= __uint_as_float(gav.y & 0xffff0000u);
        uint2 o; o.x = cvt_pk_bf16(v[0], v[1]); o.y = cvt_pk_bf16(v[2], v[3]);
        *(uint2*)(p.yar + r * 1024 + colb + d) = o;
    }
}

__device__ __forceinline__ void dot4(const float* qs, const bf16_t* kr, float (&s)[4]) {
    uint4 raw[8];
#pragma unroll
    for (int c = 0; c < 8; ++c) raw[c] = *(const uint4*)(kr + c * 8);
#pragma unroll
    for (int c = 0; c < 8; ++c) {
        float kf[8];
        kf[0] = __uint_as_float(raw[c].x << 16); kf[1] = __uint_as_float(raw[c].x & 0xffff0000u); kf[2] = __uint_as_float(raw[c].y << 16); kf[3] = __uint_as_float(raw[c].y & 0xffff0000u);
        kf[4] = __uint_as_float(raw[c].z << 16); kf[5] = __uint_as_float(raw[c].z & 0xffff0000u); kf[6] = __uint_as_float(raw[c].w << 16); kf[7] = __uint_as_float(raw[c].w & 0xffff0000u);
#pragma unroll
        for (int hh = 0; hh < 4; ++hh)
#pragma unroll
            for (int j = 0; j < 8; ++j) s[hh] += qs[hh * 64 + c * 8 + j] * kf[j];
    }
}
__device__ __forceinline__ void att_sample_unit(const Params& p, char* lds, int b, int g) {
    const int tid = opaque_tid(), lane = tid & 63, wave = tid >> 6;
    float* L = (float*)lds;
    float* qs = L;
    float* ps = L + 256;
    float* sc = L + 1296;
    int* sel = (int*)(L + 1568);
    float* red = L + 1600;
    float* part = L + 1664;
    float* pl = L + 1664 + 8 * 3 * 4 * 66 + wave * 256;
    const size_t r = TP + b;
    __syncthreads();
    if (tid < 256) qs[tid] = bf2f(p.qn[r * 512 + g * 256 + tid]);
    for (int i = tid; i < 1040; i += NT) ps[i] = 0.f;
    __syncthreads();
    const bf16_t* kc = p.kcs + (size_t)(b * 2 + g) * 1024 * 64; const bf16_t* vc = p.vcs + (size_t)(b * 2 + g) * 1024 * 64;
    const int n_c = 1023;
    float m1[4] = {-1e30f, -1e30f, -1e30f, -1e30f}, l1[4] = {0.f, 0.f, 0.f, 0.f};
    for (int cc = 0; cc < 2; ++cc) {
        const int i = wave * 128 + cc * 64 + lane; const bool valid = i < n_c;
        float s[4] = {0.f, 0.f, 0.f, 0.f};
        if (valid) dot4(qs, kc + (size_t)i * 64, s);
#pragma unroll
        for (int hh = 0; hh < 4; ++hh) {
            const float sv = valid ? s[hh] * 0.125f : -1e30f;
            const float mn = fmaxf(m1[hh], wave_max(sv));
            l1[hh] = l1[hh] * __expf(m1[hh] - mn) + wave_sum(valid ? __expf(sv - mn) : 0.f); m1[hh] = mn;
        }
    }
    if (lane == 0) {
#pragma unroll
        for (int hh = 0; hh < 4; ++hh) { red[wave * 8 + hh] = m1[hh]; red[wave * 8 + 4 + hh] = l1[hh]; }
    }
    __syncthreads();
    float M[4], Ls[4];
#pragma unroll
    for (int hh = 0; hh < 4; ++hh) {
        float mm = -1e30f;
        for (int w = 0; w < 8; ++w) mm = fmaxf(mm, red[w * 8 + hh]);
        float ll = 0.f;
        for (int w = 0; w < 8; ++w) ll += red[w * 8 + 4 + hh] * __expf(red[w * 8 + hh] - mm);
        M[hh] = mm; Ls[hh] = ll;
    }
    float oc[4] = {0.f, 0.f, 0.f, 0.f};
    for (int cc = 0; cc < 2; ++cc) {
        const int i0 = wave * 128 + cc * 64, i = i0 + lane; const bool valid = i < n_c;
        float s[4] = {0.f, 0.f, 0.f, 0.f};
        if (valid) dot4(qs, kc + (size_t)i * 64, s);
        float psum = 0.f;
#pragma unroll
        for (int hh = 0; hh < 4; ++hh) { const float pv = valid ? __expf(s[hh] * 0.125f - M[hh]) / Ls[hh] : 0.f; pl[hh * 64 + lane] = pv; psum += pv; }
        if (valid) ps[1 + i] = psum;
        WSYNC();
        const int nk = min(64, n_c - i0);
#pragma unroll 64
        for (int kk = 0; kk < 64; ++kk) {
            const float vv = bf2f(vc[(size_t)(i0 + (kk < nk ? kk : 0)) * 64 + lane]);
#pragma unroll
            for (int hh = 0; hh < 4; ++hh) oc[hh] += pl[hh * 64 + kk] * vv;
        }
        WSYNC();
    }
    __syncthreads();
    if (wave == 0) {
        const int t = PAST, jt = t >> 6;
        for (int j = lane; j < 257; j += 64) {
            float imp = 0.f;
#pragma unroll
            for (int rr = 0; rr < 4; ++rr) imp += ps[4 * j + rr + 1] + ps[4 * j + rr];
            const bool valid = j * 64 <= t, forced = (j == 0) || (j == jt) || (j == jt - 1);
            sc[j] = valid ? (forced ? 1e4f : imp) : -1e30f;
        }
        WSYNC();
        topk16(sc, sel, 257, lane);
    }
    __syncthreads();
    float msv[4] = {-1e30f, -1e30f, -1e30f, -1e30f}, lsv[4] = {0.f, 0.f, 0.f, 0.f}, osv[4] = {0.f, 0.f, 0.f, 0.f};
    for (int k = 2 * wave; k < 2 * wave + 2; ++k) {
        const int j = sel[k];
        if (j * 64 > PAST) continue;
        const bool valid = j * 64 + lane <= PAST;
        if (j == 256) attend64<float>(qs, pl, p.s_slc + (size_t)b * 256 + g * 64, p.s_slc + (size_t)b * 256 + 128 + g * 64, 256, valid, lane, msv, lsv, osv);
        else {
            const int pg = p.page_table[b * NPAGES + (j >> 1)];
            const float* base = p.cache_slc + (((size_t)pg * 128 + (j & 1) * 64) * 4 + g) * 64;
            attend64<float>(qs, pl, base, base + 128, 256, valid, lane, msv, lsv, osv);
        }
    }
    float mwv[4] = {-1e30f, -1e30f, -1e30f, -1e30f}, lwv[4] = {0.f, 0.f, 0.f, 0.f}, owv[4] = {0.f, 0.f, 0.f, 0.f};
    {
        const float* base = p.s_win + ((size_t)b * 512 + wave * 64) * 256 + g * 64;
        attend64<float>(qs, pl, base, base + 128, 256, true, lane, mwv, lwv, owv);
    }
#pragma unroll
    for (int hh = 0; hh < 4; ++hh) {
        float* pc = part + ((wave * 3 + 0) * 4 + hh) * 66; pc[lane] = oc[hh];
        float* pS = part + ((wave * 3 + 1) * 4 + hh) * 66; pS[lane] = osv[hh]; if (lane == 0) { pS[64] = msv[hh]; pS[65] = lsv[hh]; }
        float* pw = part + ((wave * 3 + 2) * 4 + hh) * 66; pw[lane] = owv[hh]; if (lane == 0) { pw[64] = mwv[hh]; pw[65] = lwv[hh]; }
    }
    __syncthreads();
    if (tid < 256) {
        const int hh = tid >> 6, d = tid & 63;
        float c = 0.f;
        for (int w = 0; w < 8; ++w) c += part[((w * 3 + 0) * 4 + hh) * 66 + d];
        float res[2];
#pragma unroll
        for (int br = 1; br < 3; ++br) {
            float mm = -1e30f;
            for (int w = 0; w < 8; ++w) mm = fmaxf(mm, part[((w * 3 + br) * 4 + hh) * 66 + 64]);
            float num = 0.f, den = 0.f;
            for (int w = 0; w < 8; ++w) { const float* q = part + ((w * 3 + br) * 4 + hh) * 66; const float e = __expf(q[64] - mm); num += q[d] * e; den += q[65] * e; }
            res[br - 1] = num / den;
        }
        const float* gt = p.gates + r * 24 + g * 12 + hh * 3;
        const int col = (g * 4 + hh) * 64 + d;
        p.yar[r * 1024 + col] = f2bf((gt[0] * c + gt[1] * res[0] + gt[2] * res[1]) * bf2f(p.ga[r * 512 + col]));
    }
    __syncthreads();
}

__device__ __forceinline__ void ret_out_item(const Params& p, char* lds, int it);
__device__ __forceinline__ void att_phase(const Params& p, char* lds, int bid, int nblk) {
    const int x = bid & 7;
    unsigned* ctr = p.bar + 3584 + 64 * x;
    volatile int* slot = (volatile int*)(lds + 147456 + 16);
    const int tid = opaque_tid();
    for (;;) {
        __syncthreads();
        if (tid == 0) *slot = (int)__hip_atomic_fetch_add(ctr, 1u, __ATOMIC_RELAXED, __HIP_MEMORY_SCOPE_AGENT);
        __syncthreads();
        const int w = *slot;
        if (w >= 136) break;
        if (w < 8) att_sample_unit(p, lds, 4 * x + (w >> 1), w & 1);
        else att_prompt_unit(p, lds, x >> 1, x & 1, 127 - (w - 8));
    }
}
__device__ __forceinline__ void ret_out_queue(const Params& p, char* lds, int bid, int nblk) {
    const int x = bid & 7;
    unsigned* ctr = p.bar + 3584 + 64 * x + 16;
    volatile int* slot = (volatile int*)(lds + 147456 + 16);
    const int tid = opaque_tid();
    wg_wait(p.bar + 3456, (unsigned)nblk, p.bar + XB_TMO);
    for (;;) {
        __syncthreads();
        if (tid == 0) *slot = (int)__hip_atomic_fetch_add(ctr, 1u, __ATOMIC_RELAXED, __HIP_MEMORY_SCOPE_AGENT);
        __syncthreads();
        const int w = *slot;
        if (w >= 80) break;
        ret_out_item(p, lds, x + 8 * w);
    }
}

__device__ __forceinline__ float ret_gamma(int h) { return 1.f - exp2f(-5.f - (float)h); }

__device__ __forceinline__ void p6a_local(const Params& p, int bid, int nblk) {
    const int tid = opaque_tid();
    const int e = tid & 127, dg = tid >> 7;
    for (int it = bid; it < 4 * 4 * 32; it += nblk) {
        const int n = it & 31, h = (it >> 5) & 3, b = it >> 7;
        const float lg = __logf(ret_gamma(h));
        float acc[16];
#pragma unroll
        for (int i = 0; i < 16; ++i) acc[i] = 0.f;
        for (int j = 0; j < 128; ++j) {
            const size_t r = (size_t)b * SEQ + n * 128 + j;
            const float z = __expf(lg * (float)(127 - j));
            const float v = bf2f(p.rv[r * 512 + h * 128 + e]) * z;
            const bf16_t* kr = p.rk + r * 256 + h * 64 + dg * 16;
#pragma unroll
            for (int i = 0; i < 16; ++i) acc[i] += bf2f(kr[i]) * v;
        }
        float* out = p.sloc + ((size_t)it * 64 + dg * 16) * 128 + e;
#pragma unroll
        for (int i = 0; i < 16; ++i) out[i * 128] = acc[i];
    }
}
__device__ __forceinline__ void p6b_scan(const Params& p, int bid, int nblk) {
    const size_t gt = (size_t)bid * NT + threadIdx.x, ngt = (size_t)nblk * NT;
    for (size_t i = gt; i < (size_t)16 * 8192; i += ngt) {
        const int bh = (int)(i >> 13), el = (int)(i & 8191), h = bh & 3;
        const float gc = __expf(__logf(ret_gamma(h)) * 128.f);
        float S = 0.f, lv[32];
#pragma unroll
        for (int n = 0; n < 32; ++n) lv[n] = p.sloc[((size_t)bh * 32 + n) * 8192 + el];
#pragma unroll
        for (int n = 0; n < 32; ++n) {
            p.spre[((size_t)bh * 32 + n) * 8192 + el] = S;
            S = S * gc + lv[n];
        }
        p.p_ret[(size_t)bh * 8192 + el] = S;
    }
    {
        constexpr int NS = 128 * 8192;
        const int gti = (int)gt, ngti = (int)ngt;
#define SR_LD(j) const int sx##j = ib + j * ngti, sc##j = sx##j < NS ? sx##j : NS - 1, bh##j = sc##j >> 13, el##j = sc##j & 8191; const float st##j = p.state_ret[sc##j]; \
        const bf16_t kk##j = p.rk[(size_t)(TP + (bh##j >> 2)) * 256 + (bh##j & 3) * 64 + (el##j >> 7)], vv##j = p.rv[(size_t)(TP + (bh##j >> 2)) * 512 + (bh##j & 3) * 128 + (el##j & 127)];
#define SR_ST(j) if (sx##j < NS) p.s_ret[sx##j] = st##j * ret_gamma(bh##j & 3) + bf2f(kk##j) * bf2f(vv##j);
        for (int ib = gti; ib < NS; ib += 8 * ngti) {
            SR_LD(0) SR_LD(1) SR_LD(2) SR_LD(3) SR_LD(4) SR_LD(5) SR_LD(6) SR_LD(7)
            SR_ST(0) SR_ST(1) SR_ST(2) SR_ST(3) SR_ST(4) SR_ST(5) SR_ST(6) SR_ST(7)
        }
#undef SR_LD
#undef SR_ST
    }
}
__device__ __forceinline__ void p6c_out(const Params& p, char* lds, int bid, int nblk) {
    float* Am = (float*)lds;
    const int tid = opaque_tid();
    for (int it = bid; it < 4 * 4 * 32 + 128; it += nblk) {
        if (it < 512) {
            const int n = it & 31, h = (it >> 5) & 3, b = it >> 7;
            const float lg = __logf(ret_gamma(h));
            const size_t r0 = (size_t)b * SEQ + n * 128;
            for (int idx = tid; idx < 128 * 128; idx += NT) {
                const int i = idx >> 7, j = idx & 127;
                float a = 0.f;
                if (j <= i) {
                    const bf16_t* qr = p.rq + (r0 + i) * 256 + h * 64; const bf16_t* kr = p.rk + (r0 + j) * 256 + h * 64;
#pragma unroll
                    for (int c = 0; c < 8; ++c) { float qf[8], kf[8]; load8(qr + c * 8, qf); load8(kr + c * 8, kf);
#pragma unroll
                        for (int u = 0; u < 8; ++u) a += qf[u] * kf[u]; }
                    a *= __expf(lg * (float)(i - j));
                }
                Am[i * 129 + j] = a;
            }
            __syncthreads();
            const int e = tid & 127, ig = tid >> 7;
            const float* S = p.spre + (size_t)it * 8192;
            for (int i = ig * 32; i < ig * 32 + 32; ++i) {
                float o = 0.f;
                for (int j = 0; j <= i; ++j) o += Am[i * 129 + j] * bf2f(p.rv[(r0 + j) * 512 + h * 128 + e]);
                float qs = 0.f;
                const bf16_t* qr = p.rq + (r0 + i) * 256 + h * 64;
                for (int d = 0; d < 64; ++d) qs += bf2f(qr[d]) * S[d * 128 + e];
                o += qs * __expf(lg * (float)(i + 1));
                p.oret[(r0 + i) * 512 + h * 128 + e] = o;
            }
            __syncthreads();
        } else {
            const int bh = it - 512, h = bh & 3, b = bh >> 2;
            const size_t r = TP + b;
            if (tid < 128) {
                const int e = tid;
                const bf16_t* qr = p.rq + r * 256 + h * 64; const bf16_t* kr = p.rk + r * 256 + h * 64;
                const float* S0 = p.state_ret + (size_t)bh * 8192;
                float qs = 0.f, qk = 0.f;
                for (int d = 0; d < 64; ++d) { const float q = bf2f(qr[d]); qs += q * S0[d * 128 + e]; qk += q * bf2f(kr[d]); }
                p.oret[r * 512 + h * 128 + e] = qs * ret_gamma(h) + qk * bf2f(p.rv[r * 512 + h * 128 + e]);
            }
        }
    }
}
__device__ __forceinline__ void p6d_norm(const Params& p, int bid, int nblk) {
    const int tid = opaque_tid(), lane = tid & 63, wave = tid >> 6;
    for (int it = bid * 8 + wave; it < R * 4; it += nblk * 8) {
        const int r = it >> 2, h = it & 3;
        const float* o = p.oret + (size_t)r * 512 + h * 128;
        const float v0 = o[lane], v1 = o[lane + 64];
        const float rs = rsqrtf(wave_sum(v0 * v0 + v1 * v1) * (1.f / 128.f) + EPS);
        p.yar[(size_t)r * 1024 + 512 + h * 128 + lane] = f2bf(v0 * rs * p.g_ret[lane] * bf2f(p.gr[(size_t)r * 512 + h * 128 + lane]));
        p.yar[(size_t)r * 1024 + 512 + h * 128 + lane + 64] = f2bf(v1 * rs * p.g_ret[lane + 64] * bf2f(p.gr[(size_t)r * 512 + h * 128 + lane + 64]));
    }
}


__device__ __forceinline__ void ret_stage(LAS char* dst, const bf16_t* src, size_t row_stride, int lg_slots, int npieces, int tid) {
    for (int pc = tid; pc < npieces; pc += NT) {
        const int row = pc >> lg_slots, slot = pc & ((1 << lg_slots) - 1);
        __builtin_amdgcn_global_load_lds((const unsigned*)(src + (size_t)row * row_stride + ((slot ^ (row & 7)) * 8)), (LAS unsigned*)(dst + pc * 16), 16, 0, 0);
    }
}
__device__ __forceinline__ s16x4 ret_tr(const LAS char* img, int RB, int r0, int c0, int fr) {
    const int row = r0 + (fr >> 2), chunk = (c0 >> 3) + ((fr & 3) >> 1);
    return __builtin_amdgcn_ds_read_tr16_b64_v4i16((LAS s16x4*)(img + row * RB + ((chunk ^ (row & 7)) * 16) + (fr & 1) * 8));
}
__device__ __forceinline__ bf16x8 cat8(s16x4 a, s16x4 b) { bf16x8 v; v[0] = a[0]; v[1] = a[1]; v[2] = a[2]; v[3] = a[3]; v[4] = b[0]; v[5] = b[1]; v[6] = b[2]; v[7] = b[3]; return v; }

__device__ __forceinline__ void ret_local_item(const Params& p, char* lds, int it) {
    LAS char* l3 = (LAS char*)lds;
    const int tid = opaque_tid(), lane = tid & 63, wave = tid >> 6, fr = lane & 15, G = lane >> 4;
    {
        const int n = it & 31, h = (it >> 5) & 3, b = it >> 7;
        const size_t r0 = (size_t)b * SEQ + n * 128;
        __syncthreads();
        ret_stage(l3, p.rk + r0 * 256 + h * 64, 256, 3, 1024, tid);
        ret_stage(l3 + 16384, p.rv + r0 * 512 + h * 128, 512, 4, 2048, tid);
        asm volatile("s_waitcnt vmcnt(0)" ::: "memory");
        __syncthreads();
        f32x4 acc[4];
#pragma unroll
        for (int dt = 0; dt < 4; ++dt) acc[dt] = (f32x4){0.f, 0.f, 0.f, 0.f};
#pragma unroll
        for (int js = 0; js < 4; ++js) {
            const int j0 = js * 32 + 4 * G;
            const bf16x8 bfr = cat8(ret_tr(l3 + 16384, 256, j0, wave * 16, fr), ret_tr(l3 + 16384, 256, j0 + 16, wave * 16, fr));
#pragma unroll
            for (int dt = 0; dt < 4; ++dt) {
                const bf16x8 afr = cat8(ret_tr(l3, 128, j0, dt * 16, fr), ret_tr(l3, 128, j0 + 16, dt * 16, fr));
                acc[dt] = __builtin_amdgcn_mfma_f32_16x16x32_bf16(afr, bfr, acc[dt], 0, 0, 0);
            }
        }
        const float sc = exp2f(__log2f(ret_gamma(h)) * 127.f);
        float* out = p.sloc + (size_t)it * 8192 + wave * 16 + fr;
#pragma unroll
        for (int dt = 0; dt < 4; ++dt)
#pragma unroll
            for (int rg = 0; rg < 4; ++rg) out[(dt * 16 + 4 * G + rg) * 128] = acc[dt][rg] * sc;
    }
}

__device__ __forceinline__ void ret_out_item(const Params& p, char* lds, int it) {
    LAS char* l3 = (LAS char*)lds;
    const int tid = opaque_tid(), lane = tid & 63, wave = tid >> 6, fr = lane & 15, G = lane >> 4;
    {
        __syncthreads();
        if (it < 512) {
            const int n = it & 31, h = (it >> 5) & 3, b = it >> 7;
            const size_t r0 = (size_t)b * SEQ + n * 128;
            const float gam = ret_gamma(h);
            ret_stage(l3, p.rk + r0 * 256 + h * 64, 256, 3, 1024, tid);
            ret_stage(l3 + 16384, p.rv + r0 * 512 + h * 128, 512, 4, 2048, tid);
            {
                const float* S = p.spre + (size_t)it * 8192;
                for (int pc = tid; pc < 1024; pc += NT) {
                    const int row = pc >> 4, slot = pc & 15;
                    const float4 a = *(const float4*)(S + row * 128 + slot * 8), c = *(const float4*)(S + row * 128 + slot * 8 + 4);
                    u32x4 v; v[0] = cvt_pk_bf16(a.x * gam, a.y * gam); v[1] = cvt_pk_bf16(a.z * gam, a.w * gam); v[2] = cvt_pk_bf16(c.x * gam, c.y * gam); v[3] = cvt_pk_bf16(c.z * gam, c.w * gam);
                    *(LAS u32x4*)(l3 + 49152 + row * 256 + ((slot ^ (row & 7)) * 16)) = v;
                }
            }
            const size_t ri = r0 + wave * 16 + fr;
            bf16x8 qf[2], qp[2];
#pragma unroll
            for (int ks = 0; ks < 2; ++ks) {
                const bf16_t* qrow = p.rq + ri * 256 + h * 64 + ks * 32;
                qf[ks] = *(const bf16x8*)(qrow + G * 8);
                const s16x4 lo = *(const s16x4*)(qrow + 4 * G), hi = *(const s16x4*)(qrow + 16 + 4 * G);
                qp[ks] = cat8(lo, hi);
            }
            asm volatile("s_waitcnt vmcnt(0)" ::: "memory");
            __syncthreads();
            f32x4 st[8];
#pragma unroll
            for (int jt = 0; jt < 8; ++jt) {
                st[jt] = (f32x4){0.f, 0.f, 0.f, 0.f};
                if (jt <= wave) {
#pragma unroll
                    for (int ks = 0; ks < 2; ++ks) {
                        const int row = jt * 16 + fr;
                        const bf16x8 kf = *(const LAS bf16x8*)(l3 + row * 128 + (((ks * 4 + G) ^ (row & 7)) * 16));
                        st[jt] = __builtin_amdgcn_mfma_f32_16x16x32_bf16(kf, qf[ks], st[jt], 0, 0, 0);
                    }
                    if (jt == wave) {
#pragma unroll
                        for (int rg = 0; rg < 4; ++rg) if (4 * G + rg > fr) st[jt][rg] = 0.f;
                    }
                }
            }
            f32x4 o[8];
#pragma unroll
            for (int et = 0; et < 8; ++et) o[et] = (f32x4){0.f, 0.f, 0.f, 0.f};
#pragma unroll
            for (int js = 0; js < 4; ++js) {
                if (2 * js <= wave) {
                    u32x4 pk;
                    pk[0] = cvt_pk_bf16(st[2 * js][0], st[2 * js][1]); pk[1] = cvt_pk_bf16(st[2 * js][2], st[2 * js][3]);
                    pk[2] = cvt_pk_bf16(st[2 * js + 1][0], st[2 * js + 1][1]); pk[3] = cvt_pk_bf16(st[2 * js + 1][2], st[2 * js + 1][3]);
                    const bf16x8 pf = __builtin_bit_cast(bf16x8, pk);
                    const int j0 = js * 32 + 4 * G;
#pragma unroll
                    for (int et = 0; et < 8; ++et) {
                        const bf16x8 vf = cat8(ret_tr(l3 + 16384, 256, j0, et * 16, fr), ret_tr(l3 + 16384, 256, j0 + 16, et * 16, fr));
                        o[et] = __builtin_amdgcn_mfma_f32_16x16x32_bf16(vf, pf, o[et], 0, 0, 0);
                    }
                }
            }
#pragma unroll
            for (int ks = 0; ks < 2; ++ks) {
                const int d0 = ks * 32 + 4 * G;
#pragma unroll
                for (int et = 0; et < 8; ++et) {
                    const bf16x8 sf = cat8(ret_tr(l3 + 49152, 256, d0, et * 16, fr), ret_tr(l3 + 49152, 256, d0 + 16, et * 16, fr));
                    o[et] = __builtin_amdgcn_mfma_f32_16x16x32_bf16(sf, qp[ks], o[et], 0, 0, 0);
                }
            }
            float ss = 0.f;
#pragma unroll
            for (int et = 0; et < 8; ++et)
#pragma unroll
                for (int rg = 0; rg < 4; ++rg) ss += o[et][rg] * o[et][rg];
            ss += __shfl_xor(ss, 16); ss += __shfl_xor(ss, 32);
            const float rs = rsqrtf(ss * (1.f / 128.f) + EPS);
            float4 grv[8]; uint2 gvv[8];
#pragma unroll
            for (int et = 0; et < 8; ++et) { const int e = et * 16 + 4 * G; grv[et] = *(const float4*)(p.g_ret + e); gvv[et] = *(const uint2*)(p.gr + ri * 512 + h * 128 + e); }
#pragma unroll
            for (int et = 0; et < 8; ++et) {
                const int e = et * 16 + 4 * G;
                const float4 gr = grv[et];
                const uint2 gv = gvv[et];
                uint2 ov;
                ov.x = cvt_pk_bf16(o[et][0] * rs * gr.x * __uint_as_float(gv.x << 16), o[et][1] * rs * gr.y * __uint_as_float(gv.x & 0xffff0000u));
                ov.y = cvt_pk_bf16(o[et][2] * rs * gr.z * __uint_as_float(gv.y << 16), o[et][3] * rs * gr.w * __uint_as_float(gv.y & 0xffff0000u));
                *(uint2*)(p.yar + ri * 1024 + 512 + h * 128 + e) = ov;
            }
        } else {
            const int bh = it - 512, h = bh & 3, b = bh >> 2;
            const size_t r = TP + b;
            float* red = (float*)lds;
            float o = 0.f;
            if (tid < 128) {
                const int e = tid;
                const bf16_t* qr = p.rq + r * 256 + h * 64; const bf16_t* kr = p.rk + r * 256 + h * 64;
                const float* S0 = p.state_ret + (size_t)bh * 8192;
                float qs = 0.f, qk = 0.f;
                for (int d = 0; d < 64; ++d) { const float q = bf2f(qr[d]); qs += q * S0[d * 128 + e]; qk += q * bf2f(kr[d]); }
                o = qs * ret_gamma(h) + qk * bf2f(p.rv[r * 512 + h * 128 + e]);
                const float s2 = wave_sum(o * o);
                if (lane == 0) red[wave] = s2;
            }
            __syncthreads();
            if (tid < 128) {
                const float rs = rsqrtf((red[0] + red[1]) * (1.f / 128.f) + EPS);
                p.yar[r * 1024 + 512 + h * 128 + tid] = f2bf(o * rs * p.g_ret[tid] * bf2f(p.gr[r * 512 + h * 128 + tid]));
            }
        }
    }
}

__device__ __forceinline__ void out_sample(const Params& p, char* lds, int bid, int nblk) {
    const int tid = opaque_tid(), lane = tid & 63, wave = tid >> 6, fr = lane & 15, G = lane >> 4;
    f32x4* part = (f32x4*)lds;
    for (int it = bid; it < 128; it += nblk) {
        const int mt = it >> 6, nt = it & 63;
        const bf16_t* arow = p.yar + (size_t)(TP + mt * 16 + fr) * 1024 + wave * 128 + G * 8;
        const bf16_t* brow = p.bt_out + (size_t)(nt * 16 + fr) * 1024 + wave * 128 + G * 8;
        bf16x8 a[4], b[4];
#pragma unroll
        for (int ks = 0; ks < 4; ++ks) { a[ks] = *(const bf16x8*)(arow + ks * 32); b[ks] = *(const bf16x8*)(brow + ks * 32); }
        const int c = nt * 16 + fr;
        float xv[4], gv[4];
        if (wave == 0) {
#pragma unroll
            for (int rg = 0; rg < 4; ++rg) { const int sb = mt * 16 + 4 * G + rg; xv[rg] = p.x_sample[(size_t)sb * 1024 + c]; gv[rg] = p.mod[(4 + sb) * 3072 + 2048 + c]; }
        }
        f32x4 acc = {0.f, 0.f, 0.f, 0.f};
#pragma unroll
        for (int ks = 0; ks < 4; ++ks) acc = __builtin_amdgcn_mfma_f32_16x16x32_bf16(a[ks], b[ks], acc, 0, 0, 0);
        __syncthreads();
        part[wave * 64 + lane] = acc;
        __syncthreads();
        if (wave == 0) {
            f32x4 tot = part[lane];
#pragma unroll
            for (int w = 1; w < 8; ++w) tot += part[w * 64 + lane];
#pragma unroll
            for (int rg = 0; rg < 4; ++rg) {
                const int sb = mt * 16 + 4 * G + rg;
                p.y[(size_t)(TP + sb) * 1024 + c] = xv[rg] + gv[rg] * tot[rg];
            }
        }
    }
}
__global__ void __launch_bounds__(NT, 2) k_mega(Params p) {
    extern __shared__ __attribute__((aligned(16))) char lds[];
    const int bid = blockIdx.x, nblk = gridDim.x;
    uint4* xbw = (uint4*)(lds + 147456);
    if (threadIdx.x == 0) *xbw = make_uint4(0u, 0u, 0u, 0u);
    __syncthreads();
    XcdBarrier bar = xcd_barrier_post(p.bar, (volatile LAS unsigned*)xbw);
    p0_w1p(p, bid, nblk); wg_signal(p.bar + 3536, true);
    p0_adaln(p, lds, bid, nblk); __syncthreads(); p0_weights(p, lds, bid, nblk); __syncthreads();
    wg_wait(p.bar + 3536, (unsigned)nblk, p.bar + XB_TMO);
    compress_sample(p, lds, bid, nblk);
    wg_wait(p.bar + 3520, 192u, p.bar + XB_TMO);
    p1_norm(p, lds, bid, nblk);
    xcd_barrier(bar);
    { EpiIn e{&p}; gemm_phase(p.H, p.bt_in, RPAD / 256, NPAD / 256, 1024, lds, bid, nblk, e); }
    if (nblk == 256) compress_seams(p, bid - 142, 114); else compress_seams(p, bid, nblk);
    xcd_barrier(bar);
    {
        volatile int* slot = (volatile int*)(lds + 147456 + 16);
        for (;;) {
            __syncthreads();
            if (threadIdx.x == 0) *slot = (int)__hip_atomic_fetch_add(p.bar + 3456 + 48, 1u, __ATOMIC_RELAXED, __HIP_MEMORY_SCOPE_AGENT);
            __syncthreads();
            const int w = *slot;
            if (w >= 136 + 512) break;
            if (w < 136) compress_prompt_ksplit_item(p, lds, w); else ret_local_item(p, lds, w - 136);
        }
    }
    xcd_barrier(bar);
    p6b_scan(p, bid, nblk); wg_signal(p.bar + 3456, true);
    att_phase(p, lds, bid, nblk);
    ret_out_queue(p, lds, bid, nblk);
    xcd_barrier(bar);
    { EpiOut e{&p}; gemm_phase(p.yar, p.bt_out, TP / 256, 4, 1024, lds, bid, nblk, e); }
    out_sample(p, lds, bid, nblk);
}
}

extern "C" void kernel_launch(void* const* d_in, const int* in_sizes, int n_in, void* d_out, int out_size, void* d_ws, size_t ws_size, hipStream_t stream) {
    Params p{};
    p.x_prompt = (const float*)d_in[0]; p.x_sample = (const float*)d_in[1]; p.c_prompt = (const float*)d_in[2]; p.c_sample = (const float*)d_in[3];
    p.cache_cmp = (const float*)d_in[4]; p.cache_slc = (const float*)d_in[5]; p.state_win = (const float*)d_in[6]; p.state_ret = (const float*)d_in[7];
    p.page_table = (const int*)d_in[8];
    p.g_norm = (const float*)d_in[9]; p.w_ada = (const float*)d_in[10]; p.b_ada = (const float*)d_in[11]; p.w_in = (const float*)d_in[12];
    p.g_q = (const float*)d_in[13]; p.g_kc = (const float*)d_in[14]; p.g_ks = (const float*)d_in[15]; p.g_kw = (const float*)d_in[16];
    p.pe_ck = (const float*)d_in[17]; p.w_ck1 = (const float*)d_in[18]; p.w_ck2 = (const float*)d_in[19];
    p.pe_cv = (const float*)d_in[20]; p.w_cv1 = (const float*)d_in[21]; p.w_cv2 = (const float*)d_in[22];
    p.g_ret = (const float*)d_in[23]; p.w_out = (const float*)d_in[24];
    float* o = (float*)d_out;
    p.y = o; o += (size_t)R * 1024;
    p.p_cmp = o; o += (size_t)TP * 256; p.p_slc = o; o += (size_t)TP * 256; p.p_win = o; o += (size_t)4 * 512 * 256; p.p_ret = o; o += (size_t)16 * 8192;
    p.s_cmp = o; o += 32 * 256; p.s_slc = o; o += 32 * 256; p.s_win = o; o += (size_t)32 * 512 * 256; p.s_ret = o; o += (size_t)128 * 8192;
    char* w = (char*)d_ws; size_t off = 0;
    auto take = [&](size_t bytes) { char* q = w + off; off += (bytes + 255) & ~(size_t)255; return q; };
    p.bar = (unsigned*)take(16384);
    p.mod = (float*)take(36 * 3072 * 4);
    p.bt_in = (bf16_t*)take((size_t)NPAD * 1024 * 2);
    p.bt_out = (bf16_t*)take((size_t)1024 * 1024 * 2);
    p.H = (bf16_t*)take((size_t)RPAD * 1024 * 2);
    p.praw = (float*)take((size_t)RPAD * NPAD * 4);
    p.qn = (bf16_t*)take((size_t)R * 512 * 2);
    p.kcr = (bf16_t*)take((size_t)TP * 128 * 2); p.vcr = (bf16_t*)take((size_t)TP * 128 * 2);
    p.ks = (bf16_t*)take((size_t)TP * 128 * 2); p.vs = (bf16_t*)take((size_t)TP * 128 * 2);
    p.kw = (bf16_t*)take((size_t)TP * 128 * 2); p.vw = (bf16_t*)take((size_t)TP * 128 * 2);
    p.gates = (float*)take((size_t)R * 24 * 4);
    p.ga = (bf16_t*)take((size_t)R * 512 * 2); p.gr = (bf16_t*)take((size_t)R * 512 * 2);
    p.rq = (bf16_t*)take((size_t)R * 256 * 2); p.rk = (bf16_t*)take((size_t)R * 256 * 2); p.rv = (bf16_t*)take((size_t)R * 512 * 2);
    p.kc = (bf16_t*)take((size_t)4 * 2 * 256 * 64 * 2); p.vc = (bf16_t*)take((size_t)4 * 2 * 256 * 64 * 2);
    p.kcs = (bf16_t*)take((size_t)32 * 2 * 1024 * 64 * 2); p.vcs = (bf16_t*)take((size_t)32 * 2 * 1024 * 64 * 2);
    p.yar = (bf16_t*)take((size_t)RPAD * 1024 * 2);
    p.sloc = (float*)take((size_t)512 * 8192 * 4); p.spre = (float*)take((size_t)512 * 8192 * 4);
    p.oret = (float*)take((size_t)R * 512 * 4);
    p.w1p = (bf16_t*)take((size_t)2 * 128 * 1024 * 2); p.w2t = (bf16_t*)take((size_t)2 * 64 * 64 * 2); p.b1 = (float*)take(128 * 4);
    p.attb = (float*)take(256);
    p.ropec = (float*)take((size_t)4097 * 32 * 4); p.ropes = (float*)take((size_t)4097 * 32 * 4);
    p.seamA = (float*)take((size_t)32 * 2 * 64 * 2 * 64 * 4); p.seamB = (float*)take((size_t)32 * 2 * 64 * 2 * 64 * 4);
    if (off > ws_size) { fprintf(stderr, "workspace too small: need %zu have %zu\n", off, ws_size); return; }
    static int grid = 0;
    if (grid == 0) {
        int dev = 0, cus = 0, per_cu = 0;
        if (hipGetDevice(&dev) != hipSuccess || hipDeviceGetAttribute(&cus, hipDeviceAttributeMultiprocessorCount, dev) != hipSuccess) { fprintf(stderr, "device query failed\n"); grid = -1; return; }
        if (hipFuncSetAttribute((const void*)k_mega, hipFuncAttributeMaxDynamicSharedMemorySize, LDS_BYTES) != hipSuccess) { fprintf(stderr, "hipFuncSetAttribute failed\n"); grid = -1; return; }
        if (hipOccupancyMaxActiveBlocksPerMultiprocessor(&per_cu, (const void*)k_mega, NT, LDS_BYTES) != hipSuccess || per_cu < 1) { fprintf(stderr, "occupancy query: %d blocks per CU\n", per_cu); grid = -1; return; }
        (void)hipGetLastError();
        grid = cus;
    }
    if (grid < 0) return;
    (void)hipMemsetAsync(p.bar, 0, 16384, stream);
    hipLaunchKernelGGL(k_mega, dim3(grid), dim3(NT), LDS_BYTES, stream, p);
}
```

```cpp
#include <hip/hip_runtime.h>
#include <stdint.h>
#include <stdio.h>

namespace {
typedef unsigned short bf16_t;
typedef short bf16x8 __attribute__((ext_vector_type(8)));
typedef float f32x4 __attribute__((ext_vector_type(4)));

constexpr int D_MODEL = 1024, BATCH = 4, SEQ = 4096, DEC_BATCH = 32, PAST = 16384;
constexpr int NPAGES = 128, NPHYS = 5120;
constexpr int TP = BATCH * SEQ;
constexpr int R = TP + DEC_BATCH;
constexpr int RPAD = 16640;
constexpr int D_IN = 3352, NPAD = 3584;
constexpr int C_Q = 0, C_KC = 512, C_KS = 768, C_KW = 1024, C_BR = 1280, C_GA = 1304, C_RQ = 1816, C_RK = 2072, C_RV = 2328, C_GR = 2840;
constexpr float EPS = 1e-6f;
constexpr int NT = 512;
constexpr int LDS_BYTES = 147456 + 64 + 8192 + 256;

struct Params {
    const float *x_prompt, *x_sample, *c_prompt, *c_sample, *cache_cmp, *cache_slc, *state_win, *state_ret;
    const int* page_table;
    const float *g_norm, *w_ada, *b_ada, *w_in, *g_q, *g_kc, *g_ks, *g_kw, *pe_ck, *w_ck1, *w_ck2, *pe_cv, *w_cv1, *w_cv2, *g_ret, *w_out;
    float *y, *p_cmp, *p_slc, *p_win, *p_ret, *s_cmp, *s_slc, *s_win, *s_ret;
    unsigned* bar;
    float* mod;
    bf16_t* bt_in;
    bf16_t* bt_out;
    bf16_t* H;
    float* praw;
    bf16_t* qn;
    bf16_t *kcr, *vcr, *ks, *vs, *kw, *vw;
    float* gates;
    bf16_t *ga, *gr;
    bf16_t *rq, *rk;
    bf16_t* rv;
    bf16_t *kc, *vc;
    bf16_t *kcs, *vcs;
    bf16_t* yar;
    float *sloc, *spre;
    float* oret;
    bf16_t* w1p;
    bf16_t* w2t;
    float* b1;
    float *seamA, *seamB;
    float* attb;
    float *ropec, *ropes;
};

__device__ __forceinline__ int tile_src(int pn) { return pn <= 4 ? pn * 256 : pn == 13 ? 1280 : 1304 + (pn - 5) * 256; }
__device__ __forceinline__ bf16_t f2bf(float f) { unsigned u = __float_as_uint(f); u += 0x7fffu + ((u >> 16) & 1u); return (bf16_t)(u >> 16); }
__device__ __forceinline__ float bf2f(bf16_t h) { return __uint_as_float(((unsigned)h) << 16); }
__device__ __forceinline__ float wave_sum(float v) {
#pragma unroll
    for (int o = 1; o < 64; o <<= 1) v += __shfl_xor(v, o);
    return v;
}
__device__ __forceinline__ float wave_max(float v) {
#pragma unroll
    for (int o = 1; o < 64; o <<= 1) v = fmaxf(v, __shfl_xor(v, o));
    return v;
}
__device__ __forceinline__ float silu(float v) { return v / (1.f + __expf(-v)); }
__device__ __forceinline__ float sigmoidf(float v) { return 1.f / (1.f + __expf(-v)); }
__device__ __forceinline__ int opaque_tid() { int t = threadIdx.x; asm volatile("" : "+v"(t)); return t; }
typedef __bf16 bf16x2_t __attribute__((ext_vector_type(2)));
typedef float f32x2_t __attribute__((ext_vector_type(2)));
__device__ __forceinline__ unsigned cvt_pk_bf16(float lo, float hi) { const f32x2_t v = {lo, hi}; return __builtin_bit_cast(unsigned, __builtin_convertvector(v, bf16x2_t)); }
#define WSYNC() asm volatile("s_waitcnt lgkmcnt(0)" ::: "memory")

__device__ __forceinline__ void load8(const bf16_t* p, float (&f)[8]) {
    uint4 u = *(const uint4*)p;
    f[0] = __uint_as_float(u.x << 16); f[1] = __uint_as_float(u.x & 0xffff0000u);
    f[2] = __uint_as_float(u.y << 16); f[3] = __uint_as_float(u.y & 0xffff0000u);
    f[4] = __uint_as_float(u.z << 16); f[5] = __uint_as_float(u.z & 0xffff0000u);
    f[6] = __uint_as_float(u.w << 16); f[7] = __uint_as_float(u.w & 0xffff0000u);
}
__device__ __forceinline__ void load8(const float* p, float (&f)[8]) {
    float4 a = *(const float4*)p, b = *(const float4*)(p + 4);
    f[0] = a.x; f[1] = a.y; f[2] = a.z; f[3] = a.w; f[4] = b.x; f[5] = b.y; f[6] = b.z; f[7] = b.w;
}
__device__ __forceinline__ float load1(const bf16_t* p) { return bf2f(*p); }
__device__ __forceinline__ float load1(const float* p) { return *p; }


#define XB_TMO      128
#define XB_XCNT(j)  (256  + 64 * (j))
#define XB_XSUB(j)  (1280 + 64 * (j))
#define XB_XGEN(j)  (2304 + 64 * (j))
#define XB_TOP      3328
#define XB_TOPGEN   3392
#define XCD_BAR_WORDS 3456
#define XB_SPIN_CAP (1u << 18)
#define LAS __attribute__((address_space(3)))
__device__ __forceinline__ unsigned xb_ld(unsigned* p)              { return __hip_atomic_load(p, __ATOMIC_RELAXED, __HIP_MEMORY_SCOPE_AGENT); }
__device__ __forceinline__ unsigned xb_add(unsigned* p, unsigned v) { return __hip_atomic_fetch_add(p, v, __ATOMIC_RELAXED, __HIP_MEMORY_SCOPE_AGENT); }
__device__ __forceinline__ unsigned xb_xcc_id() { return (unsigned)__builtin_amdgcn_s_getreg((3 << 11) | 20) & 0xFu; }
#define XB_SPIN(cond, bar) do { unsigned _sp = 0; while (cond) { __builtin_amdgcn_s_sleep(1); \
    if ((++_sp & 255u) == 0u) { if (xb_ld(&(bar)[XB_TMO])) break; if (_sp > XB_SPIN_CAP) { atomicAdd(&(bar)[XB_TMO], 1u); break; } } } } while (0)
struct XcdBarrier { unsigned* bar; unsigned x; volatile LAS unsigned* st; };
__device__ __forceinline__ XcdBarrier xcd_barrier_post(unsigned* bar, volatile LAS unsigned* st) {
    XcdBarrier b; b.bar = bar; b.x = xb_xcc_id(); b.st = st;
    if (threadIdx.x == 0) (void)xb_add(&bar[XB_XCNT(b.x)], 1u);
    return b;
}
__device__ __forceinline__ void xcd_barrier_complete(unsigned* bar, unsigned x, unsigned& nloc, unsigned& nx) {
    const unsigned G = gridDim.x * gridDim.y * gridDim.z;
    unsigned sum, cnt, mine, sp = 0u;
    for (;;) {
        sum = 0u; cnt = 0u; mine = 0u;
#pragma unroll
        for (unsigned j = 0; j < 16; ++j) { const unsigned c = xb_ld(&bar[XB_XCNT(j)]); sum += c; cnt += (c > 0u) ? 1u : 0u; mine = (j == x) ? c : mine; }
        if (sum == G) break;
        __builtin_amdgcn_s_sleep(1);
        if ((++sp & 255u) == 0u) { if (xb_ld(&bar[XB_TMO])) break; if (sp > XB_SPIN_CAP) { atomicAdd(&bar[XB_TMO], 1u); break; } }
    }
    nloc = mine > 0u ? mine : 1u; nx = cnt > 0u ? cnt : 1u;
}
__device__ __forceinline__ void xcd_barrier(const XcdBarrier& b) {
    asm volatile("s_waitcnt vmcnt(0)" ::: "memory");
    __syncthreads();
    if (threadIdx.x == 0) {
        unsigned* bar = b.bar;
        __builtin_amdgcn_s_waitcnt(0);
        unsigned nloc = b.st[0], nx = b.st[1];
        if (nloc == 0u) { xcd_barrier_complete(bar, b.x, nloc, nx); b.st[0] = nloc; b.st[1] = nx; }
        const unsigned old = xb_add(&bar[XB_XSUB(b.x)], 1u);
        const unsigned gen = old / nloc;
        if (old + 1u == (gen + 1u) * nloc) {
            __builtin_amdgcn_fence(__ATOMIC_RELEASE, "agent");
            asm volatile("s_waitcnt vmcnt(0)" ::: "memory");
            const unsigned og = xb_add(&bar[XB_TOP], 1u);
            const unsigned tg = og / nx;
            if (og + 1u == (tg + 1u) * nx) xb_add(&bar[XB_TOPGEN], 1u);
            else XB_SPIN(xb_ld(&bar[XB_TOPGEN]) == tg, bar);
            __builtin_amdgcn_fence(__ATOMIC_ACQUIRE, "agent");
            xb_add(&bar[XB_XGEN(b.x)], 1u);
            asm volatile("s_waitcnt vmcnt(0)" ::: "memory");
        } else {
            XB_SPIN(xb_ld(&bar[XB_XGEN(b.x)]) == gen, bar);
            __builtin_amdgcn_fence(__ATOMIC_ACQUIRE, "agent");
            asm volatile("s_waitcnt vmcnt(0)" ::: "memory");
        }
    }
    __syncthreads();
}


__device__ __forceinline__ void wg_signal(unsigned* ctr, bool need_release) {
    asm volatile("s_waitcnt vmcnt(0)" ::: "memory");
    __syncthreads();
    if (threadIdx.x == 0) {
        if (need_release) { __builtin_amdgcn_fence(__ATOMIC_RELEASE, "agent"); asm volatile("s_waitcnt vmcnt(0)" ::: "memory"); }
        (void)__hip_atomic_fetch_add(ctr, 1u, __ATOMIC_RELAXED, __HIP_MEMORY_SCOPE_AGENT);
    }
}
__device__ __forceinline__ void wg_wait(unsigned* ctr, unsigned target, unsigned* tmo) {
    if (threadIdx.x == 0) {
        unsigned sp = 0;
        while (__hip_atomic_load(ctr, __ATOMIC_RELAXED, __HIP_MEMORY_SCOPE_AGENT) < target) {
            __builtin_amdgcn_s_sleep(2);
            if (++sp > (1u << 22)) { atomicAdd(tmo, 1u); break; }
        }
        __builtin_amdgcn_fence(__ATOMIC_ACQUIRE, "agent");
        asm volatile("s_waitcnt vmcnt(0)" ::: "memory");
    }
    __syncthreads();
}
__device__ __forceinline__ void p0_adaln(const Params& p, char* lds, int bid, int nblk) {
    float* sc = (float*)lds;
    float* red = (float*)(lds + 73728);
    const int tid = opaque_tid(), lane = tid & 63, wave = tid >> 6;
    for (int item = bid; item < 192; item += nblk) {
        const int cb = item >> 2, r0 = (item & 3) * 9;
        __syncthreads();
        {
            float cv[18];
#pragma unroll
            for (int u = 0; u < 18; ++u) { const int i = tid + u * NT, row = r0 + (i >> 10), k = i & 1023; cv[u] = row < 4 ? p.c_prompt[row * 1024 + k] : p.c_sample[(row - 4) * 1024 + k]; }
#pragma unroll
            for (int u = 0; u < 18; ++u) sc[tid + u * NT] = silu(cv[u]);
        }
        __syncthreads();
        const int j = cb * 64 + lane;
        float acc[9];
#pragma unroll
        for (int r = 0; r < 9; ++r) acc[r] = 0.f;
        const int k0 = wave * 128;
#pragma unroll 8
        for (int k = k0; k < k0 + 128; k += 4) {
            const float w0 = p.w_ada[(size_t)k * 3072 + j], w1 = p.w_ada[(size_t)(k + 1) * 3072 + j], w2 = p.w_ada[(size_t)(k + 2) * 3072 + j], w3 = p.w_ada[(size_t)(k + 3) * 3072 + j];
#pragma unroll
            for (int r = 0; r < 9; ++r) { const float4 s = *(const float4*)(sc + r * 1024 + k); acc[r] += s.x * w0 + s.y * w1 + s.z * w2 + s.w * w3; }
        }
#pragma unroll
        for (int r = 0; r < 9; ++r) red[(wave * 9 + r) * 64 + lane] = acc[r];
        __syncthreads();
        for (int i = tid; i < 9 * 64; i += NT) {
            const int r = i >> 6, l = i & 63;
            float s = 0.f;
#pragma unroll
            for (int w = 0; w < 8; ++w) s += red[(w * 9 + r) * 64 + l];
            __hip_atomic_store(&p.mod[(r0 + r) * 3072 + cb * 64 + l], s + p.b_ada[cb * 64 + l], __ATOMIC_RELAXED, __HIP_MEMORY_SCOPE_AGENT);
        }
        wg_signal(p.bar + 3520, false);
    }
}

__device__ __forceinline__ void transpose_item(const float* W, int K, int N, bf16_t* WT, float* scr, int item, int lane, int nblkN) {
    const int kb = item / nblkN, nb = item % nblkN, k0 = kb * 64, n0 = nb * 64;
    float tv[64];
#pragma unroll
    for (int kk = 0; kk < 64; ++kk) tv[kk] = (n0 + lane < N) ? W[(size_t)(k0 + kk) * N + n0 + lane] : 0.f;
#pragma unroll
    for (int kk = 0; kk < 64; ++kk) scr[kk * 65 + lane] = tv[kk];
    WSYNC();
    for (int nn = 0; nn < 64; ++nn) WT[(size_t)(n0 + nn) * K + k0 + lane] = f2bf(scr[lane * 65 + nn]);
    WSYNC();
}
__device__ __forceinline__ void p0_w1p(const Params& p, int bid, int nblk) {
    const size_t gt = (size_t)bid * NT + opaque_tid(), ngt = (size_t)nblk * NT;
    for (size_t i = gt; i < (size_t)2 * 128 * 1024; i += ngt) {
        const int kv = (int)(i >> 17), n = (int)(i >> 10) & 127, kp = (int)i & 1023;
        const int ks = kp >> 5, G = (kp >> 3) & 3, j = kp & 7;
        const int k = ks * 32 + 16 * (j >> 2) + 4 * G + (j & 3);
        const int l = (k >> 6) + (n >= 64 ? 16 : 0), d = k & 63, f = n & 63;
        p.w1p[i] = f2bf((kv ? p.w_cv1 : p.w_ck1)[(size_t)(l * 64 + d) * 64 + f]);
    }
}
__device__ __forceinline__ void p0_weights(const Params& p, char* lds, int bid, int nblk) {
    const int tid = opaque_tid(), lane = tid & 63, wave = tid >> 6;
    float* scr = (float*)lds + wave * (64 * 65);
    const int gw = bid * 8 + wave, ngw = nblk * 8;
    constexpr int I_IN = 16 * 112, I_OUT = 16 * 16;
    for (int it = gw; it < I_IN + I_OUT; it += ngw) {
        if (it < I_IN) {
            const int kb = it / 112, nb = it % 112, k0 = kb * 64, n0 = nb * 32;
            const int pn = n0 >> 8, pl = n0 & 255, bj = pl >> 7, wc = (pl >> 5) & 3;
            const int cb = tile_src(pn) + wc * 64 + bj * 32;
            const int lim = pn == 13 ? 1304 : D_IN;
            float tv[32];
#pragma unroll
            for (int i = 0; i < 32; ++i) { const int kk = 2 * i + (lane >> 5), c = cb + (lane & 31); tv[i] = c < lim ? p.w_in[(size_t)(k0 + kk) * D_IN + c] : 0.f; }
#pragma unroll
            for (int i = 0; i < 32; ++i) scr[(2 * i + (lane >> 5)) * 33 + (lane & 31)] = tv[i];
            WSYNC();
            const int c8 = lane & 7;
            for (int j = 0; j < 4; ++j) {
                const int n = (lane >> 3) + 8 * j; const float* s = scr + (8 * c8) * 33 + n;
                uint4 o; o.x = cvt_pk_bf16(s[0], s[33]); o.y = cvt_pk_bf16(s[66], s[99]); o.z = cvt_pk_bf16(s[132], s[165]); o.w = cvt_pk_bf16(s[198], s[231]);
                *(uint4*)(p.bt_in + (size_t)(n0 + n) * 1024 + k0 + 8 * c8) = o;
            }
            WSYNC();
        } else transpose_item(p.w_out, 1024, 1024, p.bt_out, scr, it - I_IN, lane, 16);
    }
    const size_t gt = (size_t)bid * NT + tid, ngt = (size_t)nblk * NT;
    for (size_t i = gt; i < (size_t)4097 * 32; i += ngt) {
        const int pi = (int)(i >> 5), fi = (int)i & 31;
        const float ang = (float)(pi < 4096 ? pi : PAST) * powf(10000.f, -(float)fi / 32.f);
        float sn, cs; sincosf(ang, &sn, &cs);
        p.ropec[i] = cs; p.ropes[i] = sn;
    }
    if (bid == (nblk > 200 ? 200 : 0) && wave == 0) {
        const float gq = wave_max(fabsf(p.g_q[lane])), gc = wave_max(fabsf(p.g_kc[lane])), gs = wave_max(fabsf(p.g_ks[lane])), gw = wave_max(fabsf(p.g_kw[lane]));
        if (lane == 0) { const float k = 8.f * 1.03f * 1.44269504088896f * gq; p.attb[0] = k * gc; p.attb[1] = k * gs; p.attb[2] = k * gw; p.attb[3] = 0.f; }
    }
    for (size_t i = gt; i < (size_t)2 * 64 * 64; i += ngt) {
        const int kv = (int)(i >> 12), d = (int)(i >> 6) & 63, f = (int)i & 63;
        p.w2t[i] = f2bf((kv ? p.w_cv2 : p.w_ck2)[f * 64 + d]);
    }
    for (size_t i = gt; i < (size_t)2 * 8 * 64; i += ngt) {
        const int which = (int)(i >> 9), bg = (int)(i >> 6) & 7, d = (int)i & 63;
        (which ? p.vc : p.kc)[((size_t)bg * 256 + 255) * 64 + d] = 0;
    }
    {
        constexpr int NW = 32 * 511 * 64;
        const int gti = (int)gt, ngti = (int)ngt;
#define SW_SRC(i) (p.state_win + (size_t)((i) / (511 * 64)) * 512 * 256 + 256 + (size_t)((i) % (511 * 64)) * 4)
#define SW_DST(i) (p.s_win + (size_t)((i) / (511 * 64)) * 512 * 256 + (size_t)((i) % (511 * 64)) * 4)
#define SW_LD(j) const int ix##j = ib + j * ngti, cx##j = ix##j < NW ? ix##j : NW - 1; const float4 vx##j = *(const float4*)SW_SRC(cx##j);
#define SW_ST(j) if (ix##j < NW) *(float4*)SW_DST(ix##j) = vx##j;
        for (int ib = gti; ib < NW; ib += 8 * ngti) {
            SW_LD(0) SW_LD(1) SW_LD(2) SW_LD(3) SW_LD(4) SW_LD(5) SW_LD(6) SW_LD(7)
            SW_ST(0) SW_ST(1) SW_ST(2) SW_ST(3) SW_ST(4) SW_ST(5) SW_ST(6) SW_ST(7)
        }
#undef SW_SRC
#undef SW_DST
#undef SW_LD
#undef SW_ST
    }
}

__device__ __forceinline__ void p1_norm(const Params& p, char* lds, int bid, int nblk) {
    const int tid = opaque_tid(), lane = tid & 63, wave = tid >> 6;
    volatile int* slot = (volatile int*)(lds + 147456 + 16);
    for (;;) {
        __syncthreads();
        if (tid == 0) *slot = (int)__hip_atomic_fetch_add(p.bar + 3456 + 32, 1u, __ATOMIC_RELAXED, __HIP_MEMORY_SCOPE_AGENT);
        __syncthreads();
        const int pulled = *slot;
        if (pulled * 32 >= R) break;
        const int chunk = pulled == 0 ? TP / 32 : pulled - 1;
        if (chunk * 32 < TP) {
            const float* shift = p.mod + (chunk >> 7) * 3072, *scale = shift + 1024;
            const int rw = chunk * 32 + wave;
            float4 v[4][4], g[4], sc[4], sh[4];
#pragma unroll
            for (int q = 0; q < 4; ++q)
#pragma unroll
                for (int j = 0; j < 4; ++j) v[q][j] = *(const float4*)(p.x_prompt + (size_t)(rw + 8 * q) * 1024 + j * 256 + lane * 4);
#pragma unroll
            for (int j = 0; j < 4; ++j) { const int c = j * 256 + lane * 4; g[j] = *(const float4*)(p.g_norm + c); sc[j] = *(const float4*)(scale + c); sh[j] = *(const float4*)(shift + c); }
#pragma unroll
            for (int q = 0; q < 4; ++q) {
                float ss = 0.f;
#pragma unroll
                for (int j = 0; j < 4; ++j) ss += v[q][j].x * v[q][j].x + v[q][j].y * v[q][j].y + v[q][j].z * v[q][j].z + v[q][j].w * v[q][j].w;
                const float rs = rsqrtf(wave_sum(ss) * (1.f / 1024.f) + EPS);
#pragma unroll
                for (int j = 0; j < 4; ++j) {
                    ushort4 o;
                    o.x = f2bf(v[q][j].x * rs * g[j].x * (1.f + sc[j].x) + sh[j].x);
                    o.y = f2bf(v[q][j].y * rs * g[j].y * (1.f + sc[j].y) + sh[j].y);
                    o.z = f2bf(v[q][j].z * rs * g[j].z * (1.f + sc[j].z) + sh[j].z);
                    o.w = f2bf(v[q][j].w * rs * g[j].w * (1.f + sc[j].w) + sh[j].w);
                    *(ushort4*)(p.H + (size_t)(rw + 8 * q) * 1024 + j * 256 + lane * 4) = o;
                }
            }
            continue;
        }
      for (int r = chunk * 32 + wave; r < R && r < chunk * 32 + 32; r += 8) {
        const float* xr = r < TP ? p.x_prompt + (size_t)r * 1024 : p.x_sample + (size_t)(r - TP) * 1024;
        const int mrow = r < TP ? (r >> 12) : 4 + (r - TP);
        const float* shift = p.mod + mrow * 3072, *scale = shift + 1024;
        float4 v[4]; float ss = 0.f;
#pragma unroll
        for (int j = 0; j < 4; ++j) { v[j] = *(const float4*)(xr + j * 256 + lane * 4); ss += v[j].x * v[j].x + v[j].y * v[j].y + v[j].z * v[j].z + v[j].w * v[j].w; }
        const float rs = rsqrtf(wave_sum(ss) * (1.f / 1024.f) + EPS);
#pragma unroll
        for (int j = 0; j < 4; ++j) {
            const int c = j * 256 + lane * 4;
            const float4 g = *(const float4*)(p.g_norm + c), sc = *(const float4*)(scale + c), sh = *(const float4*)(shift + c);
            ushort4 o;
            o.x = f2bf(v[j].x * rs * g.x * (1.f + sc.x) + sh.x);
            o.y = f2bf(v[j].y * rs * g.y * (1.f + sc.y) + sh.y);
            o.z = f2bf(v[j].z * rs * g.z * (1.f + sc.z) + sh.z);
            o.w = f2bf(v[j].w * rs * g.w * (1.f + sc.w) + sh.w);
            *(ushort4*)(p.H + (size_t)r * 1024 + c) = o;
        }
      }
    }
}

constexpr int BM = 256, BK = 64, HALF = 128, HT = HALF * BK;
__device__ __forceinline__ int lds_byte(int r, int c) {
    int st = (r >> 4) * 2 + (c >> 5), rr = r & 15, cc = c & 31, ob = rr * 64 + cc * 2;
    return st * 1024 + (ob ^ (((ob >> 9) & 1) << 5));
}
__device__ __forceinline__ void stage_rc(int b, int& Rr, int& Cc) {
    int st = b / 1024, sb = b % 1024, swz = sb ^ (((sb >> 9) & 1) << 5);
    Rr = (st >> 1) * 16 + swz / 64; Cc = (st & 1) * 32 + (swz % 64) / 2;
}

template <class Epi>
__device__ __forceinline__ void gemm_phase(const bf16_t* __restrict__ A, const bf16_t* __restrict__ Bt, int nM, int nN, int K, char* lds, int bid, int nblk, const Epi& epi) {
    bf16_t* shm = (bf16_t*)lds;
#define SA(b, h) (shm + ((b) * 2 + (h)) * HT)
#define SB(b, h) (shm + (4 + (b) * 2 + (h)) * HT)
#define STAGE_X(T, P, BASE, br, kt) do { long _g = (long)(br) * K + (long)(kt) * BK; \
    for (int _i = 0; _i < 2; ++_i) { int _b = (T) * 16 + _i * 8192; int _r, _c; stage_rc(_b, _r, _c); \
      __builtin_amdgcn_global_load_lds((const unsigned*)(BASE + _g + (long)_r * K + _c), \
        (__attribute__((address_space(3))) unsigned*)((char*)(P) + _b), 16, 0, 0); } } while (0)
#define STAGE(P, BASE, br, kt) STAGE_X(tz0, P, BASE, br, kt)
#define LDA(dst, b, h) for (int m = 0; m < 4; ++m) for (int k = 0; k < 2; ++k) \
    dst[m][k] = *reinterpret_cast<const bf16x8*>((char*)SA(b, h) + lds_byte(wr * 64 + m * 16 + fr, k * 32 + fq * 8))
#define LDB(dst, b, h) for (int n = 0; n < 2; ++n) for (int k = 0; k < 2; ++k) \
    dst[n][k] = *reinterpret_cast<const bf16x8*>((char*)SB(b, h) + lds_byte(wc * 32 + n * 16 + fr, k * 32 + fq * 8))
#define MMA(ai, bj, At, Bt_) do { __builtin_amdgcn_s_setprio(1); \
    for (int m = 0; m < 4; ++m) for (int n = 0; n < 2; ++n) for (int k = 0; k < 2; ++k) \
      acc[ai][bj][m][n] = __builtin_amdgcn_mfma_f32_16x16x32_bf16(Bt_[n][k], At[m][k], acc[ai][bj][m][n], 0, 0, 0); \
    __builtin_amdgcn_s_setprio(0); } while (0)
#define WAIT_V(n) asm volatile("s_waitcnt vmcnt(" #n ")" ::: "memory")
#define WAIT_L(n) asm volatile("s_waitcnt lgkmcnt(" #n ")" ::: "memory")
#define BAR __builtin_amdgcn_s_barrier()
#define SCHED __builtin_amdgcn_sched_barrier(0)
    const int nwg = nM * nN;
    for (int tile = bid; tile < nwg; tile += nblk) {
        const int pm = tile / nN, pn = tile % nN;
        const int brow = pm * BM, bcol = pn * BM;
        int tz0 = threadIdx.x; asm volatile("" : "+v"(tz0));
        int wid = tz0 >> 6, lane = tz0 & 63, wr = wid >> 2, wc = wid & 3, fr = lane & 15, fq = lane >> 4;
        f32x4 acc[2][2][4][2] = {};
        bf16x8 At[4][2], B0[2][2], B1[2][2];
        const int nt = K / BK;
        STAGE(SB(0, 0), Bt, bcol, 0); STAGE(SA(0, 0), A, brow, 0);
        STAGE(SB(0, 1), Bt, bcol + HALF, 0); STAGE(SA(0, 1), A, brow + HALF, 0);
        if (wr == 1) BAR;
        WAIT_V(4); BAR;
        STAGE(SB(1, 0), Bt, bcol, 1); STAGE(SA(1, 0), A, brow, 1); STAGE(SB(1, 1), Bt, bcol + HALF, 1);
        WAIT_V(6); BAR;
        for (int t = 0; t < nt - 2; t += 2) {
            LDB(B0, 0, 0); SCHED; LDA(At, 0, 0); STAGE(SA(1, 1), A, brow + HALF, t + 1);
            WAIT_L(8); BAR; WAIT_L(0); MMA(0, 0, At, B0); BAR; SCHED;
            LDB(B1, 0, 1); STAGE(SB(0, 0), Bt, bcol, t + 2);
            BAR; WAIT_L(0); MMA(0, 1, At, B1); BAR;
            LDA(At, 0, 1); STAGE(SA(0, 0), A, brow, t + 2);
            BAR; WAIT_L(0); MMA(1, 0, At, B0); BAR; SCHED;
            STAGE(SB(0, 1), Bt, bcol + HALF, t + 2);
            WAIT_V(6); BAR; MMA(1, 1, At, B1); BAR;
            LDB(B0, 1, 0); SCHED; LDA(At, 1, 0); STAGE(SA(0, 1), A, brow + HALF, t + 2);
            WAIT_L(8); BAR; WAIT_L(0); MMA(0, 0, At, B0); BAR; SCHED;
            LDB(B1, 1, 1); STAGE(SB(1, 0), Bt, bcol, t + 3);
            BAR; WAIT_L(0); MMA(0, 1, At, B1); BAR;
            LDA(At, 1, 1); STAGE(SA(1, 0), A, brow, t + 3);
            BAR; WAIT_L(0); MMA(1, 0, At, B0); BAR; SCHED;
            STAGE(SB(1, 1), Bt, bcol + HALF, t + 3);
            WAIT_V(6); BAR; MMA(1, 1, At, B1); BAR;
        }
        int tz = threadIdx.x; asm volatile("" : "+v"(tz)); wid = tz >> 6; lane = tz & 63; wr = wid >> 2; wc = wid & 3; fr = lane & 15; fq = lane >> 4;
        { LDB(B0, 0, 0); WAIT_V(0); LDA(At, 0, 0); STAGE_X(tz, SA(1, 1), A, brow + HALF, nt - 1);
          BAR; WAIT_L(0); MMA(0, 0, At, B0); BAR;
          LDB(B1, 0, 1); BAR; WAIT_L(0); MMA(0, 1, At, B1); BAR;
          LDA(At, 0, 1); WAIT_V(4); BAR; WAIT_L(0); MMA(1, 0, At, B0); MMA(1, 1, At, B1); BAR; }
        { LDB(B0, 1, 0); LDA(At, 1, 0); WAIT_V(2); BAR; WAIT_L(0); MMA(0, 0, At, B0); BAR;
          LDB(B1, 1, 1); WAIT_V(0); BAR; WAIT_L(0); MMA(0, 1, At, B1); BAR;
          LDA(At, 1, 1); BAR; WAIT_L(0); MMA(1, 0, At, B0); MMA(1, 1, At, B1); BAR; }
        if (wr == 0) BAR;
        epi(acc, brow, bcol, wr, wc, fr, fq);
    }
#undef SA
#undef SB
#undef STAGE_X
#undef STAGE
#undef LDA
#undef LDB
#undef MMA
}

struct EpiOut {
    const Params* p;
    __device__ __forceinline__ void operator()(const f32x4 (&acc)[2][2][4][2], int brow, int bcol, int wr, int wc, int fr, int fq) const {
#pragma unroll
        for (int ai = 0; ai < 2; ++ai)
#pragma unroll
            for (int mt = 0; mt < 4; ++mt) {
                const int r = brow + ai * HALF + wr * 64 + mt * 16 + fr;
                if (r < R) {
                    const float* xr = r < TP ? p->x_prompt + (size_t)r * 1024 : p->x_sample + (size_t)(r - TP) * 1024;
                    const float* gate = p->mod + (r < TP ? (r >> 12) : 4 + (r - TP)) * 3072 + 2048;
#pragma unroll
                    for (int bj = 0; bj < 2; ++bj)
#pragma unroll
                        for (int nt = 0; nt < 2; ++nt) {
                            const int c = bcol + bj * HALF + wc * 32 + nt * 16 + 4 * fq;
                            const float4 xv = *(const float4*)(xr + c), gv = *(const float4*)(gate + c);
                            float4 o; o.x = xv.x + gv.x * acc[ai][bj][mt][nt][0]; o.y = xv.y + gv.y * acc[ai][bj][mt][nt][1];
                            o.z = xv.z + gv.z * acc[ai][bj][mt][nt][2]; o.w = xv.w + gv.w * acc[ai][bj][mt][nt][3];
                            *(float4*)(p->y + (size_t)r * 1024 + c) = o;
                        }
                }
            }
    }
};

struct EpiIn {
    const Params* p;
    __device__ __forceinline__ void operator()(const f32x4 (&acc)[2][2][4][2], int brow, int bcol, int wr, int wc, int fr, int fq) const {
        const int pn = bcol >> 8;
        const Params& P = *p;
        const bool normt = pn <= 1 || ((pn == 3 || pn == 4) && wc < 2);
        float4 g4h[2][2];
        { const float* gn = pn <= 1 ? P.g_q : pn == 3 ? P.g_ks : P.g_kw;
#pragma unroll
          for (int bj = 0; bj < 2; ++bj)
#pragma unroll
            for (int nt = 0; nt < 2; ++nt) g4h[bj][nt] = normt ? *(const float4*)(gn + bj * 32 + nt * 16 + 4 * fq) : make_float4(1.f, 1.f, 1.f, 1.f); }
#pragma unroll
        for (int ai = 0; ai < 2; ++ai)
#pragma unroll
            for (int mt = 0; mt < 4; ++mt) {
                const int r = brow + ai * HALF + wr * 64 + mt * 16 + fr;
                const bool rowok = r < R;
                const bool isp = r < TP;
                const int b = isp ? (r >> 12) : (r - TP), t = isp ? (r & 4095) : 0, pidx = isp ? t : 4096;
                f32x4 v[2][2];
#pragma unroll
                for (int bj = 0; bj < 2; ++bj)
#pragma unroll
                    for (int nt = 0; nt < 2; ++nt) v[bj][nt] = acc[ai][bj][mt][nt];
                if (normt) {
                    float ss = 0.f;
#pragma unroll
                    for (int bj = 0; bj < 2; ++bj)
#pragma unroll
                        for (int nt = 0; nt < 2; ++nt)
#pragma unroll
                            for (int rg = 0; rg < 4; ++rg) ss += v[bj][nt][rg] * v[bj][nt][rg];
                    ss += __shfl_xor(ss, 16); ss += __shfl_xor(ss, 32);
                    const float rs = rsqrtf(ss * (1.f / 64.f) + EPS);
#pragma unroll
                    for (int bj = 0; bj < 2; ++bj)
#pragma unroll
                        for (int nt = 0; nt < 2; ++nt) {
                            const float4 g4 = g4h[bj][nt];
                            v[bj][nt][0] *= rs * g4.x; v[bj][nt][1] *= rs * g4.y; v[bj][nt][2] *= rs * g4.z; v[bj][nt][3] *= rs * g4.w;
                        }
                }
                if (!rowok) continue;
                if (pn == 7 || pn == 8) {
                    const float lgm = __log2f(1.f - exp2f(-5.f - (float)wc)) * (float)((isp ? t : PAST) & 127);
                    const float sc = pn == 7 ? exp2f(lgm) : 0.125f * exp2f(-lgm);
#pragma unroll
                    for (int nt = 0; nt < 2; ++nt) {
                        const float4 c4 = *(const float4*)(P.ropec + (size_t)pidx * 32 + nt * 16 + 4 * fq), s4 = *(const float4*)(P.ropes + (size_t)pidx * 32 + nt * 16 + 4 * fq);
                        const f32x4 x1 = v[0][nt], x2 = v[1][nt];
                        v[0][nt][0] = (x1[0] * c4.x - x2[0] * s4.x) * sc; v[1][nt][0] = (x1[0] * s4.x + x2[0] * c4.x) * sc;
                        v[0][nt][1] = (x1[1] * c4.y - x2[1] * s4.y) * sc; v[1][nt][1] = (x1[1] * s4.y + x2[1] * c4.y) * sc;
                        v[0][nt][2] = (x1[2] * c4.z - x2[2] * s4.z) * sc; v[1][nt][2] = (x1[2] * s4.z + x2[2] * c4.z) * sc;
                        v[0][nt][3] = (x1[3] * c4.w - x2[3] * s4.w) * sc; v[1][nt][3] = (x1[3] * s4.w + x2[3] * c4.w) * sc;
                    }
                }
                if (pn == 5 || pn == 6 || pn == 11 || pn == 12) {
#pragma unroll
                    for (int bj = 0; bj < 2; ++bj)
#pragma unroll
                        for (int nt = 0; nt < 2; ++nt)
#pragma unroll
                            for (int rg = 0; rg < 4; ++rg) v[bj][nt][rg] = silu(v[bj][nt][rg]);
                }
                bf16_t* bdst = nullptr; float* fdst = nullptr;
                if (pn <= 1) bdst = P.qn + (size_t)r * 512 + (pn * 4 + wc) * 64;
                else if (pn == 2) fdst = (isp ? P.p_cmp + (size_t)r * 256 : P.s_cmp + (size_t)b * 256) + wc * 64;
                else if (pn == 3) { fdst = (isp ? P.p_slc + (size_t)r * 256 : P.s_slc + (size_t)b * 256) + wc * 64;
                                    if (isp) bdst = (wc < 2 ? P.ks : P.vs) + ((size_t)(b * 2 + (wc & 1)) * SEQ + t) * 64; }
                else if (pn == 4) { fdst = isp ? (t >= SEQ - 512 ? P.p_win + ((size_t)b * 512 + (t - (SEQ - 512))) * 256 + wc * 64 : nullptr) : P.s_win + ((size_t)b * 512 + 511) * 256 + wc * 64;
                                    if (isp) bdst = (wc < 2 ? P.kw : P.vw) + ((size_t)(b * 2 + (wc & 1)) * SEQ + t) * 64; }
                else if (pn == 5 || pn == 6) bdst = P.ga + (size_t)r * 512 + (pn - 5) * 256 + wc * 64;
                else if (pn == 7) bdst = P.rq + (size_t)r * 256 + wc * 64;
                else if (pn == 8) bdst = P.rk + (size_t)r * 256 + wc * 64;
                else if (pn == 9 || pn == 10) bdst = P.rv + (size_t)r * 512 + (pn - 9) * 256 + wc * 64;
                else if (pn == 11 || pn == 12) bdst = P.gr + (size_t)r * 512 + (pn - 11) * 256 + wc * 64;
                if (pn == 13) {
                    if (wc == 0) {
                        float* gd = P.gates + (size_t)r * 24;
                        { float4 o; o.x = sigmoidf(v[0][0][0]); o.y = sigmoidf(v[0][0][1]); o.z = sigmoidf(v[0][0][2]); o.w = sigmoidf(v[0][0][3]); *(float4*)(gd + 4 * fq) = o; }
                        if (fq < 2) { float4 o; o.x = sigmoidf(v[0][1][0]); o.y = sigmoidf(v[0][1][1]); o.z = sigmoidf(v[0][1][2]); o.w = sigmoidf(v[0][1][3]); *(float4*)(gd + 16 + 4 * fq) = o; }
                    }
                    continue;
                }
#pragma unroll
                for (int bj = 0; bj < 2; ++bj)
#pragma unroll
                    for (int nt = 0; nt < 2; ++nt) {
                        const int cl = bj * 32 + nt * 16 + 4 * fq;
                        if (fdst) { float4 o; o.x = v[bj][nt][0]; o.y = v[bj][nt][1]; o.z = v[bj][nt][2]; o.w = v[bj][nt][3]; *(float4*)(fdst + cl) = o; }
                        if (bdst) { uint2 o; o.x = cvt_pk_bf16(v[bj][nt][0], v[bj][nt][1]); o.y = cvt_pk_bf16(v[bj][nt][2], v[bj][nt][3]); *(uint2*)(bdst + cl) = o; }
                    }
            }
    }
};

__device__ __forceinline__ void p3_rows(const Params& p, int bid, int nblk) {
    const int tid = opaque_tid(), lane = tid & 63, wave = tid >> 6;
    for (int r = bid * 8 + wave; r < R; r += nblk * 8) {
        const float* pr = p.praw + (size_t)r * NPAD;
        const bool isp = r < TP;
        const int b = isp ? (r >> 12) : (r - TP), t = isp ? (r & 4095) : 0;
        const int pos = isp ? t : PAST;
        {
            const float gq = p.g_q[lane];
            for (int hh = 0; hh < 8; ++hh) {
                const float v = pr[C_Q + hh * 64 + lane];
                const float rs = rsqrtf(wave_sum(v * v) * (1.f / 64.f) + EPS);
                p.qn[(size_t)r * 512 + hh * 64 + lane] = f2bf(v * rs * gq);
            }
        }
        float* o_cmp = isp ? p.p_cmp + (size_t)r * 256 : p.s_cmp + (size_t)b * 256;
        float* o_slc = isp ? p.p_slc + (size_t)r * 256 : p.s_slc + (size_t)b * 256;
        float* o_win = isp ? (t >= SEQ - 512 ? p.p_win + ((size_t)b * 512 + (t - (SEQ - 512))) * 256 : nullptr) : p.s_win + ((size_t)b * 512 + 511) * 256;
        for (int j = 0; j < 4; ++j) {
            const int g = j & 1;
            const size_t cidx = ((size_t)(b * 2 + g) * SEQ + t) * 64 + lane;
            {
                const float v = pr[C_KC + j * 64 + lane];
                o_cmp[j * 64 + lane] = v;
                if (isp) { if (j < 2) p.kcr[cidx] = f2bf(v); else p.vcr[cidx] = f2bf(v); }
            }
            {
                float v = pr[C_KS + j * 64 + lane];
                if (j < 2) { const float rs = rsqrtf(wave_sum(v * v) * (1.f / 64.f) + EPS); v = v * rs * p.g_ks[lane]; }
                o_slc[j * 64 + lane] = v;
                if (isp) { if (j < 2) p.ks[cidx] = f2bf(v); else p.vs[cidx] = f2bf(v); }
            }
            {
                float v = pr[C_KW + j * 64 + lane];
                if (j < 2) { const float rs = rsqrtf(wave_sum(v * v) * (1.f / 64.f) + EPS); v = v * rs * p.g_kw[lane]; }
                if (o_win) o_win[j * 64 + lane] = v;
                if (isp) { if (j < 2) p.kw[cidx] = f2bf(v); else p.vw[cidx] = f2bf(v); }
            }
        }
        if (lane < 24) p.gates[(size_t)r * 24 + lane] = sigmoidf(pr[C_BR + lane]);
        for (int i = 0; i < 8; ++i) {
            p.ga[(size_t)r * 512 + i * 64 + lane] = f2bf(silu(pr[C_GA + i * 64 + lane]));
            p.gr[(size_t)r * 512 + i * 64 + lane] = f2bf(silu(pr[C_GR + i * 64 + lane]));
            p.rv[(size_t)r * 512 + i * 64 + lane] = f2bf(pr[C_RV + i * 64 + lane]);
        }
        {
            const int i = lane & 31;
            const float freq = powf(10000.f, -(float)i / 32.f);
            const float ang = (float)pos * freq;
            float sn, cs; sincosf(ang, &sn, &cs);
            for (int hh = 0; hh < 4; ++hh) {
                const float a = pr[C_RQ + hh * 64 + lane], ao = pr[C_RQ + hh * 64 + (lane ^ 32)];
                const float kq = pr[C_RK + hh * 64 + lane], ko = pr[C_RK + hh * 64 + (lane ^ 32)];
                const float oq = lane < 32 ? a * cs - ao * sn : ao * sn + a * cs;
                const float ok = lane < 32 ? kq * cs - ko * sn : ko * sn + kq * cs;
                const float lgm = __log2f(1.f - exp2f(-5.f - (float)hh)) * (float)(pos & 127);
                p.rq[(size_t)r * 256 + hh * 64 + lane] = f2bf(oq * exp2f(lgm));
                p.rk[(size_t)r * 256 + hh * 64 + lane] = f2bf(ok * 0.125f * exp2f(-lgm));
            }
        }
    }
}

typedef unsigned u32x4 __attribute__((ext_vector_type(4)));

struct CmpTile {
    int active;
    int b, c0;
    int seam_idx;
    int is_sample;
};

__device__ __forceinline__ void cmp_second_layer(const Params& p, int kv, const f32x4 (&pre)[4], bf16_t* hb  , const bf16_t* w2s  , bf16_t* dst  , int lane) {
    const int fr = lane & 15, G = lane >> 4;
#pragma unroll
    for (int nt = 0; nt < 4; ++nt)
#pragma unroll
        for (int r = 0; r < 4; ++r) hb[(G * 4 + r) * 64 + nt * 16 + fr] = f2bf(silu(pre[nt][r]));
    WSYNC();
    bf16x8 hf[2];
#pragma unroll
    for (int ks = 0; ks < 2; ++ks) hf[ks] = *(const bf16x8*)(hb + fr * 64 + ks * 32 + G * 8);
    f32x4 out[4];
#pragma unroll
    for (int nt = 0; nt < 4; ++nt) {
        out[nt] = (f32x4){0.f, 0.f, 0.f, 0.f};
#pragma unroll
        for (int ks = 0; ks < 2; ++ks) {
            const bf16x8 wf = *(const bf16x8*)(w2s + (nt * 16 + fr) * 64 + ks * 32 + G * 8);
            out[nt] = __builtin_amdgcn_mfma_f32_16x16x32_bf16(hf[ks], wf, out[nt], 0, 0, 0);
        }
    }
    WSYNC();
    float rs[4] = {1.f, 1.f, 1.f, 1.f};
    if (kv == 0) {
#pragma unroll
        for (int r = 0; r < 4; ++r) {
            float ss = 0.f;
#pragma unroll
            for (int nt = 0; nt < 4; ++nt) ss += out[nt][r] * out[nt][r];
            ss += __shfl_xor(ss, 1); ss += __shfl_xor(ss, 2); ss += __shfl_xor(ss, 4); ss += __shfl_xor(ss, 8);
            rs[r] = rsqrtf(ss * (1.f / 64.f) + EPS);
        }
    }
#pragma unroll
    for (int nt = 0; nt < 4; ++nt) {
        const float gk = kv == 0 ? p.g_kc[nt * 16 + fr] : 1.f;
#pragma unroll
        for (int r = 0; r < 4; ++r) {
            const int row = G * 4 + r;
            if (row < 15) dst[(size_t)row * 64 + nt * 16 + fr] = f2bf(out[nt][r] * rs[r] * gk);
        }
    }
}

constexpr int CMP_HB = 131072, CMP_W2S = 147456 + 64, CMP_B1S = CMP_W2S + 8192;
__device__ __forceinline__ void compress_setup(const Params& p, char* lds, int kv) {
    const int tid = opaque_tid();
    const float* w1 = kv ? p.w_cv1 : p.w_ck1; const float* pe = kv ? p.pe_cv : p.pe_ck; const float* w2 = kv ? p.w_cv2 : p.w_ck2;
    bf16_t* w2s = (bf16_t*)(lds + CMP_W2S); float* b1s = (float*)(lds + CMP_B1S); float* part = (float*)(lds + CMP_HB);
    __syncthreads();
    for (int i = tid; i < 4096; i += NT) { const int f = i >> 6, d = i & 63; w2s[d * 64 + f] = f2bf(w2[i]); }
    {
      const int fq4 = tid & 15, ks32 = tid >> 4;
      const float* wp = w1 + (size_t)ks32 * 64 * 64 + 4 * fq4; const float* pp = pe + ks32 * 64;
      float4 s = {0.f, 0.f, 0.f, 0.f};
#pragma unroll 16
      for (int k = 0; k < 64; ++k) { const float4 w = *(const float4*)(wp + (size_t)k * 64); const float pv = pp[k]; s.x += pv * w.x; s.y += pv * w.y; s.z += pv * w.z; s.w += pv * w.w; }
      *(float4*)(part + ks32 * 64 + 4 * fq4) = s; }
    __syncthreads();
    if (tid < 64) { float s = 0.f; for (int j = 0; j < 32; ++j) s += part[j * 64 + tid]; b1s[tid] = s; p.b1[kv * 64 + tid] = s; }
    __syncthreads();
}
template <int O>
__device__ __forceinline__ void cmp_rd4(unsigned a, bf16x8 (&b)[4]) {
    asm volatile(
        "ds_read_b128 %0, %4 offset:%5\n\t"
        "ds_read_b128 %1, %4 offset:%6\n\t"
        "ds_read_b128 %2, %4 offset:%7\n\t"
        "ds_read_b128 %3, %4 offset:%8\n\t"
        "s_waitcnt lgkmcnt(0)"
        : "=&v"(b[0]), "=&v"(b[1]), "=&v"(b[2]), "=&v"(b[3])
        : "v"(a), "i"(O), "i"(O + 1024), "i"(O + 2048), "i"(O + 3072) : "memory");
}
template <int O0, int O1>
__device__ __forceinline__ void cmp_lda(const float* a0, const float* a1, f32x4 (&q)[2][2]) {
    asm volatile("global_load_dwordx4 %0, %4, off offset:%6 nt\n\t"
                 "global_load_dwordx4 %1, %5, off offset:%6 nt\n\t"
                 "global_load_dwordx4 %2, %4, off offset:%7 nt\n\t"
                 "global_load_dwordx4 %3, %5, off offset:%7 nt"
                 : "=&v"(q[0][0]), "=&v"(q[0][1]), "=&v"(q[1][0]), "=&v"(q[1][1])
                 : "v"(a0), "v"(a1), "i"(O0), "i"(O1) : "memory");
}
template <int N>
__device__ __forceinline__ void cmp_wait(f32x4 (&q)[2][2]) {
    asm volatile("s_waitcnt vmcnt(%4)" : "+v"(q[0][0]), "+v"(q[0][1]), "+v"(q[1][0]), "+v"(q[1][1]) : "n"(N) : "memory");
}
__device__ __forceinline__ void cmp_stage_wq(const Params& p, LAS char* l3, int kv, int q, int tid) {
    const int n = tid >> 2, Gp = (tid & 3) ^ ((n >> 2) & 3);
    const bf16_t* src = p.w1p + ((size_t)kv * 128 + n) * 1024 + q * 256 + Gp * 8;
    LAS char* dst = l3 + (q & 1) * 65536 + tid * 16;
#pragma unroll
    for (int j = 0; j < 8; ++j)
        __builtin_amdgcn_global_load_lds((const unsigned*)(src + j * 32), (LAS unsigned*)(dst + j * 8192), 16, 0, 0);
}
__device__ __forceinline__ void compress_pass_s(const Params& p, char* lds, int kv, int b, int c0w, int seam_idx, bool first, bool more) {
    LAS char* l3 = (LAS char*)lds;
    const int tid = opaque_tid(), lane = tid & 63, wave = tid >> 6, fr = lane & 15, G = lane >> 4;
    bf16_t* hb = (bf16_t*)(lds + CMP_HB) + wave * 1024;
    const bf16_t* w2s = (const bf16_t*)(lds + CMP_W2S); const float* b1s = (const float*)(lds + CMP_B1S);
    const float* abase[2];
#pragma unroll
    for (int i = 0; i < 2; ++i) {
        const int c = c0w + (fr & 7) + 8 * i;
        const int pg = p.page_table[b * NPAGES + (c >> 3)];
        abase[i] = p.cache_cmp + (((size_t)pg * 128 + (c & 7) * 16) * 4 + kv * 2) * 64 + (fr >> 3) * 16 + G * 4;
    }
    const bool lowl = fr < 8;
    const unsigned bl = (unsigned)(unsigned long long)l3 + fr * 64 + ((G ^ (fr >> 2)) * 16);
    f32x4 acc[2][8];
#pragma unroll
    for (int g = 0; g < 2; ++g)
#pragma unroll
        for (int nt = 0; nt < 8; ++nt) acc[g][nt] = (f32x4){0.f, 0.f, 0.f, 0.f};
    f32x4 aq[6][2][2];
#define CMP_LOADA(u, s) do { const float* _a0 = abase[0] + ((s) >> 1) * 256; const float* _a1 = abase[1] + ((s) >> 1) * 256; \
        if ((s) & 1) cmp_lda<128, 384>(_a0, _a1, aq[u]); else cmp_lda<0, 256>(_a0, _a1, aq[u]); } while (0)
#define CMP_WAITA(u, s) do { const int _y = 31 - (s); if (_y >= 5) cmp_wait<20>(aq[u]); else if (_y == 4) cmp_wait<16>(aq[u]); else if (_y == 3) cmp_wait<12>(aq[u]); \
        else if (_y == 2) cmp_wait<8>(aq[u]); else if (_y == 1) cmp_wait<4>(aq[u]); else cmp_wait<0>(aq[u]); } while (0)
#pragma unroll
    for (int u = 0; u < 6; ++u) CMP_LOADA(u, u);
    if (first) { cmp_stage_wq(p, l3, kv, 0, tid); asm volatile("s_waitcnt vmcnt(0)" ::: "memory"); }
#pragma unroll
    for (int s = 0; s < 32; ++s) {
        const int q = s >> 3, u = s % 6;
        if ((s & 7) == 0) {
            asm volatile("" ::: "memory");
            __builtin_amdgcn_s_barrier();
            asm volatile("" ::: "memory");
            if (q < 3 || more) cmp_stage_wq(p, l3, kv, (q + 1) & 3, tid);
            asm volatile("" ::: "memory");
        }
        CMP_WAITA(u, s);
        bf16x8 af[2];
#pragma unroll
        for (int g = 0; g < 2; ++g) {
            u32x4 t;
            f32x4 x0, x1;
#pragma unroll
            for (int e = 0; e < 4; ++e) {
                const float give = lowl ? aq[u][g][1][e] : aq[u][g][0][e];
                const float recv = __builtin_bit_cast(float, __builtin_amdgcn_mov_dpp(__builtin_bit_cast(int, give), 0x128, 0xF, 0xF, true));
                x0[e] = lowl ? aq[u][g][0][e] : recv; x1[e] = lowl ? recv : aq[u][g][1][e];
            }
            t[0] = cvt_pk_bf16(x0[0], x0[1]); t[1] = cvt_pk_bf16(x0[2], x0[3]);
            t[2] = cvt_pk_bf16(x1[0], x1[1]); t[3] = cvt_pk_bf16(x1[2], x1[3]);
            af[g] = __builtin_bit_cast(bf16x8, t);
        }
        if (s + 6 < 32) CMP_LOADA(u, s + 6);
        const unsigned a = bl + (q & 1) * 65536 + (s & 7) * 8192;
        bf16x8 bf[4];
        cmp_rd4<0>(a, bf);
#pragma unroll
        for (int nt = 0; nt < 4; ++nt) {
            acc[0][nt] = __builtin_amdgcn_mfma_f32_16x16x32_bf16(af[0], bf[nt], acc[0][nt], 0, 0, 0);
            acc[1][nt] = __builtin_amdgcn_mfma_f32_16x16x32_bf16(af[1], bf[nt], acc[1][nt], 0, 0, 0);
        }
        cmp_rd4<4096>(a, bf);
#pragma unroll
        for (int nt = 0; nt < 4; ++nt) {
            acc[0][4 + nt] = __builtin_amdgcn_mfma_f32_16x16x32_bf16(af[0], bf[nt], acc[0][4 + nt], 0, 0, 0);
            acc[1][4 + nt] = __builtin_amdgcn_mfma_f32_16x16x32_bf16(af[1], bf[nt], acc[1][4 + nt], 0, 0, 0);
        }
    }
#undef CMP_LOADA
#undef CMP_WAITA
#pragma unroll
    for (int g = 0; g < 2; ++g) {
        f32x4 pre[4];
#pragma unroll
        for (int nt = 0; nt < 4; ++nt) {
            const float bias = b1s[nt * 16 + fr];
            const float nb0 = __shfl_down(acc[g][4 + nt][0], 16);
            pre[nt][0] = acc[g][nt][0] + acc[g][4 + nt][1] + bias;
            pre[nt][1] = acc[g][nt][1] + acc[g][4 + nt][2] + bias;
            pre[nt][2] = acc[g][nt][2] + acc[g][4 + nt][3] + bias;
            pre[nt][3] = acc[g][nt][3] + nb0 + bias;
            if (G == 3) p.seamA[((size_t)seam_idx * 2 + g) * 64 + nt * 16 + fr] = acc[g][nt][3];
            if (G == 0) p.seamB[((size_t)seam_idx * 2 + g) * 64 + nt * 16 + fr] = acc[g][4 + nt][0];
        }
        bf16_t* dst = (kv ? p.vcs : p.kcs) + ((size_t)(b * 2 + g) * 1024 + c0w) * 64;
        cmp_second_layer(p, kv, pre, hb, w2s, dst, lane);
    }
}

__device__ __forceinline__ void compress_sample(const Params& p, char* lds, int bid, int nblk) {
    const int wave = opaque_tid() >> 6;
    int kv_set = -1;
    for (int pass = bid; pass < 512; pass += nblk) {
        const int P = pass & 7, kv = (pass >> 3) & 1, b = pass >> 4;
        const int c0w = P * 128 + wave * 16;
        const bool first = kv != kv_set;
        if (first) { compress_setup(p, lds, kv); kv_set = kv; }
        const int nxt = pass + nblk;
        const bool more = nxt < 512 && ((nxt >> 3) & 1) == kv;
        compress_pass_s(p, lds, kv, b, c0w, (b * 2 + kv) * 64 + (c0w >> 4), first, more);
    }
}

__device__ __forceinline__ void compress_prompt_ksplit_item(const Params& p, char* lds, int item) {
    const int tid = opaque_tid(), lane = tid & 63, wave = tid >> 6, fr = lane & 15, G = lane >> 4;
    f32x4* part = (f32x4*)lds;
    {
        const int kv = item / 68, tile = item % 68, b = tile / 17, c0 = (tile % 17) * 15;
        const float* abase = p.p_cmp + (((size_t)b * SEQ + (size_t)(c0 + fr) * 16) * 4 + kv * 2) * 64 + G * 4;
        const bf16_t* wbase = p.w1p + ((size_t)kv * 128 + fr) * 1024 + G * 8;
        f32x4 acc[2][8];
#pragma unroll
        for (int g = 0; g < 2; ++g)
#pragma unroll
            for (int nt = 0; nt < 8; ++nt) acc[g][nt] = (f32x4){0.f, 0.f, 0.f, 0.f};
#pragma unroll
        for (int u = 0; u < 4; ++u) {
            const int s = wave * 4 + u;
            const float* a = abase + (s >> 1) * 256 + (s & 1) * 32;
            bf16x8 af[2];
#pragma unroll
            for (int g = 0; g < 2; ++g) {
                const f32x4 x0 = *(const f32x4*)(a + g * 64), x1 = *(const f32x4*)(a + g * 64 + 16);
                u32x4 t; t[0] = cvt_pk_bf16(x0[0], x0[1]); t[1] = cvt_pk_bf16(x0[2], x0[3]); t[2] = cvt_pk_bf16(x1[0], x1[1]); t[3] = cvt_pk_bf16(x1[2], x1[3]);
                af[g] = __builtin_bit_cast(bf16x8, t);
            }
#pragma unroll
            for (int nt = 0; nt < 8; ++nt) {
                const bf16x8 wf = *(const bf16x8*)(wbase + (size_t)nt * 16 * 1024 + s * 32);
                acc[0][nt] = __builtin_amdgcn_mfma_f32_16x16x32_bf16(af[0], wf, acc[0][nt], 0, 0, 0);
                acc[1][nt] = __builtin_amdgcn_mfma_f32_16x16x32_bf16(af[1], wf, acc[1][nt], 0, 0, 0);
            }
        }
        __syncthreads();
#pragma unroll
        for (int g = 0; g < 2; ++g)
#pragma unroll
            for (int nt = 0; nt < 8; ++nt) part[((wave * 2 + g) * 8 + nt) * 64 + lane] = acc[g][nt];
        __syncthreads();
        if (wave < 2) {
            const int g = wave;
            f32x4 tot[8];
#pragma unroll
            for (int nt = 0; nt < 8; ++nt) {
                tot[nt] = part[((0 * 2 + g) * 8 + nt) * 64 + lane];
#pragma unroll
                for (int w = 1; w < 8; ++w) tot[nt] += part[((w * 2 + g) * 8 + nt) * 64 + lane];
            }
            f32x4 pre[4];
#pragma unroll
            for (int nt = 0; nt < 4; ++nt) {
                const float bias = p.b1[kv * 64 + nt * 16 + fr];
                const float nb0 = __shfl_down(tot[4 + nt][0], 16);
                pre[nt][0] = tot[nt][0] + tot[4 + nt][1] + bias; pre[nt][1] = tot[nt][1] + tot[4 + nt][2] + bias;
                pre[nt][2] = tot[nt][2] + tot[4 + nt][3] + bias; pre[nt][3] = tot[nt][3] + nb0 + bias;
            }
            bf16_t* hb = (bf16_t*)(lds + 131072) + wave * 1024;
            bf16_t* dst = (kv ? p.vc : p.kc) + ((size_t)(b * 2 + g) * 256 + c0) * 64;
            cmp_second_layer(p, kv, pre, hb, p.w2t + (size_t)kv * 4096, dst, lane);
        }
        __syncthreads();
    }
}
__device__ __forceinline__ void compress_seams(const Params& p, int bid, int nblk) {
    const int tid = opaque_tid(), lane = tid & 63, wave = tid >> 6;
    if (bid < 0) return;
    for (int it = bid * 8 + wave; it < 32 * 2 * 2 * 63; it += nblk * 8) {
        const int Tt = it % 63, rest = it / 63, g = rest & 1, kv = (rest >> 1) & 1, b = rest >> 2;
        const size_t sa = ((size_t)((b * 2 + kv) * 64 + Tt) * 2 + g) * 64 + lane, sb = ((size_t)((b * 2 + kv) * 64 + Tt + 1) * 2 + g) * 64 + lane;
        const float h = silu(p.seamA[sa] + p.seamB[sb] + p.b1[kv * 64 + lane]);
        const float* w2 = kv ? p.w_cv2 : p.w_ck2;
        float o = 0.f;
        for (int f = 0; f < 64; ++f) o += bf2f(f2bf(__shfl(h, f))) * bf2f(f2bf(w2[f * 64 + lane]));
        if (kv == 0) { const float rs = rsqrtf(wave_sum(o * o) * (1.f / 64.f) + EPS); o = o * rs * p.g_kc[lane]; }
        ((kv ? p.vcs : p.kcs) + ((size_t)(b * 2 + g) * 1024 + 16 * Tt + 15) * 64)[lane] = f2bf(o);
    }
}
template <typename T>
__device__ __forceinline__ void attend64(const float* qs, float* pl, const T* kbase, const T* vbase, size_t stride, bool valid, int lane, float (&m)[4], float (&l)[4], float (&o)[4]) {
    float s[4] = {0.f, 0.f, 0.f, 0.f};
    if (valid) {
        const T* kr = kbase + (size_t)lane * stride;
        float kfa[8][8];
#pragma unroll
        for (int c = 0; c < 8; ++c) load8(kr + c * 8, kfa[c]);
#pragma unroll
        for (int c = 0; c < 8; ++c)
#pragma unroll
            for (int h = 0; h < 4; ++h)
#pragma unroll
                for (int j = 0; j < 8; ++j) s[h] += qs[h * 64 + c * 8 + j] * kfa[c][j];
    }
    const unsigned long long vm = __ballot(valid);
    if (vm == 0ull) return;
#pragma unroll
    for (int h = 0; h < 4; ++h) {
        const float sv = valid ? s[h] * 0.125f : -1e30f;
        const float mn = fmaxf(m[h], wave_max(sv));
        const float alpha = __expf(m[h] - mn);
        const float pv = valid ? __expf(sv - mn) : 0.f;
        l[h] = l[h] * alpha + wave_sum(pv); o[h] *= alpha; m[h] = mn;
        pl[h * 64 + lane] = pv;
    }
    WSYNC();
    const int kfirst = __ffsll((long long)vm) - 1;
#pragma unroll 64
    for (int kk = 0; kk < 64; ++kk) {
        const int kr = ((vm >> kk) & 1ull) ? kk : kfirst;
        const float vv = load1(vbase + (size_t)kr * stride + lane);
#pragma unroll
        for (int h = 0; h < 4; ++h) o[h] += pl[h * 64 + kk] * vv;
    }
    WSYNC();
}

__device__ __forceinline__ void cmp_branch(const float* qs, float* pl, float* ps, const bf16_t* kc, const bf16_t* vc, int n_c, int lane, float (&oc)[4]) {
    float m[4] = {-1e30f, -1e30f, -1e30f, -1e30f}, l[4] = {0.f, 0.f, 0.f, 0.f};
    for (int c0 = 0; c0 < n_c; c0 += 64) {
        const bool valid = c0 + lane < n_c;
        float s[4] = {0.f, 0.f, 0.f, 0.f};
        if (valid) {
            const bf16_t* kr = kc + (size_t)(c0 + lane) * 64;
#pragma unroll 2
            for (int c = 0; c < 8; ++c) {
                float kf[8]; load8(kr + c * 8, kf);
#pragma unroll
                for (int h = 0; h < 4; ++h)
#pragma unroll
                    for (int j = 0; j < 8; ++j) s[h] += qs[h * 64 + c * 8 + j] * kf[j];
            }
        }
#pragma unroll
        for (int h = 0; h < 4; ++h) {
            const float sv = valid ? s[h] * 0.125f : -1e30f;
            const float mn = fmaxf(m[h], wave_max(sv));
            const float pv = valid ? __expf(sv - mn) : 0.f;
            l[h] = l[h] * __expf(m[h] - mn) + wave_sum(pv); m[h] = mn;
        }
    }
    for (int c0 = 0; c0 < n_c; c0 += 64) {
        const bool valid = c0 + lane < n_c;
        float s[4] = {0.f, 0.f, 0.f, 0.f};
        if (valid) {
            const bf16_t* kr = kc + (size_t)(c0 + lane) * 64;
#pragma unroll 2
            for (int c = 0; c < 8; ++c) {
                float kf[8]; load8(kr + c * 8, kf);
#pragma unroll
                for (int h = 0; h < 4; ++h)
#pragma unroll
                    for (int j = 0; j < 8; ++j) s[h] += qs[h * 64 + c * 8 + j] * kf[j];
            }
        }
        float psum = 0.f;
#pragma unroll
        for (int h = 0; h < 4; ++h) {
            const float pv = valid ? __expf(s[h] * 0.125f - m[h]) / l[h] : 0.f;
            pl[h * 64 + lane] = pv; psum += pv;
        }
        if (valid) ps[1 + c0 + lane] = psum;
        WSYNC();
        const int nk = min(64, n_c - c0);
        for (int kk = 0; kk < nk; ++kk) {
            const float vv = bf2f(vc[(size_t)(c0 + kk) * 64 + lane]);
#pragma unroll
            for (int h = 0; h < 4; ++h) oc[h] += pl[h * 64 + kk] * vv;
        }
        WSYNC();
    }
}

__device__ __forceinline__ void topk16(float* sc, int* sel, int n_sel, int lane) {
    for (int round = 0; round < 16; ++round) {
        float bv = -3.0e38f; int bi = 0x7fffffff;
        for (int j = lane; j < n_sel; j += 64) { const float v = sc[j]; if (v > bv) { bv = v; bi = j; } }
#pragma unroll
        for (int o = 1; o < 64; o <<= 1) {
            const float ov = __shfl_xor(bv, o); const int oi = __shfl_xor(bi, o);
            if (ov > bv || (ov == bv && oi < bi)) { bv = ov; bi = oi; }
        }
        if (lane == 0) { sel[round] = bi; sc[bi] = -3.4e38f; }
        WSYNC();
    }
}

constexpr int ATT_WLDS = 256 + 256 + 1040 + 272 + 16;
__device__ __forceinline__ void p5_attention(const Params& p, char* lds, int bid, int nblk) {
    const int tid = threadIdx.x, lane = tid & 63, wave = tid >> 6;
    float* wl = (float*)lds + wave * ATT_WLDS;
    float *qs = wl, *pl = wl + 256, *ps = wl + 512, *sc = wl + 1552; int* sel = (int*)(wl + 1824);
    const int gw = bid * 8 + wave, ngw = nblk * 8;
    for (int it = gw; it < R * 2; it += ngw) {
        const int r = it >> 1, g = it & 1;
        const bool isp = r < TP;
        const int b = isp ? (r >> 12) : (r - TP), t = isp ? (r & 4095) : PAST;
        const int n_sel = isp ? 64 : 257;
        const int n_cmax = isp ? 255 : 1023;
#pragma unroll
        for (int h = 0; h < 4; ++h) qs[h * 64 + lane] = bf2f(p.qn[(size_t)r * 512 + (g * 4 + h) * 64 + lane]);
        for (int i = lane; i < 4 * n_sel + 1; i += 64) ps[i] = 0.f;
        WSYNC();
        int n_c = t >= 31 ? (t - 31) / 16 + 1 : 0; if (n_c > n_cmax) n_c = n_cmax;
        float oc[4] = {0.f, 0.f, 0.f, 0.f};
        {
            const bf16_t* kc = isp ? p.kc + (size_t)(b * 2 + g) * 256 * 64 : p.kcs + (size_t)(b * 2 + g) * 1024 * 64;
            const bf16_t* vc = isp ? p.vc + (size_t)(b * 2 + g) * 256 * 64 : p.vcs + (size_t)(b * 2 + g) * 1024 * 64;
            cmp_branch(qs, pl, ps, kc, vc, n_c, lane, oc);
        }
        const int jt = t >> 6;
        for (int j = lane; j < n_sel; j += 64) {
            float imp = 0.f;
#pragma unroll
            for (int rr = 0; rr < 4; ++rr) imp += ps[4 * j + rr + 1] + ps[4 * j + rr];
            const bool valid = j * 64 <= t, forced = (j == 0) || (j == jt) || (j == jt - 1);
            sc[j] = valid ? (forced ? 1e4f : imp) : -1e30f;
        }
        WSYNC();
        topk16(sc, sel, n_sel, lane);
        float ms[4] = {-1e30f, -1e30f, -1e30f, -1e30f}, lsum[4] = {0.f, 0.f, 0.f, 0.f}, os[4] = {0.f, 0.f, 0.f, 0.f};
        for (int k = 0; k < 16; ++k) {
            const int j = sel[k];
            if (j * 64 > t) continue;
            const bool valid = j * 64 + lane <= t;
            if (isp) {
                const size_t base = ((size_t)(b * 2 + g) * SEQ + (size_t)j * 64) * 64;
                attend64<bf16_t>(qs, pl, p.ks + base, p.vs + base, 64, valid, lane, ms, lsum, os);
            } else if (j == 256) {
                attend64<float>(qs, pl, p.s_slc + (size_t)b * 256 + g * 64, p.s_slc + (size_t)b * 256 + 128 + g * 64, 256, valid, lane, ms, lsum, os);
            } else {
                const int pg = p.page_table[b * NPAGES + (j >> 1)];
                const float* base = p.cache_slc + (((size_t)pg * 128 + (j & 1) * 64) * 4 + g) * 64;
                attend64<float>(qs, pl, base, base + 128, 256, valid, lane, ms, lsum, os);
            }
        }
        float mw[4] = {-1e30f, -1e30f, -1e30f, -1e30f}, lw[4] = {0.f, 0.f, 0.f, 0.f}, ow[4] = {0.f, 0.f, 0.f, 0.f};
        if (isp) {
            const int start = t - 511 > 0 ? t - 511 : 0;
            for (int c0 = start; c0 <= t; c0 += 64) {
                const size_t base = ((size_t)(b * 2 + g) * SEQ + c0) * 64;
                attend64<bf16_t>(qs, pl, p.kw + base, p.vw + base, 64, c0 + lane <= t, lane, mw, lw, ow);
            }
        } else {
            for (int c0 = 0; c0 < 512; c0 += 64) {
                const float* base = p.s_win + ((size_t)b * 512 + c0) * 256 + g * 64;
                attend64<float>(qs, pl, base, base + 128, 256, true, lane, mw, lw, ow);
            }
        }
#pragma unroll
        for (int h = 0; h < 4; ++h) {
            const float* gt = p.gates + (size_t)r * 24 + g * 12 + h * 3;
            const float o = gt[0] * oc[h] + gt[1] * (os[h] / lsum[h]) + gt[2] * (ow[h] / lw[h]);
            const int col = (g * 4 + h) * 64 + lane;
            p.yar[(size_t)r * 1024 + col] = f2bf(o * bf2f(p.ga[(size_t)r * 512 + col]));
        }
    }
}


typedef short s16x4 __attribute__((ext_vector_type(4)));
#define ATT_NEG (-__builtin_inff())
constexpr int ATT_KC = 0, ATT_VC = 32768, ATT_KB = 65536, ATT_VB = 98304, ATT_SC = 131072;
constexpr float ATT_CS = 0.125f * 1.44269504088896f;

__device__ __forceinline__ void att_stage(LAS char* dst, const bf16_t* rows, int tid) {
    const int key = tid >> 3, slot = tid & 7;
    __builtin_amdgcn_global_load_lds((const unsigned*)(rows + key * 64 + ((slot ^ (key & 7)) * 8)), (LAS unsigned*)(dst + tid * 16), 16, 0, 0);
}
__device__ __forceinline__ void att_qk(const LAS char* Kb, const bf16x8 (&qf)[2], const int (&koff)[2], f32x4 (&st)[4]) {
#pragma unroll
    for (int tk = 0; tk < 4; ++tk) {
        st[tk] = (f32x4){0.f, 0.f, 0.f, 0.f};
#pragma unroll
        for (int ks = 0; ks < 2; ++ks) {
            const bf16x8 kf = *(const LAS bf16x8*)(Kb + tk * 2048 + koff[ks]);
            st[tk] = __builtin_amdgcn_mfma_f32_16x16x32_bf16(kf, qf[ks], st[tk], 0, 0, 0);
        }
    }
}
template <int O0, int O1>
__device__ __forceinline__ void att_tr8(unsigned a0, unsigned a1, unsigned a2, unsigned a3, s16x4 (&v)[8]) {
    asm volatile(
        "ds_read_b64_tr_b16 %0, %8 offset:%12\n\t"
        "ds_read_b64_tr_b16 %1, %8 offset:%13\n\t"
        "ds_read_b64_tr_b16 %2, %9 offset:%12\n\t"
        "ds_read_b64_tr_b16 %3, %9 offset:%13\n\t"
        "ds_read_b64_tr_b16 %4, %10 offset:%12\n\t"
        "ds_read_b64_tr_b16 %5, %10 offset:%13\n\t"
        "ds_read_b64_tr_b16 %6, %11 offset:%12\n\t"
        "ds_read_b64_tr_b16 %7, %11 offset:%13\n\t"
        "s_waitcnt lgkmcnt(0)"
        : "=&v"(v[0]), "=&v"(v[1]), "=&v"(v[2]), "=&v"(v[3]), "=&v"(v[4]), "=&v"(v[5]), "=&v"(v[6]), "=&v"(v[7])
        : "v"(a0), "v"(a1), "v"(a2), "v"(a3), "i"(O0), "i"(O1) : "memory");
}
__device__ __forceinline__ void att_pv(const LAS char* Vb, const f32x4 (&pt)[4], const int (&voff)[4], f32x4 (&o)[4]) {
    const unsigned vb = (unsigned)(unsigned long long)Vb;
    const unsigned a0 = vb + voff[0], a1 = vb + voff[1], a2 = vb + voff[2], a3 = vb + voff[3];
#pragma unroll
    for (int kst = 0; kst < 2; ++kst) {
        u32x4 pk;
        pk[0] = cvt_pk_bf16(pt[2 * kst][0], pt[2 * kst][1]); pk[1] = cvt_pk_bf16(pt[2 * kst][2], pt[2 * kst][3]);
        pk[2] = cvt_pk_bf16(pt[2 * kst + 1][0], pt[2 * kst + 1][1]); pk[3] = cvt_pk_bf16(pt[2 * kst + 1][2], pt[2 * kst + 1][3]);
        const bf16x8 pf = __builtin_bit_cast(bf16x8, pk);
        s16x4 v[8];
        if (kst == 0) att_tr8<0, 2048>(a0, a1, a2, a3, v); else att_tr8<4096, 6144>(a0, a1, a2, a3, v);
#pragma unroll
        for (int dt = 0; dt < 4; ++dt) {
            const s16x4 x0 = v[2 * dt], x1 = v[2 * dt + 1];
            bf16x8 vf; vf[0] = x0[0]; vf[1] = x0[1]; vf[2] = x0[2]; vf[3] = x0[3]; vf[4] = x1[0]; vf[5] = x1[1]; vf[6] = x1[2]; vf[7] = x1[3];
            o[dt] = __builtin_amdgcn_mfma_f32_16x16x32_bf16(vf, pf, o[dt], 0, 0, 0);
        }
    }
}
__device__ __forceinline__ void att_exp(f32x4 (&st)[4], float nb, float& l) {
    typedef float f32x2 __attribute__((ext_vector_type(2)));
    const f32x2 cs2 = {ATT_CS, ATT_CS}, nb2 = {nb, nb};
    f32x2 ls2 = {0.f, 0.f};
#pragma unroll
    for (int tk = 0; tk < 4; ++tk)
#pragma unroll
        for (int r = 0; r < 4; r += 2) {
            const f32x2 s2 = {st[tk][r], st[tk][r + 1]};
            const f32x2 e2 = __builtin_elementwise_fma(s2, cs2, nb2);
            f32x2 p2; p2.x = __builtin_amdgcn_exp2f(e2.x); p2.y = __builtin_amdgcn_exp2f(e2.y);
            st[tk][r] = p2.x; st[tk][r + 1] = p2.y; ls2 += p2;
        }
    l += ls2.x + ls2.y;
}
__device__ __forceinline__ void att_prompt_unit(const Params& p, char* lds, int b, int g, int qt) {
    LAS char* l3 = (LAS char*)lds;
    const int tid = opaque_tid(), lane = tid & 63, wave = tid >> 6, fr = lane & 15, G = lane >> 4;
    const int qi = fr >> 2, h = fr & 3;
    const int t0 = qt * 32, tq0 = t0 + 4 * wave, t_row = tq0 + qi, jt = t0 >> 6;
    const size_t r = (size_t)b * SEQ + t_row;
    const size_t kvbase = (size_t)(b * 2 + g) * SEQ * 64;
    const float shc = p.attb[0], shs = p.attb[1], shw = p.attb[2];
    int koff[2], voff[4];
#pragma unroll
    for (int ks = 0; ks < 2; ++ks) koff[ks] = fr * 128 + (((ks * 4 + G) ^ (fr & 7)) * 16);
    { const int kq = 4 * G + (fr >> 2);
#pragma unroll
      for (int dt = 0; dt < 4; ++dt) voff[dt] = kq * 128 + (((dt * 2 + ((fr & 3) >> 1)) ^ (kq & 7)) * 16) + (fr & 1) * 8; }
    asm volatile("s_waitcnt lgkmcnt(0)" ::: "memory"); __builtin_amdgcn_s_barrier(); asm volatile("" ::: "memory");
    {
        const bf16_t* kc = p.kc + (size_t)(b * 2 + g) * 256 * 64; const bf16_t* vc = p.vc + (size_t)(b * 2 + g) * 256 * 64;
#pragma unroll
        for (int c = 0; c < 4; ++c) { att_stage(l3 + ATT_KC + c * 8192, kc + c * 4096, tid); att_stage(l3 + ATT_VC + c * 8192, vc + c * 4096, tid); }
    }
    bf16x8 qf[2];
#pragma unroll
    for (int ks = 0; ks < 2; ++ks) qf[ks] = *(const bf16x8*)(p.qn + r * 512 + (g * 4 + h) * 64 + ks * 32 + G * 8);
    const int c_lo = (t0 - 511 > 0 ? t0 - 511 : 0) >> 6;
    const int n_s = jt + 1, n_tot = n_s + (jt - c_lo + 1);
#define ATT_STAGE_CHUNK(idx) do { const int _i = (idx); const bool _w = _i >= n_s; const int _cj = _w ? c_lo + (_i - n_s) : _i; \
        att_stage(l3 + ATT_KB + (_i & 3) * 8192, (_w ? p.kw : p.ks) + kvbase + (size_t)_cj * 4096, tid); \
        att_stage(l3 + ATT_VB + (_i & 3) * 8192, (_w ? p.vw : p.vs) + kvbase + (size_t)_cj * 4096, tid); } while (0)
    ATT_STAGE_CHUNK(0); ATT_STAGE_CHUNK(1);
    if (n_tot > 2) { ATT_STAGE_CHUNK(2); asm volatile("s_waitcnt vmcnt(6)" ::: "memory"); }
    else asm volatile("s_waitcnt vmcnt(4)" ::: "memory");
    asm volatile("s_waitcnt lgkmcnt(0)" ::: "memory"); __builtin_amdgcn_s_barrier(); asm volatile("" ::: "memory");
    f32x4 oc[4];
#pragma unroll
    for (int dt = 0; dt < 4; ++dt) oc[dt] = (f32x4){0.f, 0.f, 0.f, 0.f};
    unsigned long long mymask;
    unsigned long long unionmask;
    {
        f32x4 sr[4][4];
#pragma unroll
        for (int c = 0; c < 4; ++c) att_qk(l3 + ATT_KC + c * 8192, qf, koff, sr[c]);
        const int ncrow = t_row >= 31 ? (t_row - 31) / 16 + 1 : 0;
        float lsum = 0.f;
#pragma unroll
        for (int c = 0; c < 4; ++c)
#pragma unroll
            for (int tk = 0; tk < 4; ++tk)
#pragma unroll
                for (int rg = 0; rg < 4; ++rg) {
                    const int i = c * 64 + tk * 16 + G * 4 + rg;
                    const float pv = i < ncrow ? __builtin_amdgcn_exp2f(sr[c][tk][rg] * ATT_CS - shc) : 0.f;
                    sr[c][tk][rg] = pv; lsum += pv;
                }
        lsum += __shfl_xor(lsum, 16); lsum += __shfl_xor(lsum, 32);
        const float inv = lsum > 0.f ? 1.f / lsum : 0.f;
        float* sc = (float*)(lds + ATT_SC) + wave * 512;
        float* bs = sc + 256;
        float av[4][4];
#pragma unroll
        for (int c = 0; c < 4; ++c)
#pragma unroll
            for (int tk = 0; tk < 4; ++tk) {
#pragma unroll
                for (int rg = 0; rg < 4; ++rg) sr[c][tk][rg] *= inv;
                float a = 2.f * (sr[c][tk][0] + sr[c][tk][1] + sr[c][tk][2]) + sr[c][tk][3], b3 = sr[c][tk][3];
                a += __builtin_bit_cast(float, __builtin_amdgcn_mov_dpp(__builtin_bit_cast(int, a), 0xB1, 0xF, 0xF, true));
                a += __builtin_bit_cast(float, __builtin_amdgcn_mov_dpp(__builtin_bit_cast(int, a), 0x4E, 0xF, 0xF, true));
                b3 += __builtin_bit_cast(float, __builtin_amdgcn_mov_dpp(__builtin_bit_cast(int, b3), 0xB1, 0xF, 0xF, true));
                b3 += __builtin_bit_cast(float, __builtin_amdgcn_mov_dpp(__builtin_bit_cast(int, b3), 0x4E, 0xF, 0xF, true));
                av[c][tk] = a;
                if (h == 0) bs[qi * 64 + (c * 4 + tk) * 4 + G] = b3;
            }
        WSYNC();
#pragma unroll
        for (int c = 0; c < 4; ++c)
#pragma unroll
            for (int tk = 0; tk < 4; ++tk) {
                const int j = (c * 4 + tk) * 4 + G;
                const float pr = j > 0 ? bs[qi * 64 + j - 1] : 0.f;
                const bool valid = j * 64 <= t_row, forced = (j == 0) || (j == jt) || (j == jt - 1);
                if (h == 0) sc[qi * 64 + j] = valid ? (forced ? 1e4f : av[c][tk] + pr) : -1e30f;
            }
#pragma unroll
        for (int c = 0; c < 4; ++c) att_pv(l3 + ATT_VC + c * 8192, sr[c], voff, oc);
        WSYNC();
        unsigned long long mq[4];
        {
            float sj[4]; int rank[4] = {0, 0, 0, 0};
#pragma unroll
            for (int q = 0; q < 4; ++q) sj[q] = sc[q * 64 + lane];
#pragma unroll 2
            for (int jp = 0; jp <= jt; ++jp) {
                const bool lower = jp < lane;
#pragma unroll
                for (int q = 0; q < 4; ++q) {
                    const float v = __builtin_bit_cast(float, __builtin_amdgcn_readlane(__builtin_bit_cast(int, sj[q]), jp));
                    rank[q] += (v > sj[q] || (v == sj[q] && lower)) ? 1 : 0;
                }
            }
#pragma unroll
            for (int q = 0; q < 4; ++q) mq[q] = __ballot(rank[q] < 16 && lane * 64 <= tq0 + q);
        }
        unionmask = mq[0] | mq[1] | mq[2] | mq[3];
        mymask = qi == 0 ? mq[0] : qi == 1 ? mq[1] : qi == 2 ? mq[2] : mq[3];
        WSYNC();
    }
    f32x4 os[4], ow[4];
#pragma unroll
    for (int dt = 0; dt < 4; ++dt) { os[dt] = (f32x4){0.f, 0.f, 0.f, 0.f}; ow[dt] = (f32x4){0.f, 0.f, 0.f, 0.f}; }
    float ls = 0.f, lw = 0.f;
    for (int it = 0; it < n_tot; ++it) {
        if (it + 2 < n_tot) asm volatile("s_waitcnt vmcnt(4)" ::: "memory");
        else if (it + 1 < n_tot) asm volatile("s_waitcnt vmcnt(2)" ::: "memory");
        else asm volatile("s_waitcnt vmcnt(0)" ::: "memory");
        asm volatile("s_waitcnt lgkmcnt(0)" ::: "memory"); __builtin_amdgcn_s_barrier(); asm volatile("" ::: "memory");
        if (it + 3 < n_tot) ATT_STAGE_CHUNK(it + 3);
        const LAS char* Kb = l3 + ATT_KB + (it & 3) * 8192; const LAS char* Vb = l3 + ATT_VB + (it & 3) * 8192;
        if (it < n_s) {
            const int j = it;
            if ((unionmask >> j) & 1ull) {
                f32x4 st[4];
                att_qk(Kb, qf, koff, st);
                const float nb = ((mymask >> j) & 1ull) ? -shs : ATT_NEG;
                if (j == jt) {
                    asm volatile("" ::: "memory");
#pragma unroll
                    for (int tk = 0; tk < 4; ++tk)
#pragma unroll
                        for (int rg = 0; rg < 4; ++rg) { const int pos = j * 64 + tk * 16 + G * 4 + rg; if (pos > t_row) st[tk][rg] = ATT_NEG; }
                }
                att_exp(st, nb, ls);
                att_pv(Vb, st, voff, os);
            }
        } else {
            const int cj = c_lo + (it - n_s);
            f32x4 st[4];
            att_qk(Kb, qf, koff, st);
            if (cj * 64 + 63 > tq0 || cj * 64 <= tq0 + 3 - 512) {
                asm volatile("" ::: "memory");
#pragma unroll
                for (int tk = 0; tk < 4; ++tk)
#pragma unroll
                    for (int rg = 0; rg < 4; ++rg) { const int pos = cj * 64 + tk * 16 + G * 4 + rg; if (!(pos <= t_row && pos > t_row - 512)) st[tk][rg] = ATT_NEG; }
            }
            att_exp(st, -shw, lw);
            att_pv(Vb, st, voff, ow);
        }
    }
#undef ATT_STAGE_CHUNK
    ls += __shfl_xor(ls, 16); ls += __shfl_xor(ls, 32);
    lw += __shfl_xor(lw, 16); lw += __shfl_xor(lw, 32);
    const float* gt = p.gates + r * 24 + g * 12 + h * 3;
    const float g0 = gt[0], g1 = gt[1] / ls, g2 = gt[2] / lw;
    const int colb = (g * 4 + h) * 64;
    uint2 gavv[4];
#pragma unroll
    for (int dt = 0; dt < 4; ++dt) gavv[dt] = *(const uint2*)(p.ga + r * 512 + colb + dt * 16 + G * 4);
#pragma unroll
    for (int dt = 0; dt < 4; ++dt) {
        const int d = dt * 16 + G * 4;
        const uint2 gav = gavv[dt];
        float v[4];
#pragma unroll
        for (int rg = 0; rg < 4; ++rg) v[rg] = g0 * oc[dt][rg] + g1 * os[dt][rg] + g2 * ow[dt][rg];
        v[0] *= __uint_as_float(gav.x << 16); v[1] *= __uint_as_float(gav.x & 0xffff0000u);
        v[2] *= __uint_as_float(gav.y << 16); v[3] *= __uint_as_float(gav.y & 0xffff0000u);
        uint2 o; o.x = cvt_pk_bf16(v[0], v[1]); o.y = cvt_pk_bf16(v[2], v[3]);
        *(uint2*)(p.yar + r * 1024 + colb + d) = o;
    }
}

__device__ __forceinline__ void dot4(const float* qs, const bf16_t* kr, float (&s)[4]) {
    uint4 raw[8];
#pragma unroll
    for (int c = 0; c < 8; ++c) raw[c] = *(const uint4*)(kr + c * 8);
#pragma unroll
    for (int c = 0; c < 8; ++c) {
        float kf[8];
        kf[0] = __uint_as_float(raw[c].x << 16); kf[1] = __uint_as_float(raw[c].x & 0xffff0000u); kf[2] = __uint_as_float(raw[c].y << 16); kf[3] = __uint_as_float(raw[c].y & 0xffff0000u);
        kf[4] = __uint_as_float(raw[c].z << 16); kf[5] = __uint_as_float(raw[c].z & 0xffff0000u); kf[6] = __uint_as_float(raw[c].w << 16); kf[7] = __uint_as_float(raw[c].w & 0xffff0000u);
#pragma unroll
        for (int hh = 0; hh < 4; ++hh)
#pragma unroll
            for (int j = 0; j < 8; ++j) s[hh] += qs[hh * 64 + c * 8 + j] * kf[j];
    }
}
__device__ __forceinline__ void att_sample_unit(const Params& p, char* lds, int b, int g) {
    const int tid = opaque_tid(), lane = tid & 63, wave = tid >> 6;
    float* L = (float*)lds;
    float* qs = L;
    float* ps = L + 256;
    float* sc = L + 1296;
    int* sel = (int*)(L + 1568);
    float* red = L + 1600;
    float* part = L + 1664;
    float* pl = L + 1664 + 8 * 3 * 4 * 66 + wave * 256;
    const size_t r = TP + b;
    __syncthreads();
    if (tid < 256) qs[tid] = bf2f(p.qn[r * 512 + g * 256 + tid]);
    for (int i = tid; i < 1040; i += NT) ps[i] = 0.f;
    __syncthreads();
    const bf16_t* kc = p.kcs + (size_t)(b * 2 + g) * 1024 * 64; const bf16_t* vc = p.vcs + (size_t)(b * 2 + g) * 1024 * 64;
    const int n_c = 1023;
    float m1[4] = {-1e30f, -1e30f, -1e30f, -1e30f}, l1[4] = {0.f, 0.f, 0.f, 0.f};
    for (int cc = 0; cc < 2; ++cc) {
        const int i = wave * 128 + cc * 64 + lane; const bool valid = i < n_c;
        float s[4] = {0.f, 0.f, 0.f, 0.f};
        if (valid) dot4(qs, kc + (size_t)i * 64, s);
#pragma unroll
        for (int hh = 0; hh < 4; ++hh) {
            const float sv = valid ? s[hh] * 0.125f : -1e30f;
            const float mn = fmaxf(m1[hh], wave_max(sv));
            l1[hh] = l1[hh] * __expf(m1[hh] - mn) + wave_sum(valid ? __expf(sv - mn) : 0.f); m1[hh] = mn;
        }
    }
    if (lane == 0) {
#pragma unroll
        for (int hh = 0; hh < 4; ++hh) { red[wave * 8 + hh] = m1[hh]; red[wave * 8 + 4 + hh] = l1[hh]; }
    }
    __syncthreads();
    float M[4], Ls[4];
#pragma unroll
    for (int hh = 0; hh < 4; ++hh) {
        float mm = -1e30f;
        for (int w = 0; w < 8; ++w) mm = fmaxf(mm, red[w * 8 + hh]);
        float ll = 0.f;
        for (int w = 0; w < 8; ++w) ll += red[w * 8 + 4 + hh] * __expf(red[w * 8 + hh] - mm);
        M[hh] = mm; Ls[hh] = ll;
    }
    float oc[4] = {0.f, 0.f, 0.f, 0.f};
    for (int cc = 0; cc < 2; ++cc) {
        const int i0 = wave * 128 + cc * 64, i = i0 + lane; const bool valid = i < n_c;
        float s[4] = {0.f, 0.f, 0.f, 0.f};
        if (valid) dot4(qs, kc + (size_t)i * 64, s);
        float psum = 0.f;
#pragma unroll
        for (int hh = 0; hh < 4; ++hh) { const float pv = valid ? __expf(s[hh] * 0.125f - M[hh]) / Ls[hh] : 0.f; pl[hh * 64 + lane] = pv; psum += pv; }
        if (valid) ps[1 + i] = psum;
        WSYNC();
        const int nk = min(64, n_c - i0);
#pragma unroll 64
        for (int kk = 0; kk < 64; ++kk) {
            const float vv = bf2f(vc[(size_t)(i0 + (kk < nk ? kk : 0)) * 64 + lane]);
#pragma unroll
            for (int hh = 0; hh < 4; ++hh) oc[hh] += pl[hh * 64 + kk] * vv;
        }
        WSYNC();
    }
    __syncthreads();
    if (tid < 257) {
        const int t = PAST, jt = t >> 6, j = tid;
        float imp = 0.f;
#pragma unroll
        for (int rr = 0; rr < 4; ++rr) imp += ps[4 * j + rr + 1] + ps[4 * j + rr];
        const bool valid = j * 64 <= t, forced = (j == 0) || (j == jt) || (j == jt - 1);
        sc[j] = valid ? (forced ? 1e4f : imp) : -1e30f;
    }
    __syncthreads();
    if (tid < 257) {
        const float v = sc[tid];
        int rank = 0;
#pragma unroll 8
        for (int i = 0; i < 257; ++i) { const float u = sc[i]; rank += (u > v || (u == v && i < tid)) ? 1 : 0; }
        if (rank < 16) sel[rank] = tid;
    }
    __syncthreads();
    float msv[4] = {-1e30f, -1e30f, -1e30f, -1e30f}, lsv[4] = {0.f, 0.f, 0.f, 0.f}, osv[4] = {0.f, 0.f, 0.f, 0.f};
    for (int k = 2 * wave; k < 2 * wave + 2; ++k) {
        const int j = sel[k];
        if (j * 64 > PAST) continue;
        const bool valid = j * 64 + lane <= PAST;
        if (j == 256) attend64<float>(qs, pl, p.s_slc + (size_t)b * 256 + g * 64, p.s_slc + (size_t)b * 256 + 128 + g * 64, 256, valid, lane, msv, lsv, osv);
        else {
            const int pg = p.page_table[b * NPAGES + (j >> 1)];
            const float* base = p.cache_slc + (((size_t)pg * 128 + (j & 1) * 64) * 4 + g) * 64;
            attend64<float>(qs, pl, base, base + 128, 256, valid, lane, msv, lsv, osv);
        }
    }
    float mwv[4] = {-1e30f, -1e30f, -1e30f, -1e30f}, lwv[4] = {0.f, 0.f, 0.f, 0.f}, owv[4] = {0.f, 0.f, 0.f, 0.f};
    {
        const float* base = p.s_win + ((size_t)b * 512 + wave * 64) * 256 + g * 64;
        attend64<float>(qs, pl, base, base + 128, 256, true, lane, mwv, lwv, owv);
    }
#pragma unroll
    for (int hh = 0; hh < 4; ++hh) {
        float* pc = part + ((wave * 3 + 0) * 4 + hh) * 66; pc[lane] = oc[hh];
        float* pS = part + ((wave * 3 + 1) * 4 + hh) * 66; pS[lane] = osv[hh]; if (lane == 0) { pS[64] = msv[hh]; pS[65] = lsv[hh]; }
        float* pw = part + ((wave * 3 + 2) * 4 + hh) * 66; pw[lane] = owv[hh]; if (lane == 0) { pw[64] = mwv[hh]; pw[65] = lwv[hh]; }
    }
    __syncthreads();
    if (tid < 256) {
        const int hh = tid >> 6, d = tid & 63;
        float c = 0.f;
        for (int w = 0; w < 8; ++w) c += part[((w * 3 + 0) * 4 + hh) * 66 + d];
        float res[2];
#pragma unroll
        for (int br = 1; br < 3; ++br) {
            float mm = -1e30f;
            for (int w = 0; w < 8; ++w) mm = fmaxf(mm, part[((w * 3 + br) * 4 + hh) * 66 + 64]);
            float num = 0.f, den = 0.f;
            for (int w = 0; w < 8; ++w) { const float* q = part + ((w * 3 + br) * 4 + hh) * 66; const float e = __expf(q[64] - mm); num += q[d] * e; den += q[65] * e; }
            res[br - 1] = num / den;
        }
        const float* gt = p.gates + r * 24 + g * 12 + hh * 3;
        const int col = (g * 4 + hh) * 64 + d;
        p.yar[r * 1024 + col] = f2bf((gt[0] * c + gt[1] * res[0] + gt[2] * res[1]) * bf2f(p.ga[r * 512 + col]));
    }
    __syncthreads();
}

__device__ __forceinline__ void ret_out_item(const Params& p, char* lds, int it);
__device__ __forceinline__ void att_phase(const Params& p, char* lds, int bid, int nblk) {
    const int x = bid & 7;
    unsigned* ctr = p.bar + 3584 + 64 * x;
    volatile int* slot = (volatile int*)(lds + 147456 + 16);
    const int tid = opaque_tid();
    for (;;) {
        __syncthreads();
        if (tid == 0) *slot = (int)__hip_atomic_fetch_add(ctr, 1u, __ATOMIC_RELAXED, __HIP_MEMORY_SCOPE_AGENT);
        __syncthreads();
        const int w = *slot;
        if (w >= 136) break;
        if (w < 8) att_sample_unit(p, lds, 4 * x + (w >> 1), w & 1);
        else att_prompt_unit(p, lds, x >> 1, x & 1, 127 - (w - 8));
    }
}
__device__ __forceinline__ void ret_out_queue(const Params& p, char* lds, int bid, int nblk) {
    const int x = bid & 7;
    unsigned* ctr = p.bar + 3584 + 64 * x + 16;
    volatile int* slot = (volatile int*)(lds + 147456 + 16);
    const int tid = opaque_tid();
    wg_wait(p.bar + 3456, (unsigned)nblk, p.bar + XB_TMO);
    for (;;) {
        __syncthreads();
        if (tid == 0) *slot = (int)__hip_atomic_fetch_add(ctr, 1u, __ATOMIC_RELAXED, __HIP_MEMORY_SCOPE_AGENT);
        __syncthreads();
        const int w = *slot;
        if (w >= 80) break;
        ret_out_item(p, lds, x + 8 * w);
    }
}

__device__ __forceinline__ float ret_gamma(int h) { return 1.f - exp2f(-5.f - (float)h); }

__device__ __forceinline__ void p6a_local(const Params& p, int bid, int nblk) {
    const int tid = opaque_tid();
    const int e = tid & 127, dg = tid >> 7;
    for (int it = bid; it < 4 * 4 * 32; it += nblk) {
        const int n = it & 31, h = (it >> 5) & 3, b = it >> 7;
        const float lg = __logf(ret_gamma(h));
        float acc[16];
#pragma unroll
        for (int i = 0; i < 16; ++i) acc[i] = 0.f;
        for (int j = 0; j < 128; ++j) {
            const size_t r = (size_t)b * SEQ + n * 128 + j;
            const float z = __expf(lg * (float)(127 - j));
            const float v = bf2f(p.rv[r * 512 + h * 128 + e]) * z;
            const bf16_t* kr = p.rk + r * 256 + h * 64 + dg * 16;
#pragma unroll
            for (int i = 0; i < 16; ++i) acc[i] += bf2f(kr[i]) * v;
        }
        float* out = p.sloc + ((size_t)it * 64 + dg * 16) * 128 + e;
#pragma unroll
        for (int i = 0; i < 16; ++i) out[i * 128] = acc[i];
    }
}
__device__ __forceinline__ void p6b_scan(const Params& p, int bid, int nblk) {
    const size_t gt = (size_t)bid * NT + threadIdx.x, ngt = (size_t)nblk * NT;
    for (size_t i = gt; i < (size_t)16 * 8192; i += ngt) {
        const int bh = (int)(i >> 13), el = (int)(i & 8191), h = bh & 3;
        const float gc = __expf(__logf(ret_gamma(h)) * 128.f);
        float S = 0.f, lv[32];
#pragma unroll
        for (int n = 0; n < 32; ++n) lv[n] = p.sloc[((size_t)bh * 32 + n) * 8192 + el];
#pragma unroll
        for (int n = 0; n < 32; ++n) {
            p.spre[((size_t)bh * 32 + n) * 8192 + el] = S;
            S = S * gc + lv[n];
        }
        p.p_ret[(size_t)bh * 8192 + el] = S;
    }
    {
        constexpr int NS = 128 * 8192;
        const int gti = (int)gt, ngti = (int)ngt;
#define SR_LD(j) const int sx##j = ib + j * ngti, sc##j = sx##j < NS ? sx##j : NS - 1, bh##j = sc##j >> 13, el##j = sc##j & 8191; const float st##j = p.state_ret[sc##j]; \
        const bf16_t kk##j = p.rk[(size_t)(TP + (bh##j >> 2)) * 256 + (bh##j & 3) * 64 + (el##j >> 7)], vv##j = p.rv[(size_t)(TP + (bh##j >> 2)) * 512 + (bh##j & 3) * 128 + (el##j & 127)];
#define SR_ST(j) if (sx##j < NS) p.s_ret[sx##j] = st##j * ret_gamma(bh##j & 3) + bf2f(kk##j) * bf2f(vv##j);
        for (int ib = gti; ib < NS; ib += 8 * ngti) {
            SR_LD(0) SR_LD(1) SR_LD(2) SR_LD(3) SR_LD(4) SR_LD(5) SR_LD(6) SR_LD(7)
            SR_ST(0) SR_ST(1) SR_ST(2) SR_ST(3) SR_ST(4) SR_ST(5) SR_ST(6) SR_ST(7)
        }
#undef SR_LD
#undef SR_ST
    }
}
__device__ __forceinline__ void p6c_out(const Params& p, char* lds, int bid, int nblk) {
    float* Am = (float*)lds;
    const int tid = opaque_tid();
    for (int it = bid; it < 4 * 4 * 32 + 128; it += nblk) {
        if (it < 512) {
            const int n = it & 31, h = (it >> 5) & 3, b = it >> 7;
            const float lg = __logf(ret_gamma(h));
            const size_t r0 = (size_t)b * SEQ + n * 128;
            for (int idx = tid; idx < 128 * 128; idx += NT) {
                const int i = idx >> 7, j = idx & 127;
                float a = 0.f;
                if (j <= i) {
                    const bf16_t* qr = p.rq + (r0 + i) * 256 + h * 64; const bf16_t* kr = p.rk + (r0 + j) * 256 + h * 64;
#pragma unroll
                    for (int c = 0; c < 8; ++c) { float qf[8], kf[8]; load8(qr + c * 8, qf); load8(kr + c * 8, kf);
#pragma unroll
                        for (int u = 0; u < 8; ++u) a += qf[u] * kf[u]; }
                    a *= __expf(lg * (float)(i - j));
                }
                Am[i * 129 + j] = a;
            }
            __syncthreads();
            const int e = tid & 127, ig = tid >> 7;
            const float* S = p.spre + (size_t)it * 8192;
            for (int i = ig * 32; i < ig * 32 + 32; ++i) {
                float o = 0.f;
                for (int j = 0; j <= i; ++j) o += Am[i * 129 + j] * bf2f(p.rv[(r0 + j) * 512 + h * 128 + e]);
                float qs = 0.f;
                const bf16_t* qr = p.rq + (r0 + i) * 256 + h * 64;
                for (int d = 0; d < 64; ++d) qs += bf2f(qr[d]) * S[d * 128 + e];
                o += qs * __expf(lg * (float)(i + 1));
                p.oret[(r0 + i) * 512 + h * 128 + e] = o;
            }
            __syncthreads();
        } else {
            const int bh = it - 512, h = bh & 3, b = bh >> 2;
            const size_t r = TP + b;
            if (tid < 128) {
                const int e = tid;
                const bf16_t* qr = p.rq + r * 256 + h * 64; const bf16_t* kr = p.rk + r * 256 + h * 64;
                const float* S0 = p.state_ret + (size_t)bh * 8192;
                float qs = 0.f, qk = 0.f;
                for (int d = 0; d < 64; ++d) { const float q = bf2f(qr[d]); qs += q * S0[d * 128 + e]; qk += q * bf2f(kr[d]); }
                p.oret[r * 512 + h * 128 + e] = qs * ret_gamma(h) + qk * bf2f(p.rv[r * 512 + h * 128 + e]);
            }
        }
    }
}
__device__ __forceinline__ void p6d_norm(const Params& p, int bid, int nblk) {
    const int tid = opaque_tid(), lane = tid & 63, wave = tid >> 6;
    for (int it = bid * 8 + wave; it < R * 4; it += nblk * 8) {
        const int r = it >> 2, h = it & 3;
        const float* o = p.oret + (size_t)r * 512 + h * 128;
        const float v0 = o[lane], v1 = o[lane + 64];
        const float rs = rsqrtf(wave_sum(v0 * v0 + v1 * v1) * (1.f / 128.f) + EPS);
        p.yar[(size_t)r * 1024 + 512 + h * 128 + lane] = f2bf(v0 * rs * p.g_ret[lane] * bf2f(p.gr[(size_t)r * 512 + h * 128 + lane]));
        p.yar[(size_t)r * 1024 + 512 + h * 128 + lane + 64] = f2bf(v1 * rs * p.g_ret[lane + 64] * bf2f(p.gr[(size_t)r * 512 + h * 128 + lane + 64]));
    }
}


__device__ __forceinline__ void ret_stage(LAS char* dst, const bf16_t* src, size_t row_stride, int lg_slots, int npieces, int tid) {
    for (int pc = tid; pc < npieces; pc += NT) {
        const int row = pc >> lg_slots, slot = pc & ((1 << lg_slots) - 1);
        __builtin_amdgcn_global_load_lds((const unsigned*)(src + (size_t)row * row_stride + ((slot ^ (row & 7)) * 8)), (LAS unsigned*)(dst + pc * 16), 16, 0, 0);
    }
}
__device__ __forceinline__ s16x4 ret_tr(const LAS char* img, int RB, int r0, int c0, int fr) {
    const int row = r0 + (fr >> 2), chunk = (c0 >> 3) + ((fr & 3) >> 1);
    return __builtin_amdgcn_ds_read_tr16_b64_v4i16((LAS s16x4*)(img + row * RB + ((chunk ^ (row & 7)) * 16) + (fr & 1) * 8));
}
__device__ __forceinline__ bf16x8 cat8(s16x4 a, s16x4 b) { bf16x8 v; v[0] = a[0]; v[1] = a[1]; v[2] = a[2]; v[3] = a[3]; v[4] = b[0]; v[5] = b[1]; v[6] = b[2]; v[7] = b[3]; return v; }

__device__ __forceinline__ void ret_local_item(const Params& p, char* lds, int it) {
    LAS char* l3 = (LAS char*)lds;
    const int tid = opaque_tid(), lane = tid & 63, wave = tid >> 6, fr = lane & 15, G = lane >> 4;
    {
        const int n = it & 31, h = (it >> 5) & 3, b = it >> 7;
        const size_t r0 = (size_t)b * SEQ + n * 128;
        __syncthreads();
        ret_stage(l3, p.rk + r0 * 256 + h * 64, 256, 3, 1024, tid);
        ret_stage(l3 + 16384, p.rv + r0 * 512 + h * 128, 512, 4, 2048, tid);
        asm volatile("s_waitcnt vmcnt(0)" ::: "memory");
        __syncthreads();
        f32x4 acc[4];
#pragma unroll
        for (int dt = 0; dt < 4; ++dt) acc[dt] = (f32x4){0.f, 0.f, 0.f, 0.f};
#pragma unroll
        for (int js = 0; js < 4; ++js) {
            const int j0 = js * 32 + 4 * G;
            const bf16x8 bfr = cat8(ret_tr(l3 + 16384, 256, j0, wave * 16, fr), ret_tr(l3 + 16384, 256, j0 + 16, wave * 16, fr));
#pragma unroll
            for (int dt = 0; dt < 4; ++dt) {
                const bf16x8 afr = cat8(ret_tr(l3, 128, j0, dt * 16, fr), ret_tr(l3, 128, j0 + 16, dt * 16, fr));
                acc[dt] = __builtin_amdgcn_mfma_f32_16x16x32_bf16(afr, bfr, acc[dt], 0, 0, 0);
            }
        }
        const float sc = exp2f(__log2f(ret_gamma(h)) * 127.f);
        float* out = p.sloc + (size_t)it * 8192 + wave * 16 + fr;
#pragma unroll
        for (int dt = 0; dt < 4; ++dt)
#pragma unroll
            for (int rg = 0; rg < 4; ++rg) out[(dt * 16 + 4 * G + rg) * 128] = acc[dt][rg] * sc;
    }
}

__device__ __forceinline__ void ret_out_item(const Params& p, char* lds, int it) {
    LAS char* l3 = (LAS char*)lds;
    const int tid = opaque_tid(), lane = tid & 63, wave = tid >> 6, fr = lane & 15, G = lane >> 4;
    {
        __syncthreads();
        if (it < 512) {
            const int n = it & 31, h = (it >> 5) & 3, b = it >> 7;
            const size_t r0 = (size_t)b * SEQ + n * 128;
            const float gam = ret_gamma(h);
            ret_stage(l3, p.rk + r0 * 256 + h * 64, 256, 3, 1024, tid);
            ret_stage(l3 + 16384, p.rv + r0 * 512 + h * 128, 512, 4, 2048, tid);
            {
                const float* S = p.spre + (size_t)it * 8192;
                for (int pc = tid; pc < 1024; pc += NT) {
                    const int row = pc >> 4, slot = pc & 15;
                    const float4 a = *(const float4*)(S + row * 128 + slot * 8), c = *(const float4*)(S + row * 128 + slot * 8 + 4);
                    u32x4 v; v[0] = cvt_pk_bf16(a.x * gam, a.y * gam); v[1] = cvt_pk_bf16(a.z * gam, a.w * gam); v[2] = cvt_pk_bf16(c.x * gam, c.y * gam); v[3] = cvt_pk_bf16(c.z * gam, c.w * gam);
                    *(LAS u32x4*)(l3 + 49152 + row * 256 + ((slot ^ (row & 7)) * 16)) = v;
                }
            }
            const size_t ri = r0 + wave * 16 + fr;
            bf16x8 qf[2], qp[2];
#pragma unroll
            for (int ks = 0; ks < 2; ++ks) {
                const bf16_t* qrow = p.rq + ri * 256 + h * 64 + ks * 32;
                qf[ks] = *(const bf16x8*)(qrow + G * 8);
                const s16x4 lo = *(const s16x4*)(qrow + 4 * G), hi = *(const s16x4*)(qrow + 16 + 4 * G);
                qp[ks] = cat8(lo, hi);
            }
            asm volatile("s_waitcnt vmcnt(0)" ::: "memory");
            __syncthreads();
            f32x4 st[8];
#pragma unroll
            for (int jt = 0; jt < 8; ++jt) {
                st[jt] = (f32x4){0.f, 0.f, 0.f, 0.f};
                if (jt <= wave) {
#pragma unroll
                    for (int ks = 0; ks < 2; ++ks) {
                        const int row = jt * 16 + fr;
                        const bf16x8 kf = *(const LAS bf16x8*)(l3 + row * 128 + (((ks * 4 + G) ^ (row & 7)) * 16));
                        st[jt] = __builtin_amdgcn_mfma_f32_16x16x32_bf16(kf, qf[ks], st[jt], 0, 0, 0);
                    }
                    if (jt == wave) {
#pragma unroll
                        for (int rg = 0; rg < 4; ++rg) if (4 * G + rg > fr) st[jt][rg] = 0.f;
                    }
                }
            }
            f32x4 o[8];
#pragma unroll
            for (int et = 0; et < 8; ++et) o[et] = (f32x4){0.f, 0.f, 0.f, 0.f};
#pragma unroll
            for (int js = 0; js < 4; ++js) {
                if (2 * js <= wave) {
                    u32x4 pk;
                    pk[0] = cvt_pk_bf16(st[2 * js][0], st[2 * js][1]); pk[1] = cvt_pk_bf16(st[2 * js][2], st[2 * js][3]);
                    pk[2] = cvt_pk_bf16(st[2 * js + 1][0], st[2 * js + 1][1]); pk[3] = cvt_pk_bf16(st[2 * js + 1][2], st[2 * js + 1][3]);
                    const bf16x8 pf = __builtin_bit_cast(bf16x8, pk);
                    const int j0 = js * 32 + 4 * G;
#pragma unroll
                    for (int et = 0; et < 8; ++et) {
                        const bf16x8 vf = cat8(ret_tr(l3 + 16384, 256, j0, et * 16, fr), ret_tr(l3 + 16384, 256, j0 + 16, et * 16, fr));
                        o[et] = __builtin_amdgcn_mfma_f32_16x16x32_bf16(vf, pf, o[et], 0, 0, 0);
                    }
                }
            }
#pragma unroll
            for (int ks = 0; ks < 2; ++ks) {
                const int d0 = ks * 32 + 4 * G;
#pragma unroll
                for (int et = 0; et < 8; ++et) {
                    const bf16x8 sf = cat8(ret_tr(l3 + 49152, 256, d0, et * 16, fr), ret_tr(l3 + 49152, 256, d0 + 16, et * 16, fr));
                    o[et] = __builtin_amdgcn_mfma_f32_16x16x32_bf16(sf, qp[ks], o[et], 0, 0, 0);
                }
            }
            float ss = 0.f;
#pragma unroll
            for (int et = 0; et < 8; ++et)
#pragma unroll
                for (int rg = 0; rg < 4; ++rg) ss += o[et][rg] * o[et][rg];
            ss += __shfl_xor(ss, 16); ss += __shfl_xor(ss, 32);
            const float rs = rsqrtf(ss * (1.f / 128.f) + EPS);
            float4 grv[8]; uint2 gvv[8];
#pragma unroll
            for (int et = 0; et < 8; ++et) { const int e = et * 16 + 4 * G; grv[et] = *(const float4*)(p.g_ret + e); gvv[et] = *(const uint2*)(p.gr + ri * 512 + h * 128 + e); }
#pragma unroll
            for (int et = 0; et < 8; ++et) {
                const int e = et * 16 + 4 * G;
                const float4 gr = grv[et];
                const uint2 gv = gvv[et];
                uint2 ov;
                ov.x = cvt_pk_bf16(o[et][0] * rs * gr.x * __uint_as_float(gv.x << 16), o[et][1] * rs * gr.y * __uint_as_float(gv.x & 0xffff0000u));
                ov.y = cvt_pk_bf16(o[et][2] * rs * gr.z * __uint_as_float(gv.y << 16), o[et][3] * rs * gr.w * __uint_as_float(gv.y & 0xffff0000u));
                *(uint2*)(p.yar + ri * 1024 + 512 + h * 128 + e) = ov;
            }
        } else {
            const int bh = it - 512, h = bh & 3, b = bh >> 2;
            const size_t r = TP + b;
            float* red = (float*)lds;
            float o = 0.f;
            if (tid < 128) {
                const int e = tid;
                const bf16_t* qr = p.rq + r * 256 + h * 64; const bf16_t* kr = p.rk + r * 256 + h * 64;
                const float* S0 = p.state_ret + (size_t)bh * 8192;
                float qs = 0.f, qk = 0.f;
                for (int d = 0; d < 64; ++d) { const float q = bf2f(qr[d]); qs += q * S0[d * 128 + e]; qk += q * bf2f(kr[d]); }
                o = qs * ret_gamma(h) + qk * bf2f(p.rv[r * 512 + h * 128 + e]);
                const float s2 = wave_sum(o * o);
                if (lane == 0) red[wave] = s2;
            }
            __syncthreads();
            if (tid < 128) {
                const float rs = rsqrtf((red[0] + red[1]) * (1.f / 128.f) + EPS);
                p.yar[r * 1024 + 512 + h * 128 + tid] = f2bf(o * rs * p.g_ret[tid] * bf2f(p.gr[r * 512 + h * 128 + tid]));
            }
        }
    }
}

__device__ __forceinline__ void out_sample(const Params& p, char* lds, int bid, int nblk) {
    const int tid = opaque_tid(), lane = tid & 63, wave = tid >> 6, fr = lane & 15, G = lane >> 4;
    f32x4* part = (f32x4*)lds;
    for (int it = bid; it < 128; it += nblk) {
        const int mt = it >> 6, nt = it & 63;
        const bf16_t* arow = p.yar + (size_t)(TP + mt * 16 + fr) * 1024 + wave * 128 + G * 8;
        const bf16_t* brow = p.bt_out + (size_t)(nt * 16 + fr) * 1024 + wave * 128 + G * 8;
        bf16x8 a[4], b[4];
#pragma unroll
        for (int ks = 0; ks < 4; ++ks) { a[ks] = *(const bf16x8*)(arow + ks * 32); b[ks] = *(const bf16x8*)(brow + ks * 32); }
        const int c = nt * 16 + fr;
        float xv[4], gv[4];
        if (wave == 0) {
#pragma unroll
            for (int rg = 0; rg < 4; ++rg) { const int sb = mt * 16 + 4 * G + rg; xv[rg] = p.x_sample[(size_t)sb * 1024 + c]; gv[rg] = p.mod[(4 + sb) * 3072 + 2048 + c]; }
        }
        f32x4 acc = {0.f, 0.f, 0.f, 0.f};
#pragma unroll
        for (int ks = 0; ks < 4; ++ks) acc = __builtin_amdgcn_mfma_f32_16x16x32_bf16(a[ks], b[ks], acc, 0, 0, 0);
        __syncthreads();
        part[wave * 64 + lane] = acc;
        __syncthreads();
        if (wave == 0) {
            f32x4 tot = part[lane];
#pragma unroll
            for (int w = 1; w < 8; ++w) tot += part[w * 64 + lane];
#pragma unroll
            for (int rg = 0; rg < 4; ++rg) {
                const int sb = mt * 16 + 4 * G + rg;
                p.y[(size_t)(TP + sb) * 1024 + c] = xv[rg] + gv[rg] * tot[rg];
            }
        }
    }
}
__global__ void __launch_bounds__(NT, 2) k_mega(Params p) {
    extern __shared__ __attribute__((aligned(16))) char lds[];
    const int bid = blockIdx.x, nblk = gridDim.x;
    uint4* xbw = (uint4*)(lds + 147456);
    if (threadIdx.x == 0) *xbw = make_uint4(0u, 0u, 0u, 0u);
    __syncthreads();
    XcdBarrier bar = xcd_barrier_post(p.bar, (volatile LAS unsigned*)xbw);
    p0_w1p(p, bid, nblk); wg_signal(p.bar + 3536, true);
    p0_adaln(p, lds, bid, nblk); __syncthreads(); p0_weights(p, lds, bid, nblk); __syncthreads();
    wg_wait(p.bar + 3536, (unsigned)nblk, p.bar + XB_TMO);
    compress_sample(p, lds, bid, nblk);
    wg_wait(p.bar + 3520, 192u, p.bar + XB_TMO);
    p1_norm(p, lds, bid, nblk);
    xcd_barrier(bar);
    { EpiIn e{&p}; gemm_phase(p.H, p.bt_in, RPAD / 256, NPAD / 256, 1024, lds, bid, nblk, e); }
    if (nblk == 256) compress_seams(p, bid - 142, 114); else compress_seams(p, bid, nblk);
    xcd_barrier(bar);
    {
        volatile int* slot = (volatile int*)(lds + 147456 + 16);
        for (;;) {
            __syncthreads();
            if (threadIdx.x == 0) *slot = (int)__hip_atomic_fetch_add(p.bar + 3456 + 48, 1u, __ATOMIC_RELAXED, __HIP_MEMORY_SCOPE_AGENT);
            __syncthreads();
            const int w = *slot;
            if (w >= 136 + 512) break;
            if (w < 136) compress_prompt_ksplit_item(p, lds, w); else ret_local_item(p, lds, w - 136);
        }
    }
    xcd_barrier(bar);
    p6b_scan(p, bid, nblk); wg_signal(p.bar + 3456, true);
    att_phase(p, lds, bid, nblk);
    ret_out_queue(p, lds, bid, nblk);
    xcd_barrier(bar);
    { EpiOut e{&p}; gemm_phase(p.yar, p.bt_out, TP / 256, 4, 1024, lds, bid, nblk, e); }
    out_sample(p, lds, bid, nblk);
}
}

extern "C" void kernel_launch(void* const* d_in, const int* in_sizes, int n_in, void* d_out, int out_size, void* d_ws, size_t ws_size, hipStream_t stream) {
    Params p{};
    p.x_prompt = (const float*)d_in[0]; p.x_sample = (const float*)d_in[1]; p.c_prompt = (const float*)d_in[2]; p.c_sample = (const float*)d_in[3];
    p.cache_cmp = (const float*)d_in[4]; p.cache_slc = (const float*)d_in[5]; p.state_win = (const float*)d_in[6]; p.state_ret = (const float*)d_in[7];
    p.page_table = (const int*)d_in[8];
    p.g_norm = (const float*)d_in[9]; p.w_ada = (const float*)d_in[10]; p.b_ada = (const float*)d_in[11]; p.w_in = (const float*)d_in[12];
    p.g_q = (const float*)d_in[13]; p.g_kc = (const float*)d_in[14]; p.g_ks = (const float*)d_in[15]; p.g_kw = (const float*)d_in[16];
    p.pe_ck = (const float*)d_in[17]; p.w_ck1 = (const float*)d_in[18]; p.w_ck2 = (const float*)d_in[19];
    p.pe_cv = (const float*)d_in[20]; p.w_cv1 = (const float*)d_in[21]; p.w_cv2 = (const float*)d_in[22];
    p.g_ret = (const float*)d_in[23]; p.w_out = (const float*)d_in[24];
    float* o = (float*)d_out;
    p.y = o; o += (size_t)R * 1024;
    p.p_cmp = o; o += (size_t)TP * 256; p.p_slc = o; o += (size_t)TP * 256; p.p_win = o; o += (size_t)4 * 512 * 256; p.p_ret = o; o += (size_t)16 * 8192;
    p.s_cmp = o; o += 32 * 256; p.s_slc = o; o += 32 * 256; p.s_win = o; o += (size_t)32 * 512 * 256; p.s_ret = o; o += (size_t)128 * 8192;
    char* w = (char*)d_ws; size_t off = 0;
    auto take = [&](size_t bytes) { char* q = w + off; off += (bytes + 255) & ~(size_t)255; return q; };
    p.bar = (unsigned*)take(16384);
    p.mod = (float*)take(36 * 3072 * 4);
    p.bt_in = (bf16_t*)take((size_t)NPAD * 1024 * 2);
    p.bt_out = (bf16_t*)take((size_t)1024 * 1024 * 2);
    p.H = (bf16_t*)take((size_t)RPAD * 1024 * 2);
    p.praw = (float*)take((size_t)RPAD * NPAD * 4);
    p.qn = (bf16_t*)take((size_t)R * 512 * 2);
    p.kcr = (bf16_t*)take((size_t)TP * 128 * 2); p.vcr = (bf16_t*)take((size_t)TP * 128 * 2);
    p.ks = (bf16_t*)take((size_t)TP * 128 * 2); p.vs = (bf16_t*)take((size_t)TP * 128 * 2);
    p.kw = (bf16_t*)take((size_t)TP * 128 * 2); p.vw = (bf16_t*)take((size_t)TP * 128 * 2);
    p.gates = (float*)take((size_t)R * 24 * 4);
    p.ga = (bf16_t*)take((size_t)R * 512 * 2); p.gr = (bf16_t*)take((size_t)R * 512 * 2);
    p.rq = (bf16_t*)take((size_t)R * 256 * 2); p.rk = (bf16_t*)take((size_t)R * 256 * 2); p.rv = (bf16_t*)take((size_t)R * 512 * 2);
    p.kc = (bf16_t*)take((size_t)4 * 2 * 256 * 64 * 2); p.vc = (bf16_t*)take((size_t)4 * 2 * 256 * 64 * 2);
    p.kcs = (bf16_t*)take((size_t)32 * 2 * 1024 * 64 * 2); p.vcs = (bf16_t*)take((size_t)32 * 2 * 1024 * 64 * 2);
    p.yar = (bf16_t*)take((size_t)RPAD * 1024 * 2);
    p.sloc = (float*)take((size_t)512 * 8192 * 4); p.spre = (float*)take((size_t)512 * 8192 * 4);
    p.oret = (float*)take((size_t)R * 512 * 4);
    p.w1p = (bf16_t*)take((size_t)2 * 128 * 1024 * 2); p.w2t = (bf16_t*)take((size_t)2 * 64 * 64 * 2); p.b1 = (float*)take(128 * 4);
    p.attb = (float*)take(256);
    p.ropec = (float*)take((size_t)4097 * 32 * 4); p.ropes = (float*)take((size_t)4097 * 32 * 4);
    p.seamA = (float*)take((size_t)32 * 2 * 64 * 2 * 64 * 4); p.seamB = (float*)take((size_t)32 * 2 * 64 * 2 * 64 * 4);
    if (off > ws_size) { fprintf(stderr, "workspace too small: need %zu have %zu\n", off, ws_size); return; }
    static int grid = 0;
    if (grid == 0) {
        int dev = 0, cus = 0, per_cu = 0;
        if (hipGetDevice(&dev) != hipSuccess || hipDeviceGetAttribute(&cus, hipDeviceAttributeMultiprocessorCount, dev) != hipSuccess) { fprintf(stderr, "device query failed\n"); grid = -1; return; }
        if (hipFuncSetAttribute((const void*)k_mega, hipFuncAttributeMaxDynamicSharedMemorySize, LDS_BYTES) != hipSuccess) { fprintf(stderr, "hipFuncSetAttribute failed\n"); grid = -1; return; }
        if (hipOccupancyMaxActiveBlocksPerMultiprocessor(&per_cu, (const void*)k_mega, NT, LDS_BYTES) != hipSuccess || per_cu < 1) { fprintf(stderr, "occupancy query: %d blocks per CU\n", per_cu); grid = -1; return; }
        (void)hipGetLastError();
        grid = cus;
    }
    if (grid < 0) return;
    (void)hipMemsetAsync(p.bar, 0, 16384, stream);
    hipLaunchKernelGGL(k_mega, dim3(grid), dim3(NT), LDS_BYTES, stream, p);
}
```

```cpp
#include <hip/hip_runtime.h>
#include <stdint.h>
#include <stdio.h>

namespace {
typedef unsigned short bf16_t;
typedef short bf16x8 __attribute__((ext_vector_type(8)));
typedef float f32x4 __attribute__((ext_vector_type(4)));

constexpr int D_MODEL = 1024, BATCH = 4, SEQ = 4096, DEC_BATCH = 32, PAST = 16384;
constexpr int NPAGES = 128, NPHYS = 5120;
constexpr int TP = BATCH * SEQ;
constexpr int R = TP + DEC_BATCH;
constexpr int RPAD = 16640;
constexpr int D_IN = 3352, NPAD = 3584;
constexpr int C_Q = 0, C_KC = 512, C_KS = 768, C_KW = 1024, C_BR = 1280, C_GA = 1304, C_RQ = 1816, C_RK = 2072, C_RV = 2328, C_GR = 2840;
constexpr float EPS = 1e-6f;
constexpr int NT = 512;
constexpr int LDS_BYTES = 147456 + 64 + 8192 + 256;

struct Params {
    const float *x_prompt, *x_sample, *c_prompt, *c_sample, *cache_cmp, *cache_slc, *state_win, *state_ret;
    const int* page_table;
    const float *g_norm, *w_ada, *b_ada, *w_in, *g_q, *g_kc, *g_ks, *g_kw, *pe_ck, *w_ck1, *w_ck2, *pe_cv, *w_cv1, *w_cv2, *g_ret, *w_out;
    float *y, *p_cmp, *p_slc, *p_win, *p_ret, *s_cmp, *s_slc, *s_win, *s_ret;
    unsigned* bar;
    float* mod;
    bf16_t* bt_in;
    bf16_t* bt_out;
    bf16_t* H;
    float* praw;
    bf16_t* qn;
    bf16_t *kcr, *vcr, *ks, *vs, *kw, *vw;
    float* gates;
    bf16_t *ga, *gr;
    bf16_t *rq, *rk;
    bf16_t* rv;
    bf16_t *kc, *vc;
    bf16_t *kcs, *vcs;
    bf16_t* yar;
    float *sloc, *spre;
    float* oret;
    bf16_t* w1p;
    bf16_t* w2t;
    float* b1;
    float *seamA, *seamB;
    float* attb;
    float *ropec, *ropes;
};

__device__ __forceinline__ int tile_src(int pn) { return pn <= 4 ? pn * 256 : pn == 13 ? 1280 : 1304 + (pn - 5) * 256; }
__device__ __forceinline__ bf16_t f2bf(float f) { unsigned u = __float_as_uint(f); u += 0x7fffu + ((u >> 16) & 1u); return (bf16_t)(u >> 16); }
__device__ __forceinline__ float bf2f(bf16_t h) { return __uint_as_float(((unsigned)h) << 16); }
__device__ __forceinline__ float wave_sum(float v) {
#pragma unroll
    for (int o = 1; o < 64; o <<= 1) v += __shfl_xor(v, o);
    return v;
}
__device__ __forceinline__ float wave_max(float v) {
#pragma unroll
    for (int o = 1; o < 64; o <<= 1) v = fmaxf(v, __shfl_xor(v, o));
    return v;
}
__device__ __forceinline__ float silu(float v) { return v / (1.f + __expf(-v)); }
__device__ __forceinline__ float sigmoidf(float v) { return 1.f / (1.f + __expf(-v)); }
__device__ __forceinline__ int opaque_tid() { int t = threadIdx.x; asm volatile("" : "+v"(t)); return t; }
typedef __bf16 bf16x2_t __attribute__((ext_vector_type(2)));
typedef float f32x2_t __attribute__((ext_vector_type(2)));
__device__ __forceinline__ unsigned cvt_pk_bf16(float lo, float hi) { const f32x2_t v = {lo, hi}; return __builtin_bit_cast(unsigned, __builtin_convertvector(v, bf16x2_t)); }
#define WSYNC() asm volatile("s_waitcnt lgkmcnt(0)" ::: "memory")

__device__ __forceinline__ void load8(const bf16_t* p, float (&f)[8]) {
    uint4 u = *(const uint4*)p;
    f[0] = __uint_as_float(u.x << 16); f[1] = __uint_as_float(u.x & 0xffff0000u);
    f[2] = __uint_as_float(u.y << 16); f[3] = __uint_as_float(u.y & 0xffff0000u);
    f[4] = __uint_as_float(u.z << 16); f[5] = __uint_as_float(u.z & 0xffff0000u);
    f[6] = __uint_as_float(u.w << 16); f[7] = __uint_as_float(u.w & 0xffff0000u);
}
__device__ __forceinline__ void load8(const float* p, float (&f)[8]) {
    float4 a = *(const float4*)p, b = *(const float4*)(p + 4);
    f[0] = a.x; f[1] = a.y; f[2] = a.z; f[3] = a.w; f[4] = b.x; f[5] = b.y; f[6] = b.z; f[7] = b.w;
}
__device__ __forceinline__ float load1(const bf16_t* p) { return bf2f(*p); }
__device__ __forceinline__ float load1(const float* p) { return *p; }


#define XB_TMO      128
#define XB_XCNT(j)  (256  + 64 * (j))
#define XB_XSUB(j)  (1280 + 64 * (j))
#define XB_XGEN(j)  (2304 + 64 * (j))
#define XB_TOP      3328
#define XB_TOPGEN   3392
#define XCD_BAR_WORDS 3456
#define XB_SPIN_CAP (1u << 18)
#define LAS __attribute__((address_space(3)))
__device__ __forceinline__ unsigned xb_ld(unsigned* p)              { return __hip_atomic_load(p, __ATOMIC_RELAXED, __HIP_MEMORY_SCOPE_AGENT); }
__device__ __forceinline__ unsigned xb_add(unsigned* p, unsigned v) { return __hip_atomic_fetch_add(p, v, __ATOMIC_RELAXED, __HIP_MEMORY_SCOPE_AGENT); }
__device__ __forceinline__ unsigned xb_xcc_id() { return (unsigned)__builtin_amdgcn_s_getreg((3 << 11) | 20) & 0xFu; }
#define XB_SPIN(cond, bar) do { unsigned _sp = 0; while (cond) { __builtin_amdgcn_s_sleep(1); \
    if ((++_sp & 255u) == 0u) { if (xb_ld(&(bar)[XB_TMO])) break; if (_sp > XB_SPIN_CAP) { atomicAdd(&(bar)[XB_TMO], 1u); break; } } } } while (0)
struct XcdBarrier { unsigned* bar; unsigned x; volatile LAS unsigned* st; };
__device__ __forceinline__ XcdBarrier xcd_barrier_post(unsigned* bar, volatile LAS unsigned* st) {
    XcdBarrier b; b.bar = bar; b.x = xb_xcc_id(); b.st = st;
    if (threadIdx.x == 0) (void)xb_add(&bar[XB_XCNT(b.x)], 1u);
    return b;
}
__device__ __forceinline__ void xcd_barrier_complete(unsigned* bar, unsigned x, unsigned& nloc, unsigned& nx) {
    const unsigned G = gridDim.x * gridDim.y * gridDim.z;
    unsigned sum, cnt, mine, sp = 0u;
    for (;;) {
        sum = 0u; cnt = 0u; mine = 0u;
#pragma unroll
        for (unsigned j = 0; j < 16; ++j) { const unsigned c = xb_ld(&bar[XB_XCNT(j)]); sum += c; cnt += (c > 0u) ? 1u : 0u; mine = (j == x) ? c : mine; }
        if (sum == G) break;
        __builtin_amdgcn_s_sleep(1);
        if ((++sp & 255u) == 0u) { if (xb_ld(&bar[XB_TMO])) break; if (sp > XB_SPIN_CAP) { atomicAdd(&bar[XB_TMO], 1u); break; } }
    }
    nloc = mine > 0u ? mine : 1u; nx = cnt > 0u ? cnt : 1u;
}
__device__ __forceinline__ void xcd_barrier(const XcdBarrier& b) {
    asm volatile("s_waitcnt vmcnt(0)" ::: "memory");
    __syncthreads();
    if (threadIdx.x == 0) {
        unsigned* bar = b.bar;
        __builtin_amdgcn_s_waitcnt(0);
        unsigned nloc = b.st[0], nx = b.st[1];
        if (nloc == 0u) { xcd_barrier_complete(bar, b.x, nloc, nx); b.st[0] = nloc; b.st[1] = nx; }
        const unsigned old = xb_add(&bar[XB_XSUB(b.x)], 1u);
        const unsigned gen = old / nloc;
        if (old + 1u == (gen + 1u) * nloc) {
            __builtin_amdgcn_fence(__ATOMIC_RELEASE, "agent");
            asm volatile("s_waitcnt vmcnt(0)" ::: "memory");
            const unsigned og = xb_add(&bar[XB_TOP], 1u);
            const unsigned tg = og / nx;
            if (og + 1u == (tg + 1u) * nx) xb_add(&bar[XB_TOPGEN], 1u);
            else XB_SPIN(xb_ld(&bar[XB_TOPGEN]) == tg, bar);
            __builtin_amdgcn_fence(__ATOMIC_ACQUIRE, "agent");
            xb_add(&bar[XB_XGEN(b.x)], 1u);
            asm volatile("s_waitcnt vmcnt(0)" ::: "memory");
        } else {
            XB_SPIN(xb_ld(&bar[XB_XGEN(b.x)]) == gen, bar);
            __builtin_amdgcn_fence(__ATOMIC_ACQUIRE, "agent");
            asm volatile("s_waitcnt vmcnt(0)" ::: "memory");
        }
    }
    __syncthreads();
}


__device__ __forceinline__ void wg_signal(unsigned* ctr, bool need_release) {
    asm volatile("s_waitcnt vmcnt(0)" ::: "memory");
    __syncthreads();
    if (threadIdx.x == 0) {
        if (need_release) { __builtin_amdgcn_fence(__ATOMIC_RELEASE, "agent"); asm volatile("s_waitcnt vmcnt(0)" ::: "memory"); }
        (void)__hip_atomic_fetch_add(ctr, 1u, __ATOMIC_RELAXED, __HIP_MEMORY_SCOPE_AGENT);
    }
}
__device__ __forceinline__ void wg_wait(unsigned* ctr, unsigned target, unsigned* tmo) {
    if (threadIdx.x == 0) {
        unsigned sp = 0;
        while (__hip_atomic_load(ctr, __ATOMIC_RELAXED, __HIP_MEMORY_SCOPE_AGENT) < target) {
            __builtin_amdgcn_s_sleep(2);
            if (++sp > (1u << 22)) { atomicAdd(tmo, 1u); break; }
        }
        __builtin_amdgcn_fence(__ATOMIC_ACQUIRE, "agent");
        asm volatile("s_waitcnt vmcnt(0)" ::: "memory");
    }
    __syncthreads();
}
__device__ __forceinline__ void p0_adaln(const Params& p, char* lds, int bid, int nblk) {
    float* sc = (float*)lds;
    float* red = (float*)(lds + 73728);
    const int tid = opaque_tid(), lane = tid & 63, wave = tid >> 6;
    for (int item = bid; item < 192; item += nblk) {
        const int cb = item >> 2, r0 = (item & 3) * 9;
        __syncthreads();
        {
            float cv[18];
#pragma unroll
            for (int u = 0; u < 18; ++u) { const int i = tid + u * NT, row = r0 + (i >> 10), k = i & 1023; cv[u] = row < 4 ? p.c_prompt[row * 1024 + k] : p.c_sample[(row - 4) * 1024 + k]; }
#pragma unroll
            for (int u = 0; u < 18; ++u) sc[tid + u * NT] = silu(cv[u]);
        }
        __syncthreads();
        const int j = cb * 64 + lane;
        float acc[9];
#pragma unroll
        for (int r = 0; r < 9; ++r) acc[r] = 0.f;
        const int k0 = wave * 128;
#pragma unroll 8
        for (int k = k0; k < k0 + 128; k += 4) {
            const float w0 = p.w_ada[(size_t)k * 3072 + j], w1 = p.w_ada[(size_t)(k + 1) * 3072 + j], w2 = p.w_ada[(size_t)(k + 2) * 3072 + j], w3 = p.w_ada[(size_t)(k + 3) * 3072 + j];
#pragma unroll
            for (int r = 0; r < 9; ++r) { const float4 s = *(const float4*)(sc + r * 1024 + k); acc[r] += s.x * w0 + s.y * w1 + s.z * w2 + s.w * w3; }
        }
#pragma unroll
        for (int r = 0; r < 9; ++r) red[(wave * 9 + r) * 64 + lane] = acc[r];
        __syncthreads();
        for (int i = tid; i < 9 * 64; i += NT) {
            const int r = i >> 6, l = i & 63;
            float s = 0.f;
#pragma unroll
            for (int w = 0; w < 8; ++w) s += red[(w * 9 + r) * 64 + l];
            __hip_atomic_store(&p.mod[(r0 + r) * 3072 + cb * 64 + l], s + p.b_ada[cb * 64 + l], __ATOMIC_RELAXED, __HIP_MEMORY_SCOPE_AGENT);
        }
        wg_signal(p.bar + 3520, false);
    }
}

__device__ __forceinline__ void transpose_item(const float* W, int K, int N, bf16_t* WT, float* scr, int item, int lane, int nblkN) {
    const int kb = item / nblkN, nb = item % nblkN, k0 = kb * 64, n0 = nb * 64;
    float tv[64];
#pragma unroll
    for (int kk = 0; kk < 64; ++kk) tv[kk] = (n0 + lane < N) ? W[(size_t)(k0 + kk) * N + n0 + lane] : 0.f;
#pragma unroll
    for (int kk = 0; kk < 64; ++kk) scr[kk * 65 + lane] = tv[kk];
    WSYNC();
    for (int nn = 0; nn < 64; ++nn) WT[(size_t)(n0 + nn) * K + k0 + lane] = f2bf(scr[lane * 65 + nn]);
    WSYNC();
}
__device__ __forceinline__ void p0_w1p(const Params& p, int bid, int nblk) {
    const size_t gt = (size_t)bid * NT + opaque_tid(), ngt = (size_t)nblk * NT;
    for (size_t i = gt; i < (size_t)2 * 128 * 1024; i += ngt) {
        const int kv = (int)(i >> 17), n = (int)(i >> 10) & 127, kp = (int)i & 1023;
        const int ks = kp >> 5, G = (kp >> 3) & 3, j = kp & 7;
        const int k = ks * 32 + 16 * (j >> 2) + 4 * G + (j & 3);
        const int l = (k >> 6) + (n >= 64 ? 16 : 0), d = k & 63, f = n & 63;
        p.w1p[i] = f2bf((kv ? p.w_cv1 : p.w_ck1)[(size_t)(l * 64 + d) * 64 + f]);
    }
}
__device__ __forceinline__ void p0_weights(const Params& p, char* lds, int bid, int nblk) {
    const int tid = opaque_tid(), lane = tid & 63, wave = tid >> 6;
    float* scr = (float*)lds + wave * (64 * 65);
    const int gw = bid * 8 + wave, ngw = nblk * 8;
    constexpr int I_IN = 16 * 112, I_OUT = 16 * 16;
    for (int it = gw; it < I_IN + I_OUT; it += ngw) {
        if (it < I_IN) {
            const int kb = it / 112, nb = it % 112, k0 = kb * 64, n0 = nb * 32;
            const int pn = n0 >> 8, pl = n0 & 255, bj = pl >> 7, wc = (pl >> 5) & 3;
            const int cb = tile_src(pn) + wc * 64 + bj * 32;
            const int lim = pn == 13 ? 1304 : D_IN;
            float tv[32];
#pragma unroll
            for (int i = 0; i < 32; ++i) { const int kk = 2 * i + (lane >> 5), c = cb + (lane & 31); tv[i] = c < lim ? p.w_in[(size_t)(k0 + kk) * D_IN + c] : 0.f; }
#pragma unroll
            for (int i = 0; i < 32; ++i) scr[(2 * i + (lane >> 5)) * 33 + (lane & 31)] = tv[i];
            WSYNC();
            const int c8 = lane & 7;
            for (int j = 0; j < 4; ++j) {
                const int n = (lane >> 3) + 8 * j; const float* s = scr + (8 * c8) * 33 + n;
                uint4 o; o.x = cvt_pk_bf16(s[0], s[33]); o.y = cvt_pk_bf16(s[66], s[99]); o.z = cvt_pk_bf16(s[132], s[165]); o.w = cvt_pk_bf16(s[198], s[231]);
                *(uint4*)(p.bt_in + (size_t)(n0 + n) * 1024 + k0 + 8 * c8) = o;
            }
            WSYNC();
        } else transpose_item(p.w_out, 1024, 1024, p.bt_out, scr, it - I_IN, lane, 16);
    }
    const size_t gt = (size_t)bid * NT + tid, ngt = (size_t)nblk * NT;
    for (size_t i = gt; i < (size_t)4097 * 32; i += ngt) {
        const int pi = (int)(i >> 5), fi = (int)i & 31;
        const float ang = (float)(pi < 4096 ? pi : PAST) * powf(10000.f, -(float)fi / 32.f);
        float sn, cs; sincosf(ang, &sn, &cs);
        p.ropec[i] = cs; p.ropes[i] = sn;
    }
    if (bid == (nblk > 200 ? 200 : 0) && wave == 0) {
        const float gq = wave_max(fabsf(p.g_q[lane])), gc = wave_max(fabsf(p.g_kc[lane])), gs = wave_max(fabsf(p.g_ks[lane])), gw = wave_max(fabsf(p.g_kw[lane]));
        if (lane == 0) { const float k = 8.f * 1.03f * 1.44269504088896f * gq; p.attb[0] = k * gc; p.attb[1] = k * gs; p.attb[2] = k * gw; p.attb[3] = 0.f; }
    }
    for (size_t i = gt; i < (size_t)2 * 64 * 64; i += ngt) {
        const int kv = (int)(i >> 12), d = (int)(i >> 6) & 63, f = (int)i & 63;
        p.w2t[i] = f2bf((kv ? p.w_cv2 : p.w_ck2)[f * 64 + d]);
    }
    for (size_t i = gt; i < (size_t)2 * 8 * 64; i += ngt) {
        const int which = (int)(i >> 9), bg = (int)(i >> 6) & 7, d = (int)i & 63;
        (which ? p.vc : p.kc)[((size_t)bg * 256 + 255) * 64 + d] = 0;
    }
    {
        constexpr int NW = 32 * 511 * 64;
        const int gti = (int)gt, ngti = (int)ngt;
#define SW_SRC(i) (p.state_win + (size_t)((i) / (511 * 64)) * 512 * 256 + 256 + (size_t)((i) % (511 * 64)) * 4)
#define SW_DST(i) (p.s_win + (size_t)((i) / (511 * 64)) * 512 * 256 + (size_t)((i) % (511 * 64)) * 4)
#define SW_LD(j) const int ix##j = ib + j * ngti, cx##j = ix##j < NW ? ix##j : NW - 1; const float4 vx##j = *(const float4*)SW_SRC(cx##j);
#define SW_ST(j) if (ix##j < NW) *(float4*)SW_DST(ix##j) = vx##j;
        for (int ib = gti; ib < NW; ib += 8 * ngti) {
            SW_LD(0) SW_LD(1) SW_LD(2) SW_LD(3) SW_LD(4) SW_LD(5) SW_LD(6) SW_LD(7)
            SW_ST(0) SW_ST(1) SW_ST(2) SW_ST(3) SW_ST(4) SW_ST(5) SW_ST(6) SW_ST(7)
        }
#undef SW_SRC
#undef SW_DST
#undef SW_LD
#undef SW_ST
    }
}

__device__ __forceinline__ void p1_norm(const Params& p, char* lds, int bid, int nblk) {
    const int tid = opaque_tid(), lane = tid & 63, wave = tid >> 6;
    volatile int* slot = (volatile int*)(lds + 147456 + 16);
    for (;;) {
        __syncthreads();
        if (tid == 0) *slot = (int)__hip_atomic_fetch_add(p.bar + 3456 + 32, 1u, __ATOMIC_RELAXED, __HIP_MEMORY_SCOPE_AGENT);
        __syncthreads();
        const int pulled = *slot;
        if (pulled * 32 >= R) break;
        const int chunk = pulled == 0 ? TP / 32 : pulled - 1;
        if (chunk * 32 < TP) {
            const float* shift = p.mod + (chunk >> 7) * 3072, *scale = shift + 1024;
            const int rw = chunk * 32 + wave;
            float4 v[4][4], g[4], sc[4], sh[4];
#pragma unroll
            for (int q = 0; q < 4; ++q)
#pragma unroll
                for (int j = 0; j < 4; ++j) v[q][j] = *(const float4*)(p.x_prompt + (size_t)(rw + 8 * q) * 1024 + j * 256 + lane * 4);
#pragma unroll
            for (int j = 0; j < 4; ++j) { const int c = j * 256 + lane * 4; g[j] = *(const float4*)(p.g_norm + c); sc[j] = *(const float4*)(scale + c); sh[j] = *(const float4*)(shift + c); }
#pragma unroll
            for (int q = 0; q < 4; ++q) {
                float ss = 0.f;
#pragma unroll
                for (int j = 0; j < 4; ++j) ss += v[q][j].x * v[q][j].x + v[q][j].y * v[q][j].y + v[q][j].z * v[q][j].z + v[q][j].w * v[q][j].w;
                const float rs = rsqrtf(wave_sum(ss) * (1.f / 1024.f) + EPS);
#pragma unroll
                for (int j = 0; j < 4; ++j) {
                    ushort4 o;
                    o.x = f2bf(v[q][j].x * rs * g[j].x * (1.f + sc[j].x) + sh[j].x);
                    o.y = f2bf(v[q][j].y * rs * g[j].y * (1.f + sc[j].y) + sh[j].y);
                    o.z = f2bf(v[q][j].z * rs * g[j].z * (1.f + sc[j].z) + sh[j].z);
                    o.w = f2bf(v[q][j].w * rs * g[j].w * (1.f + sc[j].w) + sh[j].w);
                    *(ushort4*)(p.H + (size_t)(rw + 8 * q) * 1024 + j * 256 + lane * 4) = o;
                }
            }
            continue;
        }
      for (int r = chunk * 32 + wave; r < R && r < chunk * 32 + 32; r += 8) {
        const float* xr = r < TP ? p.x_prompt + (size_t)r * 1024 : p.x_sample + (size_t)(r - TP) * 1024;
        const int mrow = r < TP ? (r >> 12) : 4 + (r - TP);
        const float* shift = p.mod + mrow * 3072, *scale = shift + 1024;
        float4 v[4]; float ss = 0.f;
#pragma unroll
        for (int j = 0; j < 4; ++j) { v[j] = *(const float4*)(xr + j * 256 + lane * 4); ss += v[j].x * v[j].x + v[j].y * v[j].y + v[j].z * v[j].z + v[j].w * v[j].w; }
        const float rs = rsqrtf(wave_sum(ss) * (1.f / 1024.f) + EPS);
#pragma unroll
        for (int j = 0; j < 4; ++j) {
            const int c = j * 256 + lane * 4;
            const float4 g = *(const float4*)(p.g_norm + c), sc = *(const float4*)(scale + c), sh = *(const float4*)(shift + c);
            ushort4 o;
            o.x = f2bf(v[j].x * rs * g.x * (1.f + sc.x) + sh.x);
            o.y = f2bf(v[j].y * rs * g.y * (1.f + sc.y) + sh.y);
            o.z = f2bf(v[j].z * rs * g.z * (1.f + sc.z) + sh.z);
            o.w = f2bf(v[j].w * rs * g.w * (1.f + sc.w) + sh.w);
            *(ushort4*)(p.H + (size_t)r * 1024 + c) = o;
        }
      }
    }
}

constexpr int BM = 256, BK = 64, HALF = 128, HT = HALF * BK;
__device__ __forceinline__ int lds_byte(int r, int c) {
    int st = (r >> 4) * 2 + (c >> 5), rr = r & 15, cc = c & 31, ob = rr * 64 + cc * 2;
    return st * 1024 + (ob ^ (((ob >> 9) & 1) << 5));
}
__device__ __forceinline__ void stage_rc(int b, int& Rr, int& Cc) {
    int st = b / 1024, sb = b % 1024, swz = sb ^ (((sb >> 9) & 1) << 5);
    Rr = (st >> 1) * 16 + swz / 64; Cc = (st & 1) * 32 + (swz % 64) / 2;
}

template <class Epi>
__device__ __forceinline__ void gemm_phase(const bf16_t* __restrict__ A, const bf16_t* __restrict__ Bt, int nM, int nN, int K, char* lds, int bid, int nblk, const Epi& epi) {
    bf16_t* shm = (bf16_t*)lds;
#define SA(b, h) (shm + ((b) * 2 + (h)) * HT)
#define SB(b, h) (shm + (4 + (b) * 2 + (h)) * HT)
#define STAGE_X(T, P, BASE, br, kt) do { long _g = (long)(br) * K + (long)(kt) * BK; \
    for (int _i = 0; _i < 2; ++_i) { int _b = (T) * 16 + _i * 8192; int _r, _c; stage_rc(_b, _r, _c); \
      __builtin_amdgcn_global_load_lds((const unsigned*)(BASE + _g + (long)_r * K + _c), \
        (__attribute__((address_space(3))) unsigned*)((char*)(P) + _b), 16, 0, 0); } } while (0)
#define STAGE(P, BASE, br, kt) STAGE_X(tz0, P, BASE, br, kt)
#define LDA(dst, b, h) for (int m = 0; m < 4; ++m) for (int k = 0; k < 2; ++k) \
    dst[m][k] = *reinterpret_cast<const bf16x8*>((char*)SA(b, h) + lds_byte(wr * 64 + m * 16 + fr, k * 32 + fq * 8))
#define LDB(dst, b, h) for (int n = 0; n < 2; ++n) for (int k = 0; k < 2; ++k) \
    dst[n][k] = *reinterpret_cast<const bf16x8*>((char*)SB(b, h) + lds_byte(wc * 32 + n * 16 + fr, k * 32 + fq * 8))
#define MMA(ai, bj, At, Bt_) do { __builtin_amdgcn_s_setprio(1); \
    for (int m = 0; m < 4; ++m) for (int n = 0; n < 2; ++n) for (int k = 0; k < 2; ++k) \
      acc[ai][bj][m][n] = __builtin_amdgcn_mfma_f32_16x16x32_bf16(Bt_[n][k], At[m][k], acc[ai][bj][m][n], 0, 0, 0); \
    __builtin_amdgcn_s_setprio(0); } while (0)
#define WAIT_V(n) asm volatile("s_waitcnt vmcnt(" #n ")" ::: "memory")
#define WAIT_L(n) asm volatile("s_waitcnt lgkmcnt(" #n ")" ::: "memory")
#define BAR __builtin_amdgcn_s_barrier()
#define SCHED __builtin_amdgcn_sched_barrier(0)
    const int nwg = nM * nN;
    for (int tile = bid; tile < nwg; tile += nblk) {
        const int pm = tile / nN, pn = tile % nN;
        const int brow = pm * BM, bcol = pn * BM;
        int tz0 = threadIdx.x; asm volatile("" : "+v"(tz0));
        int wid = tz0 >> 6, lane = tz0 & 63, wr = wid >> 2, wc = wid & 3, fr = lane & 15, fq = lane >> 4;
        f32x4 acc[2][2][4][2] = {};
        bf16x8 At[4][2], B0[2][2], B1[2][2];
        const int nt = K / BK;
        STAGE(SB(0, 0), Bt, bcol, 0); STAGE(SA(0, 0), A, brow, 0);
        STAGE(SB(0, 1), Bt, bcol + HALF, 0); STAGE(SA(0, 1), A, brow + HALF, 0);
        if (wr == 1) BAR;
        WAIT_V(4); BAR;
        STAGE(SB(1, 0), Bt, bcol, 1); STAGE(SA(1, 0), A, brow, 1); STAGE(SB(1, 1), Bt, bcol + HALF, 1);
        WAIT_V(6); BAR;
        for (int t = 0; t < nt - 2; t += 2) {
            LDB(B0, 0, 0); SCHED; LDA(At, 0, 0); STAGE(SA(1, 1), A, brow + HALF, t + 1);
            WAIT_L(8); BAR; WAIT_L(0); MMA(0, 0, At, B0); BAR; SCHED;
            LDB(B1, 0, 1); STAGE(SB(0, 0), Bt, bcol, t + 2);
            BAR; WAIT_L(0); MMA(0, 1, At, B1); BAR;
            LDA(At, 0, 1); STAGE(SA(0, 0), A, brow, t + 2);
            BAR; WAIT_L(0); MMA(1, 0, At, B0); BAR; SCHED;
            STAGE(SB(0, 1), Bt, bcol + HALF, t + 2);
            WAIT_V(6); BAR; MMA(1, 1, At, B1); BAR;
            LDB(B0, 1, 0); SCHED; LDA(At, 1, 0); STAGE(SA(0, 1), A, brow + HALF, t + 2);
            WAIT_L(8); BAR; WAIT_L(0); MMA(0, 0, At, B0); BAR; SCHED;
            LDB(B1, 1, 1); STAGE(SB(1, 0), Bt, bcol, t + 3);
            BAR; WAIT_L(0); MMA(0, 1, At, B1); BAR;
            LDA(At, 1, 1); STAGE(SA(1, 0), A, brow, t + 3);
            BAR; WAIT_L(0); MMA(1, 0, At, B0); BAR; SCHED;
            STAGE(SB(1, 1), Bt, bcol + HALF, t + 3);
            WAIT_V(6); BAR; MMA(1, 1, At, B1); BAR;
        }
        int tz = threadIdx.x; asm volatile("" : "+v"(tz)); wid = tz >> 6; lane = tz & 63; wr = wid >> 2; wc = wid & 3; fr = lane & 15; fq = lane >> 4;
        { LDB(B0, 0, 0); WAIT_V(0); LDA(At, 0, 0); STAGE_X(tz, SA(1, 1), A, brow + HALF, nt - 1);
          BAR; WAIT_L(0); MMA(0, 0, At, B0); BAR;
          LDB(B1, 0, 1); BAR; WAIT_L(0); MMA(0, 1, At, B1); BAR;
          LDA(At, 0, 1); WAIT_V(4); BAR; WAIT_L(0); MMA(1, 0, At, B0); MMA(1, 1, At, B1); BAR; }
        { LDB(B0, 1, 0); LDA(At, 1, 0); WAIT_V(2); BAR; WAIT_L(0); MMA(0, 0, At, B0); BAR;
          LDB(B1, 1, 1); WAIT_V(0); BAR; WAIT_L(0); MMA(0, 1, At, B1); BAR;
          LDA(At, 1, 1); BAR; WAIT_L(0); MMA(1, 0, At, B0); MMA(1, 1, At, B1); BAR; }
        if (wr == 0) BAR;
        epi(acc, brow, bcol, wr, wc, fr, fq);
    }
#undef SA
#undef SB
#undef STAGE_X
#undef STAGE
#undef LDA
#undef LDB
#undef MMA
}

struct EpiOut {
    const Params* p;
    __device__ __forceinline__ void operator()(const f32x4 (&acc)[2][2][4][2], int brow, int bcol, int wr, int wc, int fr, int fq) const {
#pragma unroll
        for (int ai = 0; ai < 2; ++ai)
#pragma unroll
            for (int mt = 0; mt < 4; ++mt) {
                const int r = brow + ai * HALF + wr * 64 + mt * 16 + fr;
                if (r < R) {
                    const float* xr = r < TP ? p->x_prompt + (size_t)r * 1024 : p->x_sample + (size_t)(r - TP) * 1024;
                    const float* gate = p->mod + (r < TP ? (r >> 12) : 4 + (r - TP)) * 3072 + 2048;
#pragma unroll
                    for (int bj = 0; bj < 2; ++bj)
#pragma unroll
                        for (int nt = 0; nt < 2; ++nt) {
                            const int c = bcol + bj * HALF + wc * 32 + nt * 16 + 4 * fq;
                            const float4 xv = *(const float4*)(xr + c), gv = *(const float4*)(gate + c);
                            float4 o; o.x = xv.x + gv.x * acc[ai][bj][mt][nt][0]; o.y = xv.y + gv.y * acc[ai][bj][mt][nt][1];
                            o.z = xv.z + gv.z * acc[ai][bj][mt][nt][2]; o.w = xv.w + gv.w * acc[ai][bj][mt][nt][3];
                            *(float4*)(p->y + (size_t)r * 1024 + c) = o;
                        }
                }
            }
    }
};

struct EpiIn {
    const Params* p;
    __device__ __forceinline__ void operator()(const f32x4 (&acc)[2][2][4][2], int brow, int bcol, int wr, int wc, int fr, int fq) const {
        const int pn = bcol >> 8;
        const Params& P = *p;
        const bool normt = pn <= 1 || ((pn == 3 || pn == 4) && wc < 2);
        float4 g4h[2][2];
        { const float* gn = pn <= 1 ? P.g_q : pn == 3 ? P.g_ks : P.g_kw;
#pragma unroll
          for (int bj = 0; bj < 2; ++bj)
#pragma unroll
            for (int nt = 0; nt < 2; ++nt) g4h[bj][nt] = normt ? *(const float4*)(gn + bj * 32 + nt * 16 + 4 * fq) : make_float4(1.f, 1.f, 1.f, 1.f); }
#pragma unroll
        for (int ai = 0; ai < 2; ++ai)
#pragma unroll
            for (int mt = 0; mt < 4; ++mt) {
                const int r = brow + ai * HALF + wr * 64 + mt * 16 + fr;
                const bool rowok = r < R;
                const bool isp = r < TP;
                const int b = isp ? (r >> 12) : (r - TP), t = isp ? (r & 4095) : 0, pidx = isp ? t : 4096;
                f32x4 v[2][2];
#pragma unroll
                for (int bj = 0; bj < 2; ++bj)
#pragma unroll
                    for (int nt = 0; nt < 2; ++nt) v[bj][nt] = acc[ai][bj][mt][nt];
                if (normt) {
                    float ss = 0.f;
#pragma unroll
                    for (int bj = 0; bj < 2; ++bj)
#pragma unroll
                        for (int nt = 0; nt < 2; ++nt)
#pragma unroll
                            for (int rg = 0; rg < 4; ++rg) ss += v[bj][nt][rg] * v[bj][nt][rg];
                    ss += __shfl_xor(ss, 16); ss += __shfl_xor(ss, 32);
                    const float rs = rsqrtf(ss * (1.f / 64.f) + EPS);
#pragma unroll
                    for (int bj = 0; bj < 2; ++bj)
#pragma unroll
                        for (int nt = 0; nt < 2; ++nt) {
                            const float4 g4 = g4h[bj][nt];
                            v[bj][nt][0] *= rs * g4.x; v[bj][nt][1] *= rs * g4.y; v[bj][nt][2] *= rs * g4.z; v[bj][nt][3] *= rs * g4.w;
                        }
                }
                if (!rowok) continue;
                if (pn == 7 || pn == 8) {
                    const float lgm = __log2f(1.f - exp2f(-5.f - (float)wc)) * (float)((isp ? t : PAST) & 127);
                    const float sc = pn == 7 ? exp2f(lgm) : 0.125f * exp2f(-lgm);
#pragma unroll
                    for (int nt = 0; nt < 2; ++nt) {
                        const float4 c4 = *(const float4*)(P.ropec + (size_t)pidx * 32 + nt * 16 + 4 * fq), s4 = *(const float4*)(P.ropes + (size_t)pidx * 32 + nt * 16 + 4 * fq);
                        const f32x4 x1 = v[0][nt], x2 = v[1][nt];
                        v[0][nt][0] = (x1[0] * c4.x - x2[0] * s4.x) * sc; v[1][nt][0] = (x1[0] * s4.x + x2[0] * c4.x) * sc;
                        v[0][nt][1] = (x1[1] * c4.y - x2[1] * s4.y) * sc; v[1][nt][1] = (x1[1] * s4.y + x2[1] * c4.y) * sc;
                        v[0][nt][2] = (x1[2] * c4.z - x2[2] * s4.z) * sc; v[1][nt][2] = (x1[2] * s4.z + x2[2] * c4.z) * sc;
                        v[0][nt][3] = (x1[3] * c4.w - x2[3] * s4.w) * sc; v[1][nt][3] = (x1[3] * s4.w + x2[3] * c4.w) * sc;
                    }
                }
                if (pn == 5 || pn == 6 || pn == 11 || pn == 12) {
#pragma unroll
                    for (int bj = 0; bj < 2; ++bj)
#pragma unroll
                        for (int nt = 0; nt < 2; ++nt)
#pragma unroll
                            for (int rg = 0; rg < 4; ++rg) v[bj][nt][rg] = silu(v[bj][nt][rg]);
                }
                bf16_t* bdst = nullptr; float* fdst = nullptr;
                if (pn <= 1) bdst = P.qn + (size_t)r * 512 + (pn * 4 + wc) * 64;
                else if (pn == 2) fdst = (isp ? P.p_cmp + (size_t)r * 256 : P.s_cmp + (size_t)b * 256) + wc * 64;
                else if (pn == 3) { fdst = (isp ? P.p_slc + (size_t)r * 256 : P.s_slc + (size_t)b * 256) + wc * 64;
                                    if (isp) bdst = (wc < 2 ? P.ks : P.vs) + ((size_t)(b * 2 + (wc & 1)) * SEQ + t) * 64; }
                else if (pn == 4) { fdst = isp ? (t >= SEQ - 512 ? P.p_win + ((size_t)b * 512 + (t - (SEQ - 512))) * 256 + wc * 64 : nullptr) : P.s_win + ((size_t)b * 512 + 511) * 256 + wc * 64;
                                    if (isp) bdst = (wc < 2 ? P.kw : P.vw) + ((size_t)(b * 2 + (wc & 1)) * SEQ + t) * 64; }
                else if (pn == 5 || pn == 6) bdst = P.ga + (size_t)r * 512 + (pn - 5) * 256 + wc * 64;
                else if (pn == 7) bdst = P.rq + (size_t)r * 256 + wc * 64;
                else if (pn == 8) bdst = P.rk + (size_t)r * 256 + wc * 64;
                else if (pn == 9 || pn == 10) bdst = P.rv + (size_t)r * 512 + (pn - 9) * 256 + wc * 64;
                else if (pn == 11 || pn == 12) bdst = P.gr + (size_t)r * 512 + (pn - 11) * 256 + wc * 64;
                if (pn == 13) {
                    if (wc == 0) {
                        float* gd = P.gates + (size_t)r * 24;
                        { float4 o; o.x = sigmoidf(v[0][0][0]); o.y = sigmoidf(v[0][0][1]); o.z = sigmoidf(v[0][0][2]); o.w = sigmoidf(v[0][0][3]); *(float4*)(gd + 4 * fq) = o; }
                        if (fq < 2) { float4 o; o.x = sigmoidf(v[0][1][0]); o.y = sigmoidf(v[0][1][1]); o.z = sigmoidf(v[0][1][2]); o.w = sigmoidf(v[0][1][3]); *(float4*)(gd + 16 + 4 * fq) = o; }
                    }
                    continue;
                }
#pragma unroll
                for (int bj = 0; bj < 2; ++bj)
#pragma unroll
                    for (int nt = 0; nt < 2; ++nt) {
                        const int cl = bj * 32 + nt * 16 + 4 * fq;
                        if (fdst) { float4 o; o.x = v[bj][nt][0]; o.y = v[bj][nt][1]; o.z = v[bj][nt][2]; o.w = v[bj][nt][3]; *(float4*)(fdst + cl) = o; }
                        if (bdst) { uint2 o; o.x = cvt_pk_bf16(v[bj][nt][0], v[bj][nt][1]); o.y = cvt_pk_bf16(v[bj][nt][2], v[bj][nt][3]); *(uint2*)(bdst + cl) = o; }
                    }
            }
    }
};

__device__ __forceinline__ void p3_rows(const Params& p, int bid, int nblk) {
    const int tid = opaque_tid(), lane = tid & 63, wave = tid >> 6;
    for (int r = bid * 8 + wave; r < R; r += nblk * 8) {
        const float* pr = p.praw + (size_t)r * NPAD;
        const bool isp = r < TP;
        const int b = isp ? (r >> 12) : (r - TP), t = isp ? (r & 4095) : 0;
        const int pos = isp ? t : PAST;
        {
            const float gq = p.g_q[lane];
            for (int hh = 0; hh < 8; ++hh) {
                const float v = pr[C_Q + hh * 64 + lane];
                const float rs = rsqrtf(wave_sum(v * v) * (1.f / 64.f) + EPS);
                p.qn[(size_t)r * 512 + hh * 64 + lane] = f2bf(v * rs * gq);
            }
        }
        float* o_cmp = isp ? p.p_cmp + (size_t)r * 256 : p.s_cmp + (size_t)b * 256;
        float* o_slc = isp ? p.p_slc + (size_t)r * 256 : p.s_slc + (size_t)b * 256;
        float* o_win = isp ? (t >= SEQ - 512 ? p.p_win + ((size_t)b * 512 + (t - (SEQ - 512))) * 256 : nullptr) : p.s_win + ((size_t)b * 512 + 511) * 256;
        for (int j = 0; j < 4; ++j) {
            const int g = j & 1;
            const size_t cidx = ((size_t)(b * 2 + g) * SEQ + t) * 64 + lane;
            {
                const float v = pr[C_KC + j * 64 + lane];
                o_cmp[j * 64 + lane] = v;
                if (isp) { if (j < 2) p.kcr[cidx] = f2bf(v); else p.vcr[cidx] = f2bf(v); }
            }
            {
                float v = pr[C_KS + j * 64 + lane];
                if (j < 2) { const float rs = rsqrtf(wave_sum(v * v) * (1.f / 64.f) + EPS); v = v * rs * p.g_ks[lane]; }
                o_slc[j * 64 + lane] = v;
                if (isp) { if (j < 2) p.ks[cidx] = f2bf(v); else p.vs[cidx] = f2bf(v); }
            }
            {
                float v = pr[C_KW + j * 64 + lane];
                if (j < 2) { const float rs = rsqrtf(wave_sum(v * v) * (1.f / 64.f) + EPS); v = v * rs * p.g_kw[lane]; }
                if (o_win) o_win[j * 64 + lane] = v;
                if (isp) { if (j < 2) p.kw[cidx] = f2bf(v); else p.vw[cidx] = f2bf(v); }
            }
        }
        if (lane < 24) p.gates[(size_t)r * 24 + lane] = sigmoidf(pr[C_BR + lane]);
        for (int i = 0; i < 8; ++i) {
            p.ga[(size_t)r * 512 + i * 64 + lane] = f2bf(silu(pr[C_GA + i * 64 + lane]));
            p.gr[(size_t)r * 512 + i * 64 + lane] = f2bf(silu(pr[C_GR + i * 64 + lane]));
            p.rv[(size_t)r * 512 + i * 64 + lane] = f2bf(pr[C_RV + i * 64 + lane]);
        }
        {
            const int i = lane & 31;
            const float freq = powf(10000.f, -(float)i / 32.f);
            const float ang = (float)pos * freq;
            float sn, cs; sincosf(ang, &sn, &cs);
            for (int hh = 0; hh < 4; ++hh) {
                const float a = pr[C_RQ + hh * 64 + lane], ao = pr[C_RQ + hh * 64 + (lane ^ 32)];
                const float kq = pr[C_RK + hh * 64 + lane], ko = pr[C_RK + hh * 64 + (lane ^ 32)];
                const float oq = lane < 32 ? a * cs - ao * sn : ao * sn + a * cs;
                const float ok = lane < 32 ? kq * cs - ko * sn : ko * sn + kq * cs;
                const float lgm = __log2f(1.f - exp2f(-5.f - (float)hh)) * (float)(pos & 127);
                p.rq[(size_t)r * 256 + hh * 64 + lane] = f2bf(oq * exp2f(lgm));
                p.rk[(size_t)r * 256 + hh * 64 + lane] = f2bf(ok * 0.125f * exp2f(-lgm));
            }
        }
    }
}

typedef unsigned u32x4 __attribute__((ext_vector_type(4)));

struct CmpTile {
    int active;
    int b, c0;
    int seam_idx;
    int is_sample;
};

__device__ __forceinline__ void cmp_second_layer(const Params& p, int kv, const f32x4 (&pre)[4], bf16_t* hb  , const bf16_t* w2s  , bf16_t* dst  , int lane) {
    const int fr = lane & 15, G = lane >> 4;
#pragma unroll
    for (int nt = 0; nt < 4; ++nt)
#pragma unroll
        for (int r = 0; r < 4; ++r) hb[(G * 4 + r) * 64 + nt * 16 + fr] = f2bf(silu(pre[nt][r]));
    WSYNC();
    bf16x8 hf[2];
#pragma unroll
    for (int ks = 0; ks < 2; ++ks) hf[ks] = *(const bf16x8*)(hb + fr * 64 + ks * 32 + G * 8);
    f32x4 out[4];
#pragma unroll
    for (int nt = 0; nt < 4; ++nt) {
        out[nt] = (f32x4){0.f, 0.f, 0.f, 0.f};
#pragma unroll
        for (int ks = 0; ks < 2; ++ks) {
            const bf16x8 wf = *(const bf16x8*)(w2s + (nt * 16 + fr) * 64 + ks * 32 + G * 8);
            out[nt] = __builtin_amdgcn_mfma_f32_16x16x32_bf16(hf[ks], wf, out[nt], 0, 0, 0);
        }
    }
    WSYNC();
    float rs[4] = {1.f, 1.f, 1.f, 1.f};
    if (kv == 0) {
#pragma unroll
        for (int r = 0; r < 4; ++r) {
            float ss = 0.f;
#pragma unroll
            for (int nt = 0; nt < 4; ++nt) ss += out[nt][r] * out[nt][r];
            ss += __shfl_xor(ss, 1); ss += __shfl_xor(ss, 2); ss += __shfl_xor(ss, 4); ss += __shfl_xor(ss, 8);
            rs[r] = rsqrtf(ss * (1.f / 64.f) + EPS);
        }
    }
#pragma unroll
    for (int nt = 0; nt < 4; ++nt) {
        const float gk = kv == 0 ? p.g_kc[nt * 16 + fr] : 1.f;
#pragma unroll
        for (int r = 0; r < 4; ++r) {
            const int row = G * 4 + r;
            if (row < 15) dst[(size_t)row * 64 + nt * 16 + fr] = f2bf(out[nt][r] * rs[r] * gk);
        }
    }
}

constexpr int CMP_HB = 131072, CMP_W2S = 147456 + 64, CMP_B1S = CMP_W2S + 8192;
__device__ __forceinline__ void compress_setup(const Params& p, char* lds, int kv) {
    const int tid = opaque_tid();
    const float* w1 = kv ? p.w_cv1 : p.w_ck1; const float* pe = kv ? p.pe_cv : p.pe_ck; const float* w2 = kv ? p.w_cv2 : p.w_ck2;
    bf16_t* w2s = (bf16_t*)(lds + CMP_W2S); float* b1s = (float*)(lds + CMP_B1S); float* part = (float*)(lds + CMP_HB);
    __syncthreads();
    for (int i = tid; i < 4096; i += NT) { const int f = i >> 6, d = i & 63; w2s[d * 64 + f] = f2bf(w2[i]); }
    {
      const int fq4 = tid & 15, ks32 = tid >> 4;
      const float* wp = w1 + (size_t)ks32 * 64 * 64 + 4 * fq4; const float* pp = pe + ks32 * 64;
      float4 s = {0.f, 0.f, 0.f, 0.f};
#pragma unroll 16
      for (int k = 0; k < 64; ++k) { const float4 w = *(const float4*)(wp + (size_t)k * 64); const float pv = pp[k]; s.x += pv * w.x; s.y += pv * w.y; s.z += pv * w.z; s.w += pv * w.w; }
      *(float4*)(part + ks32 * 64 + 4 * fq4) = s; }
    __syncthreads();
    if (tid < 64) { float s = 0.f; for (int j = 0; j < 32; ++j) s += part[j * 64 + tid]; b1s[tid] = s; p.b1[kv * 64 + tid] = s; }
    __syncthreads();
}
template <int O>
__device__ __forceinline__ void cmp_rd4(unsigned a, bf16x8 (&b)[4]) {
    asm volatile(
        "ds_read_b128 %0, %4 offset:%5\n\t"
        "ds_read_b128 %1, %4 offset:%6\n\t"
        "ds_read_b128 %2, %4 offset:%7\n\t"
        "ds_read_b128 %3, %4 offset:%8\n\t"
        "s_waitcnt lgkmcnt(0)"
        : "=&v"(b[0]), "=&v"(b[1]), "=&v"(b[2]), "=&v"(b[3])
        : "v"(a), "i"(O), "i"(O + 1024), "i"(O + 2048), "i"(O + 3072) : "memory");
}
template <int O0, int O1>
__device__ __forceinline__ void cmp_lda(const float* a0, const float* a1, f32x4 (&q)[2][2]) {
    asm volatile("global_load_dwordx4 %0, %4, off offset:%6 nt\n\t"
                 "global_load_dwordx4 %1, %5, off offset:%6 nt\n\t"
                 "global_load_dwordx4 %2, %4, off offset:%7 nt\n\t"
                 "global_load_dwordx4 %3, %5, off offset:%7 nt"
                 : "=&v"(q[0][0]), "=&v"(q[0][1]), "=&v"(q[1][0]), "=&v"(q[1][1])
                 : "v"(a0), "v"(a1), "i"(O0), "i"(O1) : "memory");
}
template <int N>
__device__ __forceinline__ void cmp_wait(f32x4 (&q)[2][2]) {
    asm volatile("s_waitcnt vmcnt(%4)" : "+v"(q[0][0]), "+v"(q[0][1]), "+v"(q[1][0]), "+v"(q[1][1]) : "n"(N) : "memory");
}
__device__ __forceinline__ void cmp_stage_wq(const Params& p, LAS char* l3, int kv, int q, int tid) {
    const int n = tid >> 2, Gp = (tid & 3) ^ ((n >> 2) & 3);
    const bf16_t* src = p.w1p + ((size_t)kv * 128 + n) * 1024 + q * 256 + Gp * 8;
    LAS char* dst = l3 + (q & 1) * 65536 + tid * 16;
#pragma unroll
    for (int j = 0; j < 8; ++j)
        __builtin_amdgcn_global_load_lds((const unsigned*)(src + j * 32), (LAS unsigned*)(dst + j * 8192), 16, 0, 0);
}
__device__ __forceinline__ void compress_pass_s(const Params& p, char* lds, int kv, int b, int c0w, int seam_idx, bool first, bool more) {
    LAS char* l3 = (LAS char*)lds;
    const int tid = opaque_tid(), lane = tid & 63, wave = tid >> 6, fr = lane & 15, G = lane >> 4;
    bf16_t* hb = (bf16_t*)(lds + CMP_HB) + wave * 1024;
    const bf16_t* w2s = (const bf16_t*)(lds + CMP_W2S); const float* b1s = (const float*)(lds + CMP_B1S);
    const float* abase[2];
#pragma unroll
    for (int i = 0; i < 2; ++i) {
        const int c = c0w + (fr & 7) + 8 * i;
        const int pg = p.page_table[b * NPAGES + (c >> 3)];
        abase[i] = p.cache_cmp + (((size_t)pg * 128 + (c & 7) * 16) * 4 + kv * 2) * 64 + (fr >> 3) * 16 + G * 4;
    }
    const bool lowl = fr < 8;
    const unsigned bl = (unsigned)(unsigned long long)l3 + fr * 64 + ((G ^ (fr >> 2)) * 16);
    f32x4 acc[2][8];
#pragma unroll
    for (int g = 0; g < 2; ++g)
#pragma unroll
        for (int nt = 0; nt < 8; ++nt) acc[g][nt] = (f32x4){0.f, 0.f, 0.f, 0.f};
    f32x4 aq[6][2][2];
#define CMP_LOADA(u, s) do { const float* _a0 = abase[0] + ((s) >> 1) * 256; const float* _a1 = abase[1] + ((s) >> 1) * 256; \
        if ((s) & 1) cmp_lda<128, 384>(_a0, _a1, aq[u]); else cmp_lda<0, 256>(_a0, _a1, aq[u]); } while (0)
#define CMP_WAITA(u, s) do { const int _y = 31 - (s); if (_y >= 5) cmp_wait<20>(aq[u]); else if (_y == 4) cmp_wait<16>(aq[u]); else if (_y == 3) cmp_wait<12>(aq[u]); \
        else if (_y == 2) cmp_wait<8>(aq[u]); else if (_y == 1) cmp_wait<4>(aq[u]); else cmp_wait<0>(aq[u]); } while (0)
#pragma unroll
    for (int u = 0; u < 6; ++u) CMP_LOADA(u, u);
    if (first) { cmp_stage_wq(p, l3, kv, 0, tid); asm volatile("s_waitcnt vmcnt(0)" ::: "memory"); }
#pragma unroll
    for (int s = 0; s < 32; ++s) {
        const int q = s >> 3, u = s % 6;
        if ((s & 7) == 0) {
            asm volatile("" ::: "memory");
            __builtin_amdgcn_s_barrier();
            asm volatile("" ::: "memory");
            if (q < 3 || more) cmp_stage_wq(p, l3, kv, (q + 1) & 3, tid);
            asm volatile("" ::: "memory");
        }
        CMP_WAITA(u, s);
        bf16x8 af[2];
#pragma unroll
        for (int g = 0; g < 2; ++g) {
            u32x4 t;
            f32x4 x0, x1;
#pragma unroll
            for (int e = 0; e < 4; ++e) {
                const float give = lowl ? aq[u][g][1][e] : aq[u][g][0][e];
                const float recv = __builtin_bit_cast(float, __builtin_amdgcn_mov_dpp(__builtin_bit_cast(int, give), 0x128, 0xF, 0xF, true));
                x0[e] = lowl ? aq[u][g][0][e] : recv; x1[e] = lowl ? recv : aq[u][g][1][e];
            }
            t[0] = cvt_pk_bf16(x0[0], x0[1]); t[1] = cvt_pk_bf16(x0[2], x0[3]);
            t[2] = cvt_pk_bf16(x1[0], x1[1]); t[3] = cvt_pk_bf16(x1[2], x1[3]);
            af[g] = __builtin_bit_cast(bf16x8, t);
        }
        if (s + 6 < 32) CMP_LOADA(u, s + 6);
        const unsigned a = bl + (q & 1) * 65536 + (s & 7) * 8192;
        bf16x8 bf[4];
        cmp_rd4<0>(a, bf);
#pragma unroll
        for (int nt = 0; nt < 4; ++nt) {
            acc[0][nt] = __builtin_amdgcn_mfma_f32_16x16x32_bf16(af[0], bf[nt], acc[0][nt], 0, 0, 0);
            acc[1][nt] = __builtin_amdgcn_mfma_f32_16x16x32_bf16(af[1], bf[nt], acc[1][nt], 0, 0, 0);
        }
        cmp_rd4<4096>(a, bf);
#pragma unroll
        for (int nt = 0; nt < 4; ++nt) {
            acc[0][4 + nt] = __builtin_amdgcn_mfma_f32_16x16x32_bf16(af[0], bf[nt], acc[0][4 + nt], 0, 0, 0);
            acc[1][4 + nt] = __builtin_amdgcn_mfma_f32_16x16x32_bf16(af[1], bf[nt], acc[1][4 + nt], 0, 0, 0);
        }
    }
#undef CMP_LOADA
#undef CMP_WAITA
#pragma unroll
    for (int g = 0; g < 2; ++g) {
        f32x4 pre[4];
#pragma unroll
        for (int nt = 0; nt < 4; ++nt) {
            const float bias = b1s[nt * 16 + fr];
            const float nb0 = __shfl_down(acc[g][4 + nt][0], 16);
            pre[nt][0] = acc[g][nt][0] + acc[g][4 + nt][1] + bias;
            pre[nt][1] = acc[g][nt][1] + acc[g][4 + nt][2] + bias;
            pre[nt][2] = acc[g][nt][2] + acc[g][4 + nt][3] + bias;
            pre[nt][3] = acc[g][nt][3] + nb0 + bias;
            if (G == 3) p.seamA[((size_t)seam_idx * 2 + g) * 64 + nt * 16 + fr] = acc[g][nt][3];
            if (G == 0) p.seamB[((size_t)seam_idx * 2 + g) * 64 + nt * 16 + fr] = acc[g][4 + nt][0];
        }
        bf16_t* dst = (kv ? p.vcs : p.kcs) + ((size_t)(b * 2 + g) * 1024 + c0w) * 64;
        cmp_second_layer(p, kv, pre, hb, w2s, dst, lane);
    }
}

__device__ __forceinline__ void compress_sample(const Params& p, char* lds, int bid, int nblk) {
    const int wave = opaque_tid() >> 6;
    int kv_set = -1;
    for (int pass = bid; pass < 512; pass += nblk) {
        const int P = pass & 7, kv = (pass >> 3) & 1, b = pass >> 4;
        const int c0w = P * 128 + wave * 16;
        const bool first = kv != kv_set;
        if (first) { compress_setup(p, lds, kv); kv_set = kv; }
        const int nxt = pass + nblk;
        const bool more = nxt < 512 && ((nxt >> 3) & 1) == kv;
        compress_pass_s(p, lds, kv, b, c0w, (b * 2 + kv) * 64 + (c0w >> 4), first, more);
    }
}

__device__ __forceinline__ void compress_prompt_ksplit_item(const Params& p, char* lds, int item) {
    const int tid = opaque_tid(), lane = tid & 63, wave = tid >> 6, fr = lane & 15, G = lane >> 4;
    f32x4* part = (f32x4*)lds;
    {
        const int kv = item / 68, tile = item % 68, b = tile / 17, c0 = (tile % 17) * 15;
        const float* abase = p.p_cmp + (((size_t)b * SEQ + (size_t)(c0 + fr) * 16) * 4 + kv * 2) * 64 + G * 4;
        const bf16_t* wbase = p.w1p + ((size_t)kv * 128 + fr) * 1024 + G * 8;
        f32x4 acc[2][8];
#pragma unroll
        for (int g = 0; g < 2; ++g)
#pragma unroll
            for (int nt = 0; nt < 8; ++nt) acc[g][nt] = (f32x4){0.f, 0.f, 0.f, 0.f};
#pragma unroll
        for (int u = 0; u < 4; ++u) {
            const int s = wave * 4 + u;
            const float* a = abase + (s >> 1) * 256 + (s & 1) * 32;
            bf16x8 af[2];
#pragma unroll
            for (int g = 0; g < 2; ++g) {
                const f32x4 x0 = *(const f32x4*)(a + g * 64), x1 = *(const f32x4*)(a + g * 64 + 16);
                u32x4 t; t[0] = cvt_pk_bf16(x0[0], x0[1]); t[1] = cvt_pk_bf16(x0[2], x0[3]); t[2] = cvt_pk_bf16(x1[0], x1[1]); t[3] = cvt_pk_bf16(x1[2], x1[3]);
                af[g] = __builtin_bit_cast(bf16x8, t);
            }
#pragma unroll
            for (int nt = 0; nt < 8; ++nt) {
                const bf16x8 wf = *(const bf16x8*)(wbase + (size_t)nt * 16 * 1024 + s * 32);
                acc[0][nt] = __builtin_amdgcn_mfma_f32_16x16x32_bf16(af[0], wf, acc[0][nt], 0, 0, 0);
                acc[1][nt] = __builtin_amdgcn_mfma_f32_16x16x32_bf16(af[1], wf, acc[1][nt], 0, 0, 0);
            }
        }
        __syncthreads();
#pragma unroll
        for (int g = 0; g < 2; ++g)
#pragma unroll
            for (int nt = 0; nt < 8; ++nt) part[((wave * 2 + g) * 8 + nt) * 64 + lane] = acc[g][nt];
        __syncthreads();
        if (wave < 2) {
            const int g = wave;
            f32x4 tot[8];
#pragma unroll
            for (int nt = 0; nt < 8; ++nt) {
                tot[nt] = part[((0 * 2 + g) * 8 + nt) * 64 + lane];
#pragma unroll
                for (int w = 1; w < 8; ++w) tot[nt] += part[((w * 2 + g) * 8 + nt) * 64 + lane];
            }
            f32x4 pre[4];
#pragma unroll
            for (int nt = 0; nt < 4; ++nt) {
                const float bias = p.b1[kv * 64 + nt * 16 + fr];
                const float nb0 = __shfl_down(tot[4 + nt][0], 16);
                pre[nt][0] = tot[nt][0] + tot[4 + nt][1] + bias; pre[nt][1] = tot[nt][1] + tot[4 + nt][2] + bias;
                pre[nt][2] = tot[nt][2] + tot[4 + nt][3] + bias; pre[nt][3] = tot[nt][3] + nb0 + bias;
            }
            bf16_t* hb = (bf16_t*)(lds + 131072) + wave * 1024;
            bf16_t* dst = (kv ? p.vc : p.kc) + ((size_t)(b * 2 + g) * 256 + c0) * 64;
            cmp_second_layer(p, kv, pre, hb, p.w2t + (size_t)kv * 4096, dst, lane);
        }
        __syncthreads();
    }
}
__device__ __forceinline__ void compress_seams(const Params& p, int bid, int nblk) {
    const int tid = opaque_tid(), lane = tid & 63, wave = tid >> 6;
    if (bid < 0) return;
    for (int it = bid * 8 + wave; it < 32 * 2 * 2 * 63; it += nblk * 8) {
        const int Tt = it % 63, rest = it / 63, g = rest & 1, kv = (rest >> 1) & 1, b = rest >> 2;
        const size_t sa = ((size_t)((b * 2 + kv) * 64 + Tt) * 2 + g) * 64 + lane, sb = ((size_t)((b * 2 + kv) * 64 + Tt + 1) * 2 + g) * 64 + lane;
        const float h = silu(p.seamA[sa] + p.seamB[sb] + p.b1[kv * 64 + lane]);
        const float* w2 = kv ? p.w_cv2 : p.w_ck2;
        float o = 0.f;
        for (int f = 0; f < 64; ++f) o += bf2f(f2bf(__shfl(h, f))) * bf2f(f2bf(w2[f * 64 + lane]));
        if (kv == 0) { const float rs = rsqrtf(wave_sum(o * o) * (1.f / 64.f) + EPS); o = o * rs * p.g_kc[lane]; }
        ((kv ? p.vcs : p.kcs) + ((size_t)(b * 2 + g) * 1024 + 16 * Tt + 15) * 64)[lane] = f2bf(o);
    }
}
template <typename T>
__device__ __forceinline__ void attend64(const float* qs, float* pl, const T* kbase, const T* vbase, size_t stride, bool valid, int lane, float (&m)[4], float (&l)[4], float (&o)[4]) {
    float s[4] = {0.f, 0.f, 0.f, 0.f};
    if (valid) {
        const T* kr = kbase + (size_t)lane * stride;
        float kfa[8][8];
#pragma unroll
        for (int c = 0; c < 8; ++c) load8(kr + c * 8, kfa[c]);
#pragma unroll
        for (int c = 0; c < 8; ++c)
#pragma unroll
            for (int h = 0; h < 4; ++h)
#pragma unroll
                for (int j = 0; j < 8; ++j) s[h] += qs[h * 64 + c * 8 + j] * kfa[c][j];
    }
    const unsigned long long vm = __ballot(valid);
    if (vm == 0ull) return;
#pragma unroll
    for (int h = 0; h < 4; ++h) {
        const float sv = valid ? s[h] * 0.125f : -1e30f;
        const float mn = fmaxf(m[h], wave_max(sv));
        const float alpha = __expf(m[h] - mn);
        const float pv = valid ? __expf(sv - mn) : 0.f;
        l[h] = l[h] * alpha + wave_sum(pv); o[h] *= alpha; m[h] = mn;
        pl[h * 64 + lane] = pv;
    }
    WSYNC();
    const int kfirst = __ffsll((long long)vm) - 1;
#pragma unroll 64
    for (int kk = 0; kk < 64; ++kk) {
        const int kr = ((vm >> kk) & 1ull) ? kk : kfirst;
        const float vv = load1(vbase + (size_t)kr * stride + lane);
#pragma unroll
        for (int h = 0; h < 4; ++h) o[h] += pl[h * 64 + kk] * vv;
    }
    WSYNC();
}

__device__ __forceinline__ void cmp_branch(const float* qs, float* pl, float* ps, const bf16_t* kc, const bf16_t* vc, int n_c, int lane, float (&oc)[4]) {
    float m[4] = {-1e30f, -1e30f, -1e30f, -1e30f}, l[4] = {0.f, 0.f, 0.f, 0.f};
    for (int c0 = 0; c0 < n_c; c0 += 64) {
        const bool valid = c0 + lane < n_c;
        float s[4] = {0.f, 0.f, 0.f, 0.f};
        if (valid) {
            const bf16_t* kr = kc + (size_t)(c0 + lane) * 64;
#pragma unroll 2
            for (int c = 0; c < 8; ++c) {
                float kf[8]; load8(kr + c * 8, kf);
#pragma unroll
                for (int h = 0; h < 4; ++h)
#pragma unroll
                    for (int j = 0; j < 8; ++j) s[h] += qs[h * 64 + c * 8 + j] * kf[j];
            }
        }
#pragma unroll
        for (int h = 0; h < 4; ++h) {
            const float sv = valid ? s[h] * 0.125f : -1e30f;
            const float mn = fmaxf(m[h], wave_max(sv));
            const float pv = valid ? __expf(sv - mn) : 0.f;
            l[h] = l[h] * __expf(m[h] - mn) + wave_sum(pv); m[h] = mn;
        }
    }
    for (int c0 = 0; c0 < n_c; c0 += 64) {
        const bool valid = c0 + lane < n_c;
        float s[4] = {0.f, 0.f, 0.f, 0.f};
        if (valid) {
            const bf16_t* kr = kc + (size_t)(c0 + lane) * 64;
#pragma unroll 2
            for (int c = 0; c < 8; ++c) {
                float kf[8]; load8(kr + c * 8, kf);
#pragma unroll
                for (int h = 0; h < 4; ++h)
#pragma unroll
                    for (int j = 0; j < 8; ++j) s[h] += qs[h * 64 + c * 8 + j] * kf[j];
            }
        }
        float psum = 0.f;
#pragma unroll
        for (int h = 0; h < 4; ++h) {
            const float pv = valid ? __expf(s[h] * 0.125f - m[h]) / l[h] : 0.f;
            pl[h * 64 + lane] = pv; psum += pv;
        }
        if (valid) ps[1 + c0 + lane] = psum;
        WSYNC();
        const int nk = min(64, n_c - c0);
        for (int kk = 0; kk < nk; ++kk) {
            const float vv = bf2f(vc[(size_t)(c0 + kk) * 64 + lane]);
#pragma unroll
            for (int h = 0; h < 4; ++h) oc[h] += pl[h * 64 + kk] * vv;
        }
        WSYNC();
    }
}

__device__ __forceinline__ void topk16(float* sc, int* sel, int n_sel, int lane) {
    for (int round = 0; round < 16; ++round) {
        float bv = -3.0e38f; int bi = 0x7fffffff;
        for (int j = lane; j < n_sel; j += 64) { const float v = sc[j]; if (v > bv) { bv = v; bi = j; } }
#pragma unroll
        for (int o = 1; o < 64; o <<= 1) {
            const float ov = __shfl_xor(bv, o); const int oi = __shfl_xor(bi, o);
            if (ov > bv || (ov == bv && oi < bi)) { bv = ov; bi = oi; }
        }
        if (lane == 0) { sel[round] = bi; sc[bi] = -3.4e38f; }
        WSYNC();
    }
}

constexpr int ATT_WLDS = 256 + 256 + 1040 + 272 + 16;
__device__ __forceinline__ void p5_attention(const Params& p, char* lds, int bid, int nblk) {
    const int tid = threadIdx.x, lane = tid & 63, wave = tid >> 6;
    float* wl = (float*)lds + wave * ATT_WLDS;
    float *qs = wl, *pl = wl + 256, *ps = wl + 512, *sc = wl + 1552; int* sel = (int*)(wl + 1824);
    const int gw = bid * 8 + wave, ngw = nblk * 8;
    for (int it = gw; it < R * 2; it += ngw) {
        const int r = it >> 1, g = it & 1;
        const bool isp = r < TP;
        const int b = isp ? (r >> 12) : (r - TP), t = isp ? (r & 4095) : PAST;
        const int n_sel = isp ? 64 : 257;
        const int n_cmax = isp ? 255 : 1023;
#pragma unroll
        for (int h = 0; h < 4; ++h) qs[h * 64 + lane] = bf2f(p.qn[(size_t)r * 512 + (g * 4 + h) * 64 + lane]);
        for (int i = lane; i < 4 * n_sel + 1; i += 64) ps[i] = 0.f;
        WSYNC();
        int n_c = t >= 31 ? (t - 31) / 16 + 1 : 0; if (n_c > n_cmax) n_c = n_cmax;
        float oc[4] = {0.f, 0.f, 0.f, 0.f};
        {
            const bf16_t* kc = isp ? p.kc + (size_t)(b * 2 + g) * 256 * 64 : p.kcs + (size_t)(b * 2 + g) * 1024 * 64;
            const bf16_t* vc = isp ? p.vc + (size_t)(b * 2 + g) * 256 * 64 : p.vcs + (size_t)(b * 2 + g) * 1024 * 64;
            cmp_branch(qs, pl, ps, kc, vc, n_c, lane, oc);
        }
        const int jt = t >> 6;
        for (int j = lane; j < n_sel; j += 64) {
            float imp = 0.f;
#pragma unroll
            for (int rr = 0; rr < 4; ++rr) imp += ps[4 * j + rr + 1] + ps[4 * j + rr];
            const bool valid = j * 64 <= t, forced = (j == 0) || (j == jt) || (j == jt - 1);
            sc[j] = valid ? (forced ? 1e4f : imp) : -1e30f;
        }
        WSYNC();
        topk16(sc, sel, n_sel, lane);
        float ms[4] = {-1e30f, -1e30f, -1e30f, -1e30f}, lsum[4] = {0.f, 0.f, 0.f, 0.f}, os[4] = {0.f, 0.f, 0.f, 0.f};
        for (int k = 0; k < 16; ++k) {
            const int j = sel[k];
            if (j * 64 > t) continue;
            const bool valid = j * 64 + lane <= t;
            if (isp) {
                const size_t base = ((size_t)(b * 2 + g) * SEQ + (size_t)j * 64) * 64;
                attend64<bf16_t>(qs, pl, p.ks + base, p.vs + base, 64, valid, lane, ms, lsum, os);
            } else if (j == 256) {
                attend64<float>(qs, pl, p.s_slc + (size_t)b * 256 + g * 64, p.s_slc + (size_t)b * 256 + 128 + g * 64, 256, valid, lane, ms, lsum, os);
            } else {
                const int pg = p.page_table[b * NPAGES + (j >> 1)];
                const float* base = p.cache_slc + (((size_t)pg * 128 + (j & 1) * 64) * 4 + g) * 64;
                attend64<float>(qs, pl, base, base + 128, 256, valid, lane, ms, lsum, os);
            }
        }
        float mw[4] = {-1e30f, -1e30f, -1e30f, -1e30f}, lw[4] = {0.f, 0.f, 0.f, 0.f}, ow[4] = {0.f, 0.f, 0.f, 0.f};
        if (isp) {
            const int start = t - 511 > 0 ? t - 511 : 0;
            for (int c0 = start; c0 <= t; c0 += 64) {
                const size_t base = ((size_t)(b * 2 + g) * SEQ + c0) * 64;
                attend64<bf16_t>(qs, pl, p.kw + base, p.vw + base, 64, c0 + lane <= t, lane, mw, lw, ow);
            }
        } else {
            for (int c0 = 0; c0 < 512; c0 += 64) {
                const float* base = p.s_win + ((size_t)b * 512 + c0) * 256 + g * 64;
                attend64<float>(qs, pl, base, base + 128, 256, true, lane, mw, lw, ow);
            }
        }
#pragma unroll
        for (int h = 0; h < 4; ++h) {
            const float* gt = p.gates + (size_t)r * 24 + g * 12 + h * 3;
            const float o = gt[0] * oc[h] + gt[1] * (os[h] / lsum[h]) + gt[2] * (ow[h] / lw[h]);
            const int col = (g * 4 + h) * 64 + lane;
            p.yar[(size_t)r * 1024 + col] = f2bf(o * bf2f(p.ga[(size_t)r * 512 + col]));
        }
    }
}


typedef short s16x4 __attribute__((ext_vector_type(4)));
#define ATT_NEG (-__builtin_inff())
constexpr int ATT_KC = 0, ATT_VC = 32768, ATT_KB = 65536, ATT_VB = 98304, ATT_SC = 131072;
constexpr float ATT_CS = 0.125f * 1.44269504088896f;

__device__ __forceinline__ void att_stage(LAS char* dst, const bf16_t* rows, int tid) {
    const int key = tid >> 3, slot = tid & 7;
    __builtin_amdgcn_global_load_lds((const unsigned*)(rows + key * 64 + ((slot ^ (key & 7)) * 8)), (LAS unsigned*)(dst + tid * 16), 16, 0, 0);
}
__device__ __forceinline__ void att_qk(const LAS char* Kb, const bf16x8 (&qf)[2], const int (&koff)[2], f32x4 (&st)[4]) {
#pragma unroll
    for (int tk = 0; tk < 4; ++tk) {
        st[tk] = (f32x4){0.f, 0.f, 0.f, 0.f};
#pragma unroll
        for (int ks = 0; ks < 2; ++ks) {
            const bf16x8 kf = *(const LAS bf16x8*)(Kb + tk * 2048 + koff[ks]);
            st[tk] = __builtin_amdgcn_mfma_f32_16x16x32_bf16(kf, qf[ks], st[tk], 0, 0, 0);
        }
    }
}
template <int O0, int O1>
__device__ __forceinline__ void att_tr8(unsigned a0, unsigned a1, unsigned a2, unsigned a3, s16x4 (&v)[8]) {
    asm volatile(
        "ds_read_b64_tr_b16 %0, %8 offset:%12\n\t"
        "ds_read_b64_tr_b16 %1, %8 offset:%13\n\t"
        "ds_read_b64_tr_b16 %2, %9 offset:%12\n\t"
        "ds_read_b64_tr_b16 %3, %9 offset:%13\n\t"
        "ds_read_b64_tr_b16 %4, %10 offset:%12\n\t"
        "ds_read_b64_tr_b16 %5, %10 offset:%13\n\t"
        "ds_read_b64_tr_b16 %6, %11 offset:%12\n\t"
        "ds_read_b64_tr_b16 %7, %11 offset:%13\n\t"
        "s_waitcnt lgkmcnt(0)"
        : "=&v"(v[0]), "=&v"(v[1]), "=&v"(v[2]), "=&v"(v[3]), "=&v"(v[4]), "=&v"(v[5]), "=&v"(v[6]), "=&v"(v[7])
        : "v"(a0), "v"(a1), "v"(a2), "v"(a3), "i"(O0), "i"(O1) : "memory");
}
__device__ __forceinline__ void att_pv(const LAS char* Vb, const f32x4 (&pt)[4], const int (&voff)[4], f32x4 (&o)[4]) {
    const unsigned vb = (unsigned)(unsigned long long)Vb;
    const unsigned a0 = vb + voff[0], a1 = vb + voff[1], a2 = vb + voff[2], a3 = vb + voff[3];
#pragma unroll
    for (int kst = 0; kst < 2; ++kst) {
        u32x4 pk;
        pk[0] = cvt_pk_bf16(pt[2 * kst][0], pt[2 * kst][1]); pk[1] = cvt_pk_bf16(pt[2 * kst][2], pt[2 * kst][3]);
        pk[2] = cvt_pk_bf16(pt[2 * kst + 1][0], pt[2 * kst + 1][1]); pk[3] = cvt_pk_bf16(pt[2 * kst + 1][2], pt[2 * kst + 1][3]);
        const bf16x8 pf = __builtin_bit_cast(bf16x8, pk);
        s16x4 v[8];
        if (kst == 0) att_tr8<0, 2048>(a0, a1, a2, a3, v); else att_tr8<4096, 6144>(a0, a1, a2, a3, v);
#pragma unroll
        for (int dt = 0; dt < 4; ++dt) {
            const s16x4 x0 = v[2 * dt], x1 = v[2 * dt + 1];
            bf16x8 vf; vf[0] = x0[0]; vf[1] = x0[1]; vf[2] = x0[2]; vf[3] = x0[3]; vf[4] = x1[0]; vf[5] = x1[1]; vf[6] = x1[2]; vf[7] = x1[3];
            o[dt] = __builtin_amdgcn_mfma_f32_16x16x32_bf16(vf, pf, o[dt], 0, 0, 0);
        }
    }
}
__device__ __forceinline__ void att_exp(f32x4 (&st)[4], float nb, float& l) {
    typedef float f32x2 __attribute__((ext_vector_type(2)));
    const f32x2 cs2 = {ATT_CS, ATT_CS}, nb2 = {nb, nb};
    f32x2 ls2 = {0.f, 0.f};
#pragma unroll
    for (int tk = 0; tk < 4; ++tk)
#pragma unroll
        for (int r = 0; r < 4; r += 2) {
            const f32x2 s2 = {st[tk][r], st[tk][r + 1]};
            const f32x2 e2 = __builtin_elementwise_fma(s2, cs2, nb2);
            f32x2 p2; p2.x = __builtin_amdgcn_exp2f(e2.x); p2.y = __builtin_amdgcn_exp2f(e2.y);
            st[tk][r] = p2.x; st[tk][r + 1] = p2.y; ls2 += p2;
        }
    l += ls2.x + ls2.y;
}
__device__ __forceinline__ void att_prompt_unit(const Params& p, char* lds, int b, int g, int qt, unsigned* qctr) {
    LAS char* l3 = (LAS char*)lds;
    const int tid = opaque_tid(), lane = tid & 63, wave = tid >> 6, fr = lane & 15, G = lane >> 4;
    const int qi = fr >> 2, h = fr & 3;
    const int t0 = qt * 32, tq0 = t0 + 4 * wave, t_row = tq0 + qi, jt = t0 >> 6;
    const size_t r = (size_t)b * SEQ + t_row;
    const size_t kvbase = (size_t)(b * 2 + g) * SEQ * 64;
    const float shc = p.attb[0], shs = p.attb[1], shw = p.attb[2];
    int koff[2], voff[4];
#pragma unroll
    for (int ks = 0; ks < 2; ++ks) koff[ks] = fr * 128 + (((ks * 4 + G) ^ (fr & 7)) * 16);
    { const int kq = 4 * G + (fr >> 2);
#pragma unroll
      for (int dt = 0; dt < 4; ++dt) voff[dt] = kq * 128 + (((dt * 2 + ((fr & 3) >> 1)) ^ (kq & 7)) * 16) + (fr & 1) * 8; }
    asm volatile("s_waitcnt lgkmcnt(0)" ::: "memory"); __builtin_amdgcn_s_barrier(); asm volatile("" ::: "memory");
    {
        const bf16_t* kc = p.kc + (size_t)(b * 2 + g) * 256 * 64; const bf16_t* vc = p.vc + (size_t)(b * 2 + g) * 256 * 64;
#pragma unroll
        for (int c = 0; c < 4; ++c) { att_stage(l3 + ATT_KC + c * 8192, kc + c * 4096, tid); att_stage(l3 + ATT_VC + c * 8192, vc + c * 4096, tid); }
    }
    bf16x8 qf[2];
#pragma unroll
    for (int ks = 0; ks < 2; ++ks) qf[ks] = *(const bf16x8*)(p.qn + r * 512 + (g * 4 + h) * 64 + ks * 32 + G * 8);
    const int c_lo = (t0 - 511 > 0 ? t0 - 511 : 0) >> 6;
    const int n_s = jt + 1, n_tot = n_s + (jt - c_lo + 1);
#define ATT_STAGE_CHUNK(idx) do { const int _i = (idx); const bool _w = _i >= n_s; const int _cj = _w ? c_lo + (_i - n_s) : _i; \
        att_stage(l3 + ATT_KB + (_i & 3) * 8192, (_w ? p.kw : p.ks) + kvbase + (size_t)_cj * 4096, tid); \
        att_stage(l3 + ATT_VB + (_i & 3) * 8192, (_w ? p.vw : p.vs) + kvbase + (size_t)_cj * 4096, tid); } while (0)
    ATT_STAGE_CHUNK(0); ATT_STAGE_CHUNK(1);
    if (n_tot > 2) { ATT_STAGE_CHUNK(2); asm volatile("s_waitcnt vmcnt(6)" ::: "memory"); }
    else asm volatile("s_waitcnt vmcnt(4)" ::: "memory");
    asm volatile("s_waitcnt lgkmcnt(0)" ::: "memory"); __builtin_amdgcn_s_barrier(); asm volatile("" ::: "memory");
    f32x4 oc[4];
#pragma unroll
    for (int dt = 0; dt < 4; ++dt) oc[dt] = (f32x4){0.f, 0.f, 0.f, 0.f};
    unsigned long long mymask;
    unsigned long long unionmask;
    {
        f32x4 sr[4][4];
#pragma unroll
        for (int c = 0; c < 4; ++c) att_qk(l3 + ATT_KC + c * 8192, qf, koff, sr[c]);
        const int ncrow = t_row >= 31 ? (t_row - 31) / 16 + 1 : 0;
        float lsum = 0.f;
#pragma unroll
        for (int c = 0; c < 4; ++c)
#pragma unroll
            for (int tk = 0; tk < 4; ++tk)
#pragma unroll
                for (int rg = 0; rg < 4; ++rg) {
                    const int i = c * 64 + tk * 16 + G * 4 + rg;
                    const float pv = i < ncrow ? __builtin_amdgcn_exp2f(sr[c][tk][rg] * ATT_CS - shc) : 0.f;
                    sr[c][tk][rg] = pv; lsum += pv;
                }
        lsum += __shfl_xor(lsum, 16); lsum += __shfl_xor(lsum, 32);
        const float inv = lsum > 0.f ? 1.f / lsum : 0.f;
        float* sc = (float*)(lds + ATT_SC) + wave * 512;
        float* bs = sc + 256;
        float av[4][4];
#pragma unroll
        for (int c = 0; c < 4; ++c)
#pragma unroll
            for (int tk = 0; tk < 4; ++tk) {
#pragma unroll
                for (int rg = 0; rg < 4; ++rg) sr[c][tk][rg] *= inv;
                float a = 2.f * (sr[c][tk][0] + sr[c][tk][1] + sr[c][tk][2]) + sr[c][tk][3], b3 = sr[c][tk][3];
                a += __builtin_bit_cast(float, __builtin_amdgcn_mov_dpp(__builtin_bit_cast(int, a), 0xB1, 0xF, 0xF, true));
                a += __builtin_bit_cast(float, __builtin_amdgcn_mov_dpp(__builtin_bit_cast(int, a), 0x4E, 0xF, 0xF, true));
                b3 += __builtin_bit_cast(float, __builtin_amdgcn_mov_dpp(__builtin_bit_cast(int, b3), 0xB1, 0xF, 0xF, true));
                b3 += __builtin_bit_cast(float, __builtin_amdgcn_mov_dpp(__builtin_bit_cast(int, b3), 0x4E, 0xF, 0xF, true));
                av[c][tk] = a;
                if (h == 0) bs[qi * 64 + (c * 4 + tk) * 4 + G] = b3;
            }
        WSYNC();
#pragma unroll
        for (int c = 0; c < 4; ++c)
#pragma unroll
            for (int tk = 0; tk < 4; ++tk) {
                const int j = (c * 4 + tk) * 4 + G;
                const float pr = j > 0 ? bs[qi * 64 + j - 1] : 0.f;
                const bool valid = j * 64 <= t_row, forced = (j == 0) || (j == jt) || (j == jt - 1);
                if (h == 0) sc[qi * 64 + j] = valid ? (forced ? 1e4f : av[c][tk] + pr) : -1e30f;
            }
#pragma unroll
        for (int c = 0; c < 4; ++c) att_pv(l3 + ATT_VC + c * 8192, sr[c], voff, oc);
        WSYNC();
        unsigned long long mq[4];
        {
            float sj[4]; int rank[4] = {0, 0, 0, 0};
#pragma unroll
            for (int q = 0; q < 4; ++q) sj[q] = sc[q * 64 + lane];
#pragma unroll 2
            for (int jp = 0; jp <= jt; ++jp) {
                const bool lower = jp < lane;
#pragma unroll
                for (int q = 0; q < 4; ++q) {
                    const float v = __builtin_bit_cast(float, __builtin_amdgcn_readlane(__builtin_bit_cast(int, sj[q]), jp));
                    rank[q] += (v > sj[q] || (v == sj[q] && lower)) ? 1 : 0;
                }
            }
#pragma unroll
            for (int q = 0; q < 4; ++q) mq[q] = __ballot(rank[q] < 16 && lane * 64 <= tq0 + q);
        }
        unionmask = mq[0] | mq[1] | mq[2] | mq[3];
        mymask = qi == 0 ? mq[0] : qi == 1 ? mq[1] : qi == 2 ? mq[2] : mq[3];
        WSYNC();
    }
    f32x4 os[4], ow[4];
#pragma unroll
    for (int dt = 0; dt < 4; ++dt) { os[dt] = (f32x4){0.f, 0.f, 0.f, 0.f}; ow[dt] = (f32x4){0.f, 0.f, 0.f, 0.f}; }
    float ls = 0.f, lw = 0.f;
    for (int it = 0; it < n_tot; ++it) {
        if (it + 2 < n_tot) asm volatile("s_waitcnt vmcnt(4)" ::: "memory");
        else if (it + 1 < n_tot) asm volatile("s_waitcnt vmcnt(2)" ::: "memory");
        else asm volatile("s_waitcnt vmcnt(0)" ::: "memory");
        asm volatile("s_waitcnt lgkmcnt(0)" ::: "memory"); __builtin_amdgcn_s_barrier(); asm volatile("" ::: "memory");
        if (it + 3 < n_tot) ATT_STAGE_CHUNK(it + 3);
        const LAS char* Kb = l3 + ATT_KB + (it & 3) * 8192; const LAS char* Vb = l3 + ATT_VB + (it & 3) * 8192;
        if (it < n_s) {
            const int j = it;
            if ((unionmask >> j) & 1ull) {
                f32x4 st[4];
                att_qk(Kb, qf, koff, st);
                const float nb = ((mymask >> j) & 1ull) ? -shs : ATT_NEG;
                if (j == jt) {
                    asm volatile("" ::: "memory");
#pragma unroll
                    for (int tk = 0; tk < 4; ++tk)
#pragma unroll
                        for (int rg = 0; rg < 4; ++rg) { const int pos = j * 64 + tk * 16 + G * 4 + rg; if (pos > t_row) st[tk][rg] = ATT_NEG; }
                }
                att_exp(st, nb, ls);
                att_pv(Vb, st, voff, os);
            }
        } else {
            const int cj = c_lo + (it - n_s);
            f32x4 st[4];
            att_qk(Kb, qf, koff, st);
            if (cj * 64 + 63 > tq0 || cj * 64 <= tq0 + 3 - 512) {
                asm volatile("" ::: "memory");
#pragma unroll
                for (int tk = 0; tk < 4; ++tk)
#pragma unroll
                    for (int rg = 0; rg < 4; ++rg) { const int pos = cj * 64 + tk * 16 + G * 4 + rg; if (!(pos <= t_row && pos > t_row - 512)) st[tk][rg] = ATT_NEG; }
            }
            att_exp(st, -shw, lw);
            att_pv(Vb, st, voff, ow);
        }
    }
#undef ATT_STAGE_CHUNK
    int nxt = 0;
    if (tid == 0) nxt = (int)__hip_atomic_fetch_add(qctr, 1u, __ATOMIC_RELAXED, __HIP_MEMORY_SCOPE_AGENT);
    ls += __shfl_xor(ls, 16); ls += __shfl_xor(ls, 32);
    lw += __shfl_xor(lw, 16); lw += __shfl_xor(lw, 32);
    const float* gt = p.gates + r * 24 + g * 12 + h * 3;
    const float g0 = gt[0], g1 = gt[1] / ls, g2 = gt[2] / lw;
    const int colb = (g * 4 + h) * 64;
    uint2 gavv[4];
#pragma unroll
    for (int dt = 0; dt < 4; ++dt) gavv[dt] = *(const uint2*)(p.ga + r * 512 + colb + dt * 16 + G * 4);
#pragma unroll
    for (int dt = 0; dt < 4; ++dt) {
        const int d = dt * 16 + G * 4;
        const uint2 gav = gavv[dt];
        float v[4];
#pragma unroll
        for (int rg = 0; rg < 4; ++rg) v[rg] = g0 * oc[dt][rg] + g1 * os[dt][rg] + g2 * ow[dt][rg];
        v[0] *= __uint_as_float(gav.x << 16); v[1] *= __uint_as_float(gav.x & 0xffff0000u);
        v[2] *= __uint_as_float(gav.y << 16); v[3] *= __uint_as_float(gav.y & 0xffff0000u);
        uint2 o; o.x = cvt_pk_bf16(v[0], v[1]); o.y = cvt_pk_bf16(v[2], v[3]);
        *(uint2*)(p.yar + r * 1024 + colb + d) = o;
    }
    if (tid == 0) *(volatile int*)(lds + 147456 + 16) = nxt;
}

__device__ __forceinline__ void dot4(const float* qs, const bf16_t* kr, float (&s)[4]) {
    uint4 raw[8];
#pragma unroll
    for (int c = 0; c < 8; ++c) raw[c] = *(const uint4*)(kr + c * 8);
#pragma unroll
    for (int c = 0; c < 8; ++c) {
        float kf[8];
        kf[0] = __uint_as_float(raw[c].x << 16); kf[1] = __uint_as_float(raw[c].x & 0xffff0000u); kf[2] = __uint_as_float(raw[c].y << 16); kf[3] = __uint_as_float(raw[c].y & 0xffff0000u);
        kf[4] = __uint_as_float(raw[c].z << 16); kf[5] = __uint_as_float(raw[c].z & 0xffff0000u); kf[6] = __uint_as_float(raw[c].w << 16); kf[7] = __uint_as_float(raw[c].w & 0xffff0000u);
#pragma unroll
        for (int hh = 0; hh < 4; ++hh)
#pragma unroll
            for (int j = 0; j < 8; ++j) s[hh] += qs[hh * 64 + c * 8 + j] * kf[j];
    }
}
__device__ __forceinline__ void att_sample_unit(const Params& p, char* lds, int b, int g) {
    const int tid = opaque_tid(), lane = tid & 63, wave = tid >> 6;
    float* L = (float*)lds;
    float* qs = L;
    float* ps = L + 256;
    float* sc = L + 1296;
    int* sel = (int*)(L + 1568);
    float* red = L + 1600;
    float* part = L + 1664;
    float* pl = L + 1664 + 8 * 3 * 4 * 66 + wave * 256;
    const size_t r = TP + b;
    __syncthreads();
    if (tid < 256) qs[tid] = bf2f(p.qn[r * 512 + g * 256 + tid]);
    for (int i = tid; i < 1040; i += NT) ps[i] = 0.f;
    __syncthreads();
    const bf16_t* kc = p.kcs + (size_t)(b * 2 + g) * 1024 * 64; const bf16_t* vc = p.vcs + (size_t)(b * 2 + g) * 1024 * 64;
    const int n_c = 1023;
    float m1[4] = {-1e30f, -1e30f, -1e30f, -1e30f}, l1[4] = {0.f, 0.f, 0.f, 0.f};
    for (int cc = 0; cc < 2; ++cc) {
        const int i = wave * 128 + cc * 64 + lane; const bool valid = i < n_c;
        float s[4] = {0.f, 0.f, 0.f, 0.f};
        if (valid) dot4(qs, kc + (size_t)i * 64, s);
#pragma unroll
        for (int hh = 0; hh < 4; ++hh) {
            const float sv = valid ? s[hh] * 0.125f : -1e30f;
            const float mn = fmaxf(m1[hh], wave_max(sv));
            l1[hh] = l1[hh] * __expf(m1[hh] - mn) + wave_sum(valid ? __expf(sv - mn) : 0.f); m1[hh] = mn;
        }
    }
    if (lane == 0) {
#pragma unroll
        for (int hh = 0; hh < 4; ++hh) { red[wave * 8 + hh] = m1[hh]; red[wave * 8 + 4 + hh] = l1[hh]; }
    }
    __syncthreads();
    float M[4], Ls[4];
#pragma unroll
    for (int hh = 0; hh < 4; ++hh) {
        float mm = -1e30f;
        for (int w = 0; w < 8; ++w) mm = fmaxf(mm, red[w * 8 + hh]);
        float ll = 0.f;
        for (int w = 0; w < 8; ++w) ll += red[w * 8 + 4 + hh] * __expf(red[w * 8 + hh] - mm);
        M[hh] = mm; Ls[hh] = ll;
    }
    float oc[4] = {0.f, 0.f, 0.f, 0.f};
    for (int cc = 0; cc < 2; ++cc) {
        const int i0 = wave * 128 + cc * 64, i = i0 + lane; const bool valid = i < n_c;
        float s[4] = {0.f, 0.f, 0.f, 0.f};
        if (valid) dot4(qs, kc + (size_t)i * 64, s);
        float psum = 0.f;
#pragma unroll
        for (int hh = 0; hh < 4; ++hh) { const float pv = valid ? __expf(s[hh] * 0.125f - M[hh]) / Ls[hh] : 0.f; pl[hh * 64 + lane] = pv; psum += pv; }
        if (valid) ps[1 + i] = psum;
        WSYNC();
        const int nk = min(64, n_c - i0);
#pragma unroll 64
        for (int kk = 0; kk < 64; ++kk) {
            const float vv = bf2f(vc[(size_t)(i0 + (kk < nk ? kk : 0)) * 64 + lane]);
#pragma unroll
            for (int hh = 0; hh < 4; ++hh) oc[hh] += pl[hh * 64 + kk] * vv;
        }
        WSYNC();
    }
    __syncthreads();
    if (tid < 257) {
        const int t = PAST, jt = t >> 6, j = tid;
        float imp = 0.f;
#pragma unroll
        for (int rr = 0; rr < 4; ++rr) imp += ps[4 * j + rr + 1] + ps[4 * j + rr];
        const bool valid = j * 64 <= t, forced = (j == 0) || (j == jt) || (j == jt - 1);
        sc[j] = valid ? (forced ? 1e4f : imp) : -1e30f;
    }
    __syncthreads();
    if (tid < 257) {
        const float v = sc[tid];
        int rank = 0;
#pragma unroll 8
        for (int i = 0; i < 257; ++i) { const float u = sc[i]; rank += (u > v || (u == v && i < tid)) ? 1 : 0; }
        if (rank < 16) sel[rank] = tid;
    }
    __syncthreads();
    float msv[4] = {-1e30f, -1e30f, -1e30f, -1e30f}, lsv[4] = {0.f, 0.f, 0.f, 0.f}, osv[4] = {0.f, 0.f, 0.f, 0.f};
    for (int k = 2 * wave; k < 2 * wave + 2; ++k) {
        const int j = sel[k];
        if (j * 64 > PAST) continue;
        const bool valid = j * 64 + lane <= PAST;
        if (j == 256) attend64<float>(qs, pl, p.s_slc + (size_t)b * 256 + g * 64, p.s_slc + (size_t)b * 256 + 128 + g * 64, 256, valid, lane, msv, lsv, osv);
        else {
            const int pg = p.page_table[b * NPAGES + (j >> 1)];
            const float* base = p.cache_slc + (((size_t)pg * 128 + (j & 1) * 64) * 4 + g) * 64;
            attend64<float>(qs, pl, base, base + 128, 256, valid, lane, msv, lsv, osv);
        }
    }
    float mwv[4] = {-1e30f, -1e30f, -1e30f, -1e30f}, lwv[4] = {0.f, 0.f, 0.f, 0.f}, owv[4] = {0.f, 0.f, 0.f, 0.f};
    {
        const float* base = p.s_win + ((size_t)b * 512 + wave * 64) * 256 + g * 64;
        attend64<float>(qs, pl, base, base + 128, 256, true, lane, mwv, lwv, owv);
    }
#pragma unroll
    for (int hh = 0; hh < 4; ++hh) {
        float* pc = part + ((wave * 3 + 0) * 4 + hh) * 66; pc[lane] = oc[hh];
        float* pS = part + ((wave * 3 + 1) * 4 + hh) * 66; pS[lane] = osv[hh]; if (lane == 0) { pS[64] = msv[hh]; pS[65] = lsv[hh]; }
        float* pw = part + ((wave * 3 + 2) * 4 + hh) * 66; pw[lane] = owv[hh]; if (lane == 0) { pw[64] = mwv[hh]; pw[65] = lwv[hh]; }
    }
    __syncthreads();
    if (tid < 256) {
        const int hh = tid >> 6, d = tid & 63;
        float c = 0.f;
        for (int w = 0; w < 8; ++w) c += part[((w * 3 + 0) * 4 + hh) * 66 + d];
        float res[2];
#pragma unroll
        for (int br = 1; br < 3; ++br) {
            float mm = -1e30f;
            for (int w = 0; w < 8; ++w) mm = fmaxf(mm, part[((w * 3 + br) * 4 + hh) * 66 + 64]);
            float num = 0.f, den = 0.f;
            for (int w = 0; w < 8; ++w) { const float* q = part + ((w * 3 + br) * 4 + hh) * 66; const float e = __expf(q[64] - mm); num += q[d] * e; den += q[65] * e; }
            res[br - 1] = num / den;
        }
        const float* gt = p.gates + r * 24 + g * 12 + hh * 3;
        const int col = (g * 4 + hh) * 64 + d;
        p.yar[r * 1024 + col] = f2bf((gt[0] * c + gt[1] * res[0] + gt[2] * res[1]) * bf2f(p.ga[r * 512 + col]));
    }
    __syncthreads();
}

__device__ __forceinline__ void ret_out_item(const Params& p, char* lds, int it, unsigned* qctr);
__device__ __forceinline__ void att_phase(const Params& p, char* lds, int bid, int nblk) {
    const int x = bid & 7;
    unsigned* ctr = p.bar + 3584 + 64 * x;
    volatile int* slot = (volatile int*)(lds + 147456 + 16);
    const int tid = opaque_tid();
    bool pulled = false;
    for (;;) {
        __syncthreads();
        if (!pulled && tid == 0) *slot = (int)__hip_atomic_fetch_add(ctr, 1u, __ATOMIC_RELAXED, __HIP_MEMORY_SCOPE_AGENT);
        __syncthreads();
        const int w = *slot;
        if (w >= 136) break;
        if (w < 8) { att_sample_unit(p, lds, 4 * x + (w >> 1), w & 1); pulled = false; }
        else { att_prompt_unit(p, lds, x >> 1, x & 1, 127 - (w - 8), ctr); pulled = true; }
    }
}
__device__ __forceinline__ void ret_out_queue(const Params& p, char* lds, int bid, int nblk) {
    const int x = bid & 7;
    unsigned* ctr = p.bar + 3584 + 64 * x + 16;
    volatile int* slot = (volatile int*)(lds + 147456 + 16);
    const int tid = opaque_tid();
    wg_wait(p.bar + 3456, (unsigned)nblk, p.bar + XB_TMO);
    bool pulled = false;
    for (;;) {
        __syncthreads();
        if (!pulled && tid == 0) *slot = (int)__hip_atomic_fetch_add(ctr, 1u, __ATOMIC_RELAXED, __HIP_MEMORY_SCOPE_AGENT);
        __syncthreads();
        const int w = *slot;
        if (w >= 80) break;
        ret_out_item(p, lds, x + 8 * w, ctr); pulled = true;
    }
}

__device__ __forceinline__ float ret_gamma(int h) { return 1.f - exp2f(-5.f - (float)h); }

__device__ __forceinline__ void p6a_local(const Params& p, int bid, int nblk) {
    const int tid = opaque_tid();
    const int e = tid & 127, dg = tid >> 7;
    for (int it = bid; it < 4 * 4 * 32; it += nblk) {
        const int n = it & 31, h = (it >> 5) & 3, b = it >> 7;
        const float lg = __logf(ret_gamma(h));
        float acc[16];
#pragma unroll
        for (int i = 0; i < 16; ++i) acc[i] = 0.f;
        for (int j = 0; j < 128; ++j) {
            const size_t r = (size_t)b * SEQ + n * 128 + j;
            const float z = __expf(lg * (float)(127 - j));
            const float v = bf2f(p.rv[r * 512 + h * 128 + e]) * z;
            const bf16_t* kr = p.rk + r * 256 + h * 64 + dg * 16;
#pragma unroll
            for (int i = 0; i < 16; ++i) acc[i] += bf2f(kr[i]) * v;
        }
        float* out = p.sloc + ((size_t)it * 64 + dg * 16) * 128 + e;
#pragma unroll
        for (int i = 0; i < 16; ++i) out[i * 128] = acc[i];
    }
}
__device__ __forceinline__ void p6b_scan(const Params& p, int bid, int nblk) {
    const size_t gt = (size_t)bid * NT + threadIdx.x, ngt = (size_t)nblk * NT;
    for (size_t i = gt; i < (size_t)16 * 8192; i += ngt) {
        const int bh = (int)(i >> 13), el = (int)(i & 8191), h = bh & 3;
        const float gc = __expf(__logf(ret_gamma(h)) * 128.f);
        float S = 0.f, lv[32];
#pragma unroll
        for (int n = 0; n < 32; ++n) lv[n] = p.sloc[((size_t)bh * 32 + n) * 8192 + el];
#pragma unroll
        for (int n = 0; n < 32; ++n) {
            p.spre[((size_t)bh * 32 + n) * 8192 + el] = S;
            S = S * gc + lv[n];
        }
        p.p_ret[(size_t)bh * 8192 + el] = S;
    }
    {
        constexpr int NS = 128 * 8192;
        const int gti = (int)gt, ngti = (int)ngt;
#define SR_LD(j) const int sx##j = ib + j * ngti, sc##j = sx##j < NS ? sx##j : NS - 1, bh##j = sc##j >> 13, el##j = sc##j & 8191; const float st##j = p.state_ret[sc##j]; \
        const bf16_t kk##j = p.rk[(size_t)(TP + (bh##j >> 2)) * 256 + (bh##j & 3) * 64 + (el##j >> 7)], vv##j = p.rv[(size_t)(TP + (bh##j >> 2)) * 512 + (bh##j & 3) * 128 + (el##j & 127)];
#define SR_ST(j) if (sx##j < NS) p.s_ret[sx##j] = st##j * ret_gamma(bh##j & 3) + bf2f(kk##j) * bf2f(vv##j);
        for (int ib = gti; ib < NS; ib += 8 * ngti) {
            SR_LD(0) SR_LD(1) SR_LD(2) SR_LD(3) SR_LD(4) SR_LD(5) SR_LD(6) SR_LD(7)
            SR_ST(0) SR_ST(1) SR_ST(2) SR_ST(3) SR_ST(4) SR_ST(5) SR_ST(6) SR_ST(7)
        }
#undef SR_LD
#undef SR_ST
    }
}
__device__ __forceinline__ void p6c_out(const Params& p, char* lds, int bid, int nblk) {
    float* Am = (float*)lds;
    const int tid = opaque_tid();
    for (int it = bid; it < 4 * 4 * 32 + 128; it += nblk) {
        if (it < 512) {
            const int n = it & 31, h = (it >> 5) & 3, b = it >> 7;
            const float lg = __logf(ret_gamma(h));
            const size_t r0 = (size_t)b * SEQ + n * 128;
            for (int idx = tid; idx < 128 * 128; idx += NT) {
                const int i = idx >> 7, j = idx & 127;
                float a = 0.f;
                if (j <= i) {
                    const bf16_t* qr = p.rq + (r0 + i) * 256 + h * 64; const bf16_t* kr = p.rk + (r0 + j) * 256 + h * 64;
#pragma unroll
                    for (int c = 0; c < 8; ++c) { float qf[8], kf[8]; load8(qr + c * 8, qf); load8(kr + c * 8, kf);
#pragma unroll
                        for (int u = 0; u < 8; ++u) a += qf[u] * kf[u]; }
                    a *= __expf(lg * (float)(i - j));
                }
                Am[i * 129 + j] = a;
            }
            __syncthreads();
            const int e = tid & 127, ig = tid >> 7;
            const float* S = p.spre + (size_t)it * 8192;
            for (int i = ig * 32; i < ig * 32 + 32; ++i) {
                float o = 0.f;
                for (int j = 0; j <= i; ++j) o += Am[i * 129 + j] * bf2f(p.rv[(r0 + j) * 512 + h * 128 + e]);
                float qs = 0.f;
                const bf16_t* qr = p.rq + (r0 + i) * 256 + h * 64;
                for (int d = 0; d < 64; ++d) qs += bf2f(qr[d]) * S[d * 128 + e];
                o += qs * __expf(lg * (float)(i + 1));
                p.oret[(r0 + i) * 512 + h * 128 + e] = o;
            }
            __syncthreads();
        } else {
            const int bh = it - 512, h = bh & 3, b = bh >> 2;
            const size_t r = TP + b;
            if (tid < 128) {
                const int e = tid;
                const bf16_t* qr = p.rq + r * 256 + h * 64; const bf16_t* kr = p.rk + r * 256 + h * 64;
                const float* S0 = p.state_ret + (size_t)bh * 8192;
                float qs = 0.f, qk = 0.f;
                for (int d = 0; d < 64; ++d) { const float q = bf2f(qr[d]); qs += q * S0[d * 128 + e]; qk += q * bf2f(kr[d]); }
                p.oret[r * 512 + h * 128 + e] = qs * ret_gamma(h) + qk * bf2f(p.rv[r * 512 + h * 128 + e]);
            }
        }
    }
}
__device__ __forceinline__ void p6d_norm(const Params& p, int bid, int nblk) {
    const int tid = opaque_tid(), lane = tid & 63, wave = tid >> 6;
    for (int it = bid * 8 + wave; it < R * 4; it += nblk * 8) {
        const int r = it >> 2, h = it & 3;
        const float* o = p.oret + (size_t)r * 512 + h * 128;
        const float v0 = o[lane], v1 = o[lane + 64];
        const float rs = rsqrtf(wave_sum(v0 * v0 + v1 * v1) * (1.f / 128.f) + EPS);
        p.yar[(size_t)r * 1024 + 512 + h * 128 + lane] = f2bf(v0 * rs * p.g_ret[lane] * bf2f(p.gr[(size_t)r * 512 + h * 128 + lane]));
        p.yar[(size_t)r * 1024 + 512 + h * 128 + lane + 64] = f2bf(v1 * rs * p.g_ret[lane + 64] * bf2f(p.gr[(size_t)r * 512 + h * 128 + lane + 64]));
    }
}


__device__ __forceinline__ void ret_stage(LAS char* dst, const bf16_t* src, size_t row_stride, int lg_slots, int npieces, int tid) {
    for (int pc = tid; pc < npieces; pc += NT) {
        const int row = pc >> lg_slots, slot = pc & ((1 << lg_slots) - 1);
        __builtin_amdgcn_global_load_lds((const unsigned*)(src + (size_t)row * row_stride + ((slot ^ (row & 7)) * 8)), (LAS unsigned*)(dst + pc * 16), 16, 0, 0);
    }
}
__device__ __forceinline__ s16x4 ret_tr(const LAS char* img, int RB, int r0, int c0, int fr) {
    const int row = r0 + (fr >> 2), chunk = (c0 >> 3) + ((fr & 3) >> 1);
    return __builtin_amdgcn_ds_read_tr16_b64_v4i16((LAS s16x4*)(img + row * RB + ((chunk ^ (row & 7)) * 16) + (fr & 1) * 8));
}
__device__ __forceinline__ bf16x8 cat8(s16x4 a, s16x4 b) { bf16x8 v; v[0] = a[0]; v[1] = a[1]; v[2] = a[2]; v[3] = a[3]; v[4] = b[0]; v[5] = b[1]; v[6] = b[2]; v[7] = b[3]; return v; }

__device__ __forceinline__ void ret_local_item(const Params& p, char* lds, int it) {
    LAS char* l3 = (LAS char*)lds;
    const int tid = opaque_tid(), lane = tid & 63, wave = tid >> 6, fr = lane & 15, G = lane >> 4;
    {
        const int n = it & 31, h = (it >> 5) & 3, b = it >> 7;
        const size_t r0 = (size_t)b * SEQ + n * 128;
        __syncthreads();
        ret_stage(l3, p.rk + r0 * 256 + h * 64, 256, 3, 1024, tid);
        ret_stage(l3 + 16384, p.rv + r0 * 512 + h * 128, 512, 4, 2048, tid);
        asm volatile("s_waitcnt vmcnt(0)" ::: "memory");
        __syncthreads();
        f32x4 acc[4];
#pragma unroll
        for (int dt = 0; dt < 4; ++dt) acc[dt] = (f32x4){0.f, 0.f, 0.f, 0.f};
#pragma unroll
        for (int js = 0; js < 4; ++js) {
            const int j0 = js * 32 + 4 * G;
            const bf16x8 bfr = cat8(ret_tr(l3 + 16384, 256, j0, wave * 16, fr), ret_tr(l3 + 16384, 256, j0 + 16, wave * 16, fr));
#pragma unroll
            for (int dt = 0; dt < 4; ++dt) {
                const bf16x8 afr = cat8(ret_tr(l3, 128, j0, dt * 16, fr), ret_tr(l3, 128, j0 + 16, dt * 16, fr));
                acc[dt] = __builtin_amdgcn_mfma_f32_16x16x32_bf16(afr, bfr, acc[dt], 0, 0, 0);
            }
        }
        const float sc = exp2f(__log2f(ret_gamma(h)) * 127.f);
        float* out = p.sloc + (size_t)it * 8192 + wave * 16 + fr;
#pragma unroll
        for (int dt = 0; dt < 4; ++dt)
#pragma unroll
            for (int rg = 0; rg < 4; ++rg) out[(dt * 16 + 4 * G + rg) * 128] = acc[dt][rg] * sc;
    }
}

__device__ __forceinline__ void ret_out_item(const Params& p, char* lds, int it, unsigned* qctr) {
    LAS char* l3 = (LAS char*)lds;
    const int tid = opaque_tid(), lane = tid & 63, wave = tid >> 6, fr = lane & 15, G = lane >> 4;
    int nxt = 0;
    {
        __syncthreads();
        if (it < 512) {
            const int n = it & 31, h = (it >> 5) & 3, b = it >> 7;
            const size_t r0 = (size_t)b * SEQ + n * 128;
            const float gam = ret_gamma(h);
            ret_stage(l3, p.rk + r0 * 256 + h * 64, 256, 3, 1024, tid);
            ret_stage(l3 + 16384, p.rv + r0 * 512 + h * 128, 512, 4, 2048, tid);
            {
                const float* S = p.spre + (size_t)it * 8192;
                for (int pc = tid; pc < 1024; pc += NT) {
                    const int row = pc >> 4, slot = pc & 15;
                    const float4 a = *(const float4*)(S + row * 128 + slot * 8), c = *(const float4*)(S + row * 128 + slot * 8 + 4);
                    u32x4 v; v[0] = cvt_pk_bf16(a.x * gam, a.y * gam); v[1] = cvt_pk_bf16(a.z * gam, a.w * gam); v[2] = cvt_pk_bf16(c.x * gam, c.y * gam); v[3] = cvt_pk_bf16(c.z * gam, c.w * gam);
                    *(LAS u32x4*)(l3 + 49152 + row * 256 + ((slot ^ (row & 7)) * 16)) = v;
                }
            }
            const size_t ri = r0 + wave * 16 + fr;
            bf16x8 qf[2], qp[2];
#pragma unroll
            for (int ks = 0; ks < 2; ++ks) {
                const bf16_t* qrow = p.rq + ri * 256 + h * 64 + ks * 32;
                qf[ks] = *(const bf16x8*)(qrow + G * 8);
                const s16x4 lo = *(const s16x4*)(qrow + 4 * G), hi = *(const s16x4*)(qrow + 16 + 4 * G);
                qp[ks] = cat8(lo, hi);
            }
            asm volatile("s_waitcnt vmcnt(0)" ::: "memory");
            __syncthreads();
            f32x4 st[8];
#pragma unroll
            for (int jt = 0; jt < 8; ++jt) {
                st[jt] = (f32x4){0.f, 0.f, 0.f, 0.f};
                if (jt <= wave) {
#pragma unroll
                    for (int ks = 0; ks < 2; ++ks) {
                        const int row = jt * 16 + fr;
                        const bf16x8 kf = *(const LAS bf16x8*)(l3 + row * 128 + (((ks * 4 + G) ^ (row & 7)) * 16));
                        st[jt] = __builtin_amdgcn_mfma_f32_16x16x32_bf16(kf, qf[ks], st[jt], 0, 0, 0);
                    }
                    if (jt == wave) {
#pragma unroll
                        for (int rg = 0; rg < 4; ++rg) if (4 * G + rg > fr) st[jt][rg] = 0.f;
                    }
                }
            }
            f32x4 o[8];
#pragma unroll
            for (int et = 0; et < 8; ++et) o[et] = (f32x4){0.f, 0.f, 0.f, 0.f};
#pragma unroll
            for (int js = 0; js < 4; ++js) {
                if (2 * js <= wave) {
                    u32x4 pk;
                    pk[0] = cvt_pk_bf16(st[2 * js][0], st[2 * js][1]); pk[1] = cvt_pk_bf16(st[2 * js][2], st[2 * js][3]);
                    pk[2] = cvt_pk_bf16(st[2 * js + 1][0], st[2 * js + 1][1]); pk[3] = cvt_pk_bf16(st[2 * js + 1][2], st[2 * js + 1][3]);
                    const bf16x8 pf = __builtin_bit_cast(bf16x8, pk);
                    const int j0 = js * 32 + 4 * G;
#pragma unroll
                    for (int et = 0; et < 8; ++et) {
                        const bf16x8 vf = cat8(ret_tr(l3 + 16384, 256, j0, et * 16, fr), ret_tr(l3 + 16384, 256, j0 + 16, et * 16, fr));
                        o[et] = __builtin_amdgcn_mfma_f32_16x16x32_bf16(vf, pf, o[et], 0, 0, 0);
                    }
                }
            }
#pragma unroll
            for (int ks = 0; ks < 2; ++ks) {
                const int d0 = ks * 32 + 4 * G;
#pragma unroll
                for (int et = 0; et < 8; ++et) {
                    const bf16x8 sf = cat8(ret_tr(l3 + 49152, 256, d0, et * 16, fr), ret_tr(l3 + 49152, 256, d0 + 16, et * 16, fr));
                    o[et] = __builtin_amdgcn_mfma_f32_16x16x32_bf16(sf, qp[ks], o[et], 0, 0, 0);
                }
            }
            if (tid == 0) nxt = (int)__hip_atomic_fetch_add(qctr, 1u, __ATOMIC_RELAXED, __HIP_MEMORY_SCOPE_AGENT);
            float ss = 0.f;
#pragma unroll
            for (int et = 0; et < 8; ++et)
#pragma unroll
                for (int rg = 0; rg < 4; ++rg) ss += o[et][rg] * o[et][rg];
            ss += __shfl_xor(ss, 16); ss += __shfl_xor(ss, 32);
            const float rs = rsqrtf(ss * (1.f / 128.f) + EPS);
            float4 grv[8]; uint2 gvv[8];
#pragma unroll
            for (int et = 0; et < 8; ++et) { const int e = et * 16 + 4 * G; grv[et] = *(const float4*)(p.g_ret + e); gvv[et] = *(const uint2*)(p.gr + ri * 512 + h * 128 + e); }
#pragma unroll
            for (int et = 0; et < 8; ++et) {
                const int e = et * 16 + 4 * G;
                const float4 gr = grv[et];
                const uint2 gv = gvv[et];
                uint2 ov;
                ov.x = cvt_pk_bf16(o[et][0] * rs * gr.x * __uint_as_float(gv.x << 16), o[et][1] * rs * gr.y * __uint_as_float(gv.x & 0xffff0000u));
                ov.y = cvt_pk_bf16(o[et][2] * rs * gr.z * __uint_as_float(gv.y << 16), o[et][3] * rs * gr.w * __uint_as_float(gv.y & 0xffff0000u));
                *(uint2*)(p.yar + ri * 1024 + 512 + h * 128 + e) = ov;
            }
        } else {
            const int bh = it - 512, h = bh & 3, b = bh >> 2;
            const size_t r = TP + b;
            if (tid == 0) nxt = (int)__hip_atomic_fetch_add(qctr, 1u, __ATOMIC_RELAXED, __HIP_MEMORY_SCOPE_AGENT);
            float* red = (float*)lds;
            float o = 0.f;
            if (tid < 128) {
                const int e = tid;
                const bf16_t* qr = p.rq + r * 256 + h * 64; const bf16_t* kr = p.rk + r * 256 + h * 64;
                const float* S0 = p.state_ret + (size_t)bh * 8192;
                float qs = 0.f, qk = 0.f;
                for (int d = 0; d < 64; ++d) { const float q = bf2f(qr[d]); qs += q * S0[d * 128 + e]; qk += q * bf2f(kr[d]); }
                o = qs * ret_gamma(h) + qk * bf2f(p.rv[r * 512 + h * 128 + e]);
                const float s2 = wave_sum(o * o);
                if (lane == 0) red[wave] = s2;
            }
            __syncthreads();
            if (tid < 128) {
                const float rs = rsqrtf((red[0] + red[1]) * (1.f / 128.f) + EPS);
                p.yar[r * 1024 + 512 + h * 128 + tid] = f2bf(o * rs * p.g_ret[tid] * bf2f(p.gr[r * 512 + h * 128 + tid]));
            }
        }
    }
    if (tid == 0) *(volatile int*)(lds + 147456 + 16) = nxt;
}

__device__ __forceinline__ void out_sample(const Params& p, char* lds, int bid, int nblk) {
    const int tid = opaque_tid(), lane = tid & 63, wave = tid >> 6, fr = lane & 15, G = lane >> 4;
    f32x4* part = (f32x4*)lds;
    for (int it = bid; it < 128; it += nblk) {
        const int mt = it >> 6, nt = it & 63;
        const bf16_t* arow = p.yar + (size_t)(TP + mt * 16 + fr) * 1024 + wave * 128 + G * 8;
        const bf16_t* brow = p.bt_out + (size_t)(nt * 16 + fr) * 1024 + wave * 128 + G * 8;
        bf16x8 a[4], b[4];
#pragma unroll
        for (int ks = 0; ks < 4; ++ks) { a[ks] = *(const bf16x8*)(arow + ks * 32); b[ks] = *(const bf16x8*)(brow + ks * 32); }
        const int c = nt * 16 + fr;
        float xv[4], gv[4];
        if (wave == 0) {
#pragma unroll
            for (int rg = 0; rg < 4; ++rg) { const int sb = mt * 16 + 4 * G + rg; xv[rg] = p.x_sample[(size_t)sb * 1024 + c]; gv[rg] = p.mod[(4 + sb) * 3072 + 2048 + c]; }
        }
        f32x4 acc = {0.f, 0.f, 0.f, 0.f};
#pragma unroll
        for (int ks = 0; ks < 4; ++ks) acc = __builtin_amdgcn_mfma_f32_16x16x32_bf16(a[ks], b[ks], acc, 0, 0, 0);
        __syncthreads();
        part[wave * 64 + lane] = acc;
        __syncthreads();
        if (wave == 0) {
            f32x4 tot = part[lane];
#pragma unroll
            for (int w = 1; w < 8; ++w) tot += part[w * 64 + lane];
#pragma unroll
            for (int rg = 0; rg < 4; ++rg) {
                const int sb = mt * 16 + 4 * G + rg;
                p.y[(size_t)(TP + sb) * 1024 + c] = xv[rg] + gv[rg] * tot[rg];
            }
        }
    }
}
__global__ void __launch_bounds__(NT, 2) k_mega(Params p) {
    extern __shared__ __attribute__((aligned(16))) char lds[];
    const int bid = blockIdx.x, nblk = gridDim.x;
    uint4* xbw = (uint4*)(lds + 147456);
    if (threadIdx.x == 0) *xbw = make_uint4(0u, 0u, 0u, 0u);
    __syncthreads();
    XcdBarrier bar = xcd_barrier_post(p.bar, (volatile LAS unsigned*)xbw);
    p0_w1p(p, bid, nblk); wg_signal(p.bar + 3536, true);
    p0_adaln(p, lds, bid, nblk); __syncthreads(); p0_weights(p, lds, bid, nblk); __syncthreads();
    wg_wait(p.bar + 3536, (unsigned)nblk, p.bar + XB_TMO);
    compress_sample(p, lds, bid, nblk);
    wg_wait(p.bar + 3520, 192u, p.bar + XB_TMO);
    p1_norm(p, lds, bid, nblk);
    xcd_barrier(bar);
    { EpiIn e{&p}; gemm_phase(p.H, p.bt_in, RPAD / 256, NPAD / 256, 1024, lds, bid, nblk, e); }
    if (nblk == 256) compress_seams(p, bid - 142, 114); else compress_seams(p, bid, nblk);
    xcd_barrier(bar);
    {
        volatile int* slot = (volatile int*)(lds + 147456 + 16);
        for (;;) {
            __syncthreads();
            if (threadIdx.x == 0) *slot = (int)__hip_atomic_fetch_add(p.bar + 3456 + 48, 1u, __ATOMIC_RELAXED, __HIP_MEMORY_SCOPE_AGENT);
            __syncthreads();
            const int w = *slot;
            if (w >= 136 + 512) break;
            if (w < 136) compress_prompt_ksplit_item(p, lds, w); else ret_local_item(p, lds, w - 136);
        }
    }
    xcd_barrier(bar);
    p6b_scan(p, bid, nblk); wg_signal(p.bar + 3456, true);
    att_phase(p, lds, bid, nblk);
    ret_out_queue(p, lds, bid, nblk);
    xcd_barrier(bar);
    { EpiOut e{&p}; gemm_phase(p.yar, p.bt_out, TP / 256, 4, 1024, lds, bid, nblk, e); }
    out_sample(p, lds, bid, nblk);
}
}

extern "C" void kernel_launch(void* const* d_in, const int* in_sizes, int n_in, void* d_out, int out_size, void* d_ws, size_t ws_size, hipStream_t stream) {
    Params p{};
    p.x_prompt = (const float*)d_in[0]; p.x_sample = (const float*)d_in[1]; p.c_prompt = (const float*)d_in[2]; p.c_sample = (const float*)d_in[3];
    p.cache_cmp = (const float*)d_in[4]; p.cache_slc = (const float*)d_in[5]; p.state_win = (const float*)d_in[6]; p.state_ret = (const float*)d_in[7];
    p.page_table = (const int*)d_in[8];
    p.g_norm = (const float*)d_in[9]; p.w_ada = (const float*)d_in[10]; p.b_ada = (const float*)d_in[11]; p.w_in = (const float*)d_in[12];
    p.g_q = (const float*)d_in[13]; p.g_kc = (const float*)d_in[14]; p.g_ks = (const float*)d_in[15]; p.g_kw = (const float*)d_in[16];
    p.pe_ck = (const float*)d_in[17]; p.w_ck1 = (const float*)d_in[18]; p.w_ck2 = (const float*)d_in[19];
    p.pe_cv = (const float*)d_in[20]; p.w_cv1 = (const float*)d_in[21]; p.w_cv2 = (const float*)d_in[22];
    p.g_ret = (const float*)d_in[23]; p.w_out = (const float*)d_in[24];
    float* o = (float*)d_out;
    p.y = o; o += (size_t)R * 1024;
    p.p_cmp = o; o += (size_t)TP * 256; p.p_slc = o; o += (size_t)TP * 256; p.p_win = o; o += (size_t)4 * 512 * 256; p.p_ret = o; o += (size_t)16 * 8192;
    p.s_cmp = o; o += 32 * 256; p.s_slc = o; o += 32 * 256; p.s_win = o; o += (size_t)32 * 512 * 256; p.s_ret = o; o += (size_t)128 * 8192;
    char* w = (char*)d_ws; size_t off = 0;
    auto take = [&](size_t bytes) { char* q = w + off; off += (bytes + 255) & ~(size_t)255; return q; };
    p.bar = (unsigned*)take(16384);
    p.mod = (float*)take(36 * 3072 * 4);
    p.bt_in = (bf16_t*)take((size_t)NPAD * 1024 * 2);
    p.bt_out = (bf16_t*)take((size_t)1024 * 1024 * 2);
    p.H = (bf16_t*)take((size_t)RPAD * 1024 * 2);
    p.praw = (float*)take((size_t)RPAD * NPAD * 4);
    p.qn = (bf16_t*)take((size_t)R * 512 * 2);
    p.kcr = (bf16_t*)take((size_t)TP * 128 * 2); p.vcr = (bf16_t*)take((size_t)TP * 128 * 2);
    p.ks = (bf16_t*)take((size_t)TP * 128 * 2); p.vs = (bf16_t*)take((size_t)TP * 128 * 2);
    p.kw = (bf16_t*)take((size_t)TP * 128 * 2); p.vw = (bf16_t*)take((size_t)TP * 128 * 2);
    p.gates = (float*)take((size_t)R * 24 * 4);
    p.ga = (bf16_t*)take((size_t)R * 512 * 2); p.gr = (bf16_t*)take((size_t)R * 512 * 2);
    p.rq = (bf16_t*)take((size_t)R * 256 * 2); p.rk = (bf16_t*)take((size_t)R * 256 * 2); p.rv = (bf16_t*)take((size_t)R * 512 * 2);
    p.kc = (bf16_t*)take((size_t)4 * 2 * 256 * 64 * 2); p.vc = (bf16_t*)take((size_t)4 * 2 * 256 * 64 * 2);
    p.kcs = (bf16_t*)take((size_t)32 * 2 * 1024 * 64 * 2); p.vcs = (bf16_t*)take((size_t)32 * 2 * 1024 * 64 * 2);
    p.yar = (bf16_t*)take((size_t)RPAD * 1024 * 2);
    p.sloc = (float*)take((size_t)512 * 8192 * 4); p.spre = (float*)take((size_t)512 * 8192 * 4);
    p.oret = (float*)take((size_t)R * 512 * 4);
    p.w1p = (bf16_t*)take((size_t)2 * 128 * 1024 * 2); p.w2t = (bf16_t*)take((size_t)2 * 64 * 64 * 2); p.b1 = (float*)take(128 * 4);
    p.attb = (float*)take(256);
    p.ropec = (float*)take((size_t)4097 * 32 * 4); p.ropes = (float*)take((size_t)4097 * 32 * 4);
    p.seamA = (float*)take((size_t)32 * 2 * 64 * 2 * 64 * 4); p.seamB = (float*)take((size_t)32 * 2 * 64 * 2 * 64 * 4);
    if (off > ws_size) { fprintf(stderr, "workspace too small: need %zu have %zu\n", off, ws_size); return; }
    static int grid = 0;
    if (grid == 0) {
        int dev = 0, cus = 0, per_cu = 0;
        if (hipGetDevice(&dev) != hipSuccess || hipDeviceGetAttribute(&cus, hipDeviceAttributeMultiprocessorCount, dev) != hipSuccess) { fprintf(stderr, "device query failed\n"); grid = -1; return; }
        if (hipFuncSetAttribute((const void*)k_mega, hipFuncAttributeMaxDynamicSharedMemorySize, LDS_BYTES) != hipSuccess) { fprintf(stderr, "hipFuncSetAttribute failed\n"); grid = -1; return; }
        if (hipOccupancyMaxActiveBlocksPerMultiprocessor(&per_cu, (const void*)k_mega, NT, LDS_BYTES) != hipSuccess || per_cu < 1) { fprintf(stderr, "occupancy query: %d blocks per CU\n", per_cu); grid = -1; return; }
        (void)hipGetLastError();
        grid = cus;
    }
    if (grid < 0) return;
    (void)hipMemsetAsync(p.bar, 0, 16384, stream);
    hipLaunchKernelGGL(k_mega, dim3(grid), dim3(NT), LDS_BYTES, stream, p);
}
```
